# Optimizing an MI355X kernel written in HIP

```python
import jax, jax.numpy as jnp
from jax import lax
import numpy as np

D_MODEL = 2048
BATCH = 16
SEQ = 2048
DEPTH = 1

HEAD_DIM = 128
A_HEADS = D_MODEL // (2 * HEAD_DIM)
A_WIDTH = A_HEADS * HEAD_DIM
DILATED_PAIRS = ((128, 1), (512, 4), (2048, 16))
BLK = 128
ROPE_THETA = 500000.0
A_ROT_DIM = HEAD_DIM // 4

B_HEADS = D_MODEL // (2 * HEAD_DIM)
MLA_Q_RANK = D_MODEL // 4
MLA_KV_RANK = D_MODEL // 4
MLA_NOPE = 128
MLA_ROPE = 64
MLA_V = 128
B_WIDTH = B_HEADS * MLA_V

MIX_WIDTH = A_WIDTH + B_WIDTH
IN_SPLITS = [A_WIDTH, 2 * A_WIDTH, 3 * A_WIDTH, 3 * A_WIDTH + MLA_Q_RANK,
             3 * A_WIDTH + MLA_Q_RANK + MLA_KV_RANK]
IN_COLS = 3 * A_WIDTH + MLA_Q_RANK + MLA_KV_RANK + MLA_ROPE

PEER_HEADS = 8
PEER_N_KEYS = 128
PEER_N_EXPERTS = PEER_N_KEYS ** 2
PEER_TOPK = 16
PEER_KEY_DIM = 256
PEER_CHUNK = 128

DN_ALPHA = (2 * DEPTH) ** 0.25
DN_BETA = (8 * DEPTH) ** -0.25

kernel_name = 'hybrid_dilated_mla_peer_block'


def layer_norm(x, g=None, b=None, eps=1e-5):
    xf = x.astype(jnp.float32)
    mu = xf.mean(-1, keepdims=True)
    var = jnp.square(xf - mu).mean(-1, keepdims=True)
    y = (xf - mu) * lax.rsqrt(var + eps)
    if g is not None:
        y = y * g.astype(jnp.float32) + b.astype(jnp.float32)
    return y.astype(x.dtype)


def rms_norm(x, g, eps=1e-6):
    xf = x.astype(jnp.float32)
    y = xf * lax.rsqrt(jnp.mean(xf * xf, -1, keepdims=True) + eps) * g.astype(jnp.float32)
    return y.astype(x.dtype)


def rope(x, pos, rot_dim):
    half = rot_dim // 2
    inv = ROPE_THETA ** (-jnp.arange(half, dtype=jnp.float32) * 2.0 / rot_dim)
    ang = pos[:, None] * inv[None, :]
    cos = jnp.cos(ang)[:, None, :]
    sin = jnp.sin(ang)[:, None, :]
    xf = x.astype(jnp.float32)
    x1 = xf[..., :half]
    x2 = xf[..., half:rot_dim]
    out = jnp.concatenate([x1 * cos - x2 * sin, x2 * cos + x1 * sin, xf[..., rot_dim:]], -1)
    return out.astype(x.dtype)


def dilated_window_attn(q, k, v, n_back, dil):
    B, S, H, E = q.shape
    L = S // dil
    nb = -(-L // BLK)
    Lp = nb * BLK

    def blocks(t):
        t = t.reshape(B, L, dil, H, E)
        t = jnp.pad(t, ((0, 0), (0, Lp - L), (0, 0), (0, 0), (0, 0)))
        return t.reshape(B, nb, BLK, dil, H, E)

    def with_prev(t):
        prev = jnp.pad(t, ((0, 0), (1, 0), (0, 0), (0, 0), (0, 0), (0, 0)))[:, :-1]
        return jnp.concatenate([prev, t], axis=2)

    qb = blocks(q)
    kk = with_prev(blocks(k))
    vv = with_prev(blocks(v))
    s = jnp.einsum('bnqrhe,bnkrhe->bnrhqk', qb, kk).astype(jnp.float32) * (E ** -0.5)
    qpos = jnp.arange(nb)[:, None] * BLK + jnp.arange(BLK)[None, :]
    kpos = jnp.arange(nb)[:, None] * BLK - BLK + jnp.arange(2 * BLK)[None, :]
    dist = qpos[:, :, None] - kpos[:, None, :]
    valid = (dist >= 0) & (dist <= n_back) & (kpos[:, None, :] >= 0)
    s = jnp.where(valid[None, :, None, None], s, -jnp.inf)
    m = s.max(-1, keepdims=True)
    p = jnp.exp(s - m)
    l = p.sum(-1, keepdims=True)
    o = jnp.einsum('bnrhqk,bnkrhe->bnqrhe', p.astype(vv.dtype), vv).astype(jnp.float32)
    l_t = jnp.moveaxis(l[..., 0], -1, 2)
    lse = jnp.moveaxis((m + jnp.log(l))[..., 0], -1, 2)
    o = o / l_t[..., None]
    o = o.reshape(B, Lp, dil, H, E)[:, :L].reshape(B, S, H, E)
    lse = lse.reshape(B, Lp, dil, H)[:, :L].reshape(B, S, H)
    return o, lse


def dilated_mixture(q, k, v):
    outs, lses = [], []
    for window, dil in DILATED_PAIRS:
        o, lse = dilated_window_attn(q, k, v, window // dil, dil)
        outs.append(o)
        lses.append(lse)
    wts = jax.nn.softmax(jnp.stack(lses, 0), axis=0)
    o = jnp.sum(wts[..., None] * jnp.stack(outs, 0), axis=0)
    return o.astype(q.dtype)


def mla_attention(q_nope, q_rope, k_nope, k_rope, v):
    B, S, H, _ = q_nope.shape
    nq = S // BLK
    scale = (MLA_NOPE + MLA_ROPE) ** -0.5
    kpos = jnp.arange(S)

    def to_blocks(t):
        return jnp.moveaxis(t.reshape(B, nq, BLK, *t.shape[2:]), 1, 0)

    def one_block(args):
        qn, qr, start = args
        s = (jnp.einsum('bqhe,bkhe->bhqk', qn, k_nope).astype(jnp.float32)
             + jnp.einsum('bqhr,bkr->bhqk', qr, k_rope).astype(jnp.float32)) * scale
        qpos = start + jnp.arange(BLK)
        s = jnp.where(kpos[None, :] <= qpos[:, None], s, -jnp.inf)
        p = jax.nn.softmax(s, axis=-1).astype(v.dtype)
        return jnp.einsum('bhqk,bkhe->bqhe', p, v)

    out = lax.map(one_block, (to_blocks(q_nope), to_blocks(q_rope), jnp.arange(nq) * BLK))
    return jnp.moveaxis(out, 0, 1).reshape(B, S, H, MLA_V)


def token_mix(h, pos, w_in, g_q_lat, g_kv_lat, w_uq, w_uk, w_uv, g_out_a, g_out_b, w_o):
    B, S, _ = h.shape
    proj = jnp.dot(h, w_in)
    qa, ka, va, cq, ckv, kr = jnp.split(proj, IN_SPLITS, axis=-1)
    qa = rope(qa.reshape(B, S, A_HEADS, HEAD_DIM), pos, A_ROT_DIM)
    ka = rope(ka.reshape(B, S, A_HEADS, HEAD_DIM), pos, A_ROT_DIM)
    va = va.reshape(B, S, A_HEADS, HEAD_DIM)
    o_a = dilated_mixture(qa, ka, va)
    cq = rms_norm(cq, g_q_lat)
    ckv = rms_norm(ckv, g_kv_lat)
    qb = jnp.dot(cq, w_uq).reshape(B, S, B_HEADS, MLA_NOPE + MLA_ROPE)
    q_nope = qb[..., :MLA_NOPE]
    q_rope = rope(qb[..., MLA_NOPE:], pos, MLA_ROPE)
    k_nope = jnp.dot(ckv, w_uk).reshape(B, S, B_HEADS, MLA_NOPE)
    v_b = jnp.dot(ckv, w_uv).reshape(B, S, B_HEADS, MLA_V)
    k_rope = rope(kr[:, :, None, :], pos, MLA_ROPE)[:, :, 0, :]
    o_b = mla_attention(q_nope, q_rope, k_nope, k_rope, v_b)
    o = jnp.concatenate([rms_norm(o_a.reshape(B, S, A_WIDTH), g_out_a),
                         rms_norm(o_b.reshape(B, S, B_WIDTH), g_out_b)], axis=-1)
    return jnp.dot(o, w_o)


def peer(h, w_pq, sub_key_1, sub_key_2, u_table, v_table):
    B, S, D = h.shape
    q = jnp.dot(h, w_pq).reshape(B, S, PEER_HEADS, 2, PEER_KEY_DIM // 2)
    s1 = jnp.einsum('bshe,ke->bshk', q[..., 0, :], sub_key_1).astype(jnp.float32)
    s2 = jnp.einsum('bshe,ke->bshk', q[..., 1, :], sub_key_2).astype(jnp.float32)
    v1, i1 = lax.top_k(s1, PEER_TOPK)
    v2, i2 = lax.top_k(s2, PEER_TOPK)
    cand = (v1[..., :, None] + v2[..., None, :]).reshape(B, S, PEER_HEADS, PEER_TOPK * PEER_TOPK)
    vals, ci = lax.top_k(cand, PEER_TOPK)
    idx = (jnp.take_along_axis(i1, ci // PEER_TOPK, -1) * PEER_N_KEYS
           + jnp.take_along_axis(i2, ci % PEER_TOPK, -1))
    g = jax.nn.softmax(vals, axis=-1)
    nc = (B * S) // PEER_CHUNK
    kk = PEER_HEADS * PEER_TOPK
    hc = h.reshape(nc, PEER_CHUNK, D)
    idc = idx.reshape(nc, PEER_CHUNK, kk)
    gc = g.reshape(nc, PEER_CHUNK, kk).astype(h.dtype)

    def chunk(args):
        ht, it, gt = args
        u = u_table[it]
        a = jnp.einsum('td,tkd->tk', ht, u)
        w = jax.nn.gelu(a.astype(jnp.float32), approximate=False).astype(ht.dtype) * gt
        return jnp.einsum('tk,tkd->td', w, v_table[it])

    return lax.map(chunk, (hc, idc, gc)).reshape(B, S, D)


def setup_inputs(seed: int = 0) -> dict:
    key = jax.random.key(seed)
    ks = jax.random.split(key, 24)

    def nrm(k, shape, s):
        return jax.random.normal(k, shape, jnp.float32) * s

    col_scale = jnp.ones((IN_COLS,), jnp.float32).at[2 * A_WIDTH:3 * A_WIDTH].set(DN_BETA)
    return {
        'x': nrm(ks[0], (BATCH, SEQ, D_MODEL), 1.0),
        'c': nrm(ks[1], (BATCH, D_MODEL), 1.0),
        'w_ada': nrm(ks[2], (DEPTH, D_MODEL, 6 * D_MODEL), 0.5 * D_MODEL ** -0.5),
        'b_ada': nrm(ks[3], (DEPTH, 6 * D_MODEL), 0.02),
        'w_in': nrm(ks[4], (DEPTH, D_MODEL, IN_COLS), D_MODEL ** -0.5) * col_scale,
        'g_q_lat': 1.0 + nrm(ks[5], (DEPTH, MLA_Q_RANK), 0.02),
        'g_kv_lat': 1.0 + nrm(ks[6], (DEPTH, MLA_KV_RANK), 0.02),
        'w_uq': nrm(ks[7], (DEPTH, MLA_Q_RANK, B_HEADS * (MLA_NOPE + MLA_ROPE)), MLA_Q_RANK ** -0.5),
        'w_uk': nrm(ks[8], (DEPTH, MLA_KV_RANK, B_HEADS * MLA_NOPE), MLA_KV_RANK ** -0.5),
        'w_uv': nrm(ks[9], (DEPTH, MLA_KV_RANK, B_HEADS * MLA_V), MLA_KV_RANK ** -0.5 * DN_BETA),
        'g_out_a': 1.0 + nrm(ks[10], (DEPTH, A_WIDTH), 0.02),
        'g_out_b': 1.0 + nrm(ks[11], (DEPTH, B_WIDTH), 0.02),
        'w_o': nrm(ks[12], (DEPTH, MIX_WIDTH, D_MODEL), MIX_WIDTH ** -0.5 * DN_BETA),
        'ln1_g': 1.0 + nrm(ks[13], (DEPTH, D_MODEL), 0.02),
        'ln1_b': nrm(ks[14], (DEPTH, D_MODEL), 0.02),
        'w_pq': nrm(ks[15], (DEPTH, D_MODEL, PEER_HEADS * PEER_KEY_DIM), D_MODEL ** -0.5),
        'sub_key_1': nrm(ks[16], (DEPTH, PEER_N_KEYS, PEER_KEY_DIM // 2), (PEER_KEY_DIM // 2) ** -0.5),
        'sub_key_2': nrm(ks[17], (DEPTH, PEER_N_KEYS, PEER_KEY_DIM // 2), (PEER_KEY_DIM // 2) ** -0.5),
        'u_table': nrm(ks[18], (DEPTH, PEER_N_EXPERTS, D_MODEL), D_MODEL ** -0.5),
        'v_table': nrm(ks[19], (DEPTH, PEER_N_EXPERTS, D_MODEL), DN_BETA),
        'ln2_g': 1.0 + nrm(ks[20], (DEPTH, D_MODEL), 0.02),
        'ln2_b': nrm(ks[21], (DEPTH, D_MODEL), 0.02),
    }


def reference(x, c, w_ada, b_ada, w_in, g_q_lat, g_kv_lat, w_uq, w_uk, w_uv, g_out_a, g_out_b,
              w_o, ln1_g, ln1_b, w_pq, sub_key_1, sub_key_2, u_table, v_table, ln2_g, ln2_b):
    S = x.shape[1]
    pos = jnp.arange(S, dtype=jnp.float32)
    c_act = jax.nn.silu(c)
    for l in range(DEPTH):
        mod = jnp.dot(c_act, w_ada[l]) + b_ada[l]
        sh1, sc1, g1, sh2, sc2, g2 = [m[:, None, :] for m in jnp.split(mod, 6, axis=-1)]
        h = layer_norm(x) * (1.0 + sc1) + sh1
        mix = token_mix(h, pos, w_in[l], g_q_lat[l], g_kv_lat[l], w_uq[l], w_uk[l], w_uv[l],
                        g_out_a[l], g_out_b[l], w_o[l])
        x = layer_norm(DN_ALPHA * x + g1 * mix, ln1_g[l], ln1_b[l])
        h = layer_norm(x) * (1.0 + sc2) + sh2
        ffn = peer(h, w_pq[l], sub_key_1[l], sub_key_2[l], u_table[l], v_table[l])
        x = layer_norm(DN_ALPHA * x + g2 * ffn, ln2_g[l], ln2_b[l])
    return x
```

```cpp
#include <hip/hip_runtime.h>
#include <hip/hip_cooperative_groups.h>
#include <cstdio>
#include <cstdint>
namespace cg = cooperative_groups;

#ifndef MK_N_LAUNCHES
#define MK_N_LAUNCHES 1
#ifndef REP_MASK
#define REP_MASK 0
#endif
#define DBG_MIX 1.0f
#define DBG_FFN 1.0f
#endif

#define LAS __attribute__((address_space(3)))
typedef unsigned short bf16_t;
typedef short bf16x8 __attribute__((ext_vector_type(8)));
typedef short s16x4 __attribute__((ext_vector_type(4)));
typedef float f32x2 __attribute__((ext_vector_type(2)));
typedef float f32x4 __attribute__((ext_vector_type(4)));
typedef float f32x16 __attribute__((ext_vector_type(16)));
typedef unsigned u32x2 __attribute__((ext_vector_type(2)));
typedef unsigned u32x4 __attribute__((ext_vector_type(4)));
typedef __bf16 bf16x2_t __attribute__((ext_vector_type(2)));

constexpr int NB = 16, SEQ = 2048, DM = 2048, T = NB * SEQ;
constexpr int NPROJ = 4160, NPROJ_PAD = 4352;
constexpr float DN_ALPHA = 1.189207115002721f;
constexpr int NE = 16384;

constexpr size_t MiB = 1u << 20;
constexpr size_t WS_MOD = 1 * MiB;
constexpr size_t WS_ROPEA = 2 * MiB;
constexpr size_t WS_ROPEB = 2 * MiB + 256 * 1024;
constexpr size_t WS_SSQ_Q = 3 * MiB;
constexpr size_t WS_SSQ_KV = 4 * MiB;
constexpr size_t WS_SSQ_O = 5 * MiB;
constexpr size_t WS_SM = 7 * MiB;
constexpr size_t WS_SL = 8 * MiB;
constexpr size_t WS_K1 = 9 * MiB;
constexpr size_t WS_K2 = 9 * MiB + 32768;
constexpr size_t WS_WIN = 10 * MiB;
constexpr size_t WS_WUQ = 27 * MiB;
constexpr size_t WS_WUKV = 29 * MiB;
constexpr size_t WS_WO = 31 * MiB;
constexpr size_t WS_WPQ = 39 * MiB;
constexpr size_t WS_UT = 64 * MiB;
constexpr size_t WS_VT = 128 * MiB;
constexpr size_t WS_A = 192 * MiB;
constexpr size_t WS_QA = 320 * MiB, WS_KA = 384 * MiB, WS_VA = 448 * MiB, WS_CQ = 512 * MiB, WS_CKV = 544 * MiB, WS_KR = 576 * MiB;
constexpr size_t WS_Y = 320 * MiB;
constexpr size_t WS_QN = 580 * MiB, WS_QR = 644 * MiB, WS_KN = 676 * MiB, WS_VB = 740 * MiB;
constexpr size_t WS_H2 = 580 * MiB;
constexpr size_t WS_O = 804 * MiB;
constexpr size_t WS_IDX = 932 * MiB;
constexpr size_t WS_G = 940 * MiB;
constexpr size_t WS_END = 972 * MiB;
constexpr size_t WS_SU = 9 * MiB + 65536;
constexpr size_t WS_SH = 9 * MiB + 196608;
constexpr size_t WS_U8 = 64 * MiB;
constexpr size_t WS_V8 = 96 * MiB;
constexpr size_t WS_PART = 320 * MiB;
constexpr size_t WS_H8 = 804 * MiB;
constexpr size_t WS_IDX2 = 932 * MiB;
constexpr size_t WS_WT = 956 * MiB;
constexpr size_t WS_H2S = 128 * MiB;
constexpr size_t WS_X1 = 804 * MiB;
constexpr size_t WS_FFN = 192 * MiB;

constexpr int NWAVES = 8;
constexpr int LDS_BYTES = 147456;

__device__ __forceinline__ int opaque(int v) { asm volatile("" : "+v"(v)); return v; }
__device__ __forceinline__ unsigned cvtpk(float lo, float hi) { f32x2 v = {lo, hi}; bf16x2_t b = __builtin_convertvector(v, bf16x2_t); return __builtin_bit_cast(unsigned, b); }
__device__ __forceinline__ float dot2bf(unsigned a, unsigned b, float c) { return __builtin_amdgcn_fdot2_f32_bf16(__builtin_bit_cast(bf16x2_t, a), __builtin_bit_cast(bf16x2_t, b), c, false); }
__device__ __forceinline__ void fmac(float& d, float a, float b) { asm("v_fmac_f32_e32 %0, %1, %2" : "+v"(d) : "v"(a), "v"(b)); }
__device__ __forceinline__ float bf_lo(unsigned u) { return __uint_as_float(u << 16); }
__device__ __forceinline__ float bf_hi(unsigned u) { return __uint_as_float(u & 0xffff0000u); }
#define DPPF(v, ctrl) __builtin_bit_cast(float, __builtin_amdgcn_update_dpp(0, __builtin_bit_cast(int, (v)), (ctrl), 0xf, 0xf, false))
#define RLF(v, l) __builtin_bit_cast(float, __builtin_amdgcn_readlane(__builtin_bit_cast(int, (v)), (l)))
__device__ __forceinline__ float wsum(float v) {
    v += DPPF(v, 0xB1); v += DPPF(v, 0x4E); v += DPPF(v, 0x141); v += DPPF(v, 0x140);
    return (RLF(v, 0) + RLF(v, 16)) + (RLF(v, 32) + RLF(v, 48));
}
__device__ __forceinline__ float wmax(float v) {
    v = fmaxf(v, DPPF(v, 0xB1)); v = fmaxf(v, DPPF(v, 0x4E)); v = fmaxf(v, DPPF(v, 0x141)); v = fmaxf(v, DPPF(v, 0x140));
    return fmaxf(fmaxf(RLF(v, 0), RLF(v, 16)), fmaxf(RLF(v, 32), RLF(v, 48)));
}
__device__ __forceinline__ float wave_max(float v) {
#pragma unroll
    for (int o = 1; o < 64; o <<= 1) v = fmaxf(v, __shfl_xor(v, o));
    return v;
}
__device__ __forceinline__ unsigned pack_fp8x4(float a, float b, float c, float d) {
    int w = __builtin_amdgcn_cvt_pk_fp8_f32(a, b, 0, false); w = __builtin_amdgcn_cvt_pk_fp8_f32(c, d, w, true); return (unsigned)w;
}
__device__ __forceinline__ unsigned pack_i8x4(float a, float b, float c, float d) {
    const int ia = (int)__builtin_rintf(a), ib = (int)__builtin_rintf(b), ic = (int)__builtin_rintf(c), id = (int)__builtin_rintf(d);
    return ((unsigned)ia & 255u) | (((unsigned)ib & 255u) << 8) | (((unsigned)ic & 255u) << 16) | ((unsigned)id << 24);
}
__device__ __forceinline__ float wave_sum(float v) {
#pragma unroll
    for (int o = 1; o < 64; o <<= 1) v += __shfl_xor(v, o);
    return v;
}

namespace pg8 {
constexpr int BM = 256, BK = 64, HALF = 128, HTB = HALF * BK * 2, STAGE_BYTES = 8 * HTB, NXCD = 8, WGM = 8;
__host__ __device__ __forceinline__ int lds_byte(int r, int c) { const int st = (r >> 4) * 2 + (c >> 5), rr = r & 15, cc = c & 31, ob = rr * 64 + cc * 2; return st * 1024 + (ob ^ (((ob >> 9) & 1) << 5)); }
__host__ __device__ __forceinline__ void stage_rc(int b, int& R, int& C) { const int st = b / 1024, sb = b % 1024, swz = sb ^ (((sb >> 9) & 1) << 5); R = (st >> 1) * 16 + swz / 64; C = (st & 1) * 32 + (swz % 64) / 2; }
__host__ __device__ __forceinline__ int perm32(int rho) { const int n = rho >> 4, i = rho & 15; return 8 * (i >> 2) + 4 * n + (i & 3); }

struct Unit { int pm, pn; };
struct Gemm { const bf16_t* A; const bf16_t* Bt; int M, N, K; };

struct StaticOrder {
    int nM, nN, nwg, G, c;
    __host__ __device__ __forceinline__ void init(int M, int N, int G_, int c_) { nM = M / BM; nN = N / BM; nwg = nM * nN; G = G_; c = c_; }
    __host__ __device__ __forceinline__ bool next(int i, Unit& u) const {
        const long L = (long)i * G + c; if (L >= nwg) return false;
        int wgid = (int)L; { const int q = nwg / NXCD, r = nwg % NXCD, xcd = wgid % NXCD, off = wgid / NXCD; wgid = (xcd < r ? xcd * (q + 1) : r * (q + 1) + (xcd - r) * q) + off; }
        const int nig = WGM * nN, gid = wgid / nig, fm = gid * WGM, gsz = (nM - fm) < WGM ? (nM - fm) : WGM;
        u.pm = fm + ((wgid % nig) % gsz); u.pn = (wgid % nig) / gsz; return true;
    }
};

template <class Epi, class Sched>
__device__ __forceinline__ void gemm_phase(const int tid, LAS unsigned char* lds, const Gemm g, const Sched& S, const Epi& E) {
    const int wid = __builtin_amdgcn_readfirstlane(tid >> 6), lane = tid & 63, wr = wid >> 2, wc = wid & 3, fr = lane & 15, fq = lane >> 4;
    const int K = g.K, nt = K / BK;
    unsigned voffA[2], voffB[2];
#pragma unroll
    for (int i = 0; i < 2; ++i) { int R, C; stage_rc(tid * 16 + i * 8192, R, C); const int Rb = Epi::PERM ? ((R & ~31) + perm32(R & 31)) : R;
        voffA[i] = (unsigned)(R * K + C) * 2u; voffB[i] = (unsigned)(Rb * K + C) * 2u; }
    const size_t kstep = (size_t)(BK * 2);
    const size_t hstep = (size_t)HALF * K * 2;
    const size_t tstep = 2 * hstep;
    const unsigned ldsw = (unsigned)wid * 1024u;
    const int aoff = lds_byte(wr * 64 + fr, fq * 8), boff = lds_byte(wc * 32 + fr, fq * 8);
#define PG8_SA(b, h) (((b) * 2 + (h)) * HTB)
#define PG8_SB(b, h) ((4 + (b) * 2 + (h)) * HTB)
#define PG8_STAGE(bufoff, gbase, voff) do { _Pragma("unroll") for (int _i = 0; _i < 2; ++_i) \
        __builtin_amdgcn_global_load_lds((const unsigned*)((const char*)(gbase) + (voff)[_i]), (LAS unsigned*)(lds + (bufoff) + ldsw + _i * 8192), 16, 0, 0); } while (0)
#define PG8_LDA(dst, b, h) do { _Pragma("unroll") for (int m = 0; m < 4; ++m) _Pragma("unroll") for (int k = 0; k < 2; ++k) dst[m][k] = *(const LAS bf16x8*)(lds + PG8_SA(b, h) + aoff + m * 2048 + k * 1024); } while (0)
#define PG8_LDB(dst, b, h) do { _Pragma("unroll") for (int n = 0; n < 2; ++n) _Pragma("unroll") for (int k = 0; k < 2; ++k) dst[n][k] = *(const LAS bf16x8*)(lds + PG8_SB(b, h) + boff + n * 2048 + k * 1024); } while (0)
#define PG8_MMA(ai, bj, At, Bt) do { __builtin_amdgcn_s_setprio(1); _Pragma("unroll") for (int m = 0; m < 4; ++m) _Pragma("unroll") for (int n = 0; n < 2; ++n) _Pragma("unroll") for (int k = 0; k < 2; ++k) \
        acc[ai][bj][m][n] = __builtin_amdgcn_mfma_f32_16x16x32_bf16(Bt[n][k], At[m][k], acc[ai][bj][m][n], 0, 0, 0); __builtin_amdgcn_s_setprio(0); } while (0)
#define PG8_WAIT_V(n) asm volatile("s_waitcnt vmcnt(" #n ")" ::: "memory")
#define PG8_WAIT_L(n) asm volatile("s_waitcnt lgkmcnt(" #n ")" ::: "memory")
#define PG8_BAR __builtin_amdgcn_s_barrier()
#define PG8_SCHED __builtin_amdgcn_sched_barrier(0)
    Unit cur, nxt; int ui = 0;
    if (!S.next(0, cur)) return;
    f32x4 acc[2][2][4][2];
#pragma unroll
    for (int a = 0; a < 2; ++a)
#pragma unroll
        for (int b = 0; b < 2; ++b)
#pragma unroll
            for (int m = 0; m < 4; ++m)
#pragma unroll
                for (int n = 0; n < 2; ++n) acc[a][b][m][n] = (f32x4){0.f, 0.f, 0.f, 0.f};
    bf16x8 At[4][2], B0[2][2], B1[2][2];
    const char* cA = (const char*)g.A + (size_t)cur.pm * tstep; const char* cB = (const char*)g.Bt + (size_t)cur.pn * tstep;
    PG8_STAGE(PG8_SB(0, 0), cB, voffB); PG8_STAGE(PG8_SB(0, 1), cB + hstep, voffB); PG8_STAGE(PG8_SA(0, 0), cA, voffA); PG8_STAGE(PG8_SA(0, 1), cA + hstep, voffA);
    if (wr == 1) PG8_BAR;
    PG8_WAIT_V(2); PG8_BAR;
    PG8_STAGE(PG8_SB(1, 0), cB + kstep, voffB); PG8_STAGE(PG8_SA(1, 0), cA + kstep, voffA); PG8_STAGE(PG8_SB(1, 1), cB + hstep + kstep, voffB);
    PG8_WAIT_V(6); PG8_BAR;
    for (;;) {
        const bool has_next = S.next(ui + 1, nxt);
        const char* nA = has_next ? (const char*)g.A + (size_t)nxt.pm * tstep : cA; const char* nB = has_next ? (const char*)g.Bt + (size_t)nxt.pn * tstep : cB;
        for (int t = 0; t < nt; t += 2) {
            if constexpr (Epi::MID) { if (t == (nt >> 1)) E.mid(acc, cur, ui, tid); }
            const bool last = (t == nt - 2);
            const char* a1 = cA + (size_t)(t + 1) * kstep;
            const char* a2 = last ? nA : cA + (size_t)(t + 2) * kstep; const char* b2 = last ? nB : cB + (size_t)(t + 2) * kstep;
            const char* a3 = a2 + kstep; const char* b3 = b2 + kstep;
            PG8_LDB(B0, 0, 0); PG8_LDB(B1, 0, 1); PG8_SCHED; PG8_LDA(At, 0, 0); PG8_STAGE(PG8_SA(1, 1), a1 + hstep, voffA);
            PG8_WAIT_V(8); PG8_WAIT_L(0); PG8_BAR; PG8_MMA(0, 0, At, B0); PG8_MMA(0, 1, At, B1); PG8_BAR; PG8_SCHED;
            PG8_LDA(At, 0, 1); PG8_STAGE(PG8_SB(0, 0), b2, voffB); PG8_STAGE(PG8_SB(0, 1), b2 + hstep, voffB); PG8_STAGE(PG8_SA(0, 0), a2, voffA);
            PG8_WAIT_V(8); PG8_WAIT_L(0); PG8_BAR; PG8_MMA(1, 0, At, B0); PG8_MMA(1, 1, At, B1); PG8_BAR; PG8_SCHED;
            PG8_LDB(B0, 1, 0); PG8_LDB(B1, 1, 1); PG8_SCHED; PG8_LDA(At, 1, 0); PG8_STAGE(PG8_SA(0, 1), a2 + hstep, voffA);
            PG8_WAIT_V(8); PG8_WAIT_L(0); PG8_BAR; PG8_MMA(0, 0, At, B0); PG8_MMA(0, 1, At, B1); PG8_BAR; PG8_SCHED;
            PG8_LDA(At, 1, 1); PG8_STAGE(PG8_SB(1, 0), b3, voffB); PG8_STAGE(PG8_SB(1, 1), b3 + hstep, voffB); PG8_STAGE(PG8_SA(1, 0), a3, voffA);
            PG8_WAIT_V(8); PG8_WAIT_L(0); PG8_BAR; PG8_MMA(1, 0, At, B0); PG8_MMA(1, 1, At, B1); PG8_BAR; PG8_SCHED;
        }
        if (wr == 0) PG8_BAR;
        E(acc, cur, ui, tid);
        if (!has_next) break;
#pragma unroll
        for (int a = 0; a < 2; ++a)
#pragma unroll
            for (int b = 0; b < 2; ++b)
#pragma unroll
                for (int m = 0; m < 4; ++m)
#pragma unroll
                    for (int n = 0; n < 2; ++n) acc[a][b][m][n] = (f32x4){0.f, 0.f, 0.f, 0.f};
        cur = nxt; cA = nA; cB = nB; ++ui;
        if (wr == 1) PG8_BAR;
    }
    PG8_WAIT_V(0);
    PG8_BAR;
#undef PG8_SA
#undef PG8_SB
#undef PG8_STAGE
#undef PG8_LDA
#undef PG8_LDB
#undef PG8_MMA
#undef PG8_WAIT_V
#undef PG8_WAIT_L
#undef PG8_BAR
#undef PG8_SCHED
}

__device__ __forceinline__ void store8(bf16_t* p, f32x4 v0, f32x4 v1) {
    u32x4 w; w.x = cvtpk(v0[0], v0[1]); w.y = cvtpk(v0[2], v0[3]); w.z = cvtpk(v1[0], v1[1]); w.w = cvtpk(v1[2], v1[3]);
    *(u32x4*)p = w;
}


struct Rope4 { float f[4];
    __device__ __forceinline__ void init(int ibase, float kexp) {
#pragma unroll
        for (int j = 0; j < 4; ++j) f[j] = __builtin_amdgcn_exp2f(-(float)(ibase + j) * kexp) * 0.15915494309189535f; }
    __device__ __forceinline__ void sincos(int s, f32x4& cs, f32x4& sn) const {
#pragma unroll
        for (int j = 0; j < 4; ++j) { float rev = (float)s * f[j]; rev -= floorf(rev); sn[j] = __builtin_amdgcn_sinf(rev); cs[j] = __builtin_amdgcn_cosf(rev); } }
    __device__ __forceinline__ static void rot(f32x4& v0, f32x4& v1, const f32x4& cs, const f32x4& sn) {
        const f32x4 a = v0 * cs - v1 * sn, b = v1 * cs + v0 * sn; v0 = a; v1 = b; }
    __device__ __forceinline__ void apply(f32x4& v0, f32x4& v1, int s) const { f32x4 cs, sn; sincos(s, cs, sn); rot(v0, v1, cs, sn); }
};
constexpr float ROPE_KA = 18.931568569324174f / 16.0f, ROPE_KB = 18.931568569324174f / 32.0f;

struct EpiProj {
    static constexpr bool PERM = true, MID = false;
    bf16_t* QKV;
    bf16_t* CQKV;
    bf16_t* KR; float* ssq;
    __device__ __forceinline__ void mid(f32x4 (&)[2][2][4][2], const Unit&, int, int) const {}
    __device__ __forceinline__ void operator()(const f32x4 (&acc)[2][2][4][2], const Unit& u, int ui, int tid_) const {
        const int tid = opaque(tid_), lane = tid & 63, wid = __builtin_amdgcn_readfirstlane(tid >> 6), wr = wid >> 2, wc = wid & 3, fr = lane & 15, fq = lane >> 4;
        const int pn = u.pn, row0 = u.pm * BM + wr * 64 + fr;
        if (pn < 12) {
            bf16_t* base = QKV + (size_t)(pn >> 2) * (32u << 20);
            const int colt = (pn & 3) * 256 + wc * 32 + 8 * fq;
            const bool rope = (pn < 8) && (wc == 0);
            Rope4 R; R.init(4 * fq, ROPE_KA);
#pragma unroll
            for (int ai = 0; ai < 2; ++ai)
#pragma unroll
                for (int m = 0; m < 4; ++m) {
                    const int row = row0 + ai * HALF + m * 16; const int s = row & (SEQ - 1);
                    f32x4 rcs = {1.f, 1.f, 1.f, 1.f}, rsn = {0.f, 0.f, 0.f, 0.f};
                    if (rope) R.sincos(s, rcs, rsn);
#pragma unroll
                    for (int bj = 0; bj < 2; ++bj) {
                        f32x4 v0 = acc[ai][bj][m][0], v1 = acc[ai][bj][m][1];
                        if (rope) Rope4::rot(v0, v1, rcs, rsn);
                        if (pn < 4) store8(base + (size_t)row * 1024 + colt + bj * HALF, v0, v1);
                        else { u32x2 w; w.x = pack_fp8x4(v0[0], v0[1], v0[2], v0[3]); w.y = pack_fp8x4(v1[0], v1[1], v1[2], v1[3]);
                            *(u32x2*)((unsigned char*)base + (size_t)row * 1024 + colt + bj * HALF) = w; }
                    }
                }
        } else if (pn < 16) {
            bf16_t* base = CQKV + (size_t)((pn >> 1) & 1) * (16u << 20); float* sq = ssq + (size_t)((pn >> 1) & 1) * (256u << 10);
            const int colt = (pn & 1) * 256 + wc * 32 + 8 * fq; const int slot = (pn & 1) * 4 + wc;
#pragma unroll
            for (int ai = 0; ai < 2; ++ai)
#pragma unroll
                for (int m = 0; m < 4; ++m) {
                    const int row = row0 + ai * HALF + m * 16; float q = 0.f;
#pragma unroll
                    for (int bj = 0; bj < 2; ++bj) {
                        const f32x4 v0 = acc[ai][bj][m][0], v1 = acc[ai][bj][m][1];
                        q += (v0[0] * v0[0] + v0[1] * v0[1]) + (v0[2] * v0[2] + v0[3] * v0[3]) + (v1[0] * v1[0] + v1[1] * v1[1]) + (v1[2] * v1[2] + v1[3] * v1[3]);
                        store8(base + (size_t)row * 512 + colt + bj * HALF, v0 * 1.0f, v1 * 1.0f);
                    }
                    q += __shfl_xor(q, 16); q += __shfl_xor(q, 32);
                    if (fq == 0) sq[(size_t)slot * T + row] = q;
                }
        } else {
            if (wc < 2) {
                Rope4 R; R.init(16 * wc + 4 * fq, ROPE_KB);
#pragma unroll
                for (int ai = 0; ai < 2; ++ai)
#pragma unroll
                    for (int m = 0; m < 4; ++m) {
                        const int row = row0 + ai * HALF + m * 16; const int s = row & (SEQ - 1);
                        f32x4 v0 = acc[ai][0][m][0] * 1.0f, v1 = acc[ai][0][m][1] * 1.0f;
                        R.apply(v0, v1, s);
                        store8(KR + (size_t)row * 64 + wc * 32 + 8 * fq, v0, v1);
                    }
            }
        }
    }
};

struct EpiKr {
    static constexpr bool PERM = true, MID = false;
    bf16_t* KR;
    __device__ __forceinline__ void mid(f32x4 (&)[2][2][4][2], const Unit&, int, int) const {}
    __device__ __forceinline__ void operator()(const f32x4 (&acc)[2][2][4][2], const Unit& u, int ui, int tid_) const {
        const int tid = opaque(tid_), lane = tid & 63, wid = __builtin_amdgcn_readfirstlane(tid >> 6), wr = wid >> 2, wc = wid & 3, fr = lane & 15, fq = lane >> 4;
        const int row0 = u.pm * BM + wr * 64 + fr;
        if (wc < 2) {
            Rope4 R; R.init(16 * wc + 4 * fq, ROPE_KB);
#pragma unroll
            for (int ai = 0; ai < 2; ++ai)
#pragma unroll
                for (int m = 0; m < 4; ++m) {
                    const int row = row0 + ai * HALF + m * 16; const int s = row & (SEQ - 1);
                    f32x4 v0 = acc[ai][0][m][0] * 1.0f, v1 = acc[ai][0][m][1] * 1.0f;
                    R.apply(v0, v1, s);
                    store8(KR + (size_t)row * 64 + wc * 32 + 8 * fq, v0, v1);
                }
        }
    }
};

struct EpiQ {
    static constexpr bool PERM = true, MID = false;
    bf16_t *Qn, *Qr; const LAS float* tab;
    __device__ __forceinline__ void mid(f32x4 (&)[2][2][4][2], const Unit&, int, int) const {}
    __device__ __forceinline__ void operator()(const f32x4 (&acc)[2][2][4][2], const Unit& u, int ui, int tid_) const {
        const int tid = opaque(tid_), lane = tid & 63, wid = __builtin_amdgcn_readfirstlane(tid >> 6), wr = wid >> 2, wc = wid & 3, fr = lane & 15, fq = lane >> 4;
        const int pn = u.pn, rl0 = wr * 64 + fr, row0 = u.pm * BM + rl0;
        Rope4 R; R.init(16 * (wc & 1) + 4 * fq, ROPE_KB);
#pragma unroll
        for (int ai = 0; ai < 2; ++ai)
#pragma unroll
            for (int m = 0; m < 4; ++m) {
                const int row = row0 + ai * HALF + m * 16; const int s = row & (SEQ - 1);
                const float rs = tab[ui * 256 + rl0 + ai * HALF + m * 16];
                if (pn < 4) {
#pragma unroll
                    for (int bj = 0; bj < 2; ++bj)
                        store8(Qn + (size_t)row * 1024 + pn * 256 + bj * HALF + wc * 32 + 8 * fq, acc[ai][bj][m][0] * rs, acc[ai][bj][m][1] * rs);
                } else {
                    f32x4 rcs, rsn; R.sincos(s, rcs, rsn);
#pragma unroll
                    for (int bj = 0; bj < 2; ++bj) {
                        f32x4 v0 = acc[ai][bj][m][0] * rs, v1 = acc[ai][bj][m][1] * rs;
                        Rope4::rot(v0, v1, rcs, rsn);
                        store8(Qr + (size_t)row * 512 + (pn - 4) * 256 + bj * HALF + wc * 32 + 8 * fq, v0, v1);
                    }
                }
            }
    }
};

struct EpiKV {
    static constexpr bool PERM = true, MID = false;
    bf16_t *Kn, *Vb; const LAS float* tab;
    __device__ __forceinline__ void mid(f32x4 (&)[2][2][4][2], const Unit&, int, int) const {}
    __device__ __forceinline__ void operator()(const f32x4 (&acc)[2][2][4][2], const Unit& u, int ui, int tid_) const {
        const int tid = opaque(tid_), lane = tid & 63, wid = __builtin_amdgcn_readfirstlane(tid >> 6), wr = wid >> 2, wc = wid & 3, fr = lane & 15, fq = lane >> 4;
        const int pn = u.pn, rl0 = wr * 64 + fr, row0 = u.pm * BM + rl0;
        bf16_t* base = pn < 4 ? Kn : Vb;
#pragma unroll
        for (int ai = 0; ai < 2; ++ai)
#pragma unroll
            for (int m = 0; m < 4; ++m) {
                const int row = row0 + ai * HALF + m * 16;
                const float rs = tab[ui * 256 + rl0 + ai * HALF + m * 16];
#pragma unroll
                for (int bj = 0; bj < 2; ++bj)
                    store8(base + (size_t)row * 1024 + (pn & 3) * 256 + bj * HALF + wc * 32 + 8 * fq, acc[ai][bj][m][0] * rs, acc[ai][bj][m][1] * rs);
            }
    }
};

struct EpiMix {
    static constexpr bool PERM = true, MID = true;
    bf16_t* MIX; const LAS float* tab;
    __device__ __forceinline__ void mid(f32x4 (&acc)[2][2][4][2], const Unit& u, int ui, int tid_) const {
        const int tid = opaque(tid_), lane = tid & 63, wid = __builtin_amdgcn_readfirstlane(tid >> 6), wr = wid >> 2, wc = wid & 3, fr = lane & 15, fq = lane >> 4;
        const int rl0 = wr * 64 + fr;
#pragma unroll
        for (int ai = 0; ai < 2; ++ai)
#pragma unroll
            for (int m = 0; m < 4; ++m) {
                const float ratio = tab[(ui * 256 + rl0 + ai * HALF + m * 16) * 2];
#pragma unroll
                for (int bj = 0; bj < 2; ++bj) { acc[ai][bj][m][0] *= ratio; acc[ai][bj][m][1] *= ratio; }
            }
    }
    __device__ __forceinline__ void operator()(const f32x4 (&acc)[2][2][4][2], const Unit& u, int ui, int tid_) const {
        const int tid = opaque(tid_), lane = tid & 63, wid = __builtin_amdgcn_readfirstlane(tid >> 6), wr = wid >> 2, wc = wid & 3, fr = lane & 15, fq = lane >> 4;
        const int rl0 = wr * 64 + fr, row0 = u.pm * BM + rl0;
#pragma unroll
        for (int ai = 0; ai < 2; ++ai)
#pragma unroll
            for (int m = 0; m < 4; ++m) {
                const int row = row0 + ai * HALF + m * 16;
                const float rb = tab[(ui * 256 + rl0 + ai * HALF + m * 16) * 2 + 1];
#pragma unroll
                for (int bj = 0; bj < 2; ++bj)
                    store8(MIX + (size_t)row * DM + u.pn * BM + bj * HALF + wc * 32 + 8 * fq, acc[ai][bj][m][0] * rb, acc[ai][bj][m][1] * rb);
            }
    }
};

struct EpiPlain {
    static constexpr bool PERM = true, MID = false;
    bf16_t* O; int ldc;
    __device__ __forceinline__ void mid(f32x4 (&)[2][2][4][2], const Unit&, int, int) const {}
    __device__ __forceinline__ void operator()(const f32x4 (&acc)[2][2][4][2], const Unit& u, int ui, int tid_) const {
        const int tid = opaque(tid_), lane = tid & 63, wid = __builtin_amdgcn_readfirstlane(tid >> 6), wr = wid >> 2, wc = wid & 3, fr = lane & 15, fq = lane >> 4;
        const int row0 = u.pm * BM + wr * 64 + fr;
#pragma unroll
        for (int ai = 0; ai < 2; ++ai)
#pragma unroll
            for (int m = 0; m < 4; ++m) {
                const int row = row0 + ai * HALF + m * 16;
#pragma unroll
                for (int bj = 0; bj < 2; ++bj)
                    store8(O + (size_t)row * ldc + u.pn * BM + bj * HALF + wc * 32 + 8 * fq, acc[ai][bj][m][0], acc[ai][bj][m][1]);
            }
    }
};
}

namespace att {
#define KSWZ(row, colB) ((row) * 256 + ((colB) ^ (((row) & 7) << 4)))
#define SBAR() __builtin_amdgcn_sched_barrier(0)
__device__ __forceinline__ int crow(int r, int hi) { return (r & 3) + 8 * (r >> 2) + 4 * hi; }
constexpr int L_KN = 0, L_KR = 32768, L_V = 49152, L_WS = 81920, L_QR = 83968, L_END = 83968 + 32768;
__device__ __forceinline__ int v_st(int k, int c) { const int kk = (k & ~0xC) | ((k & 4) << 1) | ((k & 8) >> 1); return ((kk >> 3) * 4 + (c >> 5)) * 512 + ((kk & 7) * 32 + (c & 31)) * 2; }
__device__ __forceinline__ int v_rd_base(int lane) { return ((lane & 3) << 3) | (((lane >> 2) & 3) << 6) | (((lane >> 4) & 1) << 5) | (((lane >> 5) & 1) << 8); }
constexpr int v_rd_off(int d0, int ks, int half) { return d0 * 512 + ks * 4096 + half * 2048; }
template <int OFF> __device__ __forceinline__ s16x4 tr_read(int vb) {
    s16x4 r; asm volatile("ds_read_b64_tr_b16 %0, %1 offset:%2" : "=&v"(r) : "v"(vb), "i"(OFF) : "memory"); return r;
}
template <int D0> __device__ __forceinline__ void pv_one(f32x16& od, int vb, bf16x8 pa0, bf16x8 pa1, bf16x8 pa2, bf16x8 pa3) {
    const s16x4 l0 = tr_read<v_rd_off(D0, 0, 0)>(vb), h0 = tr_read<v_rd_off(D0, 0, 1)>(vb), l1 = tr_read<v_rd_off(D0, 1, 0)>(vb), h1 = tr_read<v_rd_off(D0, 1, 1)>(vb);
    const s16x4 l2 = tr_read<v_rd_off(D0, 2, 0)>(vb), h2 = tr_read<v_rd_off(D0, 2, 1)>(vb), l3 = tr_read<v_rd_off(D0, 3, 0)>(vb), h3 = tr_read<v_rd_off(D0, 3, 1)>(vb);
    asm volatile("s_waitcnt lgkmcnt(0)" ::: "memory"); SBAR();
#define PK(L, H) (bf16x8){L[0], L[1], L[2], L[3], H[0], H[1], H[2], H[3]}
    od = __builtin_amdgcn_mfma_f32_32x32x16_bf16(pa0, PK(l0, h0), od, 0, 0, 0);
    od = __builtin_amdgcn_mfma_f32_32x32x16_bf16(pa1, PK(l1, h1), od, 0, 0, 0);
    od = __builtin_amdgcn_mfma_f32_32x32x16_bf16(pa2, PK(l2, h2), od, 0, 0, 0);
    od = __builtin_amdgcn_mfma_f32_32x32x16_bf16(pa3, PK(l3, h3), od, 0, 0, 0);
#undef PK
}

struct UnitP { int b, h, dil, rho0, ngrp, qbase, kfirst, tpg, W, mode; };
struct Tens { const bf16_t *Qm, *Qr, *Km, *Kr, *Vm; bf16_t* So; float *Sm, *Sl; bf16_t* Oout; int ocol0; float* ssq; int ssq0; };

template <bool MLA>
__device__ __forceinline__ void attn_unit(const int tid_in, const UnitP P, LAS unsigned char* lds, const Tens& X) {
    const int tid = opaque(tid_in);
    constexpr float SCALE = MLA ? 0.07216878364870322f : 0.08838834764831845f;
    constexpr float C = SCALE * 1.4426950408889634f;
    constexpr float THRS = 8.f / SCALE;
    constexpr int NQ = 8;
    const int wid = __builtin_amdgcn_readfirstlane(tid >> 6), lane = tid & 63, r32 = lane & 31, hi = lane >> 5;
    const int g = (P.ngrp == 2) ? (wid >> 2) : 0, wq = (P.ngrp == 2) ? (wid & 3) : wid;
    const int qpos0 = P.qbase + 32 * wq, rho_w = P.rho0 + g;
    const long tb = (long)P.b * SEQ;
    const long qtok = tb + (long)(qpos0 + r32) * P.dil + rho_w;
    LAS float* wsf = (LAS float*)(lds + L_WS) + wid * 64;
    bf16x8 qr[NQ];
    { const bf16_t* qp = X.Qm + qtok * 1024 + P.h * 128 + hi * 8;
#pragma unroll
      for (int d0 = 0; d0 < 8; ++d0) qr[d0] = *(const bf16x8*)(qp + d0 * 16); }
    LAS unsigned char* qrp = lds + L_QR + wid * 4096 + lane * 16;
    if constexpr (MLA) { const bf16_t* qp = X.Qr + qtok * 512 + P.h * 64 + hi * 8;
#pragma unroll
      for (int d0 = 0; d0 < 4; ++d0) *(LAS bf16x8*)(qrp + d0 * 1024) = *(const bf16x8*)(qp + d0 * 16); }
    float m_reg = -1e30f, l_reg = 0.f; f32x16 o[4];
#pragma unroll
    for (int d = 0; d < 4; ++d) o[d] = f32x16{};
    LAS unsigned char* stg = lds + wid * 8704;
    if (P.mode & 1) {
        m_reg = X.Sm[qtok * 8 + P.h]; l_reg = X.Sl[qtok * 8 + P.h];
#pragma unroll 2
        for (int i = 0; i < 8; ++i) { const int le = opaque(lane), row = i * 4 + (le >> 4), ch = le & 15; const long tr = tb + (long)(qpos0 + row) * P.dil + rho_w;
            *(LAS u32x4*)(stg + row * 272 + ch * 16) = *(const u32x4*)(X.So + tr * 1024 + P.h * 128 + ch * 8); }
        asm volatile("s_waitcnt lgkmcnt(0)" ::: "memory");
#pragma unroll
        for (int r = 0; r < 16; ++r)
#pragma unroll
            for (int d = 0; d < 4; ++d) o[d][r] = __uint_as_float((unsigned)(*(const LAS unsigned short*)(stg + crow(r, hi) * 272 + (32 * d + r32) * 2)) << 16);
        asm volatile("s_waitcnt lgkmcnt(0)" ::: "memory");
        __syncthreads();
    }
    const int sr = tid >> 4, sc = (tid & 15) * 8;
    const int rr = tid >> 3, rc = tid & 7;
    const int NT = P.ngrp * P.tpg;
    const int vb0 = (int)(uintptr_t)(lds + L_V) + v_rd_base(lane);
    bf16x8 ks0, ks1, vs0, vs1, krs, ks0b, ks1b, vs0b, vs1b, krsb;
#define LOADT(jt) do { const int gj_ = (jt) / P.tpg; const int kp_ = P.kfirst + 64 * ((jt) - gj_ * P.tpg); const int rho_ = P.rho0 + gj_; \
        const long t0_ = tb + (long)(kp_ + sr) * P.dil + rho_, t1_ = tb + (long)(kp_ + 32 + sr) * P.dil + rho_; \
        ks0 = *(const bf16x8*)(X.Km + t0_ * 1024 + P.h * 128 + sc); ks1 = *(const bf16x8*)(X.Km + t1_ * 1024 + P.h * 128 + sc); \
        vs0 = *(const bf16x8*)(X.Vm + t0_ * 1024 + P.h * 128 + sc); vs1 = *(const bf16x8*)(X.Vm + t1_ * 1024 + P.h * 128 + sc); \
        if constexpr (MLA) { const long t2_ = tb + (long)(kp_ + rr) * P.dil + rho_; krs = *(const bf16x8*)(X.Kr + t2_ * 64 + rc * 8); } } while (0)
#define WRITET(buf) do { *(LAS bf16x8*)(lds + L_KN + (buf) * 16384 + KSWZ(sr, sc * 2)) = ks0; *(LAS bf16x8*)(lds + L_KN + (buf) * 16384 + KSWZ(32 + sr, sc * 2)) = ks1; \
        *(LAS bf16x8*)(lds + L_V + (buf) * 16384 + v_st(sr, sc)) = vs0; *(LAS bf16x8*)(lds + L_V + (buf) * 16384 + v_st(32 + sr, sc)) = vs1; \
        if constexpr (MLA) { *(LAS bf16x8*)(lds + L_KR + (buf) * 8192 + rr * 128 + ((rc ^ ((rr >> 1) & 7)) << 4)) = krs; } } while (0)
#define LOADTB(jt) do { const int gj_ = (jt) / P.tpg; const int kp_ = P.kfirst + 64 * ((jt) - gj_ * P.tpg); const int rho_ = P.rho0 + gj_; \
        const long t0_ = tb + (long)(kp_ + sr) * P.dil + rho_, t1_ = tb + (long)(kp_ + 32 + sr) * P.dil + rho_; \
        ks0b = *(const bf16x8*)(X.Km + t0_ * 1024 + P.h * 128 + sc); ks1b = *(const bf16x8*)(X.Km + t1_ * 1024 + P.h * 128 + sc); \
        vs0b = *(const bf16x8*)(X.Vm + t0_ * 1024 + P.h * 128 + sc); vs1b = *(const bf16x8*)(X.Vm + t1_ * 1024 + P.h * 128 + sc); \
        if constexpr (MLA) { const long t2_ = tb + (long)(kp_ + rr) * P.dil + rho_; krsb = *(const bf16x8*)(X.Kr + t2_ * 64 + rc * 8); } } while (0)
#define WRITETB(buf) do { *(LAS bf16x8*)(lds + L_KN + (buf) * 16384 + KSWZ(sr, sc * 2)) = ks0b; *(LAS bf16x8*)(lds + L_KN + (buf) * 16384 + KSWZ(32 + sr, sc * 2)) = ks1b; \
        *(LAS bf16x8*)(lds + L_V + (buf) * 16384 + v_st(sr, sc)) = vs0b; *(LAS bf16x8*)(lds + L_V + (buf) * 16384 + v_st(32 + sr, sc)) = vs1b; \
        if constexpr (MLA) { *(LAS bf16x8*)(lds + L_KR + (buf) * 8192 + rr * 128 + ((rc ^ ((rr >> 1) & 7)) << 4)) = krsb; } } while (0)
    LOADT(0);
    if (NT > 1) LOADTB(1);
    if (wid >= 4) __builtin_amdgcn_s_setprio(1);
    for (int jt0 = 0; jt0 < NT; jt0 += 2)
#pragma unroll
    for (int par = 0; par < 2; ++par) {
        const int jt = jt0 + par; if (jt >= NT) break;
        const int buf = par;
        if (par == 0) { WRITET(buf); if (jt + 2 < NT) LOADT(jt + 2); } else { WRITETB(buf); if (jt + 2 < NT) LOADTB(jt + 2); }
        __syncthreads();
        const int gj = jt / P.tpg, kpos0 = P.kfirst + 64 * (jt - gj * P.tpg);
        const bool active = (gj == g) && (kpos0 <= qpos0 + 31) && (kpos0 + 63 >= qpos0 - P.W);
        if (active) {
            f32x16 p0 = f32x16{}, p1 = f32x16{};
            { const LAS unsigned char* kb = lds + L_KN + buf * 16384;
#pragma unroll
              for (int d0 = 0; d0 < 8; ++d0) { const int cb = (d0 * 16 + hi * 8) * 2;
                const bf16x8 b0 = *(const LAS bf16x8*)(kb + KSWZ(r32, cb)), b1 = *(const LAS bf16x8*)(kb + KSWZ(32 + r32, cb));
                p0 = __builtin_amdgcn_mfma_f32_32x32x16_bf16(b0, qr[d0], p0, 0, 0, 0);
                p1 = __builtin_amdgcn_mfma_f32_32x32x16_bf16(b1, qr[d0], p1, 0, 0, 0); } }
            if constexpr (MLA) { const LAS unsigned char* kb = lds + L_KR + buf * 8192;
#pragma unroll
              for (int d0 = 0; d0 < 4; ++d0) { const int ch = 2 * d0 + hi; const int off = ((ch ^ ((r32 >> 1) & 7)) << 4);
                const bf16x8 b0 = *(const LAS bf16x8*)(kb + r32 * 128 + off), b1 = *(const LAS bf16x8*)(kb + (32 + r32) * 128 + off);
                const bf16x8 qf = *(const LAS bf16x8*)(qrp + d0 * 1024);
                p0 = __builtin_amdgcn_mfma_f32_32x32x16_bf16(b0, qf, p0, 0, 0, 0);
                p1 = __builtin_amdgcn_mfma_f32_32x32x16_bf16(b1, qf, p1, 0, 0, 0); } }
            const bool full = (kpos0 + 63 <= qpos0) && (kpos0 >= qpos0 + 31 - P.W);
            if (!full) { const int qp = qpos0 + r32;
#pragma unroll
                for (int r = 0; r < 16; ++r) { const int dq0 = qp - (kpos0 + crow(r, hi)), dq1 = dq0 - 32;
                    if (dq0 < 0 || dq0 > P.W) p0[r] = -INFINITY; if (dq1 < 0 || dq1 > P.W) p1[r] = -INFINITY; } }
            float pmax = p0[0];
#pragma unroll
            for (int r = 1; r < 16; ++r) pmax = fmaxf(pmax, p0[r]);
#pragma unroll
            for (int r = 0; r < 16; ++r) pmax = fmaxf(pmax, p1[r]);
            { auto sw = __builtin_amdgcn_permlane32_swap(__float_as_uint(pmax), __float_as_uint(pmax), false, false); pmax = fmaxf(__uint_as_float(sw[0]), __uint_as_float(sw[1])); }
            float mn, alpha;
            if (__builtin_expect(__all(pmax - m_reg <= THRS), 1)) { mn = m_reg; alpha = 1.f; }
            else { mn = fmaxf(m_reg, pmax); alpha = __builtin_amdgcn_exp2f((m_reg - mn) * C); m_reg = mn; }
            const float mnC = -mn * C;
#pragma unroll
            for (int r = 0; r < 16; ++r) { p0[r] = __builtin_amdgcn_exp2f(fmaf(p0[r], C, mnC)); p1[r] = __builtin_amdgcn_exp2f(fmaf(p1[r], C, mnC)); }
            if (__any(alpha < 1.f)) { if (hi == 0) wsf[r32] = alpha; asm volatile("s_waitcnt lgkmcnt(0)" ::: "memory");
#pragma unroll
                for (int r = 0; r < 16; ++r) { const float al = wsf[crow(r, hi)];
#pragma unroll
                    for (int d = 0; d < 4; ++d) o[d][r] *= al; }
                asm volatile("s_waitcnt lgkmcnt(0)" ::: "memory"); }
            float ps = 0.f;
#pragma unroll
            for (int r = 0; r < 16; ++r) ps += p0[r];
#pragma unroll
            for (int r = 0; r < 16; ++r) ps += p1[r];
            { auto sw = __builtin_amdgcn_permlane32_swap(__float_as_uint(ps), __float_as_uint(ps), false, false); ps = __uint_as_float(sw[0]) + __uint_as_float(sw[1]); }
            l_reg = l_reg * alpha + ps;
            bf16x8 pa0, pa1, pa2, pa3;
#define PK4(Pv, BASE, OUT) do { unsigned a0 = cvtpk(Pv[BASE + 0], Pv[BASE + 1]), a1 = cvtpk(Pv[BASE + 2], Pv[BASE + 3]);   \
    unsigned b0 = cvtpk(Pv[BASE + 4], Pv[BASE + 5]), b1 = cvtpk(Pv[BASE + 6], Pv[BASE + 7]);                              \
    auto r0 = __builtin_amdgcn_permlane32_swap(a0, b0, false, false); auto r1 = __builtin_amdgcn_permlane32_swap(a1, b1, false, false); \
    u32x4 w = {r0[0], r1[0], r0[1], r1[1]}; OUT = __builtin_bit_cast(bf16x8, w); } while (0)
            PK4(p0, 0, pa0); PK4(p0, 8, pa1); PK4(p1, 0, pa2); PK4(p1, 8, pa3);
#undef PK4
            SBAR();
            const int vb = vb0 + buf * 16384;
            pv_one<0>(o[0], vb, pa0, pa1, pa2, pa3); pv_one<1>(o[1], vb, pa0, pa1, pa2, pa3); pv_one<2>(o[2], vb, pa0, pa1, pa2, pa3); pv_one<3>(o[3], vb, pa0, pa1, pa2, pa3);
        }
    }
#undef LOADT
#undef WRITET
#undef LOADTB
#undef WRITETB
    __builtin_amdgcn_s_setprio(0);
    asm volatile("s_waitcnt lgkmcnt(0)" ::: "memory");
    __syncthreads();
    if (P.mode & 2) {
        if (hi == 0) wsf[32 + r32] = l_reg; asm volatile("s_waitcnt lgkmcnt(0)" ::: "memory");
#pragma unroll
        for (int r = 0; r < 16; ++r) { const int qrow = crow(r, hi); const float rl = 1.0f / wsf[32 + qrow];
            const long tr = tb + (long)(qpos0 + qrow) * P.dil + rho_w; float sq = 0.f;
#pragma unroll
            for (int d = 0; d < 4; ++d) { const float v = o[d][r] * rl; sq += v * v; *(LAS unsigned short*)(stg + qrow * 272 + (32 * d + r32) * 2) = (unsigned short)(cvtpk(v, v) & 0xffffu); }
            sq += __shfl_xor(sq, 1); sq += __shfl_xor(sq, 2); sq += __shfl_xor(sq, 4); sq += __shfl_xor(sq, 8); sq += __shfl_xor(sq, 16);
            if (r32 == 0) X.ssq[tr * 16 + X.ssq0 + P.h] = sq; }
        asm volatile("s_waitcnt lgkmcnt(0)" ::: "memory");
#pragma unroll 2
        for (int i = 0; i < 8; ++i) { const int le = opaque(lane), row = i * 4 + (le >> 4), ch = le & 15; const long tr = tb + (long)(qpos0 + row) * P.dil + rho_w;
            *(u32x4*)(X.Oout + tr * 2048 + X.ocol0 + P.h * 128 + ch * 8) = *(const LAS u32x4*)(stg + row * 272 + ch * 16); }
    } else {
        if (hi == 0) { X.Sm[qtok * 8 + P.h] = m_reg; X.Sl[qtok * 8 + P.h] = l_reg; }
#pragma unroll
        for (int r = 0; r < 16; ++r)
#pragma unroll
            for (int d = 0; d < 4; ++d) { const float v = o[d][r]; *(LAS unsigned short*)(stg + crow(r, hi) * 272 + (32 * d + r32) * 2) = (unsigned short)(cvtpk(v, v) & 0xffffu); }
        asm volatile("s_waitcnt lgkmcnt(0)" ::: "memory");
#pragma unroll 2
        for (int i = 0; i < 8; ++i) { const int le = opaque(lane), row = i * 4 + (le >> 4), ch = le & 15; const long tr = tb + (long)(qpos0 + row) * P.dil + rho_w;
            *(u32x4*)(X.So + tr * 1024 + P.h * 128 + ch * 8) = *(const LAS u32x4*)(stg + row * 272 + ch * 16); }
    }
    asm volatile("s_waitcnt lgkmcnt(0)" ::: "memory");
    __syncthreads();
}

struct WaveA { int b, h, dil, rho, qpos0, mode; };
__device__ __forceinline__ void attnA_wave(const int lane_in, const WaveA P, LAS unsigned char* wl  , LAS float* wsf, const Tens& X) {
    constexpr float SCALE = 0.08838834764831845f, C = SCALE * 1.4426950408889634f, THRS = 8.f / SCALE;
    const int lane = opaque(lane_in), r32 = lane & 31, hi = lane >> 5;
    const long tb = (long)P.b * SEQ;
    const long qtok = tb + (long)(P.qpos0 + r32) * P.dil + P.rho;
    LAS unsigned char* vbuf = wl; LAS unsigned char* stg = wl + 8192;
    bf16x8 qr[8];
    { const bf16_t* qp = X.Qm + qtok * 1024 + P.h * 128 + hi * 64;
#pragma unroll
      for (int d0 = 0; d0 < 8; ++d0) qr[d0] = *(const bf16x8*)(qp + d0 * 8); }
    float m_reg = -1e30f, l_reg = 0.f; f32x16 o[4];
#pragma unroll
    for (int d = 0; d < 4; ++d) o[d] = f32x16{};
    if (P.mode & 1) {
        m_reg = X.Sm[qtok * 8 + P.h]; l_reg = X.Sl[qtok * 8 + P.h];
#pragma unroll 2
        for (int i = 0; i < 8; ++i) { const int le = opaque(lane), row = i * 4 + (le >> 4), ch = le & 15; const long tr = tb + (long)(P.qpos0 + row) * P.dil + P.rho;
            *(LAS u32x4*)(stg + row * 272 + ch * 16) = *(const u32x4*)(X.So + tr * 1024 + P.h * 128 + ch * 8); }
        asm volatile("s_waitcnt lgkmcnt(0)" ::: "memory");
#pragma unroll
        for (int r = 0; r < 16; ++r)
#pragma unroll
            for (int d = 0; d < 4; ++d) o[d][r] = __uint_as_float((unsigned)(*(const LAS unsigned short*)(stg + crow(r, hi) * 272 + (32 * d + r32) * 2)) << 16);
    }
    const int kfirst = P.qpos0 >= 128 ? P.qpos0 - 128 : 0;
    const int vrow = lane >> 3, vcol = (lane & 7) * 16;
    const int vb = (int)(uintptr_t)vbuf + v_rd_base(lane);
    const unsigned char* K8 = (const unsigned char*)X.Km; const unsigned char* V8 = (const unsigned char*)X.Vm;
    u32x4 nk[4], nv[4];
#define A_LOAD(kc) do { const long tk_ = tb + (long)((kc) + r32) * P.dil + P.rho; const unsigned char* kp_ = K8 + tk_ * 1024 + P.h * 128 + hi * 64; \
        _Pragma("unroll") for (int j = 0; j < 4; ++j) nk[j] = *(const u32x4*)(kp_ + j * 16); \
        _Pragma("unroll") for (int i = 0; i < 4; ++i) { const long tv_ = tb + (long)((kc) + vrow + 8 * i) * P.dil + P.rho; nv[i] = *(const u32x4*)(V8 + tv_ * 1024 + P.h * 128 + vcol); } } while (0)
#define A_CVT8(lo, hi_) ({ const f32x2 a_ = __builtin_amdgcn_cvt_pk_f32_fp8((int)(lo), false), b_ = __builtin_amdgcn_cvt_pk_f32_fp8((int)(lo), true), \
        c_ = __builtin_amdgcn_cvt_pk_f32_fp8((int)(hi_), false), d_ = __builtin_amdgcn_cvt_pk_f32_fp8((int)(hi_), true); \
        u32x4 w_ = {cvtpk(a_[0], a_[1]), cvtpk(b_[0], b_[1]), cvtpk(c_[0], c_[1]), cvtpk(d_[0], d_[1])}; __builtin_bit_cast(bf16x8, w_); })
    A_LOAD(kfirst);
    for (int kc0 = kfirst; kc0 <= P.qpos0; kc0 += 32) {
        bf16x8 kf[8];
#pragma unroll
        for (int j = 0; j < 4; ++j) { const unsigned x0 = nk[j][0], x1 = nk[j][1], x2 = nk[j][2], x3 = nk[j][3]; kf[2 * j] = A_CVT8(x0, x1); kf[2 * j + 1] = A_CVT8(x2, x3); }
#pragma unroll
        for (int i = 0; i < 4; ++i) { const unsigned x0 = nv[i][0], x1 = nv[i][1], x2 = nv[i][2], x3 = nv[i][3];
            *(LAS bf16x8*)(vbuf + v_st(vrow + 8 * i, vcol)) = A_CVT8(x0, x1); *(LAS bf16x8*)(vbuf + v_st(vrow + 8 * i, vcol + 8)) = A_CVT8(x2, x3); }
        if (kc0 + 32 <= P.qpos0) A_LOAD(kc0 + 32);
        f32x16 p0 = f32x16{};
#pragma unroll
        for (int d0 = 0; d0 < 8; ++d0) p0 = __builtin_amdgcn_mfma_f32_32x32x16_bf16(kf[d0], qr[d0], p0, 0, 0, 0);
        const bool full = (kc0 + 31 <= P.qpos0) && (kc0 >= P.qpos0 + 31 - 128);
        if (!full) { const int qp = P.qpos0 + r32;
#pragma unroll
            for (int r = 0; r < 16; ++r) { const int dq = qp - (kc0 + crow(r, hi)); if (dq < 0 || dq > 128) p0[r] = -INFINITY; } }
        float pmax = p0[0];
#pragma unroll
        for (int r = 1; r < 16; ++r) pmax = fmaxf(pmax, p0[r]);
        { auto sw = __builtin_amdgcn_permlane32_swap(__float_as_uint(pmax), __float_as_uint(pmax), false, false); pmax = fmaxf(__uint_as_float(sw[0]), __uint_as_float(sw[1])); }
        float mn, alpha;
        if (__builtin_expect(__all(pmax - m_reg <= THRS), 1)) { mn = m_reg; alpha = 1.f; }
        else { mn = fmaxf(m_reg, pmax); alpha = __builtin_amdgcn_exp2f((m_reg - mn) * C); m_reg = mn; }
        const float mnC = -mn * C;
#pragma unroll
        for (int r = 0; r < 16; ++r) p0[r] = __builtin_amdgcn_exp2f(fmaf(p0[r], C, mnC));
        if (__any(alpha < 1.f)) { if (hi == 0) wsf[r32] = alpha; asm volatile("s_waitcnt lgkmcnt(0)" ::: "memory");
#pragma unroll
            for (int r = 0; r < 16; ++r) { const float al = wsf[crow(r, hi)];
#pragma unroll
                for (int d = 0; d < 4; ++d) o[d][r] *= al; }
            asm volatile("s_waitcnt lgkmcnt(0)" ::: "memory"); }
        float ps = 0.f;
#pragma unroll
        for (int r = 0; r < 16; ++r) ps += p0[r];
        { auto sw = __builtin_amdgcn_permlane32_swap(__float_as_uint(ps), __float_as_uint(ps), false, false); ps = __uint_as_float(sw[0]) + __uint_as_float(sw[1]); }
        l_reg = l_reg * alpha + ps;
        bf16x8 pa0, pa1;
#define PK4(Pv, BASE, OUT) do { unsigned a0 = cvtpk(Pv[BASE + 0], Pv[BASE + 1]), a1 = cvtpk(Pv[BASE + 2], Pv[BASE + 3]);   \
    unsigned b0 = cvtpk(Pv[BASE + 4], Pv[BASE + 5]), b1 = cvtpk(Pv[BASE + 6], Pv[BASE + 7]);                              \
    auto r0 = __builtin_amdgcn_permlane32_swap(a0, b0, false, false); auto r1 = __builtin_amdgcn_permlane32_swap(a1, b1, false, false); \
    u32x4 w = {r0[0], r1[0], r0[1], r1[1]}; OUT = __builtin_bit_cast(bf16x8, w); } while (0)
        PK4(p0, 0, pa0); PK4(p0, 8, pa1);
#undef PK4
        SBAR();
#define A_PV(D0) do { const s16x4 l0 = tr_read<v_rd_off(D0, 0, 0)>(vb), h0 = tr_read<v_rd_off(D0, 0, 1)>(vb), l1 = tr_read<v_rd_off(D0, 1, 0)>(vb), h1 = tr_read<v_rd_off(D0, 1, 1)>(vb); \
        asm volatile("s_waitcnt lgkmcnt(0)" ::: "memory"); SBAR(); \
        o[D0] = __builtin_amdgcn_mfma_f32_32x32x16_bf16(pa0, (bf16x8){l0[0], l0[1], l0[2], l0[3], h0[0], h0[1], h0[2], h0[3]}, o[D0], 0, 0, 0); \
        o[D0] = __builtin_amdgcn_mfma_f32_32x32x16_bf16(pa1, (bf16x8){l1[0], l1[1], l1[2], l1[3], h1[0], h1[1], h1[2], h1[3]}, o[D0], 0, 0, 0); } while (0)
        A_PV(0); A_PV(1); A_PV(2); A_PV(3);
#undef A_PV
        asm volatile("s_waitcnt lgkmcnt(0)" ::: "memory");
    }
#undef A_LOAD
#undef A_CVT8
    if (P.mode & 2) {
        if (hi == 0) wsf[32 + r32] = l_reg; asm volatile("s_waitcnt lgkmcnt(0)" ::: "memory");
#pragma unroll
        for (int r = 0; r < 16; ++r) { const int qrow = crow(r, hi); const float rl = 1.0f / wsf[32 + qrow];
            const long tr = tb + (long)(P.qpos0 + qrow) * P.dil + P.rho; float sq = 0.f;
#pragma unroll
            for (int d = 0; d < 4; ++d) { const float v = o[d][r] * rl; sq += v * v; *(LAS unsigned short*)(stg + qrow * 272 + (32 * d + r32) * 2) = (unsigned short)(cvtpk(v, v) & 0xffffu); }
            sq += __shfl_xor(sq, 1); sq += __shfl_xor(sq, 2); sq += __shfl_xor(sq, 4); sq += __shfl_xor(sq, 8); sq += __shfl_xor(sq, 16);
            if (r32 == 0) X.ssq[tr * 16 + X.ssq0 + P.h] = sq; }
        asm volatile("s_waitcnt lgkmcnt(0)" ::: "memory");
#pragma unroll 2
        for (int i = 0; i < 8; ++i) { const int le = opaque(lane), row = i * 4 + (le >> 4), ch = le & 15; const long tr = tb + (long)(P.qpos0 + row) * P.dil + P.rho;
            *(u32x4*)(X.Oout + tr * 2048 + X.ocol0 + P.h * 128 + ch * 8) = *(const LAS u32x4*)(stg + row * 272 + ch * 16); }
    } else {
        if (hi == 0) { X.Sm[qtok * 8 + P.h] = m_reg; X.Sl[qtok * 8 + P.h] = l_reg; }
#pragma unroll
        for (int r = 0; r < 16; ++r)
#pragma unroll
            for (int d = 0; d < 4; ++d) { const float v = o[d][r]; *(LAS unsigned short*)(stg + crow(r, hi) * 272 + (32 * d + r32) * 2) = (unsigned short)(cvtpk(v, v) & 0xffffu); }
        asm volatile("s_waitcnt lgkmcnt(0)" ::: "memory");
#pragma unroll 2
        for (int i = 0; i < 8; ++i) { const int le = opaque(lane), row = i * 4 + (le >> 4), ch = le & 15; const long tr = tb + (long)(P.qpos0 + row) * P.dil + P.rho;
            *(u32x4*)(X.So + tr * 1024 + P.h * 128 + ch * 8) = *(const LAS u32x4*)(stg + row * 272 + ch * 16); }
    }
    asm volatile("s_waitcnt lgkmcnt(0)" ::: "memory");
}
}

namespace pk {
__device__ __forceinline__ void ce(int& a, int& b) { const int hi = max(a, b), lo = min(a, b); a = hi; b = lo; }
__device__ __forceinline__ void sort16(int (&v)[16]) {
#pragma unroll
    for (int k = 2; k <= 16; k <<= 1)
#pragma unroll
        for (int j = k >> 1; j > 0; j >>= 1)
#pragma unroll
            for (int i = 0; i < 16; ++i) { const int l = i ^ j; if (l > i) { if ((i & k) == 0) ce(v[i], v[l]); else ce(v[l], v[i]); } }
}
__device__ __forceinline__ void bmerge16(int (&c)[16]) {
#pragma unroll
    for (int j = 8; j > 0; j >>= 1)
#pragma unroll
        for (int i = 0; i < 16; ++i) { const int l = i ^ j; if (l > i) ce(c[i], c[l]); }
}
__device__ __forceinline__ void merge_top16(int (&a)[16], const int (&b)[16]) {
#pragma unroll
    for (int i = 0; i < 16; ++i) a[i] = max(a[i], b[15 - i]);
    bmerge16(a);
}
__device__ __forceinline__ int f2key(float f) { const int b = __float_as_int(f); return b ^ ((b >> 31) & 0x7fffffff); }
__device__ __forceinline__ float key2f(int k) { return __int_as_float(k ^ ((k >> 31) & 0x7fffffff)); }
}

#define XB_TMO      128
#define XB_XCNT(j)  (256  + 64 * (j))
#define XB_XSUB(j)  (1280 + 64 * (j))
#define XB_XGEN(j)  (2304 + 64 * (j))
#define XB_TOP      3328
#define XB_TOPGEN   3392
#define XCD_BAR_WORDS 3456
#define XB_SPIN_CAP (1u << 22)
__device__ __forceinline__ unsigned xb_ld(unsigned* p)              { return __hip_atomic_load(p, __ATOMIC_RELAXED, __HIP_MEMORY_SCOPE_AGENT); }
__device__ __forceinline__ unsigned xb_add(unsigned* p, unsigned v) { return __hip_atomic_fetch_add(p, v, __ATOMIC_RELAXED, __HIP_MEMORY_SCOPE_AGENT); }
__device__ __forceinline__ unsigned xb_xcc_id() { return (unsigned)__builtin_amdgcn_s_getreg((3 << 11) | 20) & 0xFu; }
#define XB_SPIN(cond, bar) do { unsigned _sp = 0; while (cond) { __builtin_amdgcn_s_sleep(1); \
    if ((++_sp & 255u) == 0u) { if (xb_ld(&(bar)[XB_TMO])) break; if (_sp > XB_SPIN_CAP) { atomicAdd(&(bar)[XB_TMO], 1u); break; } } } } while (0)
struct XcdBarrier { unsigned* bar; unsigned x; volatile LAS unsigned* st; };
__device__ __forceinline__ XcdBarrier xcd_barrier_post(unsigned* bar, volatile LAS unsigned* st) {
    XcdBarrier b; b.bar = bar; b.x = xb_xcc_id(); b.st = st;
    if (threadIdx.x == 0) (void)xb_add(&bar[XB_XCNT(b.x)], 1u);
    return b;
}
__device__ __forceinline__ void xcd_barrier_complete(unsigned* bar, unsigned x, unsigned& nloc, unsigned& nx) {
    const unsigned G = gridDim.x * gridDim.y * gridDim.z;
    unsigned sum, cnt, mine, sp = 0u;
    for (;;) {
        sum = 0u; cnt = 0u; mine = 0u;
#pragma unroll
        for (unsigned j = 0; j < 16; ++j) { const unsigned c = xb_ld(&bar[XB_XCNT(j)]); sum += c; cnt += (c > 0u) ? 1u : 0u; mine = (j == x) ? c : mine; }
        if (sum == G) break;
        __builtin_amdgcn_s_sleep(1);
        if ((++sp & 255u) == 0u) { if (xb_ld(&bar[XB_TMO])) break; if (sp > XB_SPIN_CAP) { atomicAdd(&bar[XB_TMO], 1u); break; } }
    }
    nloc = mine > 0u ? mine : 1u; nx = cnt > 0u ? cnt : 1u;
}
__device__ __forceinline__ void xcd_barrier(const XcdBarrier& b) {
    asm volatile("s_waitcnt vmcnt(0)" ::: "memory");
    __syncthreads();
    if (threadIdx.x == 0) {
        unsigned* bar = b.bar;
        __builtin_amdgcn_s_waitcnt(0);
        unsigned nloc = b.st[0], nx = b.st[1];
        if (nloc == 0u) { xcd_barrier_complete(bar, b.x, nloc, nx); b.st[0] = nloc; b.st[1] = nx; }
        const unsigned old = xb_add(&bar[XB_XSUB(b.x)], 1u);
        const unsigned gen = old / nloc;
        if (old + 1u == (gen + 1u) * nloc) {
            __builtin_amdgcn_fence(__ATOMIC_RELEASE, "agent");
            asm volatile("s_waitcnt vmcnt(0)" ::: "memory");
            const unsigned og = xb_add(&bar[XB_TOP], 1u);
            const unsigned tg = og / nx;
            if (og + 1u == (tg + 1u) * nx) xb_add(&bar[XB_TOPGEN], 1u);
            else XB_SPIN(xb_ld(&bar[XB_TOPGEN]) == tg, bar);
            __builtin_amdgcn_fence(__ATOMIC_ACQUIRE, "agent");
            xb_add(&bar[XB_XGEN(b.x)], 1u);
            asm volatile("s_waitcnt vmcnt(0)" ::: "memory");
        } else {
            XB_SPIN(xb_ld(&bar[XB_XGEN(b.x)]) == gen, bar);
            __builtin_amdgcn_fence(__ATOMIC_ACQUIRE, "agent");
            asm volatile("s_waitcnt vmcnt(0)" ::: "memory");
        }
    }
    __syncthreads();
}

struct Args { const float* in[22]; float* out; unsigned char* ws; int ph_lo, ph_hi; };
#if defined(NAIVE_PEER)
constexpr int N_PHASES = 12;
#else
constexpr int N_PHASES = 15;
#endif

__device__ __forceinline__ float gelu_erf(float v) { return 0.5f * v * (1.0f + erff(v * 0.70710678118654752f)); }

template <class Map>
__device__ __forceinline__ void transpose_item(const float* W, int K, int N, bf16_t* WT, const float* rscale, LAS float* scr, int item, int lane, Map dst_row) {
    const int nblk = N / 32, kb = item / nblk, nb = item % nblk, k0 = 64 * kb, n0 = 32 * nb;
    float tv[32];
#pragma unroll
    for (int i = 0; i < 32; ++i) tv[i] = W[(size_t)(k0 + 2 * i + (lane >> 5)) * N + n0 + (lane & 31)];
    if (rscale) {
#pragma unroll
        for (int i = 0; i < 32; ++i) tv[i] *= rscale[k0 + 2 * i + (lane >> 5)];
    }
#pragma unroll
    for (int i = 0; i < 32; ++i) scr[(2 * i + (lane >> 5)) * 33 + (lane & 31)] = tv[i];
    asm volatile("s_waitcnt lgkmcnt(0)" ::: "memory");
    const int c = lane & 7;
#pragma unroll
    for (int j = 0; j < 4; ++j) { const int n = (lane >> 3) + 8 * j; const LAS float* s = scr + (8 * c) * 33 + n;
        u32x4 o; o.x = cvtpk(s[0 * 33], s[1 * 33]); o.y = cvtpk(s[2 * 33], s[3 * 33]); o.z = cvtpk(s[4 * 33], s[5 * 33]); o.w = cvtpk(s[6 * 33], s[7 * 33]);
        *(u32x4*)(WT + (size_t)dst_row(n0 + n) * K + k0 + 8 * c) = o; }
    asm volatile("s_waitcnt lgkmcnt(0)" ::: "memory");
}
struct MapIn { __device__ __forceinline__ int operator()(int o) const {
    if (o < 2048) { const int e = o & 127; if (e < 32) { const int i = e & 15, n = e >> 4; return (o & ~127) + 8 * (i >> 2) + 4 * n + (i & 3); } return o; }
    if (o < 4096) return o;
    const int e = o - 4096, n = e >> 5, i = e & 31; return 4096 + 32 * (i >> 4) + 8 * ((i >> 2) & 3) + 4 * n + (i & 3); } };
struct MapUq { __device__ __forceinline__ int operator()(int o) const {
    const int hd = o / 192, e = o - hd * 192; if (e < 128) return hd * 128 + e;
    const int r = e - 128, n = r >> 5, i = r & 31; return 1024 + hd * 64 + 32 * (i >> 4) + 8 * ((i >> 2) & 3) + 4 * n + (i & 3); } };
struct MapOff { int off; __device__ __forceinline__ int operator()(int o) const { return o + off; } };

#define WS_PTRS \
    const float* x = AR.in[0]; \
    float* mod = (float*)(ws + WS_MOD); \
    float* ropeA = (float*)(ws + WS_ROPEA); float* ropeB = (float*)(ws + WS_ROPEB); \
    bf16_t* Win_t = (bf16_t*)(ws + WS_WIN); bf16_t* Wuq_t = (bf16_t*)(ws + WS_WUQ); bf16_t* Wukv_t = (bf16_t*)(ws + WS_WUKV); \
    bf16_t* Wo_t = (bf16_t*)(ws + WS_WO); bf16_t* Wpq_t = (bf16_t*)(ws + WS_WPQ); \
    bf16_t* UT = (bf16_t*)(ws + WS_UT); bf16_t* VT = (bf16_t*)(ws + WS_VT); \
    bf16_t* Hb = (bf16_t*)(ws + WS_A); bf16_t* So = (bf16_t*)(ws + WS_A); bf16_t* Qp = (bf16_t*)(ws + WS_A); \
    bf16_t* QA = (bf16_t*)(ws + WS_QA); bf16_t* KA = (bf16_t*)(ws + WS_KA); bf16_t* VA = (bf16_t*)(ws + WS_VA); \
    bf16_t* CQ = (bf16_t*)(ws + WS_CQ); bf16_t* CKV = (bf16_t*)(ws + WS_CKV); bf16_t* KR = (bf16_t*)(ws + WS_KR); \
    float* Y = (float*)(ws + WS_Y); bf16_t* MIXb = (bf16_t*)(ws + WS_Y); \
    bf16_t* Qn = (bf16_t*)(ws + WS_QN); bf16_t* Qr = (bf16_t*)(ws + WS_QR); bf16_t* Kn = (bf16_t*)(ws + WS_KN); bf16_t* Vb = (bf16_t*)(ws + WS_VB); \
    bf16_t* H2 = (bf16_t*)(ws + WS_H2); bf16_t* Ob = (bf16_t*)(ws + WS_O); \
    float* ssq_q = (float*)(ws + WS_SSQ_Q); float* ssq_kv = (float*)(ws + WS_SSQ_KV); float* ssq_o = (float*)(ws + WS_SSQ_O); \
    float* Sm = (float*)(ws + WS_SM); float* Sl = (float*)(ws + WS_SL); \
    bf16_t* K1b = (bf16_t*)(ws + WS_K1); bf16_t* K2b = (bf16_t*)(ws + WS_K2); \
    unsigned short* IDX = (unsigned short*)(ws + WS_IDX); float* Gt = (float*)(ws + WS_G); \
    float* SU = (float*)(ws + WS_SU); float* SH = (float*)(ws + WS_SH); \
    unsigned char* U8 = ws + WS_U8; unsigned char* H8 = ws + WS_H8; \
    float* PART = (float*)(ws + WS_PART); unsigned short* IDX2 = (unsigned short*)(ws + WS_IDX2); unsigned char* WTq = ws + WS_WT; float* WSC = (float*)(ws + WS_WT + 8 * MiB); \
    bf16_t* FFN = (bf16_t*)(ws + WS_FFN); bf16_t* X1b = (bf16_t*)(ws + WS_X1); unsigned char* H2S = ws + WS_H2S;

__global__ void __launch_bounds__(NWAVES * 64, 2) mega_fwd(Args args) {
    extern __shared__ __attribute__((aligned(16))) unsigned char lds_raw[];
    LAS unsigned char* lds = (LAS unsigned char*)lds_raw;
    const int G = gridDim.x, bid = blockIdx.x, NGW = G * NWAVES;
    const int wave0 = __builtin_amdgcn_readfirstlane((int)threadIdx.x >> 6);
#define PH_LOCALS const int lane = opaque((int)__builtin_amdgcn_mbcnt_hi(~0u, __builtin_amdgcn_mbcnt_lo(~0u, 0u))), wave = wave0, tid = wave * 64 + lane, gw = bid * NWAVES + wave; (void)gw; \
    const __attribute__((address_space(4))) Args* arp_ = (const __attribute__((address_space(4))) Args*)__builtin_amdgcn_kernarg_segment_ptr(); asm volatile("" : "+s"(arp_)); const __attribute__((address_space(4))) Args& AR = *arp_; unsigned char* ws = AR.ws; WS_PTRS
    unsigned char* ws0 = args.ws;
    const int lo = args.ph_lo, hi_ph = args.ph_hi;
    if (threadIdx.x < 4) ((LAS unsigned*)(lds + LDS_BYTES - 16))[threadIdx.x] = 0u;
    __syncthreads();
    XcdBarrier xbar = xcd_barrier_post((unsigned*)ws0, (volatile LAS unsigned*)(lds + LDS_BYTES - 16));
#ifdef ONLY_PH
#define IN(k) ((k) == ONLY_PH && lo <= (k) && (k) < hi_ph)
#else
#define IN(k) (lo <= (k) && (k) < hi_ph)
#endif
#if MK_N_LAUNCHES == 1
#define GRID_BAR(k) do { if (IN(k) && IN((k) + 1)) { if ((k) == 0) cg::this_grid().sync(); else xcd_barrier(xbar); } } while (0)
#else
#define GRID_BAR(k) do { } while (0)
#endif
    for (int rep_ = 0; rep_ < (IN(0) ? 1 + ((REP_MASK >> 0) & 1) : 0); ++rep_) {
        PH_LOCALS;
        for (int cb = bid; cb < 192; cb += G) {
            LAS float* cact = (LAS float*)lds;
            const float* cin = AR.in[1];
            for (int i = tid; i < 16 * 2048; i += NWAVES * 64) { const float v = cin[i]; cact[i] = v / (1.0f + __expf(-v)); }
            __syncthreads();
            const int col = cb * 64 + lane;
            float acc[16];
#pragma unroll
            for (int b = 0; b < 16; ++b) acc[b] = 0.f;
            const float* wp = AR.in[2] + (size_t)(wave * 256) * 12288 + col;
            for (int k0 = 0; k0 < 256; k0 += 16) {
                float w[16];
#pragma unroll
                for (int i = 0; i < 16; ++i) w[i] = wp[(size_t)(k0 + i) * 12288];
#pragma unroll
                for (int b = 0; b < 16; ++b) {
#pragma unroll
                    for (int i4 = 0; i4 < 4; ++i4) { const f32x4 cv = *(const LAS f32x4*)(cact + b * 2048 + wave * 256 + k0 + 4 * i4);
                        acc[b] += cv[0] * w[4 * i4] + cv[1] * w[4 * i4 + 1] + cv[2] * w[4 * i4 + 2] + cv[3] * w[4 * i4 + 3]; }
                }
            }
            __syncthreads();
            LAS float* red = (LAS float*)lds;
#pragma unroll
            for (int b = 0; b < 16; ++b) red[(wave * 16 + b) * 64 + lane] = acc[b];
            __syncthreads();
            for (int o = tid; o < 1024; o += NWAVES * 64) { const int b = o >> 6, cl = o & 63; float s = 0.f;
#pragma unroll
                for (int w = 0; w < 8; ++w) s += red[(w * 16 + b) * 64 + cl];
                mod[(size_t)b * 12288 + cb * 64 + cl] = s + AR.in[3][cb * 64 + cl]; }
            __syncthreads();
        }
        {
            LAS float* scr = (LAS float*)(lds + wave * 16384);
            constexpr int I_IN = 32 * 130, I_UQ = 8 * 48, I_UK = 8 * 32, I_UV = 8 * 32, I_O = 32 * 64, I_PQ = 32 * 64;
            constexpr int NITEMS = I_IN + I_UQ + I_UK + I_UV + I_O + I_PQ;
            for (int it = gw; it < NITEMS; it += NGW) {
                int r = it;
                if (r < I_IN) { transpose_item(AR.in[4], 2048, NPROJ, Win_t, (const float*)nullptr, scr, r, lane, MapIn{}); continue; } r -= I_IN;
                if (r < I_UQ) { transpose_item(AR.in[7], 512, 1536, Wuq_t, AR.in[5], scr, r, lane, MapUq{}); continue; } r -= I_UQ;
                if (r < I_UK) { transpose_item(AR.in[8], 512, 1024, Wukv_t, AR.in[6], scr, r, lane, MapOff{0}); continue; } r -= I_UK;
                if (r < I_UV) { transpose_item(AR.in[9], 512, 1024, Wukv_t, AR.in[6], scr, r, lane, MapOff{1024}); continue; } r -= I_UV;
                if (r < I_O) { const int kb = r / 64; transpose_item(AR.in[12], 2048, 2048, Wo_t, kb < 16 ? AR.in[10] : AR.in[11] - 1024, scr, r, lane, MapOff{0}); continue; } r -= I_O;
                transpose_item(AR.in[15], 2048, 2048, Wpq_t, (const float*)nullptr, scr, r, lane, MapOff{0});
            }
            for (size_t i = (size_t)gw * 64 + lane; i < (size_t)(NPROJ_PAD - NPROJ) * 2048 / 8; i += (size_t)NGW * 64)
                *(u32x4*)(Win_t + (size_t)NPROJ * 2048 + i * 8) = (u32x4){0u, 0u, 0u, 0u};
        }
#if defined(NAIVE_PEER)
        for (int r = gw; r < 2 * NE; r += NGW) {
            const float* src = (r < NE ? AR.in[18] : AR.in[19]) + (size_t)(r & (NE - 1)) * 2048;
            bf16_t* dst = (r < NE ? UT : VT) + (size_t)(r & (NE - 1)) * 2048;
            f32x4 v[8];
#pragma unroll
            for (int c = 0; c < 4; ++c) { const f32x4* p = (const f32x4*)(src + c * 512 + lane * 8); v[2 * c] = p[0]; v[2 * c + 1] = p[1]; }
#pragma unroll
            for (int c = 0; c < 4; ++c) pg8::store8(dst + c * 512 + lane * 8, v[2 * c], v[2 * c + 1]);
        }
#else
        {
            f32x4 nv[8];
#define TB_LOAD(rr) do { const float* src_ = (((rr) >> 14) ? AR.in[19] : AR.in[18]) + (size_t)((rr) & (NE - 1)) * 2048; \
                _Pragma("unroll") for (int c = 0; c < 4; ++c) { const f32x4* p_ = (const f32x4*)(src_ + c * 512 + lane * 8); nv[2 * c] = p_[0]; nv[2 * c + 1] = p_[1]; } } while (0)
            if (gw < 2 * NE) TB_LOAD(gw);
            for (int r = gw; r < 2 * NE; r += NGW) {
                const int tbl = r >> 14, e = r & (NE - 1);
                f32x4 v[8]; float mx = 0.f, sq = 0.f;
#pragma unroll
                for (int i = 0; i < 8; ++i) { v[i] = nv[i]; mx = fmaxf(fmaxf(mx, fmaxf(fabsf(v[i][0]), fabsf(v[i][1]))), fmaxf(fabsf(v[i][2]), fabsf(v[i][3])));
                    sq += (v[i][0] * v[i][0] + v[i][1] * v[i][1]) + (v[i][2] * v[i][2] + v[i][3] * v[i][3]); }
                if (r + NGW < 2 * NE) TB_LOAD(r + NGW);
                mx = wmax(mx);
                if (tbl == 0) {
                    const float rms = sqrtf(wsum(sq) * (1.0f / 2048.0f));
                    const float step = rms > 0.f ? fmaxf(0.335f * rms, mx * (1.0f / 64.0f)) : 1.0f;
                    const float inv = 1.0f / step;
                    if (lane == 0) SU[e] = step;
                    unsigned char* dst = U8 + (size_t)e * 128 + (lane & 31) * 4;
#pragma unroll
                    for (int c = 0; c < 4; ++c) { unsigned w = 0u;
#pragma unroll
                        for (int i = 0; i < 4; ++i) { const float a = v[2 * c][i] * inv, b = v[2 * c + 1][i] * inv;
                            const int qa = (int)__builtin_rintf(fminf(fmaxf(a, -7.f), 7.f)) + 8, qb = (int)__builtin_rintf(fminf(fmaxf(b, -7.f), 7.f)) + 8;
                            w |= ((unsigned)qa | ((unsigned)qb << 4)) << (8 * i); }
                        *(unsigned*)(dst + (size_t)(c * 2 + (lane >> 5)) * (2u << 20)) = w; }
                } else {
                    const float sc = mx > 0.f ? 127.0f / mx : 1.0f;
                    if (lane == 0) SU[NE + e] = mx > 0.f ? mx * (1.0f / 127.0f) : 1.0f;
                    unsigned char* dst = U8 + (size_t)(32u << 20) + (size_t)e * 128 + (lane & 15) * 8;
#pragma unroll
                    for (int c = 0; c < 4; ++c) { const f32x4 a = v[2 * c] * sc, b = v[2 * c + 1] * sc;
                        u32x2 w; w.x = pack_i8x4(a[0], a[1], a[2], a[3]); w.y = pack_i8x4(b[0], b[1], b[2], b[3]);
                        *(u32x2*)(dst + (size_t)(c * 4 + (lane >> 4)) * (2u << 20)) = w; }
                }
            }
#undef TB_LOAD
        }
#endif
        for (int i = gw * 64 + lane; i < 2 * 16384; i += NGW * 64) {
            const float v = (i < 16384 ? AR.in[16] : AR.in[17])[i & 16383];
            (i < 16384 ? K1b : K2b)[i & 16383] = (bf16_t)(cvtpk(v, v) & 0xffffu);
        }
    }
    GRID_BAR(0);

    for (int rep_ = 0; rep_ < (IN(1) ? 1 + ((REP_MASK >> 1) & 1) : 0); ++rep_) {
        PH_LOCALS;
        f32x4 nv[8];
        { const f32x4* xr = (const f32x4*)(x + (size_t)gw * DM) + lane;
#pragma unroll
          for (int j = 0; j < 8; ++j) nv[j] = xr[64 * j]; }
        for (int row = gw; row < T; row += NGW) {
            const int b = row >> 11;
            f32x4 v[8]; float s = 0.f;
#pragma unroll
            for (int j = 0; j < 8; ++j) { v[j] = nv[j]; s += (v[j][0] + v[j][1]) + (v[j][2] + v[j][3]); }
            if (row + NGW < T) { const f32x4* xr = (const f32x4*)(x + (size_t)(row + NGW) * DM) + lane;
#pragma unroll
                for (int j = 0; j < 8; ++j) nv[j] = xr[64 * j]; }
            const float mean = wsum(s) * (1.0f / DM); float s2 = 0.f;
#pragma unroll
            for (int j = 0; j < 8; ++j) { v[j] = v[j] - mean; s2 += (v[j][0] * v[j][0] + v[j][1] * v[j][1]) + (v[j][2] * v[j][2] + v[j][3] * v[j][3]); }
            const float rstd = 1.0f / sqrtf(wsum(s2) * (1.0f / DM) + 1e-5f);
            const float* mb = mod + (size_t)b * 12288;
#pragma unroll
            for (int j = 0; j < 8; ++j) { const int d = 4 * (lane + 64 * j);
                const f32x4 sh = *(const f32x4*)(mb + d), sc = *(const f32x4*)(mb + 2048 + d);
                const f32x4 y = v[j] * rstd * (sc + 1.0f) + sh;
                u32x2 w; w.x = cvtpk(y[0], y[1]); w.y = cvtpk(y[2], y[3]);
                *(u32x2*)(Hb + (size_t)row * DM + d) = w; }
        }
    }
    GRID_BAR(1);

    for (int rep_ = 0; rep_ < (IN(2) ? 1 + ((REP_MASK >> 2) & 1) : 0); ++rep_) {
        PH_LOCALS;
        pg8::Gemm g{Hb, Win_t, T, NPROJ_PAD, DM}; pg8::StaticOrder S; S.init(T, NPROJ_PAD, G, bid);
        pg8::EpiProj E{QA, CQ, KR, ssq_q};
        pg8::gemm_phase(tid, lds, g, S, E);
    }
    GRID_BAR(2);

    for (int rep_ = 0; rep_ < (IN(3) ? 1 + ((REP_MASK >> 3) & 1) : 0); ++rep_) {
        PH_LOCALS;
        LAS float* tab = (LAS float*)(lds + pg8::STAGE_BYTES);
        { pg8::Gemm g{CQ, Wuq_t, T, 1536, 512}; pg8::StaticOrder S; S.init(T, 1536, G, bid);
          if (tid < 256) {
              float qv[4][8]; bool ok[4];
#pragma unroll
              for (int i = 0; i < 4; ++i) { pg8::Unit u; ok[i] = S.next(i, u); const int row = (ok[i] ? u.pm : 0) * 256 + tid;
#pragma unroll
                  for (int sl = 0; sl < 8; ++sl) qv[i][sl] = ssq_q[(size_t)sl * T + row]; }
#pragma unroll
              for (int i = 0; i < 4; ++i) if (ok[i]) { float q = 0.f;
#pragma unroll
                  for (int sl = 0; sl < 8; ++sl) q += qv[i][sl];
                  tab[i * 256 + tid] = 1.0f / sqrtf(q * (1.0f / 512.0f) + 1e-6f); } }
          __syncthreads();
          pg8::EpiQ E{Qn, Qr, tab}; pg8::gemm_phase(tid, lds, g, S, E); }
        __syncthreads();
        { pg8::Gemm g{CKV, Wukv_t, T, 2048, 512}; pg8::StaticOrder S; S.init(T, 2048, G, bid);
          if (tid < 256) {
              float qv[4][8]; bool ok[4];
#pragma unroll
              for (int i = 0; i < 4; ++i) { pg8::Unit u; ok[i] = S.next(i, u); const int row = (ok[i] ? u.pm : 0) * 256 + tid;
#pragma unroll
                  for (int sl = 0; sl < 8; ++sl) qv[i][sl] = ssq_kv[(size_t)sl * T + row]; }
#pragma unroll
              for (int i = 0; i < 4; ++i) if (ok[i]) { float q = 0.f;
#pragma unroll
                  for (int sl = 0; sl < 8; ++sl) q += qv[i][sl];
                  tab[i * 256 + tid] = 1.0f / sqrtf(q * (1.0f / 512.0f) + 1e-6f); } }
          __syncthreads();
          pg8::EpiKV E{Kn, Vb, tab}; pg8::gemm_phase(tid, lds, g, S, E); }
    }
    GRID_BAR(3);


#if defined(NAIVE_ATTN)
    for (int rep_ = 0; rep_ < (IN(4) ? 1 + ((REP_MASK >> 4) & 1) : 0); ++rep_) {
        PH_LOCALS;
        for (int it = gw; it < T * 8; it += NGW) {
            const int t = it >> 3, h = it & 7, b = t >> 11, s = t & 2047;
            {
                const unsigned qv = *(const unsigned*)(QA + (size_t)t * 1024 + h * 128 + 2 * lane);
                const float q0 = bf_lo(qv), q1 = bf_hi(qv);
                float m = -1e30f, l = 0.f, a0 = 0.f, a1 = 0.f;
                for (int br = 0; br < 3; ++br) { const int dil = br == 0 ? 1 : (br == 1 ? 4 : 16);
                    for (int j = 0; j <= 128; ++j) { const int sk = s - j * dil; if (sk < 0) break;
                        const size_t tk = (size_t)b * SEQ + sk;
                        const unsigned kv = *(const unsigned*)(KA + tk * 1024 + h * 128 + 2 * lane);
                        const unsigned vv = *(const unsigned*)(VA + tk * 1024 + h * 128 + 2 * lane);
                        const float sc = wave_sum(q0 * bf_lo(kv) + q1 * bf_hi(kv)) * 0.08838834764831845f;
                        const float mn = fmaxf(m, sc), corr = __expf(m - mn), pp = __expf(sc - mn);
                        l = l * corr + pp; a0 = a0 * corr + pp * bf_lo(vv); a1 = a1 * corr + pp * bf_hi(vv); m = mn; } }
                const float r0 = a0 / l, r1 = a1 / l;
                *(unsigned*)(Ob + (size_t)t * 2048 + h * 128 + 2 * lane) = cvtpk(r0, r1);
                const float sq = wave_sum(r0 * r0 + r1 * r1);
                if (lane == 0) ssq_o[(size_t)t * 16 + h] = sq;
            }
            {
                const unsigned qv = *(const unsigned*)(Qn + (size_t)t * 1024 + h * 128 + 2 * lane);
                const float q0 = bf_lo(qv), q1 = bf_hi(qv);
                const unsigned short qrv = Qr[(size_t)t * 512 + h * 64 + lane]; const float qr0 = __uint_as_float((unsigned)qrv << 16);
                float m = -1e30f, l = 0.f, a0 = 0.f, a1 = 0.f;
                for (int sk = 0; sk <= s; ++sk) { const size_t tk = (size_t)b * SEQ + sk;
                    const unsigned kv = *(const unsigned*)(Kn + tk * 1024 + h * 128 + 2 * lane);
                    const unsigned vv = *(const unsigned*)(Vb + tk * 1024 + h * 128 + 2 * lane);
                    const float krv = __uint_as_float((unsigned)KR[tk * 64 + lane] << 16);
                    const float sc = wave_sum(q0 * bf_lo(kv) + q1 * bf_hi(kv) + qr0 * krv) * 0.07216878364870322f;
                    const float mn = fmaxf(m, sc), corr = __expf(m - mn), pp = __expf(sc - mn);
                    l = l * corr + pp; a0 = a0 * corr + pp * bf_lo(vv); a1 = a1 * corr + pp * bf_hi(vv); m = mn; }
                const float r0 = a0 / l, r1 = a1 / l;
                *(unsigned*)(Ob + (size_t)t * 2048 + 1024 + h * 128 + 2 * lane) = cvtpk(r0, r1);
                const float sq = wave_sum(r0 * r0 + r1 * r1);
                if (lane == 0) ssq_o[(size_t)t * 16 + 8 + h] = sq;
            }
        }
    }
#else
    for (int rep_ = 0; rep_ < (IN(4) ? 1 + ((REP_MASK >> 4) & 1) : 0); ++rep_) {
        PH_LOCALS;
        att::Tens XA{QA, nullptr, KA, nullptr, VA, So, Sm, Sl, Ob, 0, ssq_o, 0};
        {
            LAS unsigned char* wl = lds + wave * 17408; LAS float* wsf = (LAS float*)(lds + 8 * 17408) + wave * 64;
            for (int repa = 0; repa < 1 + ((REP_MASK >> 16) & 1); ++repa)
            for (int u = bid; u < 512; u += G) {
                const int J = (u >> 3) & 3, bh = (u & 7) + 8 * (u >> 5), b = bh >> 3, h = bh & 7;
#pragma unroll 1
                for (int br = 0; br < 3; ++br) {
#pragma unroll 1
                    for (int k = 0; k < 2; ++k) { const int wu = wave + 8 * k;
                        att::WaveA P;
                        P.b = b; P.h = h; P.mode = br == 0 ? 0 : (br == 1 ? 1 : 3);
                        if (br == 0) { P.dil = 1; P.rho = 0; P.qpos0 = 512 * J + 32 * wu; }
                        else if (br == 1) { P.dil = 4; P.rho = wu >> 2; P.qpos0 = 128 * J + 32 * (wu & 3); }
                        else { P.dil = 16; P.rho = wu; P.qpos0 = 32 * J; }
                        att::attnA_wave(lane, P, wl, wsf, XA); }
                    asm volatile("s_waitcnt vmcnt(0)" ::: "memory");
                    __syncthreads();
                }
            }
            __syncthreads();
        }
        att::Tens XB{Qn, Qr, Kn, KR, Vb, nullptr, nullptr, nullptr, Ob, 1024, ssq_o, 8};
        for (int repb = 0; repb < 1 + ((REP_MASK >> 17) & 1); ++repb)
        for (int i = 0; i < 4 * ((1024 + 4 * G - 1) / (4 * G)); ++i) {
            const int v = bid + (i >> 2) * G; if (v >= 256) break;
            const int bh = (v & 7) + 8 * (v >> 4), s = (v >> 3) & 1, ii = i & 3;
            const int qt = ii == 0 ? 2 * s : (ii == 1 ? 2 * s + 1 : (ii == 2 ? 7 - 2 * s : 6 - 2 * s));
            att::UnitP P{bh >> 3, bh & 7, 1, 0, 1, 256 * qt, 0, 4 * (qt + 1), 1 << 28, 2};
            att::attn_unit<true>(tid, P, lds, XB);
        }
    }
    GRID_BAR(4);


#endif

    for (int rep_ = 0; rep_ < (IN(7) ? 1 + ((REP_MASK >> 7) & 1) : 0); ++rep_) {
        PH_LOCALS;
        pg8::Gemm g{Ob, Wo_t, T, DM, DM}; pg8::StaticOrder S; S.init(T, DM, G, bid);
        LAS float* tab = (LAS float*)(lds + pg8::STAGE_BYTES);
        if (tid < 256) {
            f32x4 sv[4][4]; bool ok[4];
#pragma unroll
            for (int i = 0; i < 4; ++i) { pg8::Unit u; ok[i] = S.next(i, u); const int row = (ok[i] ? u.pm : 0) * 256 + tid; const f32x4* p4 = (const f32x4*)(ssq_o + (size_t)row * 16);
                sv[i][0] = p4[0]; sv[i][1] = p4[1]; sv[i][2] = p4[2]; sv[i][3] = p4[3]; }
#pragma unroll
            for (int i = 0; i < 4; ++i) if (ok[i]) { const f32x4 a0 = sv[i][0], a1 = sv[i][1], b0 = sv[i][2], b1 = sv[i][3];
                const float sa = (a0[0] + a0[1]) + (a0[2] + a0[3]) + (a1[0] + a1[1]) + (a1[2] + a1[3]);
                const float sb = (b0[0] + b0[1]) + (b0[2] + b0[3]) + (b1[0] + b1[1]) + (b1[2] + b1[3]);
                const float ra = 1.0f / sqrtf(sa * (1.0f / 1024.0f) + 1e-6f), rb = 1.0f / sqrtf(sb * (1.0f / 1024.0f) + 1e-6f);
                tab[(i * 256 + tid) * 2] = ra / rb; tab[(i * 256 + tid) * 2 + 1] = rb; } }
        __syncthreads();
        pg8::EpiMix E{MIXb, tab}; pg8::gemm_phase(tid, lds, g, S, E);
    }
    GRID_BAR(7);

    for (int rep_ = 0; rep_ < (IN(8) ? 1 + ((REP_MASK >> 8) & 1) : 0); ++rep_) {
        PH_LOCALS;
        const float* lg = AR.in[13]; const float* lb = AR.in[14];
        f32x4 nx[8], ng[8]; u32x2 nm[8];
#define P8_LOAD(rr) do { const f32x4* xr_ = (const f32x4*)(x + (size_t)(rr) * DM) + lane; const u32x2* mr_ = (const u32x2*)(MIXb + (size_t)(rr) * DM) + lane; \
            const f32x4* gr_ = (const f32x4*)(mod + (size_t)((rr) >> 11) * 12288 + 4096) + lane; \
            _Pragma("unroll") for (int j = 0; j < 8; ++j) { nx[j] = xr_[64 * j]; nm[j] = mr_[64 * j]; ng[j] = gr_[64 * j]; } } while (0)
        P8_LOAD(gw);
        for (int row = gw; row < T; row += NGW) {
            const int b = row >> 11;
            f32x4 v[8]; float s = 0.f;
#pragma unroll
            for (int j = 0; j < 8; ++j) { const f32x4 xv = nx[j], gv = ng[j]; const unsigned m0 = nm[j].x, m1 = nm[j].y;
                v[j][0] = xv[0] * DN_ALPHA + gv[0] * bf_lo(m0) * DBG_MIX; v[j][1] = xv[1] * DN_ALPHA + gv[1] * bf_hi(m0) * DBG_MIX;
                v[j][2] = xv[2] * DN_ALPHA + gv[2] * bf_lo(m1) * DBG_MIX; v[j][3] = xv[3] * DN_ALPHA + gv[3] * bf_hi(m1) * DBG_MIX;
                s += (v[j][0] + v[j][1]) + (v[j][2] + v[j][3]); }
            if (row + NGW < T) P8_LOAD(row + NGW);
            float mean = wsum(s) * (1.0f / DM); float s2 = 0.f;
#pragma unroll
            for (int j = 0; j < 8; ++j) { v[j] = v[j] - mean; s2 += (v[j][0] * v[j][0] + v[j][1] * v[j][1]) + (v[j][2] * v[j][2] + v[j][3] * v[j][3]); }
            float rstd = 1.0f / sqrtf(wsum(s2) * (1.0f / DM) + 1e-5f);
            s = 0.f;
#pragma unroll
            for (int j = 0; j < 8; ++j) { const int d = 4 * (lane + 64 * j);
                v[j] = v[j] * rstd * *(const f32x4*)(lg + d) + *(const f32x4*)(lb + d);
#if defined(NAIVE_PEER)
                *(f32x4*)(AR.out + (size_t)row * DM + d) = v[j];
#else
                { u32x2 w1; w1.x = cvtpk(v[j][0], v[j][1]); w1.y = cvtpk(v[j][2], v[j][3]); *(u32x2*)(X1b + (size_t)row * DM + d) = w1; }
#endif
                s += (v[j][0] + v[j][1]) + (v[j][2] + v[j][3]); }
            mean = wsum(s) * (1.0f / DM); s2 = 0.f;
#pragma unroll
            for (int j = 0; j < 8; ++j) { v[j] = v[j] - mean; s2 += (v[j][0] * v[j][0] + v[j][1] * v[j][1]) + (v[j][2] * v[j][2] + v[j][3] * v[j][3]); }
            rstd = 1.0f / sqrtf(wsum(s2) * (1.0f / DM) + 1e-5f);
            const float* mb = mod + (size_t)b * 12288;
#pragma unroll
            for (int j = 0; j < 8; ++j) { const int d = 4 * (lane + 64 * j);
                const f32x4 sh = *(const f32x4*)(mb + 6144 + d), sc = *(const f32x4*)(mb + 8192 + d);
                const f32x4 y = v[j] * rstd * (sc + 1.0f) + sh; v[j] = y;
                u32x2 w; w.x = cvtpk(y[0], y[1]); w.y = cvtpk(y[2], y[3]);
                *(u32x2*)(H2 + (size_t)row * DM + d) = w; }
#if !defined(NAIVE_PEER)
            {
                float mx = 0.f;
#pragma unroll
                for (int j = 0; j < 8; ++j) mx = fmaxf(fmaxf(mx, fmaxf(fabsf(v[j][0]), fabsf(v[j][1]))), fmaxf(fabsf(v[j][2]), fabsf(v[j][3])));
                mx = wmax(mx);
                const float hs = mx > 0.f ? 127.0f / mx : 1.0f;
                if (lane == 0) SH[row] = mx > 0.f ? mx * (1.0f / 127.0f) : 1.0f;
#pragma unroll
                for (int j = 0; j < 8; ++j) { const int d = 4 * (lane + 64 * j); const f32x4 y = v[j] * hs;
                    *(unsigned*)(H2S + ((size_t)(d >> 8) * T + row) * 256 + (d & 255)) = pack_i8x4(y[0], y[1], y[2], y[3]); }
            }
#endif
        }
    }
    GRID_BAR(8);

    for (int rep_ = 0; rep_ < (IN(9) ? 1 + ((REP_MASK >> 9) & 1) : 0); ++rep_) {
        PH_LOCALS;
        pg8::Gemm g{H2, Wpq_t, T, DM, DM}; pg8::StaticOrder S; S.init(T, DM, G, bid);
        pg8::EpiPlain E{Qp, DM}; pg8::gemm_phase(tid, lds, g, S, E);
    }
    GRID_BAR(9);


#if defined(NAIVE_TOPK)
    for (int rep_ = 0; rep_ < (IN(10) ? 1 + ((REP_MASK >> 10) & 1) : 0); ++rep_) {
        PH_LOCALS;
        LAS float* vs = (LAS float*)(lds + wave * 256);
        for (int it = gw; it < T * 8; it += NGW) {
            const int t = it >> 3, h = it & 7;
            float sA[2][2];
#pragma unroll
            for (int half = 0; half < 2; ++half) {
                const bf16_t* qp = Qp + (size_t)t * DM + h * 256 + half * 128;
                const float* kp = half ? AR.in[17] : AR.in[16];
                float s0 = 0.f, s1 = 0.f;
                for (int d = 0; d < 128; ++d) { const float qv = __uint_as_float((unsigned)qp[d] << 16); s0 += qv * kp[lane * 128 + d]; s1 += qv * kp[(lane + 64) * 128 + d]; }
                sA[half][0] = s0; sA[half][1] = s1;
            }
#pragma unroll
            for (int half = 0; half < 2; ++half) {
                float c0 = sA[half][0], c1 = sA[half][1];
                for (int r = 0; r < 16; ++r) {
                    float bv = fmaxf(c0, c1); int bi = (c0 >= c1) ? lane : lane + 64;
#pragma unroll
                    for (int o = 1; o < 64; o <<= 1) { const float ov = __shfl_xor(bv, o); const int oi = __shfl_xor(bi, o); if (ov > bv || (ov == bv && oi < bi)) { bv = ov; bi = oi; } }
                    if (lane == 0) { vs[half * 16 + r] = bv; ((LAS int*)vs)[32 + half * 16 + r] = bi; }
                    if (bi == lane) c0 = -INFINITY; if (bi == lane + 64) c1 = -INFINITY;
                }
            }
            asm volatile("s_waitcnt lgkmcnt(0)" ::: "memory");
            float cd[4];
#pragma unroll
            for (int m2 = 0; m2 < 4; ++m2) { const int c = lane + 64 * m2; cd[m2] = vs[c >> 4] + vs[16 + (c & 15)]; }
            float val[16]; int ci[16];
#pragma unroll
            for (int r = 0; r < 16; ++r) {
                float bv = cd[0]; int bi = lane;
#pragma unroll
                for (int m2 = 1; m2 < 4; ++m2) if (cd[m2] > bv) { bv = cd[m2]; bi = lane + 64 * m2; }
#pragma unroll
                for (int o = 1; o < 64; o <<= 1) { const float ov = __shfl_xor(bv, o); const int oi = __shfl_xor(bi, o); if (ov > bv || (ov == bv && oi < bi)) { bv = ov; bi = oi; } }
                val[r] = bv; ci[r] = bi;
#pragma unroll
                for (int m2 = 0; m2 < 4; ++m2) if (bi == lane + 64 * m2) cd[m2] = -INFINITY;
            }
            float se = 0.f, e[16];
#pragma unroll
            for (int r = 0; r < 16; ++r) { e[r] = __expf(val[r] - val[0]); se += e[r]; }
            if (lane < 16) {
                float ev = 0.f; int cc = 0;
#pragma unroll
                for (int r = 0; r < 16; ++r) if (lane == r) { ev = e[r]; cc = ci[r]; }
                const int i1 = ((LAS int*)vs)[32 + (cc >> 4)], i2 = ((LAS int*)vs)[48 + (cc & 15)];
                IDX[((size_t)t * 8 + h) * 16 + lane] = (unsigned short)(i1 * 128 + i2);
                Gt[((size_t)t * 8 + h) * 16 + lane] = ev / se;
            }
            asm volatile("s_waitcnt lgkmcnt(0)" ::: "memory");
        }
    }
#else
    for (int rep_ = 0; rep_ < (IN(10) ? 1 + ((REP_MASK >> 10) & 1) : 0); ++rep_) {
        PH_LOCALS;
        for (int i = tid; i < 2 * 128 * 16; i += NWAVES * 64) { const int t2 = i >> 11, rem = i & 2047, key = rem >> 4, ch = rem & 15;
            const bf16x8 v = *(const bf16x8*)((t2 ? K2b : K1b) + key * 128 + ch * 8);
            *(LAS bf16x8*)(lds + t2 * 32768 + KSWZ(key, ch * 16)) = v; }
        __syncthreads();
        const int r32 = lane & 31, hi = lane >> 5;
        LAS unsigned char* tb8 = lds + 65536 + wave * 2048 + lane * 32;
        for (int tg = bid; tg < T / 32; tg += G) {
            const int tok = tg * 32 + r32;
            int v12[2][16];
#pragma unroll
            for (int half = 0; half < 2; ++half) {
                const bf16_t* qp = Qp + (size_t)tok * DM + wave * 256 + half * 128 + hi * 8;
                bf16x8 qf[8];
#pragma unroll
                for (int d0 = 0; d0 < 8; ++d0) qf[d0] = *(const bf16x8*)(qp + d0 * 16);
                int best[16];
#pragma unroll
                for (int kb = 0; kb < 4; ++kb) {
                    f32x16 acc = f32x16{};
#pragma unroll
                    for (int d0 = 0; d0 < 8; ++d0) { const bf16x8 a = *(const LAS bf16x8*)(lds + half * 32768 + KSWZ(32 * kb + r32, (d0 * 16 + hi * 8) * 2));
                        acc = __builtin_amdgcn_mfma_f32_32x32x16_bf16(a, qf[d0], acc, 0, 0, 0); }
                    int cur[16];
#pragma unroll
                    for (int r = 0; r < 16; ++r) cur[r] = (pk::f2key(acc[r]) & ~127) | (32 * kb + (r & 3) + 8 * (r >> 2) + 4 * hi);
                    pk::sort16(cur);
                    if (kb == 0) {
#pragma unroll
                        for (int r = 0; r < 16; ++r) best[r] = cur[r];
                    } else pk::merge_top16(best, cur);
                }
                int oth[16], mine[16];
#pragma unroll
                for (int r = 0; r < 16; ++r) { auto sw = __builtin_amdgcn_permlane32_swap((unsigned)best[r], (unsigned)best[r], false, false); mine[r] = (int)sw[0]; oth[r] = (int)sw[1]; }
                pk::merge_top16(mine, oth);
#pragma unroll
                for (int r = 0; r < 16; ++r) v12[half][r] = mine[r];
            }
            {
                u32x4 w0, w1;
#pragma unroll
                for (int q = 0; q < 4; ++q) {
                    w0[q] = (unsigned)(v12[0][4 * q] & 127) | ((unsigned)(v12[0][4 * q + 1] & 127) << 8) | ((unsigned)(v12[0][4 * q + 2] & 127) << 16) | ((unsigned)(v12[0][4 * q + 3] & 127) << 24);
                    w1[q] = (unsigned)(v12[1][4 * q] & 127) | ((unsigned)(v12[1][4 * q + 1] & 127) << 8) | ((unsigned)(v12[1][4 * q + 2] & 127) << 16) | ((unsigned)(v12[1][4 * q + 3] & 127) << 24);
                }
                *(LAS u32x4*)(tb8) = w0; *(LAS u32x4*)(tb8 + 16) = w1;
            }
            float f1[16], f2[16];
#pragma unroll
            for (int r = 0; r < 16; ++r) { f1[r] = pk::key2f(v12[0][r]); f2[r] = pk::key2f(v12[1][r]); }
#define CAND(i, j) ((pk::f2key(f1[i] + f2[j]) & ~255) | ((i) * 16 + (j)))
            int M[16], Gb[16];
#pragma unroll
            for (int j = 0; j < 16; ++j) M[j] = CAND(0, j);
#pragma unroll
            for (int j = 0; j < 8; ++j) { Gb[j] = CAND(1, j); Gb[8 + j] = CAND(15 - j, 0); }
            pk::bmerge16(Gb); pk::merge_top16(M, Gb);
            Gb[0] = CAND(2, 0); Gb[1] = CAND(2, 1); Gb[2] = CAND(2, 2); Gb[3] = CAND(2, 3); Gb[4] = CAND(2, 4);
            Gb[5] = CAND(3, 0); Gb[6] = CAND(3, 1); Gb[7] = CAND(3, 2); Gb[8] = CAND(3, 3);
            Gb[9] = CAND(4, 0); Gb[10] = CAND(4, 1); Gb[11] = CAND(4, 2);
            Gb[12] = CAND(5, 0); Gb[13] = CAND(5, 1); Gb[14] = CAND(6, 0); Gb[15] = CAND(6, 1);
            pk::sort16(Gb); pk::merge_top16(M, Gb);
            Gb[0] = CAND(7, 0); Gb[1] = CAND(7, 1);
#pragma unroll
            for (int j = 2; j < 16; ++j) Gb[j] = (int)0x80000000;
            pk::merge_top16(M, Gb);
#undef CAND
            asm volatile("s_waitcnt lgkmcnt(0)" ::: "memory");
            float val[16], e[16]; float se = 0.f; unsigned short ex[16];
#pragma unroll
            for (int k = 0; k < 16; ++k) { val[k] = pk::key2f(M[k] & ~255); }
#pragma unroll
            for (int k = 0; k < 16; ++k) { e[k] = __expf(val[k] - val[0]); se += e[k];
                const int code = M[k] & 255; const unsigned i1 = *(const LAS unsigned char*)(tb8 + (code >> 4)), i2 = *(const LAS unsigned char*)(tb8 + 16 + (code & 15));
                ex[k] = (unsigned short)(i1 * 128 + i2); }
            const float inv = 1.0f / se;
#if defined(NAIVE_PEER)
            if (hi == 0) {
                u32x4 w0, w1;
#pragma unroll
                for (int q = 0; q < 4; ++q) { w0[q] = (unsigned)ex[2 * q] | ((unsigned)ex[2 * q + 1] << 16); w1[q] = (unsigned)ex[8 + 2 * q] | ((unsigned)ex[8 + 2 * q + 1] << 16); }
                u32x4* ip = (u32x4*)(IDX + ((size_t)tok * 8 + wave) * 16); ip[0] = w0; ip[1] = w1;
            } else {
                f32x4* gp = (f32x4*)(Gt + ((size_t)tok * 8 + wave) * 16);
#pragma unroll
                for (int q = 0; q < 4; ++q) gp[q] = (f32x4){e[4 * q] * inv, e[4 * q + 1] * inv, e[4 * q + 2] * inv, e[4 * q + 3] * inv};
            }
#else
            if (hi == 0) {
#pragma unroll
                for (int sl = 0; sl < 8; ++sl) *(unsigned*)(IDX2 + (size_t)tok * 128 + sl * 16 + wave * 2) = (unsigned)ex[sl] | ((unsigned)ex[sl + 8] << 16);
            } else {
#pragma unroll
                for (int sl = 0; sl < 8; ++sl) *(f32x2*)(Gt + (size_t)tok * 128 + sl * 16 + wave * 2) = (f32x2){e[sl] * inv, e[sl + 8] * inv};
            }
#endif
            asm volatile("s_waitcnt lgkmcnt(0)" ::: "memory");
        }
    }
#endif
    GRID_BAR(10);

#if defined(NAIVE_PEER)
    for (int rep_ = 0; rep_ < (IN(11) ? 1 + ((REP_MASK >> 11) & 1) : 0); ++rep_) {
        PH_LOCALS;
        const float* lg = AR.in[20]; const float* lb = AR.in[21];
        for (int t = gw; t < T; t += NGW) {
            const int b = t >> 11;
            u32x4 hv[4];
#pragma unroll
            for (int c = 0; c < 4; ++c) hv[c] = *(const u32x4*)(H2 + (size_t)t * DM + c * 512 + lane * 8);
            const unsigned idx2 = ((const unsigned*)IDX)[(size_t)t * 64 + lane];
            const f32x2 g2 = ((const f32x2*)Gt)[(size_t)t * 64 + lane];
            float a0 = 0.f, a1 = 0.f;
            for (int k = 0; k < 128; k += 4) {
                u32x4 uv[4][4];
#pragma unroll
                for (int j = 0; j < 4; ++j) { const unsigned pr = (unsigned)__builtin_amdgcn_readlane((int)idx2, (k + j) >> 1); const unsigned e = ((k + j) & 1) ? (pr >> 16) : (pr & 0xffffu);
                    const bf16_t* up = UT + (size_t)e * 2048 + lane * 8;
#pragma unroll
                    for (int c = 0; c < 4; ++c) uv[j][c] = *(const u32x4*)(up + c * 512); }
#pragma unroll
                for (int j = 0; j < 4; ++j) { float d = 0.f;
#pragma unroll
                    for (int c = 0; c < 4; ++c)
#pragma unroll
                        for (int q = 0; q < 4; ++q) { const unsigned ua = uv[j][c][q], ha = hv[c][q]; d = dot2bf(ua, ha, d); }
                    d = wave_sum(d);
                    if (lane == ((k + j) >> 1)) { if ((k + j) & 1) a1 = d; else a0 = d; } }
            }
            const float w0 = gelu_erf(a0) * g2[0], w1 = gelu_erf(a1) * g2[1];
            float acc[32];
#pragma unroll
            for (int i = 0; i < 32; ++i) acc[i] = 0.f;
            for (int k = 0; k < 128; k += 4) {
                u32x4 vv[4][4]; float wk[4];
#pragma unroll
                for (int j = 0; j < 4; ++j) { const unsigned pr = (unsigned)__builtin_amdgcn_readlane((int)idx2, (k + j) >> 1); const unsigned e = ((k + j) & 1) ? (pr >> 16) : (pr & 0xffffu);
                    wk[j] = __int_as_float(__builtin_amdgcn_readlane(__float_as_int(((k + j) & 1) ? w1 : w0), (k + j) >> 1));
                    const bf16_t* vp = VT + (size_t)e * 2048 + lane * 8;
#pragma unroll
                    for (int c = 0; c < 4; ++c) vv[j][c] = *(const u32x4*)(vp + c * 512); }
#pragma unroll
                for (int j = 0; j < 4; ++j)
#pragma unroll
                    for (int c = 0; c < 4; ++c)
#pragma unroll
                        for (int q = 0; q < 4; ++q) { acc[c * 8 + 2 * q] += wk[j] * bf_lo(vv[j][c][q]); acc[c * 8 + 2 * q + 1] += wk[j] * bf_hi(vv[j][c][q]); }
            }
            const float* mb = mod + (size_t)b * 12288 + 10240;
            float s = 0.f;
#pragma unroll
            for (int c = 0; c < 4; ++c) { const int d = c * 512 + lane * 8;
                const f32x4 x0 = *(const f32x4*)(AR.out + (size_t)t * DM + d), x1 = *(const f32x4*)(AR.out + (size_t)t * DM + d + 4);
                const f32x4 m0 = *(const f32x4*)(mb + d), m1 = *(const f32x4*)(mb + d + 4);
#pragma unroll
                for (int q = 0; q < 4; ++q) { acc[c * 8 + q] = x0[q] * DN_ALPHA + m0[q] * acc[c * 8 + q] * DBG_FFN; acc[c * 8 + 4 + q] = x1[q] * DN_ALPHA + m1[q] * acc[c * 8 + 4 + q] * DBG_FFN; }
#pragma unroll
                for (int q = 0; q < 8; ++q) s += acc[c * 8 + q]; }
            const float mean = wave_sum(s) * (1.0f / DM); float s2 = 0.f;
#pragma unroll
            for (int i = 0; i < 32; ++i) { acc[i] -= mean; s2 += acc[i] * acc[i]; }
            const float rstd = 1.0f / sqrtf(wave_sum(s2) * (1.0f / DM) + 1e-5f);
#pragma unroll
            for (int c = 0; c < 4; ++c) { const int d = c * 512 + lane * 8;
                const f32x4 g0 = *(const f32x4*)(lg + d), g1 = *(const f32x4*)(lg + d + 4), b0 = *(const f32x4*)(lb + d), b1 = *(const f32x4*)(lb + d + 4);
                f32x4 o0, o1;
#pragma unroll
                for (int q = 0; q < 4; ++q) { o0[q] = acc[c * 8 + q] * rstd * g0[q] + b0[q]; o1[q] = acc[c * 8 + 4 + q] * rstd * g1[q] + b1[q]; }
                *(f32x4*)(AR.out + (size_t)t * DM + d) = o0; *(f32x4*)(AR.out + (size_t)t * DM + d + 4) = o1; }
        }
    }
#else
    for (int rep_ = 0; rep_ < (IN(11) ? 1 + ((REP_MASK >> 11) & 1) : 0); ++rep_) {
        PH_LOCALS;
        const int xs = bid & 7, rank = bid >> 3, nrank = G >> 3;
        const int rg = lane >> 3, dc = lane & 7;
        const int tstep = nrank * NWAVES, t0 = rank * NWAVES + wave;
        const int ntok = rank < nrank ? (T - t0 + tstep - 1) / tstep : 0;
        const unsigned dco = 16u * (unsigned)dc;
        const int slice = xs;
        const unsigned char* Us = U8 + (size_t)slice * (2u << 20);
#define U_LOADI(IA, IB, HA, HB, tt) do { const u32x4* ip_ = (const u32x4*)(IDX2 + ((size_t)(tt) * 8 + rg) * 16); IA = ip_[0]; IB = ip_[1]; \
            const u32x4* hp_ = (const u32x4*)(H2S + ((size_t)slice * T + (tt)) * 256 + 32 * dc); HA = hp_[0]; HB = hp_[1]; } while (0)
#define U_GATH(VV, IX) do { _Pragma("unroll") for (int q = 0; q < 4; ++q) { const unsigned x_ = IX[q]; \
            VV[2 * q] = *(const u32x4*)(Us + ((x_ & 0xffffu) * 128u + dco)); VV[2 * q + 1] = *(const u32x4*)(Us + ((x_ >> 16) * 128u + dco)); } } while (0)
#define U_DPPADD(v, ctrl) ((v) + __builtin_amdgcn_update_dpp(0, (v), (ctrl), 0xf, 0xf, false))
#define U_COMP8(VV, OUT) do { _Pragma("unroll") for (int i_ = 0; i_ < 8; ++i_) { int d_ = hoff; \
                _Pragma("unroll") for (int q = 0; q < 4; ++q) { const unsigned x4 = VV[i_][q]; \
                    d_ = __builtin_amdgcn_sdot4((int)(x4 & 0x0f0f0f0fu), hq[2 * q], d_, false); d_ = __builtin_amdgcn_sdot4((int)((x4 >> 4) & 0x0f0f0f0fu), hq[2 * q + 1], d_, false); } \
                d_ = U_DPPADD(d_, 0xB1); d_ = U_DPPADD(d_, 0x4E); d_ = U_DPPADD(d_, 0x141); OUT[i_] = d_; } } while (0)
        {
            u32x4 ia, ib, ha, hb, nia, nib, nha, nhb, mia, mib, mha, mhb; u32x4 vX[8], vY[8];
            U_LOADI(ia, ib, ha, hb, t0);
            nia = ia; nib = ib; nha = ha; nhb = hb; mia = ia; mib = ib; mha = ha; mhb = hb;
            if (ntok > 1) U_LOADI(nia, nib, nha, nhb, t0 + tstep);
            U_GATH(vX, ia);
            for (int i = 0; i < ntok; ++i) {
                const int t = t0 + i * tstep;
                if (i + 2 < ntok) U_LOADI(mia, mib, mha, mhb, t + 2 * tstep);
                U_GATH(vY, ib);
                __builtin_amdgcn_sched_barrier(0);
                int hq[8]; int hs_ = 0;
#pragma unroll
                for (int q = 0; q < 4; ++q) { const unsigned x0 = ha[q], x1 = hb[q]; hq[q] = (int)x0; hq[4 + q] = (int)x1; }
#pragma unroll
                for (int q = 0; q < 8; ++q) hs_ = __builtin_amdgcn_sdot4(hq[q], 0x01010101, hs_, false);
                const int hoff = -8 * hs_;
                int o0[8], o1[8];
                U_COMP8(vX, o0);
                __builtin_amdgcn_sched_barrier(0);
                if (i + 1 < ntok) U_GATH(vX, nia);
                __builtin_amdgcn_sched_barrier(0);
                U_COMP8(vY, o1);
                {
                    int s0 = (dc & 1) ? o0[2] : o0[0], s1 = (dc & 1) ? o0[3] : o0[1];
                    int u0 = (dc & 1) ? o0[6] : o0[4], u1 = (dc & 1) ? o0[7] : o0[5];
                    int v0 = (dc & 1) ? o1[2] : o1[0], v1 = (dc & 1) ? o1[3] : o1[1];
                    int x0 = (dc & 1) ? o1[6] : o1[4], x1 = (dc & 1) ? o1[7] : o1[5];
                    s0 = (dc & 2) ? u0 : s0; s1 = (dc & 2) ? u1 : s1; v0 = (dc & 2) ? x0 : v0; v1 = (dc & 2) ? x1 : v1;
                    s0 = (dc & 4) ? v0 : s0; s1 = (dc & 4) ? v1 : s1;
                    __builtin_nontemporal_store(cvtpk((float)s0, (float)s1), (unsigned*)PART + ((size_t)slice * T + t) * 64 + rg * 8 + dc); }
                ia = nia; ib = nib; ha = nha; hb = nhb; nia = mia; nib = mib; nha = mha; nhb = mhb;
            }
        }
#undef U_LOADI
#undef U_GATH
#undef U_COMP8
#undef U_DPPADD
    }
    GRID_BAR(11);

    for (int rep_ = 0; rep_ < (IN(12) ? 1 + ((REP_MASK >> 12) & 1) : 0); ++rep_) {
        PH_LOCALS;
        unsigned nidx, npv[8]; f32x2 ng; float nhs, nsu0, nsu1, nsv0, nsv1;
#define P12_LOAD(tt) do { nidx = ((const unsigned*)IDX2)[(size_t)(tt) * 64 + lane]; ng = ((const f32x2*)Gt)[(size_t)(tt) * 64 + lane]; nhs = SH[(tt)]; \
            _Pragma("unroll") for (int sl = 0; sl < 8; ++sl) npv[sl] = ((const unsigned*)PART)[((size_t)sl * T + (tt)) * 64 + lane]; } while (0)
#define P12_SCALES() do { const unsigned e0_ = nidx & 0xffffu, e1_ = nidx >> 16; nsu0 = SU[e0_]; nsu1 = SU[e1_]; nsv0 = SU[NE + e0_]; nsv1 = SU[NE + e1_]; } while (0)
        if (gw < T) { P12_LOAD(gw); P12_SCALES(); }
        for (int t = gw; t < T; t += NGW) {
            const f32x2 g2 = ng; const float hs = nhs, su0 = nsu0, su1 = nsu1, sv0 = nsv0, sv1 = nsv1;
            f32x2 a = {0.f, 0.f};
#pragma unroll
            for (int sl = 0; sl < 8; ++sl) { const unsigned pv = npv[sl]; a[0] += bf_lo(pv); a[1] += bf_hi(pv); }
            if (t + NGW < T) P12_LOAD(t + NGW);
            const float w0 = gelu_erf(a[0] * hs * su0) * g2[0] * sv0, w1 = gelu_erf(a[1] * hs * su1) * g2[1] * sv1;
            const float wm = wmax(fmaxf(fabsf(w0), fabsf(w1)));
            const float qs = wm > 0.f ? 127.0f / wm : 1.0f;
            if (lane == 0) WSC[t] = wm > 0.f ? wm * (1.0f / 127.0f) : 1.0f;
            const int q0 = (int)__builtin_rintf(w0 * qs), q1 = (int)__builtin_rintf(w1 * qs);
            ((unsigned short*)WTq)[(size_t)t * 64 + lane] = (unsigned short)(((unsigned)q0 & 255u) | (((unsigned)q1 & 255u) << 8));
            if (t + NGW < T) P12_SCALES();
        }
#undef P12_LOAD
#undef P12_SCALES
    }
    GRID_BAR(12);

    for (int rep_ = 0; rep_ < (IN(13) ? 1 + ((REP_MASK >> 13) & 1) : 0); ++rep_) {
        PH_LOCALS;
        const int xs = bid & 7, rank = bid >> 3, nrank = G >> 3;
        const int rg = lane >> 3, dc = lane & 7;
        const int tstep = nrank * NWAVES, t0 = rank * NWAVES + wave;
        const int ntok = rank < nrank ? (T - t0 + tstep - 1) / tstep : 0;
        const unsigned dco = 16u * (unsigned)dc;
        const int doff = 16 * dc + ((lane >> 5) & 1) * 8 + ((lane >> 4) & 1) * 4 + ((lane >> 3) & 1) * 2;
#define V_LOADI(IA, IB, WQ, tt) do { const u32x4* ip_ = (const u32x4*)(IDX2 + ((size_t)(tt) * 8 + rg) * 16); IA = ip_[0]; IB = ip_[1]; \
            WQ = *(const u32x4*)(WTq + ((size_t)(tt) * 8 + rg) * 16); } while (0)
#define V_GATH(VV, IX) do { _Pragma("unroll") for (int q = 0; q < 4; ++q) { const unsigned x_ = IX[q]; \
            VV[2 * q] = *(const u32x4*)(Vs + ((x_ & 0xffffu) * 128u + dco)); VV[2 * q + 1] = *(const u32x4*)(Vs + ((x_ >> 16) * 128u + dco)); } } while (0)
#define V_COMP4(A, B, C, D, WG) do { _Pragma("unroll") for (int q = 0; q < 4; ++q) { const unsigned a_ = A[q], b_ = B[q], c_ = C[q], d_ = D[q]; \
            const unsigned p0 = __builtin_amdgcn_perm(b_, a_, 0x05010400u), p1 = __builtin_amdgcn_perm(b_, a_, 0x07030602u); \
            const unsigned q0 = __builtin_amdgcn_perm(d_, c_, 0x05010400u), q1 = __builtin_amdgcn_perm(d_, c_, 0x07030602u); \
            acc[4 * q]     = __builtin_amdgcn_sdot4((int)__builtin_amdgcn_perm(q0, p0, 0x05040100u), (int)(WG), acc[4 * q], false); \
            acc[4 * q + 1] = __builtin_amdgcn_sdot4((int)__builtin_amdgcn_perm(q0, p0, 0x07060302u), (int)(WG), acc[4 * q + 1], false); \
            acc[4 * q + 2] = __builtin_amdgcn_sdot4((int)__builtin_amdgcn_perm(q1, p1, 0x05040100u), (int)(WG), acc[4 * q + 2], false); \
            acc[4 * q + 3] = __builtin_amdgcn_sdot4((int)__builtin_amdgcn_perm(q1, p1, 0x07060302u), (int)(WG), acc[4 * q + 3], false); } } while (0)
        for (int pass = 0; pass < 2; ++pass) {
            const int slice = xs + 8 * pass;
            const unsigned char* Vs = U8 + (32u << 20) + (size_t)slice * (2u << 20);
            u32x4 ia, ib, wq, nia, nib, nwq, mia, mib, mwq; u32x4 vX[8], vY[8];
            V_LOADI(ia, ib, wq, t0);
            nia = ia; nib = ib; nwq = wq; mia = ia; mib = ib; mwq = wq;
            if (ntok > 1) V_LOADI(nia, nib, nwq, t0 + tstep);
            V_GATH(vX, ia);
            for (int i = 0; i < ntok; ++i) {
                const int t = t0 + i * tstep;
                if (i + 2 < ntok) V_LOADI(mia, mib, mwq, t + 2 * tstep);
                V_GATH(vY, ib);
                __builtin_amdgcn_sched_barrier(0);
                int acc[16];
#pragma unroll
                for (int i_ = 0; i_ < 16; ++i_) acc[i_] = 0;
                { const unsigned w0_ = wq[0], w1_ = wq[1]; V_COMP4(vX[0], vX[1], vX[2], vX[3], w0_); V_COMP4(vX[4], vX[5], vX[6], vX[7], w1_); }
                __builtin_amdgcn_sched_barrier(0);
                if (i + 1 < ntok) V_GATH(vX, nia);
                __builtin_amdgcn_sched_barrier(0);
                { const unsigned w2_ = wq[2], w3_ = wq[3]; V_COMP4(vY[0], vY[1], vY[2], vY[3], w2_); V_COMP4(vY[4], vY[5], vY[6], vY[7], w3_); }
                int k8[8], k4[4], k2[2];
                { const bool up = (lane & 32) != 0;
#pragma unroll
                  for (int i_ = 0; i_ < 8; ++i_) { const int keep = up ? acc[8 + i_] : acc[i_], send = up ? acc[i_] : acc[8 + i_]; k8[i_] = keep + __shfl_xor(send, 32); } }
                { const bool up = (lane & 16) != 0;
#pragma unroll
                  for (int i_ = 0; i_ < 4; ++i_) { const int keep = up ? k8[4 + i_] : k8[i_], send = up ? k8[i_] : k8[4 + i_]; k4[i_] = keep + __shfl_xor(send, 16); } }
                { const bool up = (lane & 8) != 0;
#pragma unroll
                  for (int i_ = 0; i_ < 2; ++i_) { const int keep = up ? k4[2 + i_] : k4[i_], send = up ? k4[i_] : k4[2 + i_]; k2[i_] = keep + __shfl_xor(send, 8); } }
                const float wsc = WSC[t];
                *(unsigned*)(FFN + (size_t)t * DM + slice * 128 + doff) = cvtpk((float)k2[0] * wsc, (float)k2[1] * wsc);
                ia = nia; ib = nib; wq = nwq; nia = mia; nib = mib; nwq = mwq;
            }
        }
#undef V_LOADI
#undef V_GATH
#undef V_COMP4
    }
    GRID_BAR(13);

    for (int rep_ = 0; rep_ < (IN(14) ? 1 + ((REP_MASK >> 14) & 1) : 0); ++rep_) {
        PH_LOCALS;
        const float* lg = AR.in[20]; const float* lb = AR.in[21];
        u32x4 nx[4]; u32x4 nf[4];
#define P14_LOAD(tt) do { _Pragma("unroll") for (int c = 0; c < 4; ++c) { const int d_ = c * 512 + lane * 8; nf[c] = *(const u32x4*)(FFN + (size_t)(tt) * DM + d_); \
            nx[c] = *(const u32x4*)(X1b + (size_t)(tt) * DM + d_); } } while (0)
        P14_LOAD(gw);
        for (int t = gw; t < T; t += NGW) {
            const int b = t >> 11;
            const float* mb = mod + (size_t)b * 12288 + 10240;
            float acc[32]; float s = 0.f;
#pragma unroll
            for (int c = 0; c < 4; ++c) { const int d = c * 512 + lane * 8;
                const u32x4 fv = nf[c]; const u32x4 xv = nx[c]; const unsigned xa = xv.x, xb = xv.y, xc = xv.z, xd = xv.w;
                const f32x4 x0 = {bf_lo(xa), bf_hi(xa), bf_lo(xb), bf_hi(xb)}, x1 = {bf_lo(xc), bf_hi(xc), bf_lo(xd), bf_hi(xd)};
                const f32x4 m0 = *(const f32x4*)(mb + d), m1 = *(const f32x4*)(mb + d + 4);
                const unsigned f0 = fv.x, f1 = fv.y, f2 = fv.z, f3 = fv.w;
                acc[c * 8 + 0] = x0[0] * DN_ALPHA + m0[0] * bf_lo(f0); acc[c * 8 + 1] = x0[1] * DN_ALPHA + m0[1] * bf_hi(f0);
                acc[c * 8 + 2] = x0[2] * DN_ALPHA + m0[2] * bf_lo(f1); acc[c * 8 + 3] = x0[3] * DN_ALPHA + m0[3] * bf_hi(f1);
                acc[c * 8 + 4] = x1[0] * DN_ALPHA + m1[0] * bf_lo(f2); acc[c * 8 + 5] = x1[1] * DN_ALPHA + m1[1] * bf_hi(f2);
                acc[c * 8 + 6] = x1[2] * DN_ALPHA + m1[2] * bf_lo(f3); acc[c * 8 + 7] = x1[3] * DN_ALPHA + m1[3] * bf_hi(f3);
#pragma unroll
                for (int q = 0; q < 8; ++q) s += acc[c * 8 + q]; }
            if (t + NGW < T) P14_LOAD(t + NGW);
            const float mean = wsum(s) * (1.0f / DM); float s2 = 0.f;
#pragma unroll
            for (int i = 0; i < 32; ++i) { acc[i] -= mean; s2 += acc[i] * acc[i]; }
            const float rstd = 1.0f / sqrtf(wsum(s2) * (1.0f / DM) + 1e-5f);
#pragma unroll
            for (int c = 0; c < 4; ++c) { const int d = c * 512 + lane * 8;
                const f32x4 g0 = *(const f32x4*)(lg + d), g1 = *(const f32x4*)(lg + d + 4), b0 = *(const f32x4*)(lb + d), b1 = *(const f32x4*)(lb + d + 4);
                f32x4 o0, o1;
#pragma unroll
                for (int q = 0; q < 4; ++q) { o0[q] = acc[c * 8 + q] * rstd * g0[q] + b0[q]; o1[q] = acc[c * 8 + 4 + q] * rstd * g1[q] + b1[q]; }
                *(f32x4*)(AR.out + (size_t)t * DM + d) = o0; *(f32x4*)(AR.out + (size_t)t * DM + d + 4) = o1; }
        }
    }
#endif
#undef IN
#undef GRID_BAR
}

extern "C" void kernel_launch(void* const* d_in, const int* in_sizes, int n_in, void* d_out, int out_size, void* d_ws, size_t ws_size, hipStream_t stream) {
    static int grid = 0;
    if (grid == 0) {
        if (n_in != 22 || out_size != T * DM || ws_size < WS_END) { fprintf(stderr, "kernel_launch: unexpected shapes (n_in %d out %d ws %zu)\n", n_in, out_size, ws_size); grid = -1; return; }
        int dev = 0, cus = 0, per_cu = 0;
        if (hipGetDevice(&dev) != hipSuccess || hipDeviceGetAttribute(&cus, hipDeviceAttributeMultiprocessorCount, dev) != hipSuccess) { grid = -1; return; }
        if (hipFuncSetAttribute((const void*)mega_fwd, hipFuncAttributeMaxDynamicSharedMemorySize, LDS_BYTES) != hipSuccess) { fprintf(stderr, "kernel_launch: hipFuncSetAttribute failed\n"); grid = -1; return; }
        if (hipOccupancyMaxActiveBlocksPerMultiprocessor(&per_cu, (const void*)mega_fwd, NWAVES * 64, LDS_BYTES) != hipSuccess || per_cu < 1) { fprintf(stderr, "kernel_launch: occupancy query says %d\n", per_cu); grid = -1; (void)hipGetLastError(); return; }
        grid = cus;
    }
    if (grid < 0) return;
    (void)hipMemsetAsync(d_ws, 0, 16384, stream);
    Args a{};
    for (int i = 0; i < 22; ++i) a.in[i] = (const float*)d_in[i];
    a.out = (float*)d_out; a.ws = (unsigned char*)d_ws;
#if MK_N_LAUNCHES == 1
    a.ph_lo = 0; a.ph_hi = N_PHASES;
    void* kargs[] = {&a};
    hipError_t e = hipLaunchCooperativeKernel((const void*)mega_fwd, dim3(grid), dim3(NWAVES * 64), kargs, LDS_BYTES, stream);
    if (e != hipSuccess) fprintf(stderr, "kernel_launch: cooperative launch failed: %s (grid %d)\n", hipGetErrorString(e), grid);
#else
    for (int p = 0; p < N_PHASES; ++p) {
        a.ph_lo = p; a.ph_hi = p + 1;
        hipLaunchKernelGGL(mega_fwd, dim3(grid), dim3(NWAVES * 64), LDS_BYTES, stream, a);
    }
    const hipError_t le = hipPeekAtLastError();
    if (le != hipSuccess) fprintf(stderr, "kernel_launch: launch failed: %s\n", hipGetErrorName(le));
#endif
}
```

```cpp
#include <hip/hip_runtime.h>
#include <hip/hip_cooperative_groups.h>
#include <cstdio>
#include <cstdint>
namespace cg = cooperative_groups;

#ifndef MK_N_LAUNCHES
#define MK_N_LAUNCHES 1
#ifndef REP_MASK
#define REP_MASK 0
#endif
#define DBG_MIX 1.0f
#define DBG_FFN 1.0f
#endif

#define LAS __attribute__((address_space(3)))
typedef unsigned short bf16_t;
typedef short bf16x8 __attribute__((ext_vector_type(8)));
typedef short s16x4 __attribute__((ext_vector_type(4)));
typedef float f32x2 __attribute__((ext_vector_type(2)));
typedef float f32x4 __attribute__((ext_vector_type(4)));
typedef float f32x16 __attribute__((ext_vector_type(16)));
typedef unsigned u32x2 __attribute__((ext_vector_type(2)));
typedef unsigned u32x4 __attribute__((ext_vector_type(4)));
typedef int i32x4 __attribute__((ext_vector_type(4)));
typedef __bf16 bf16x2_t __attribute__((ext_vector_type(2)));

constexpr int NB = 16, SEQ = 2048, DM = 2048, T = NB * SEQ;
constexpr int NPROJ = 4160, NPROJ_PAD = 4352;
constexpr float DN_ALPHA = 1.189207115002721f;
constexpr int NE = 16384;

constexpr size_t MiB = 1u << 20;
constexpr size_t WS_MOD = 1 * MiB;
constexpr size_t WS_ROPEA = 2 * MiB;
constexpr size_t WS_ROPEB = 2 * MiB + 256 * 1024;
constexpr size_t WS_SSQ_Q = 3 * MiB;
constexpr size_t WS_SSQ_KV = 4 * MiB;
constexpr size_t WS_SSQ_O = 5 * MiB;
constexpr size_t WS_SM = 7 * MiB;
constexpr size_t WS_SL = 8 * MiB;
constexpr size_t WS_K1 = 9 * MiB;
constexpr size_t WS_K2 = 9 * MiB + 32768;
constexpr size_t WS_WIN = 10 * MiB;
constexpr size_t WS_WUQ = 27 * MiB;
constexpr size_t WS_WUKV = 29 * MiB;
constexpr size_t WS_WO = 31 * MiB;
constexpr size_t WS_WPQ = 39 * MiB;
constexpr size_t WS_UT = 64 * MiB;
constexpr size_t WS_VT = 128 * MiB;
constexpr size_t WS_A = 192 * MiB;
constexpr size_t WS_QA = 320 * MiB, WS_KA = 384 * MiB, WS_VA = 448 * MiB, WS_CQ = 512 * MiB, WS_CKV = 544 * MiB, WS_KR = 576 * MiB;
constexpr size_t WS_Y = 320 * MiB;
constexpr size_t WS_QN = 580 * MiB, WS_QR = 644 * MiB, WS_KN = 676 * MiB, WS_VB = 740 * MiB;
constexpr size_t WS_H2 = 580 * MiB;
constexpr size_t WS_O = 804 * MiB;
constexpr size_t WS_IDX = 932 * MiB;
constexpr size_t WS_G = 940 * MiB;
constexpr size_t WS_END = 972 * MiB;
constexpr size_t WS_SU = 9 * MiB + 65536;
constexpr size_t WS_SH = 9 * MiB + 196608;
constexpr size_t WS_CMAX = 9 * MiB + 327680;
constexpr size_t WS_WS1 = 9 * MiB + 491520;
constexpr size_t WS_HS1 = 9 * MiB + 524288;
constexpr size_t WS_CMAX2 = 9 * MiB + 655360;
constexpr size_t WS_WS4 = 9 * MiB + 720896;
constexpr size_t WS_OS = 9 * MiB + 786432;
constexpr size_t WS_CMAX3 = 9 * MiB + 917504;
constexpr size_t WS_WS3 = 9 * MiB + 983040;
constexpr size_t WS_U8 = 64 * MiB;
constexpr size_t WS_V8 = 96 * MiB;
constexpr size_t WS_PART = 320 * MiB;
constexpr size_t WS_H8 = 804 * MiB;
constexpr size_t WS_IDX2 = 932 * MiB;
constexpr size_t WS_WT = 956 * MiB;
constexpr size_t WS_H2S = 128 * MiB;
constexpr size_t WS_X1 = 804 * MiB;
constexpr size_t WS_FFN = 192 * MiB;

constexpr int NWAVES = 8;
constexpr int LDS_BYTES = 147456;

__device__ __forceinline__ int opaque(int v) { asm volatile("" : "+v"(v)); return v; }
#define RAW_LD4(dst, sb, vo, imm) asm volatile("global_load_dwordx4 %0, %1, %2 offset:" #imm : "=v"(dst) : "v"(vo), "s"(sb) : "memory")
#define RAW_TAKE2F(WAITSTR, D0, D1, S0, S1) do { float a0_, a1_, a2_, a3_, a4_, a5_, a6_, a7_; \
        asm volatile(WAITSTR "\n\tv_mov_b32 %0, %8\n\tv_mov_b32 %1, %9\n\tv_mov_b32 %2, %10\n\tv_mov_b32 %3, %11\n\tv_mov_b32 %4, %12\n\tv_mov_b32 %5, %13\n\tv_mov_b32 %6, %14\n\tv_mov_b32 %7, %15" \
            : "=&v"(a0_), "=&v"(a1_), "=&v"(a2_), "=&v"(a3_), "=&v"(a4_), "=&v"(a5_), "=&v"(a6_), "=&v"(a7_) \
            : "v"(S0.x), "v"(S0.y), "v"(S0.z), "v"(S0.w), "v"(S1.x), "v"(S1.y), "v"(S1.z), "v"(S1.w) : "memory"); \
        D0 = (f32x4){a0_, a1_, a2_, a3_}; D1 = (f32x4){a4_, a5_, a6_, a7_}; } while (0)
#define RAW_ROW8(BUF, base_, vo_) do { const unsigned char* sa_ = (const unsigned char*)(base_); const unsigned char* sb_ = sa_ + 4096; \
        RAW_LD4(BUF[0], sa_, vo_, 0); RAW_LD4(BUF[1], sa_, vo_, 1024); RAW_LD4(BUF[2], sa_, vo_, 2048); RAW_LD4(BUF[3], sa_, vo_, 3072); \
        RAW_LD4(BUF[4], sb_, vo_, 0); RAW_LD4(BUF[5], sb_, vo_, 1024); RAW_LD4(BUF[6], sb_, vo_, 2048); RAW_LD4(BUF[7], sb_, vo_, 3072); } while (0)
#define RAW_TAKE8F(WAITSTR, V, BUF) do { RAW_TAKE2F(WAITSTR, V[0], V[1], BUF[0], BUF[1]); RAW_TAKE2F("s_nop 0", V[2], V[3], BUF[2], BUF[3]); \
        RAW_TAKE2F("s_nop 0", V[4], V[5], BUF[4], BUF[5]); RAW_TAKE2F("s_nop 0", V[6], V[7], BUF[6], BUF[7]); } while (0)
__device__ __forceinline__ unsigned cvtpk(float lo, float hi) { f32x2 v = {lo, hi}; bf16x2_t b = __builtin_convertvector(v, bf16x2_t); return __builtin_bit_cast(unsigned, b); }
__device__ __forceinline__ float dot2bf(unsigned a, unsigned b, float c) { return __builtin_amdgcn_fdot2_f32_bf16(__builtin_bit_cast(bf16x2_t, a), __builtin_bit_cast(bf16x2_t, b), c, false); }
__device__ __forceinline__ void fmac(float& d, float a, float b) { asm("v_fmac_f32_e32 %0, %1, %2" : "+v"(d) : "v"(a), "v"(b)); }
__device__ __forceinline__ float bf_lo(unsigned u) { return __uint_as_float(u << 16); }
__device__ __forceinline__ float bf_hi(unsigned u) { return __uint_as_float(u & 0xffff0000u); }
#define DPPF(v, ctrl) __builtin_bit_cast(float, __builtin_amdgcn_update_dpp(0, __builtin_bit_cast(int, (v)), (ctrl), 0xf, 0xf, false))
#define RLF(v, l) __builtin_bit_cast(float, __builtin_amdgcn_readlane(__builtin_bit_cast(int, (v)), (l)))
__device__ __forceinline__ float wsum(float v) {
    v += DPPF(v, 0xB1); v += DPPF(v, 0x4E); v += DPPF(v, 0x141); v += DPPF(v, 0x140);
    return (RLF(v, 0) + RLF(v, 16)) + (RLF(v, 32) + RLF(v, 48));
}
__device__ __forceinline__ float wmax(float v) {
    v = fmaxf(v, DPPF(v, 0xB1)); v = fmaxf(v, DPPF(v, 0x4E)); v = fmaxf(v, DPPF(v, 0x141)); v = fmaxf(v, DPPF(v, 0x140));
    return fmaxf(fmaxf(RLF(v, 0), RLF(v, 16)), fmaxf(RLF(v, 32), RLF(v, 48)));
}
__device__ __forceinline__ float wave_max(float v) {
#pragma unroll
    for (int o = 1; o < 64; o <<= 1) v = fmaxf(v, __shfl_xor(v, o));
    return v;
}
__device__ __forceinline__ unsigned pack_fp8x4(float a, float b, float c, float d) {
    int w = __builtin_amdgcn_cvt_pk_fp8_f32(a, b, 0, false); w = __builtin_amdgcn_cvt_pk_fp8_f32(c, d, w, true); return (unsigned)w;
}
__device__ __forceinline__ unsigned pack_i8x4(float a, float b, float c, float d) {
    const int ia = (int)__builtin_rintf(a), ib = (int)__builtin_rintf(b), ic = (int)__builtin_rintf(c), id = (int)__builtin_rintf(d);
    return ((unsigned)ia & 255u) | (((unsigned)ib & 255u) << 8) | (((unsigned)ic & 255u) << 16) | ((unsigned)id << 24);
}
__device__ __forceinline__ float wave_sum(float v) {
#pragma unroll
    for (int o = 1; o < 64; o <<= 1) v += __shfl_xor(v, o);
    return v;
}

namespace pg8 {
constexpr int BM = 256, BK = 64, HALF = 128, HTB = HALF * BK * 2, STAGE_BYTES = 8 * HTB, NXCD = 8, WGM = 8;
__host__ __device__ __forceinline__ int lds_byte(int r, int c) { const int st = (r >> 4) * 2 + (c >> 5), rr = r & 15, cc = c & 31, ob = rr * 64 + cc * 2; return st * 1024 + (ob ^ (((ob >> 9) & 1) << 5)); }
__host__ __device__ __forceinline__ void stage_rc(int b, int& R, int& C) { const int st = b / 1024, sb = b % 1024, swz = sb ^ (((sb >> 9) & 1) << 5); R = (st >> 1) * 16 + swz / 64; C = (st & 1) * 32 + (swz % 64) / 2; }
__host__ __device__ __forceinline__ int perm32(int rho) { const int n = rho >> 4, i = rho & 15; return 8 * (i >> 2) + 4 * n + (i & 3); }

struct Unit { int pm, pn; };
struct Gemm { const bf16_t* A; const bf16_t* Bt; int M, N, K; };

struct StaticOrder {
    int nM, nN, nwg, G, c;
    __host__ __device__ __forceinline__ void init(int M, int N, int G_, int c_) { nM = M / BM; nN = N / BM; nwg = nM * nN; G = G_; c = c_; }
    __host__ __device__ __forceinline__ bool next(int i, Unit& u) const {
        const long L = (long)i * G + c; if (L >= nwg) return false;
        int wgid = (int)L; { const int q = nwg / NXCD, r = nwg % NXCD, xcd = wgid % NXCD, off = wgid / NXCD; wgid = (xcd < r ? xcd * (q + 1) : r * (q + 1) + (xcd - r) * q) + off; }
        const int nig = WGM * nN, gid = wgid / nig, fm = gid * WGM, gsz = (nM - fm) < WGM ? (nM - fm) : WGM;
        u.pm = fm + ((wgid % nig) % gsz); u.pn = (wgid % nig) / gsz; return true;
    }
};

template <class Epi, class Sched>
__device__ __forceinline__ void gemm_phase(const int tid, LAS unsigned char* lds, const Gemm g, const Sched& S, const Epi& E) {
    const int wid = __builtin_amdgcn_readfirstlane(tid >> 6), lane = tid & 63, wr = wid >> 2, wc = wid & 3, fr = lane & 15, fq = lane >> 4;
    const int K = g.K, nt = K / BK;
    unsigned voffA[2], voffB[2];
#pragma unroll
    for (int i = 0; i < 2; ++i) { int R, C; stage_rc(tid * 16 + i * 8192, R, C); const int Rb = Epi::PERM ? ((R & ~31) + perm32(R & 31)) : R;
        voffA[i] = (unsigned)(R * K + C) * 2u; voffB[i] = (unsigned)(Rb * K + C) * 2u; }
    const size_t kstep = (size_t)(BK * 2);
    const size_t hstep = (size_t)HALF * K * 2;
    const size_t tstep = 2 * hstep;
    const unsigned ldsw = (unsigned)wid * 1024u;
    const int aoff = lds_byte(wr * 64 + fr, fq * 8), boff = lds_byte(wc * 32 + fr, fq * 8);
#define PG8_SA(b, h) (((b) * 2 + (h)) * HTB)
#define PG8_SB(b, h) ((4 + (b) * 2 + (h)) * HTB)
#define PG8_STAGE(bufoff, gbase, voff) do { _Pragma("unroll") for (int _i = 0; _i < 2; ++_i) \
        __builtin_amdgcn_global_load_lds((const unsigned*)((const char*)(gbase) + (voff)[_i]), (LAS unsigned*)(lds + (bufoff) + ldsw + _i * 8192), 16, 0, 0); } while (0)
#define PG8_LDA(dst, b, h) do { _Pragma("unroll") for (int m = 0; m < 4; ++m) _Pragma("unroll") for (int k = 0; k < 2; ++k) dst[m][k] = *(const LAS bf16x8*)(lds + PG8_SA(b, h) + aoff + m * 2048 + k * 1024); } while (0)
#define PG8_LDB(dst, b, h) do { _Pragma("unroll") for (int n = 0; n < 2; ++n) _Pragma("unroll") for (int k = 0; k < 2; ++k) dst[n][k] = *(const LAS bf16x8*)(lds + PG8_SB(b, h) + boff + n * 2048 + k * 1024); } while (0)
#define PG8_MMA(ai, bj, At, Bt) do { __builtin_amdgcn_s_setprio(1); _Pragma("unroll") for (int m = 0; m < 4; ++m) _Pragma("unroll") for (int n = 0; n < 2; ++n) _Pragma("unroll") for (int k = 0; k < 2; ++k) \
        { if constexpr (Epi::I8) acc[ai][bj][m][n] = __builtin_bit_cast(f32x4, __builtin_amdgcn_mfma_i32_16x16x64_i8(__builtin_bit_cast(i32x4, Bt[n][k]), __builtin_bit_cast(i32x4, At[m][k]), __builtin_bit_cast(i32x4, acc[ai][bj][m][n]), 0, 0, 0)); \
          else acc[ai][bj][m][n] = __builtin_amdgcn_mfma_f32_16x16x32_bf16(Bt[n][k], At[m][k], acc[ai][bj][m][n], 0, 0, 0); } __builtin_amdgcn_s_setprio(0); } while (0)
#define PG8_WAIT_V(n) asm volatile("s_waitcnt vmcnt(" #n ")" ::: "memory")
#define PG8_WAIT_L(n) asm volatile("s_waitcnt lgkmcnt(" #n ")" ::: "memory")
#define PG8_BAR __builtin_amdgcn_s_barrier()
#define PG8_SCHED __builtin_amdgcn_sched_barrier(0)
    Unit cur, nxt; int ui = 0;
    if (!S.next(0, cur)) return;
    f32x4 acc[2][2][4][2];
#pragma unroll
    for (int a = 0; a < 2; ++a)
#pragma unroll
        for (int b = 0; b < 2; ++b)
#pragma unroll
            for (int m = 0; m < 4; ++m)
#pragma unroll
                for (int n = 0; n < 2; ++n) acc[a][b][m][n] = (f32x4){0.f, 0.f, 0.f, 0.f};
    bf16x8 At[4][2], B0[2][2], B1[2][2];
    const char* cA = (const char*)g.A + (size_t)cur.pm * tstep; const char* cB = (const char*)g.Bt + (size_t)cur.pn * tstep;
    PG8_STAGE(PG8_SB(0, 0), cB, voffB); PG8_STAGE(PG8_SB(0, 1), cB + hstep, voffB); PG8_STAGE(PG8_SA(0, 0), cA, voffA); PG8_STAGE(PG8_SA(0, 1), cA + hstep, voffA);
    if (wr == 1) PG8_BAR;
    PG8_WAIT_V(2); PG8_BAR;
    PG8_STAGE(PG8_SB(1, 0), cB + kstep, voffB); PG8_STAGE(PG8_SA(1, 0), cA + kstep, voffA); PG8_STAGE(PG8_SB(1, 1), cB + hstep + kstep, voffB);
    PG8_WAIT_V(6); PG8_BAR;
    for (;;) {
        const bool has_next = S.next(ui + 1, nxt);
        const char* nA = has_next ? (const char*)g.A + (size_t)nxt.pm * tstep : cA; const char* nB = has_next ? (const char*)g.Bt + (size_t)nxt.pn * tstep : cB;
        for (int t = 0; t < nt; t += 2) {
            if constexpr (Epi::MID) { if (t == (nt >> 1)) E.mid(acc, cur, ui, tid); }
            const bool last = (t == nt - 2);
            const char* a1 = cA + (size_t)(t + 1) * kstep;
            const char* a2 = last ? nA : cA + (size_t)(t + 2) * kstep; const char* b2 = last ? nB : cB + (size_t)(t + 2) * kstep;
            const char* a3 = a2 + kstep; const char* b3 = b2 + kstep;
            PG8_LDB(B0, 0, 0); PG8_LDB(B1, 0, 1); PG8_SCHED; PG8_LDA(At, 0, 0); PG8_STAGE(PG8_SA(1, 1), a1 + hstep, voffA);
            PG8_WAIT_V(8); PG8_WAIT_L(0); PG8_BAR; PG8_MMA(0, 0, At, B0); PG8_MMA(0, 1, At, B1); PG8_BAR; PG8_SCHED;
            PG8_LDA(At, 0, 1); PG8_STAGE(PG8_SB(0, 0), b2, voffB); PG8_STAGE(PG8_SB(0, 1), b2 + hstep, voffB); PG8_STAGE(PG8_SA(0, 0), a2, voffA);
            PG8_WAIT_V(8); PG8_WAIT_L(0); PG8_BAR; PG8_MMA(1, 0, At, B0); PG8_MMA(1, 1, At, B1); PG8_BAR; PG8_SCHED;
            PG8_LDB(B0, 1, 0); PG8_LDB(B1, 1, 1); PG8_SCHED; PG8_LDA(At, 1, 0); PG8_STAGE(PG8_SA(0, 1), a2 + hstep, voffA);
            PG8_WAIT_V(8); PG8_WAIT_L(0); PG8_BAR; PG8_MMA(0, 0, At, B0); PG8_MMA(0, 1, At, B1); PG8_BAR; PG8_SCHED;
            PG8_LDA(At, 1, 1); PG8_STAGE(PG8_SB(1, 0), b3, voffB); PG8_STAGE(PG8_SB(1, 1), b3 + hstep, voffB); PG8_STAGE(PG8_SA(1, 0), a3, voffA);
            PG8_WAIT_V(8); PG8_WAIT_L(0); PG8_BAR; PG8_MMA(1, 0, At, B0); PG8_MMA(1, 1, At, B1); PG8_BAR; PG8_SCHED;
        }
        if (wr == 0) PG8_BAR;
        E(acc, cur, ui, tid);
        if (!has_next) break;
#pragma unroll
        for (int a = 0; a < 2; ++a)
#pragma unroll
            for (int b = 0; b < 2; ++b)
#pragma unroll
                for (int m = 0; m < 4; ++m)
#pragma unroll
                    for (int n = 0; n < 2; ++n) acc[a][b][m][n] = (f32x4){0.f, 0.f, 0.f, 0.f};
        cur = nxt; cA = nA; cB = nB; ++ui;
        if (wr == 1) PG8_BAR;
    }
    PG8_WAIT_V(0);
    PG8_BAR;
#undef PG8_SA
#undef PG8_SB
#undef PG8_STAGE
#undef PG8_LDA
#undef PG8_LDB
#undef PG8_MMA
#undef PG8_WAIT_V
#undef PG8_WAIT_L
#undef PG8_BAR
#undef PG8_SCHED
}

__device__ __forceinline__ void store8(bf16_t* p, f32x4 v0, f32x4 v1) {
    u32x4 w; w.x = cvtpk(v0[0], v0[1]); w.y = cvtpk(v0[2], v0[3]); w.z = cvtpk(v1[0], v1[1]); w.w = cvtpk(v1[2], v1[3]);
    *(u32x4*)p = w;
}


struct Rope4 { float f[4];
    __device__ __forceinline__ void init(int ibase, float kexp) {
#pragma unroll
        for (int j = 0; j < 4; ++j) f[j] = __builtin_amdgcn_exp2f(-(float)(ibase + j) * kexp) * 0.15915494309189535f; }
    __device__ __forceinline__ void sincos(int s, f32x4& cs, f32x4& sn) const {
#pragma unroll
        for (int j = 0; j < 4; ++j) { float rev = (float)s * f[j]; rev -= floorf(rev); sn[j] = __builtin_amdgcn_sinf(rev); cs[j] = __builtin_amdgcn_cosf(rev); } }
    __device__ __forceinline__ static void rot(f32x4& v0, f32x4& v1, const f32x4& cs, const f32x4& sn) {
        const f32x4 a = v0 * cs - v1 * sn, b = v1 * cs + v0 * sn; v0 = a; v1 = b; }
    __device__ __forceinline__ void apply(f32x4& v0, f32x4& v1, int s) const { f32x4 cs, sn; sincos(s, cs, sn); rot(v0, v1, cs, sn); }
};
constexpr float ROPE_KA = 18.931568569324174f / 16.0f, ROPE_KB = 18.931568569324174f / 32.0f;

struct EpiProj {
    static constexpr bool PERM = true, MID = false, I8 = true;
    bf16_t* QKV;
    bf16_t* CQKV;
    bf16_t* KR; float* ssq;
    const float* hs; const float* wsn;
    static __device__ __forceinline__ f32x4 i2f4(const f32x4 a) { const float a0 = a[0], a1 = a[1], a2 = a[2], a3 = a[3];
        return (f32x4){(float)__float_as_int(a0), (float)__float_as_int(a1), (float)__float_as_int(a2), (float)__float_as_int(a3)}; }
    __device__ __forceinline__ void mid(f32x4 (&)[2][2][4][2], const Unit&, int, int) const {}
    __device__ __forceinline__ void operator()(const f32x4 (&acc_)[2][2][4][2], const Unit& u, int ui, int tid_) const {
        const int tid = opaque(tid_), lane = tid & 63, wid = __builtin_amdgcn_readfirstlane(tid >> 6), wr = wid >> 2, wc = wid & 3, fr = lane & 15, fq = lane >> 4;
        const int pn = u.pn, row0 = u.pm * BM + wr * 64 + fr;
        f32x4 cs[2][2]; float rs[2][4];
        { const float* wp_ = wsn + pn * BM + wc * 32 + 8 * fq;
#pragma unroll
          for (int bj = 0; bj < 2; ++bj) { cs[bj][0] = *(const f32x4*)(wp_ + bj * HALF); cs[bj][1] = *(const f32x4*)(wp_ + bj * HALF + 4); }
#pragma unroll
          for (int ai = 0; ai < 2; ++ai)
#pragma unroll
              for (int m = 0; m < 4; ++m) rs[ai][m] = hs[row0 + ai * HALF + m * 16]; }
#define ACCF(ai, bj, m, n) (i2f4(acc_[ai][bj][m][n]) * rs[ai][m] * cs[bj][n])
        if (pn < 12) {
            bf16_t* base = QKV + (size_t)(pn >> 2) * (32u << 20);
            const int colt = (pn & 3) * 256 + wc * 32 + 8 * fq;
            const bool rope = (pn < 8) && (wc == 0);
            Rope4 R; R.init(4 * fq, ROPE_KA);
#pragma unroll
            for (int ai = 0; ai < 2; ++ai)
#pragma unroll
                for (int m = 0; m < 4; ++m) {
                    const int row = row0 + ai * HALF + m * 16; const int s = row & (SEQ - 1);
                    f32x4 rcs = {1.f, 1.f, 1.f, 1.f}, rsn = {0.f, 0.f, 0.f, 0.f};
                    if (rope) R.sincos(s, rcs, rsn);
#pragma unroll
                    for (int bj = 0; bj < 2; ++bj) {
                        f32x4 v0 = ACCF(ai, bj, m, 0), v1 = ACCF(ai, bj, m, 1);
                        if (rope) Rope4::rot(v0, v1, rcs, rsn);
                        if (pn < 4) store8(base + (size_t)row * 1024 + colt + bj * HALF, v0, v1);
                        else { u32x2 w; w.x = pack_fp8x4(v0[0], v0[1], v0[2], v0[3]); w.y = pack_fp8x4(v1[0], v1[1], v1[2], v1[3]);
                            *(u32x2*)((unsigned char*)base + (size_t)row * 1024 + colt + bj * HALF) = w; }
                    }
                }
        } else if (pn < 16) {
            bf16_t* base = CQKV + (size_t)((pn >> 1) & 1) * (16u << 20); float* sq = ssq + (size_t)((pn >> 1) & 1) * (256u << 10);
            const int colt = (pn & 1) * 256 + wc * 32 + 8 * fq; const int slot = (pn & 1) * 4 + wc;
#pragma unroll
            for (int ai = 0; ai < 2; ++ai)
#pragma unroll
                for (int m = 0; m < 4; ++m) {
                    const int row = row0 + ai * HALF + m * 16; float q = 0.f;
#pragma unroll
                    for (int bj = 0; bj < 2; ++bj) {
                        const f32x4 v0 = ACCF(ai, bj, m, 0), v1 = ACCF(ai, bj, m, 1);
                        q += (v0[0] * v0[0] + v0[1] * v0[1]) + (v0[2] * v0[2] + v0[3] * v0[3]) + (v1[0] * v1[0] + v1[1] * v1[1]) + (v1[2] * v1[2] + v1[3] * v1[3]);
                        store8(base + (size_t)row * 512 + colt + bj * HALF, v0 * 1.0f, v1 * 1.0f);
                    }
                    q += __shfl_xor(q, 16); q += __shfl_xor(q, 32);
                    if (fq == 0) sq[(size_t)slot * T + row] = q;
                }
        } else {
            if (wc < 2) {
                Rope4 R; R.init(16 * wc + 4 * fq, ROPE_KB);
#pragma unroll
                for (int ai = 0; ai < 2; ++ai)
#pragma unroll
                    for (int m = 0; m < 4; ++m) {
                        const int row = row0 + ai * HALF + m * 16; const int s = row & (SEQ - 1);
                        f32x4 v0 = ACCF(ai, 0, m, 0), v1 = ACCF(ai, 0, m, 1);
                        R.apply(v0, v1, s);
                        store8(KR + (size_t)row * 64 + wc * 32 + 8 * fq, v0, v1);
                    }
            }
        }
    }
};
#undef ACCF

struct EpiKr {
    static constexpr bool PERM = true, MID = false, I8 = false;
    bf16_t* KR;
    __device__ __forceinline__ void mid(f32x4 (&)[2][2][4][2], const Unit&, int, int) const {}
    __device__ __forceinline__ void operator()(const f32x4 (&acc)[2][2][4][2], const Unit& u, int ui, int tid_) const {
        const int tid = opaque(tid_), lane = tid & 63, wid = __builtin_amdgcn_readfirstlane(tid >> 6), wr = wid >> 2, wc = wid & 3, fr = lane & 15, fq = lane >> 4;
        const int row0 = u.pm * BM + wr * 64 + fr;
        if (wc < 2) {
            Rope4 R; R.init(16 * wc + 4 * fq, ROPE_KB);
#pragma unroll
            for (int ai = 0; ai < 2; ++ai)
#pragma unroll
                for (int m = 0; m < 4; ++m) {
                    const int row = row0 + ai * HALF + m * 16; const int s = row & (SEQ - 1);
                    f32x4 v0 = acc[ai][0][m][0] * 1.0f, v1 = acc[ai][0][m][1] * 1.0f;
                    R.apply(v0, v1, s);
                    store8(KR + (size_t)row * 64 + wc * 32 + 8 * fq, v0, v1);
                }
        }
    }
};

struct EpiQ {
    static constexpr bool PERM = true, MID = false, I8 = false;
    bf16_t *Qn, *Qr; const LAS float* tab;
    __device__ __forceinline__ void mid(f32x4 (&)[2][2][4][2], const Unit&, int, int) const {}
    __device__ __forceinline__ void operator()(const f32x4 (&acc)[2][2][4][2], const Unit& u, int ui, int tid_) const {
        const int tid = opaque(tid_), lane = tid & 63, wid = __builtin_amdgcn_readfirstlane(tid >> 6), wr = wid >> 2, wc = wid & 3, fr = lane & 15, fq = lane >> 4;
        const int pn = u.pn, rl0 = wr * 64 + fr, row0 = u.pm * BM + rl0;
        Rope4 R; R.init(16 * (wc & 1) + 4 * fq, ROPE_KB);
#pragma unroll
        for (int ai = 0; ai < 2; ++ai)
#pragma unroll
            for (int m = 0; m < 4; ++m) {
                const int row = row0 + ai * HALF + m * 16; const int s = row & (SEQ - 1);
                const float rs = tab[ui * 256 + rl0 + ai * HALF + m * 16];
                if (pn < 4) {
#pragma unroll
                    for (int bj = 0; bj < 2; ++bj)
                        store8(Qn + (size_t)row * 1024 + pn * 256 + bj * HALF + wc * 32 + 8 * fq, acc[ai][bj][m][0] * rs, acc[ai][bj][m][1] * rs);
                } else {
                    f32x4 rcs, rsn; R.sincos(s, rcs, rsn);
#pragma unroll
                    for (int bj = 0; bj < 2; ++bj) {
                        f32x4 v0 = acc[ai][bj][m][0] * rs, v1 = acc[ai][bj][m][1] * rs;
                        Rope4::rot(v0, v1, rcs, rsn);
                        store8(Qr + (size_t)row * 512 + (pn - 4) * 256 + bj * HALF + wc * 32 + 8 * fq, v0, v1);
                    }
                }
            }
    }
};

struct EpiKV {
    static constexpr bool PERM = true, MID = false, I8 = false;
    bf16_t *Kn, *Vb; const LAS float* tab;
    __device__ __forceinline__ void mid(f32x4 (&)[2][2][4][2], const Unit&, int, int) const {}
    __device__ __forceinline__ void operator()(const f32x4 (&acc)[2][2][4][2], const Unit& u, int ui, int tid_) const {
        const int tid = opaque(tid_), lane = tid & 63, wid = __builtin_amdgcn_readfirstlane(tid >> 6), wr = wid >> 2, wc = wid & 3, fr = lane & 15, fq = lane >> 4;
        const int pn = u.pn, rl0 = wr * 64 + fr, row0 = u.pm * BM + rl0;
        bf16_t* base = pn < 4 ? Kn : Vb;
#pragma unroll
        for (int ai = 0; ai < 2; ++ai)
#pragma unroll
            for (int m = 0; m < 4; ++m) {
                const int row = row0 + ai * HALF + m * 16;
                const float rs = tab[ui * 256 + rl0 + ai * HALF + m * 16];
#pragma unroll
                for (int bj = 0; bj < 2; ++bj)
                    store8(base + (size_t)row * 1024 + (pn & 3) * 256 + bj * HALF + wc * 32 + 8 * fq, acc[ai][bj][m][0] * rs, acc[ai][bj][m][1] * rs);
            }
    }
};

struct EpiMix {
    static constexpr bool PERM = true, MID = true, I8 = false;
    bf16_t* MIX; const LAS float* tab;
    __device__ __forceinline__ void mid(f32x4 (&acc)[2][2][4][2], const Unit& u, int ui, int tid_) const {
        const int tid = opaque(tid_), lane = tid & 63, wid = __builtin_amdgcn_readfirstlane(tid >> 6), wr = wid >> 2, wc = wid & 3, fr = lane & 15, fq = lane >> 4;
        const int rl0 = wr * 64 + fr;
#pragma unroll
        for (int ai = 0; ai < 2; ++ai)
#pragma unroll
            for (int m = 0; m < 4; ++m) {
                const float ratio = tab[(ui * 256 + rl0 + ai * HALF + m * 16) * 2];
#pragma unroll
                for (int bj = 0; bj < 2; ++bj) { acc[ai][bj][m][0] *= ratio; acc[ai][bj][m][1] *= ratio; }
            }
    }
    __device__ __forceinline__ void operator()(const f32x4 (&acc)[2][2][4][2], const Unit& u, int ui, int tid_) const {
        const int tid = opaque(tid_), lane = tid & 63, wid = __builtin_amdgcn_readfirstlane(tid >> 6), wr = wid >> 2, wc = wid & 3, fr = lane & 15, fq = lane >> 4;
        const int rl0 = wr * 64 + fr, row0 = u.pm * BM + rl0;
#pragma unroll
        for (int ai = 0; ai < 2; ++ai)
#pragma unroll
            for (int m = 0; m < 4; ++m) {
                const int row = row0 + ai * HALF + m * 16;
                const float rb = tab[(ui * 256 + rl0 + ai * HALF + m * 16) * 2 + 1];
#pragma unroll
                for (int bj = 0; bj < 2; ++bj)
                    store8(MIX + (size_t)row * DM + u.pn * BM + bj * HALF + wc * 32 + 8 * fq, acc[ai][bj][m][0] * rb, acc[ai][bj][m][1] * rb);
            }
    }
};

struct EpiPlainQ8 {
    static constexpr bool PERM = true, MID = false, I8 = true;
    bf16_t* O; int ldc; const float* hs; const float* wsn;
    __device__ __forceinline__ void mid(f32x4 (&)[2][2][4][2], const Unit&, int, int) const {}
    __device__ __forceinline__ void operator()(const f32x4 (&acc)[2][2][4][2], const Unit& u, int ui, int tid_) const {
        const int tid = opaque(tid_), lane = tid & 63, wid = __builtin_amdgcn_readfirstlane(tid >> 6), wr = wid >> 2, wc = wid & 3, fr = lane & 15, fq = lane >> 4;
        const int row0 = u.pm * BM + wr * 64 + fr, col0 = u.pn * BM + wc * 32 + 8 * fq;
        f32x4 cs[2][2];
#pragma unroll
        for (int bj = 0; bj < 2; ++bj) { cs[bj][0] = *(const f32x4*)(wsn + col0 + bj * HALF); cs[bj][1] = *(const f32x4*)(wsn + col0 + bj * HALF + 4); }
#pragma unroll
        for (int ai = 0; ai < 2; ++ai)
#pragma unroll
            for (int m = 0; m < 4; ++m) {
                const int row = row0 + ai * HALF + m * 16; const float rs = hs[row];
#pragma unroll
                for (int bj = 0; bj < 2; ++bj)
                    store8(O + (size_t)row * ldc + col0 + bj * HALF, EpiProj::i2f4(acc[ai][bj][m][0]) * rs * cs[bj][0], EpiProj::i2f4(acc[ai][bj][m][1]) * rs * cs[bj][1]);
            }
    }
};

struct EpiPlain {
    static constexpr bool PERM = true, MID = false, I8 = false;
    bf16_t* O; int ldc;
    __device__ __forceinline__ void mid(f32x4 (&)[2][2][4][2], const Unit&, int, int) const {}
    __device__ __forceinline__ void operator()(const f32x4 (&acc)[2][2][4][2], const Unit& u, int ui, int tid_) const {
        const int tid = opaque(tid_), lane = tid & 63, wid = __builtin_amdgcn_readfirstlane(tid >> 6), wr = wid >> 2, wc = wid & 3, fr = lane & 15, fq = lane >> 4;
        const int row0 = u.pm * BM + wr * 64 + fr;
#pragma unroll
        for (int ai = 0; ai < 2; ++ai)
#pragma unroll
            for (int m = 0; m < 4; ++m) {
                const int row = row0 + ai * HALF + m * 16;
#pragma unroll
                for (int bj = 0; bj < 2; ++bj)
                    store8(O + (size_t)row * ldc + u.pn * BM + bj * HALF + wc * 32 + 8 * fq, acc[ai][bj][m][0], acc[ai][bj][m][1]);
            }
    }
};
}

namespace att {
#define KSWZ(row, colB) ((row) * 256 + ((colB) ^ (((row) & 7) << 4)))
#define SBAR() __builtin_amdgcn_sched_barrier(0)
__device__ __forceinline__ int crow(int r, int hi) { return (r & 3) + 8 * (r >> 2) + 4 * hi; }
constexpr int L_KN = 0, L_KR = 32768, L_V = 49152, L_WS = 81920, L_QR = 83968, L_END = 83968 + 32768;
__device__ __forceinline__ int v_st(int k, int c) { const int kk = (k & ~0xC) | ((k & 4) << 1) | ((k & 8) >> 1); return ((kk >> 3) * 4 + (c >> 5)) * 512 + ((kk & 7) * 32 + (c & 31)) * 2; }
__device__ __forceinline__ int v_rd_base(int lane) { return ((lane & 3) << 3) | (((lane >> 2) & 3) << 6) | (((lane >> 4) & 1) << 5) | (((lane >> 5) & 1) << 8); }
constexpr int v_rd_off(int d0, int ks, int half) { return d0 * 512 + ks * 4096 + half * 2048; }
template <int OFF> __device__ __forceinline__ s16x4 tr_read(int vb) {
    s16x4 r; asm volatile("ds_read_b64_tr_b16 %0, %1 offset:%2" : "=&v"(r) : "v"(vb), "i"(OFF) : "memory"); return r;
}
template <int D0> __device__ __forceinline__ void pv_one(f32x16& od, int vb, bf16x8 pa0, bf16x8 pa1, bf16x8 pa2, bf16x8 pa3) {
    const s16x4 l0 = tr_read<v_rd_off(D0, 0, 0)>(vb), h0 = tr_read<v_rd_off(D0, 0, 1)>(vb), l1 = tr_read<v_rd_off(D0, 1, 0)>(vb), h1 = tr_read<v_rd_off(D0, 1, 1)>(vb);
    const s16x4 l2 = tr_read<v_rd_off(D0, 2, 0)>(vb), h2 = tr_read<v_rd_off(D0, 2, 1)>(vb), l3 = tr_read<v_rd_off(D0, 3, 0)>(vb), h3 = tr_read<v_rd_off(D0, 3, 1)>(vb);
    asm volatile("s_waitcnt lgkmcnt(0)" ::: "memory"); SBAR();
#define PK(L, H) (bf16x8){L[0], L[1], L[2], L[3], H[0], H[1], H[2], H[3]}
    od = __builtin_amdgcn_mfma_f32_32x32x16_bf16(pa0, PK(l0, h0), od, 0, 0, 0);
    od = __builtin_amdgcn_mfma_f32_32x32x16_bf16(pa1, PK(l1, h1), od, 0, 0, 0);
    od = __builtin_amdgcn_mfma_f32_32x32x16_bf16(pa2, PK(l2, h2), od, 0, 0, 0);
    od = __builtin_amdgcn_mfma_f32_32x32x16_bf16(pa3, PK(l3, h3), od, 0, 0, 0);
#undef PK
}

struct UnitP { int b, h, dil, rho0, ngrp, qbase, kfirst, tpg, W, mode; };
struct Tens { const bf16_t *Qm, *Qr, *Km, *Kr, *Vm; bf16_t* So; float *Sm, *Sl; bf16_t* Oout; int ocol0; float* ssq; int ssq0; };

template <bool MLA>
__device__ __forceinline__ void attn_unit(const int tid_in, const UnitP P, LAS unsigned char* lds, const Tens& X) {
    const int tid = opaque(tid_in);
    constexpr float SCALE = MLA ? 0.07216878364870322f : 0.08838834764831845f;
    constexpr float C = SCALE * 1.4426950408889634f;
    constexpr float THRS = 8.f / SCALE;
    constexpr int NQ = 8;
    const int wid = __builtin_amdgcn_readfirstlane(tid >> 6), lane = tid & 63, r32 = lane & 31, hi = lane >> 5;
    const int g = (P.ngrp == 2) ? (wid >> 2) : 0, wq = (P.ngrp == 2) ? (wid & 3) : wid;
    const int qpos0 = P.qbase + 32 * wq, rho_w = P.rho0 + g;
    const long tb = (long)P.b * SEQ;
    const long qtok = tb + (long)(qpos0 + r32) * P.dil + rho_w;
    LAS float* wsf = (LAS float*)(lds + L_WS) + wid * 64;
    bf16x8 qr[NQ];
    { const bf16_t* qp = X.Qm + qtok * 1024 + P.h * 128 + hi * 8;
#pragma unroll
      for (int d0 = 0; d0 < 8; ++d0) qr[d0] = *(const bf16x8*)(qp + d0 * 16); }
    LAS unsigned char* qrp = lds + L_QR + wid * 4096 + lane * 16;
    if constexpr (MLA) { const bf16_t* qp = X.Qr + qtok * 512 + P.h * 64 + hi * 8;
#pragma unroll
      for (int d0 = 0; d0 < 4; ++d0) *(LAS bf16x8*)(qrp + d0 * 1024) = *(const bf16x8*)(qp + d0 * 16); }
    float m_reg = -1e30f, l_reg = 0.f; f32x16 o[4];
#pragma unroll
    for (int d = 0; d < 4; ++d) o[d] = f32x16{};
    LAS unsigned char* stg = lds + wid * 8704;
    if (P.mode & 1) {
        m_reg = X.Sm[qtok * 8 + P.h]; l_reg = X.Sl[qtok * 8 + P.h];
#pragma unroll 2
        for (int i = 0; i < 8; ++i) { const int le = opaque(lane), row = i * 4 + (le >> 4), ch = le & 15; const long tr = tb + (long)(qpos0 + row) * P.dil + rho_w;
            *(LAS u32x4*)(stg + row * 272 + ch * 16) = *(const u32x4*)(X.So + tr * 1024 + P.h * 128 + ch * 8); }
        asm volatile("s_waitcnt lgkmcnt(0)" ::: "memory");
#pragma unroll
        for (int r = 0; r < 16; ++r)
#pragma unroll
            for (int d = 0; d < 4; ++d) o[d][r] = __uint_as_float((unsigned)(*(const LAS unsigned short*)(stg + crow(r, hi) * 272 + (32 * d + r32) * 2)) << 16);
        asm volatile("s_waitcnt lgkmcnt(0)" ::: "memory");
        __syncthreads();
    }
    const int sr = tid >> 4, sc = (tid & 15) * 8;
    const int rr = tid >> 3, rc = tid & 7;
    const int NT = P.ngrp * P.tpg;
    const int vb0 = (int)(uintptr_t)(lds + L_V) + v_rd_base(lane);
    bf16x8 ks0, ks1, vs0, vs1, krs;
#define LOADT(jt) do { const int gj_ = (jt) / P.tpg; const int kp_ = P.kfirst + 64 * ((jt) - gj_ * P.tpg); const int rho_ = P.rho0 + gj_; \
        const long t0_ = tb + (long)(kp_ + sr) * P.dil + rho_, t1_ = tb + (long)(kp_ + 32 + sr) * P.dil + rho_; \
        ks0 = *(const bf16x8*)(X.Km + t0_ * 1024 + P.h * 128 + sc); ks1 = *(const bf16x8*)(X.Km + t1_ * 1024 + P.h * 128 + sc); \
        vs0 = *(const bf16x8*)(X.Vm + t0_ * 1024 + P.h * 128 + sc); vs1 = *(const bf16x8*)(X.Vm + t1_ * 1024 + P.h * 128 + sc); \
        if constexpr (MLA) { const long t2_ = tb + (long)(kp_ + rr) * P.dil + rho_; krs = *(const bf16x8*)(X.Kr + t2_ * 64 + rc * 8); } } while (0)
#define WRITET(buf) do { *(LAS bf16x8*)(lds + L_KN + (buf) * 16384 + KSWZ(sr, sc * 2)) = ks0; *(LAS bf16x8*)(lds + L_KN + (buf) * 16384 + KSWZ(32 + sr, sc * 2)) = ks1; \
        *(LAS bf16x8*)(lds + L_V + (buf) * 16384 + v_st(sr, sc)) = vs0; *(LAS bf16x8*)(lds + L_V + (buf) * 16384 + v_st(32 + sr, sc)) = vs1; \
        if constexpr (MLA) { *(LAS bf16x8*)(lds + L_KR + (buf) * 8192 + rr * 128 + ((rc ^ ((rr >> 1) & 7)) << 4)) = krs; } } while (0)
    LOADT(0);
    if (wid >= 4) __builtin_amdgcn_s_setprio(1);
    for (int jt = 0; jt < NT; ++jt) {
        const int buf = jt & 1;
        WRITET(buf);
        if (jt + 1 < NT) LOADT(jt + 1);
        __syncthreads();
        const int gj = jt / P.tpg, kpos0 = P.kfirst + 64 * (jt - gj * P.tpg);
        const bool active = (gj == g) && (kpos0 <= qpos0 + 31) && (kpos0 + 63 >= qpos0 - P.W);
        if (active) {
            f32x16 p0 = f32x16{}, p1 = f32x16{};
            { const LAS unsigned char* kb = lds + L_KN + buf * 16384;
#pragma unroll
              for (int d0 = 0; d0 < 8; ++d0) { const int cb = (d0 * 16 + hi * 8) * 2;
                const bf16x8 b0 = *(const LAS bf16x8*)(kb + KSWZ(r32, cb)), b1 = *(const LAS bf16x8*)(kb + KSWZ(32 + r32, cb));
                p0 = __builtin_amdgcn_mfma_f32_32x32x16_bf16(b0, qr[d0], p0, 0, 0, 0);
                p1 = __builtin_amdgcn_mfma_f32_32x32x16_bf16(b1, qr[d0], p1, 0, 0, 0); } }
            if constexpr (MLA) { const LAS unsigned char* kb = lds + L_KR + buf * 8192;
#pragma unroll
              for (int d0 = 0; d0 < 4; ++d0) { const int ch = 2 * d0 + hi; const int off = ((ch ^ ((r32 >> 1) & 7)) << 4);
                const bf16x8 b0 = *(const LAS bf16x8*)(kb + r32 * 128 + off), b1 = *(const LAS bf16x8*)(kb + (32 + r32) * 128 + off);
                const bf16x8 qf = *(const LAS bf16x8*)(qrp + d0 * 1024);
                p0 = __builtin_amdgcn_mfma_f32_32x32x16_bf16(b0, qf, p0, 0, 0, 0);
                p1 = __builtin_amdgcn_mfma_f32_32x32x16_bf16(b1, qf, p1, 0, 0, 0); } }
            const bool full = (kpos0 + 63 <= qpos0) && (kpos0 >= qpos0 + 31 - P.W);
            if (!full) { const int qp = qpos0 + r32;
#pragma unroll
                for (int r = 0; r < 16; ++r) { const int dq0 = qp - (kpos0 + crow(r, hi)), dq1 = dq0 - 32;
                    if (dq0 < 0 || dq0 > P.W) p0[r] = -INFINITY; if (dq1 < 0 || dq1 > P.W) p1[r] = -INFINITY; } }
            float pmax = p0[0];
#pragma unroll
            for (int r = 1; r < 16; ++r) pmax = fmaxf(pmax, p0[r]);
#pragma unroll
            for (int r = 0; r < 16; ++r) pmax = fmaxf(pmax, p1[r]);
            { auto sw = __builtin_amdgcn_permlane32_swap(__float_as_uint(pmax), __float_as_uint(pmax), false, false); pmax = fmaxf(__uint_as_float(sw[0]), __uint_as_float(sw[1])); }
            float mn, alpha;
            if (__builtin_expect(__all(pmax - m_reg <= THRS), 1)) { mn = m_reg; alpha = 1.f; }
            else { mn = fmaxf(m_reg, pmax); alpha = __builtin_amdgcn_exp2f((m_reg - mn) * C); m_reg = mn; }
            const float mnC = -mn * C;
#pragma unroll
            for (int r = 0; r < 16; ++r) { p0[r] = __builtin_amdgcn_exp2f(fmaf(p0[r], C, mnC)); p1[r] = __builtin_amdgcn_exp2f(fmaf(p1[r], C, mnC)); }
            if (__any(alpha < 1.f)) { if (hi == 0) wsf[r32] = alpha; asm volatile("s_waitcnt lgkmcnt(0)" ::: "memory");
#pragma unroll
                for (int r = 0; r < 16; ++r) { const float al = wsf[crow(r, hi)];
#pragma unroll
                    for (int d = 0; d < 4; ++d) o[d][r] *= al; }
                asm volatile("s_waitcnt lgkmcnt(0)" ::: "memory"); }
            float ps = 0.f;
#pragma unroll
            for (int r = 0; r < 16; ++r) ps += p0[r];
#pragma unroll
            for (int r = 0; r < 16; ++r) ps += p1[r];
            { auto sw = __builtin_amdgcn_permlane32_swap(__float_as_uint(ps), __float_as_uint(ps), false, false); ps = __uint_as_float(sw[0]) + __uint_as_float(sw[1]); }
            l_reg = l_reg * alpha + ps;
            bf16x8 pa0, pa1, pa2, pa3;
#define PK4(Pv, BASE, OUT) do { unsigned a0 = cvtpk(Pv[BASE + 0], Pv[BASE + 1]), a1 = cvtpk(Pv[BASE + 2], Pv[BASE + 3]);   \
    unsigned b0 = cvtpk(Pv[BASE + 4], Pv[BASE + 5]), b1 = cvtpk(Pv[BASE + 6], Pv[BASE + 7]);                              \
    auto r0 = __builtin_amdgcn_permlane32_swap(a0, b0, false, false); auto r1 = __builtin_amdgcn_permlane32_swap(a1, b1, false, false); \
    u32x4 w = {r0[0], r1[0], r0[1], r1[1]}; OUT = __builtin_bit_cast(bf16x8, w); } while (0)
            PK4(p0, 0, pa0); PK4(p0, 8, pa1); PK4(p1, 0, pa2); PK4(p1, 8, pa3);
#undef PK4
            SBAR();
            const int vb = vb0 + buf * 16384;
            pv_one<0>(o[0], vb, pa0, pa1, pa2, pa3); pv_one<1>(o[1], vb, pa0, pa1, pa2, pa3); pv_one<2>(o[2], vb, pa0, pa1, pa2, pa3); pv_one<3>(o[3], vb, pa0, pa1, pa2, pa3);
        }
    }
#undef LOADT
#undef WRITET
    __builtin_amdgcn_s_setprio(0);
    asm volatile("s_waitcnt lgkmcnt(0)" ::: "memory");
    __syncthreads();
    if (P.mode & 2) {
        if (hi == 0) wsf[32 + r32] = l_reg; asm volatile("s_waitcnt lgkmcnt(0)" ::: "memory");
#pragma unroll
        for (int r = 0; r < 16; ++r) { const int qrow = crow(r, hi); const float rl = 1.0f / wsf[32 + qrow];
            const long tr = tb + (long)(qpos0 + qrow) * P.dil + rho_w; float sq = 0.f;
#pragma unroll
            for (int d = 0; d < 4; ++d) { const float v = o[d][r] * rl; sq += v * v; *(LAS unsigned short*)(stg + qrow * 272 + (32 * d + r32) * 2) = (unsigned short)(cvtpk(v, v) & 0xffffu); }
            sq += __shfl_xor(sq, 1); sq += __shfl_xor(sq, 2); sq += __shfl_xor(sq, 4); sq += __shfl_xor(sq, 8); sq += __shfl_xor(sq, 16);
            if (r32 == 0) X.ssq[tr * 16 + X.ssq0 + P.h] = sq; }
        asm volatile("s_waitcnt lgkmcnt(0)" ::: "memory");
#pragma unroll 2
        for (int i = 0; i < 8; ++i) { const int le = opaque(lane), row = i * 4 + (le >> 4), ch = le & 15; const long tr = tb + (long)(qpos0 + row) * P.dil + rho_w;
            *(u32x4*)(X.Oout + tr * 2048 + X.ocol0 + P.h * 128 + ch * 8) = *(const LAS u32x4*)(stg + row * 272 + ch * 16); }
    } else {
        if (hi == 0) { X.Sm[qtok * 8 + P.h] = m_reg; X.Sl[qtok * 8 + P.h] = l_reg; }
#pragma unroll
        for (int r = 0; r < 16; ++r)
#pragma unroll
            for (int d = 0; d < 4; ++d) { const float v = o[d][r]; *(LAS unsigned short*)(stg + crow(r, hi) * 272 + (32 * d + r32) * 2) = (unsigned short)(cvtpk(v, v) & 0xffffu); }
        asm volatile("s_waitcnt lgkmcnt(0)" ::: "memory");
#pragma unroll 2
        for (int i = 0; i < 8; ++i) { const int le = opaque(lane), row = i * 4 + (le >> 4), ch = le & 15; const long tr = tb + (long)(qpos0 + row) * P.dil + rho_w;
            *(u32x4*)(X.So + tr * 1024 + P.h * 128 + ch * 8) = *(const LAS u32x4*)(stg + row * 272 + ch * 16); }
    }
    asm volatile("s_waitcnt lgkmcnt(0)" ::: "memory");
    __syncthreads();
}

struct WaveA { int b, h, dil, rho, qpos0, mode; };
__device__ __forceinline__ void attnA_wave(const int lane_in, const WaveA P, LAS unsigned char* wl  , LAS float* wsf, const Tens& X) {
    constexpr float SCALE = 0.08838834764831845f, C = SCALE * 1.4426950408889634f, THRS = 8.f / SCALE;
    const int lane = opaque(lane_in), r32 = lane & 31, hi = lane >> 5;
    const long tb = (long)P.b * SEQ;
    const long qtok = tb + (long)(P.qpos0 + r32) * P.dil + P.rho;
    LAS unsigned char* vbuf = wl; LAS unsigned char* stg = wl + 8192;
    bf16x8 qr[8];
    { const bf16_t* qp = X.Qm + qtok * 1024 + P.h * 128 + hi * 64;
#pragma unroll
      for (int d0 = 0; d0 < 8; ++d0) qr[d0] = *(const bf16x8*)(qp + d0 * 8); }
    float m_reg = -1e30f, l_reg = 0.f; f32x16 o[4];
#pragma unroll
    for (int d = 0; d < 4; ++d) o[d] = f32x16{};
    if (P.mode & 1) {
        m_reg = X.Sm[qtok * 8 + P.h]; l_reg = X.Sl[qtok * 8 + P.h];
#pragma unroll 2
        for (int i = 0; i < 8; ++i) { const int le = opaque(lane), row = i * 4 + (le >> 4), ch = le & 15; const long tr = tb + (long)(P.qpos0 + row) * P.dil + P.rho;
            *(LAS u32x4*)(stg + row * 272 + ch * 16) = *(const u32x4*)(X.So + tr * 1024 + P.h * 128 + ch * 8); }
        asm volatile("s_waitcnt lgkmcnt(0)" ::: "memory");
#pragma unroll
        for (int r = 0; r < 16; ++r)
#pragma unroll
            for (int d = 0; d < 4; ++d) o[d][r] = __uint_as_float((unsigned)(*(const LAS unsigned short*)(stg + crow(r, hi) * 272 + (32 * d + r32) * 2)) << 16);
    }
    const int kfirst = P.qpos0 >= 128 ? P.qpos0 - 128 : 0;
    const int vrow = lane >> 3, vcol = (lane & 7) * 16;
    const int vb = (int)(uintptr_t)vbuf + v_rd_base(lane);
    const unsigned char* K8 = (const unsigned char*)X.Km; const unsigned char* V8 = (const unsigned char*)X.Vm;
    u32x4 nk[4], nv[4];
#define A_LOAD(kc) do { const long tk_ = tb + (long)((kc) + r32) * P.dil + P.rho; const unsigned char* kp_ = K8 + tk_ * 1024 + P.h * 128 + hi * 64; \
        _Pragma("unroll") for (int j = 0; j < 4; ++j) nk[j] = *(const u32x4*)(kp_ + j * 16); \
        _Pragma("unroll") for (int i = 0; i < 4; ++i) { const long tv_ = tb + (long)((kc) + vrow + 8 * i) * P.dil + P.rho; nv[i] = *(const u32x4*)(V8 + tv_ * 1024 + P.h * 128 + vcol); } } while (0)
#define A_CVT8(lo, hi_) ({ const f32x2 a_ = __builtin_amdgcn_cvt_pk_f32_fp8((int)(lo), false), b_ = __builtin_amdgcn_cvt_pk_f32_fp8((int)(lo), true), \
        c_ = __builtin_amdgcn_cvt_pk_f32_fp8((int)(hi_), false), d_ = __builtin_amdgcn_cvt_pk_f32_fp8((int)(hi_), true); \
        u32x4 w_ = {cvtpk(a_[0], a_[1]), cvtpk(b_[0], b_[1]), cvtpk(c_[0], c_[1]), cvtpk(d_[0], d_[1])}; __builtin_bit_cast(bf16x8, w_); })
    A_LOAD(kfirst);
    for (int kc0 = kfirst; kc0 <= P.qpos0; kc0 += 32) {
        bf16x8 kf[8];
#pragma unroll
        for (int j = 0; j < 4; ++j) { const unsigned x0 = nk[j][0], x1 = nk[j][1], x2 = nk[j][2], x3 = nk[j][3]; kf[2 * j] = A_CVT8(x0, x1); kf[2 * j + 1] = A_CVT8(x2, x3); }
#pragma unroll
        for (int i = 0; i < 4; ++i) { const unsigned x0 = nv[i][0], x1 = nv[i][1], x2 = nv[i][2], x3 = nv[i][3];
            *(LAS bf16x8*)(vbuf + v_st(vrow + 8 * i, vcol)) = A_CVT8(x0, x1); *(LAS bf16x8*)(vbuf + v_st(vrow + 8 * i, vcol + 8)) = A_CVT8(x2, x3); }
        if (kc0 + 32 <= P.qpos0) A_LOAD(kc0 + 32);
        f32x16 p0 = f32x16{};
#pragma unroll
        for (int d0 = 0; d0 < 8; ++d0) p0 = __builtin_amdgcn_mfma_f32_32x32x16_bf16(kf[d0], qr[d0], p0, 0, 0, 0);
        const bool full = (kc0 + 31 <= P.qpos0) && (kc0 >= P.qpos0 + 31 - 128);
        if (!full) { const int qp = P.qpos0 + r32;
#pragma unroll
            for (int r = 0; r < 16; ++r) { const int dq = qp - (kc0 + crow(r, hi)); if (dq < 0 || dq > 128) p0[r] = -INFINITY; } }
        float pmax = p0[0];
#pragma unroll
        for (int r = 1; r < 16; ++r) pmax = fmaxf(pmax, p0[r]);
        { auto sw = __builtin_amdgcn_permlane32_swap(__float_as_uint(pmax), __float_as_uint(pmax), false, false); pmax = fmaxf(__uint_as_float(sw[0]), __uint_as_float(sw[1])); }
        float mn, alpha;
        if (__builtin_expect(__all(pmax - m_reg <= THRS), 1)) { mn = m_reg; alpha = 1.f; }
        else { mn = fmaxf(m_reg, pmax); alpha = __builtin_amdgcn_exp2f((m_reg - mn) * C); m_reg = mn; }
        const float mnC = -mn * C;
#pragma unroll
        for (int r = 0; r < 16; ++r) p0[r] = __builtin_amdgcn_exp2f(fmaf(p0[r], C, mnC));
        if (__any(alpha < 1.f)) { if (hi == 0) wsf[r32] = alpha; asm volatile("s_waitcnt lgkmcnt(0)" ::: "memory");
#pragma unroll
            for (int r = 0; r < 16; ++r) { const float al = wsf[crow(r, hi)];
#pragma unroll
                for (int d = 0; d < 4; ++d) o[d][r] *= al; }
            asm volatile("s_waitcnt lgkmcnt(0)" ::: "memory"); }
        float ps = 0.f;
#pragma unroll
        for (int r = 0; r < 16; ++r) ps += p0[r];
        { auto sw = __builtin_amdgcn_permlane32_swap(__float_as_uint(ps), __float_as_uint(ps), false, false); ps = __uint_as_float(sw[0]) + __uint_as_float(sw[1]); }
        l_reg = l_reg * alpha + ps;
        bf16x8 pa0, pa1;
#define PK4(Pv, BASE, OUT) do { unsigned a0 = cvtpk(Pv[BASE + 0], Pv[BASE + 1]), a1 = cvtpk(Pv[BASE + 2], Pv[BASE + 3]);   \
    unsigned b0 = cvtpk(Pv[BASE + 4], Pv[BASE + 5]), b1 = cvtpk(Pv[BASE + 6], Pv[BASE + 7]);                              \
    auto r0 = __builtin_amdgcn_permlane32_swap(a0, b0, false, false); auto r1 = __builtin_amdgcn_permlane32_swap(a1, b1, false, false); \
    u32x4 w = {r0[0], r1[0], r0[1], r1[1]}; OUT = __builtin_bit_cast(bf16x8, w); } while (0)
        PK4(p0, 0, pa0); PK4(p0, 8, pa1);
#undef PK4
        SBAR();
#define A_PV(D0) do { const s16x4 l0 = tr_read<v_rd_off(D0, 0, 0)>(vb), h0 = tr_read<v_rd_off(D0, 0, 1)>(vb), l1 = tr_read<v_rd_off(D0, 1, 0)>(vb), h1 = tr_read<v_rd_off(D0, 1, 1)>(vb); \
        asm volatile("s_waitcnt lgkmcnt(0)" ::: "memory"); SBAR(); \
        o[D0] = __builtin_amdgcn_mfma_f32_32x32x16_bf16(pa0, (bf16x8){l0[0], l0[1], l0[2], l0[3], h0[0], h0[1], h0[2], h0[3]}, o[D0], 0, 0, 0); \
        o[D0] = __builtin_amdgcn_mfma_f32_32x32x16_bf16(pa1, (bf16x8){l1[0], l1[1], l1[2], l1[3], h1[0], h1[1], h1[2], h1[3]}, o[D0], 0, 0, 0); } while (0)
        A_PV(0); A_PV(1); A_PV(2); A_PV(3);
#undef A_PV
        asm volatile("s_waitcnt lgkmcnt(0)" ::: "memory");
    }
#undef A_LOAD
#undef A_CVT8
    if (P.mode & 2) {
        if (hi == 0) wsf[32 + r32] = l_reg; asm volatile("s_waitcnt lgkmcnt(0)" ::: "memory");
#pragma unroll
        for (int r = 0; r < 16; ++r) { const int qrow = crow(r, hi); const float rl = 1.0f / wsf[32 + qrow];
            const long tr = tb + (long)(P.qpos0 + qrow) * P.dil + P.rho; float sq = 0.f;
#pragma unroll
            for (int d = 0; d < 4; ++d) { const float v = o[d][r] * rl; sq += v * v; *(LAS unsigned short*)(stg + qrow * 272 + (32 * d + r32) * 2) = (unsigned short)(cvtpk(v, v) & 0xffffu); }
            sq += __shfl_xor(sq, 1); sq += __shfl_xor(sq, 2); sq += __shfl_xor(sq, 4); sq += __shfl_xor(sq, 8); sq += __shfl_xor(sq, 16);
            if (r32 == 0) X.ssq[tr * 16 + X.ssq0 + P.h] = sq; }
        asm volatile("s_waitcnt lgkmcnt(0)" ::: "memory");
#pragma unroll 2
        for (int i = 0; i < 8; ++i) { const int le = opaque(lane), row = i * 4 + (le >> 4), ch = le & 15; const long tr = tb + (long)(P.qpos0 + row) * P.dil + P.rho;
            *(u32x4*)(X.Oout + tr * 2048 + X.ocol0 + P.h * 128 + ch * 8) = *(const LAS u32x4*)(stg + row * 272 + ch * 16); }
    } else {
        if (hi == 0) { X.Sm[qtok * 8 + P.h] = m_reg; X.Sl[qtok * 8 + P.h] = l_reg; }
#pragma unroll
        for (int r = 0; r < 16; ++r)
#pragma unroll
            for (int d = 0; d < 4; ++d) { const float v = o[d][r]; *(LAS unsigned short*)(stg + crow(r, hi) * 272 + (32 * d + r32) * 2) = (unsigned short)(cvtpk(v, v) & 0xffffu); }
        asm volatile("s_waitcnt lgkmcnt(0)" ::: "memory");
#pragma unroll 2
        for (int i = 0; i < 8; ++i) { const int le = opaque(lane), row = i * 4 + (le >> 4), ch = le & 15; const long tr = tb + (long)(P.qpos0 + row) * P.dil + P.rho;
            *(u32x4*)(X.So + tr * 1024 + P.h * 128 + ch * 8) = *(const LAS u32x4*)(stg + row * 272 + ch * 16); }
    }
    asm volatile("s_waitcnt lgkmcnt(0)" ::: "memory");
}
}

namespace pk {
__device__ __forceinline__ void ce(int& a, int& b) { const int hi = max(a, b), lo = min(a, b); a = hi; b = lo; }
__device__ __forceinline__ void sort16(int (&v)[16]) {
#pragma unroll
    for (int k = 2; k <= 16; k <<= 1)
#pragma unroll
        for (int j = k >> 1; j > 0; j >>= 1)
#pragma unroll
            for (int i = 0; i < 16; ++i) { const int l = i ^ j; if (l > i) { if ((i & k) == 0) ce(v[i], v[l]); else ce(v[l], v[i]); } }
}
__device__ __forceinline__ void bmerge16(int (&c)[16]) {
#pragma unroll
    for (int j = 8; j > 0; j >>= 1)
#pragma unroll
        for (int i = 0; i < 16; ++i) { const int l = i ^ j; if (l > i) ce(c[i], c[l]); }
}
__device__ __forceinline__ void merge_top16(int (&a)[16], const int (&b)[16]) {
#pragma unroll
    for (int i = 0; i < 16; ++i) a[i] = max(a[i], b[15 - i]);
    bmerge16(a);
}
__device__ __forceinline__ int f2key(float f) { const int b = __float_as_int(f); return b ^ ((b >> 31) & 0x7fffffff); }
__device__ __forceinline__ float key2f(int k) { return __int_as_float(k ^ ((k >> 31) & 0x7fffffff)); }
}

#define XB_TMO      128
#define XB_XCNT(j)  (256  + 64 * (j))
#define XB_XSUB(j)  (1280 + 64 * (j))
#define XB_XGEN(j)  (2304 + 64 * (j))
#define XB_TOP      3328
#define XB_TOPGEN   3392
#define XCD_BAR_WORDS 3456
#define XB_SPIN_CAP (1u << 22)
__device__ __forceinline__ unsigned xb_ld(unsigned* p)              { return __hip_atomic_load(p, __ATOMIC_RELAXED, __HIP_MEMORY_SCOPE_AGENT); }
__device__ __forceinline__ unsigned xb_add(unsigned* p, unsigned v) { return __hip_atomic_fetch_add(p, v, __ATOMIC_RELAXED, __HIP_MEMORY_SCOPE_AGENT); }
__device__ __forceinline__ unsigned xb_xcc_id() { return (unsigned)__builtin_amdgcn_s_getreg((3 << 11) | 20) & 0xFu; }
#define XB_SPIN(cond, bar) do { unsigned _sp = 0; while (cond) { __builtin_amdgcn_s_sleep(1); \
    if ((++_sp & 255u) == 0u) { if (xb_ld(&(bar)[XB_TMO])) break; if (_sp > XB_SPIN_CAP) { atomicAdd(&(bar)[XB_TMO], 1u); break; } } } } while (0)
struct XcdBarrier { unsigned* bar; unsigned x; volatile LAS unsigned* st; };
__device__ __forceinline__ XcdBarrier xcd_barrier_post(unsigned* bar, volatile LAS unsigned* st) {
    XcdBarrier b; b.bar = bar; b.x = xb_xcc_id(); b.st = st;
    if (threadIdx.x == 0) (void)xb_add(&bar[XB_XCNT(b.x)], 1u);
    return b;
}
__device__ __forceinline__ void xcd_barrier_complete(unsigned* bar, unsigned x, unsigned& nloc, unsigned& nx) {
    const unsigned G = gridDim.x * gridDim.y * gridDim.z;
    unsigned sum, cnt, mine, sp = 0u;
    for (;;) {
        sum = 0u; cnt = 0u; mine = 0u;
#pragma unroll
        for (unsigned j = 0; j < 16; ++j) { const unsigned c = xb_ld(&bar[XB_XCNT(j)]); sum += c; cnt += (c > 0u) ? 1u : 0u; mine = (j == x) ? c : mine; }
        if (sum == G) break;
        __builtin_amdgcn_s_sleep(1);
        if ((++sp & 255u) == 0u) { if (xb_ld(&bar[XB_TMO])) break; if (sp > XB_SPIN_CAP) { atomicAdd(&bar[XB_TMO], 1u); break; } }
    }
    nloc = mine > 0u ? mine : 1u; nx = cnt > 0u ? cnt : 1u;
}
__device__ __forceinline__ void xcd_barrier(const XcdBarrier& b) {
    asm volatile("s_waitcnt vmcnt(0)" ::: "memory");
    __syncthreads();
    if (threadIdx.x == 0) {
        unsigned* bar = b.bar;
        __builtin_amdgcn_s_waitcnt(0);
        unsigned nloc = b.st[0], nx = b.st[1];
        if (nloc == 0u) { xcd_barrier_complete(bar, b.x, nloc, nx); b.st[0] = nloc; b.st[1] = nx; }
        const unsigned old = xb_add(&bar[XB_XSUB(b.x)], 1u);
        const unsigned gen = old / nloc;
        if (old + 1u == (gen + 1u) * nloc) {
            __builtin_amdgcn_fence(__ATOMIC_RELEASE, "agent");
            asm volatile("s_waitcnt vmcnt(0)" ::: "memory");
            const unsigned og = xb_add(&bar[XB_TOP], 1u);
            const unsigned tg = og / nx;
            if (og + 1u == (tg + 1u) * nx) xb_add(&bar[XB_TOPGEN], 1u);
            else XB_SPIN(xb_ld(&bar[XB_TOPGEN]) == tg, bar);
            __builtin_amdgcn_fence(__ATOMIC_ACQUIRE, "agent");
            xb_add(&bar[XB_XGEN(b.x)], 1u);
            asm volatile("s_waitcnt vmcnt(0)" ::: "memory");
        } else {
            XB_SPIN(xb_ld(&bar[XB_XGEN(b.x)]) == gen, bar);
            __builtin_amdgcn_fence(__ATOMIC_ACQUIRE, "agent");
            asm volatile("s_waitcnt vmcnt(0)" ::: "memory");
        }
    }
    __syncthreads();
}

struct Args { const float* in[22]; float* out; unsigned char* ws; int ph_lo, ph_hi; };
#if defined(NAIVE_PEER)
constexpr int N_PHASES = 12;
#else
constexpr int N_PHASES = 15;
#endif

__device__ __forceinline__ float gelu_erf(float v) { return 0.5f * v * (1.0f + erff(v * 0.70710678118654752f)); }

template <class Map>
__device__ __forceinline__ void transpose_item(const float* W, int K, int N, bf16_t* WT, const float* rscale, LAS float* scr, int item, int lane, Map dst_row) {
    const int nblk = N / 32, kb = item / nblk, nb = item % nblk, k0 = 64 * kb, n0 = 32 * nb;
    float tv[32];
#pragma unroll
    for (int i = 0; i < 32; ++i) tv[i] = W[(size_t)(k0 + 2 * i + (lane >> 5)) * N + n0 + (lane & 31)];
    if (rscale) {
#pragma unroll
        for (int i = 0; i < 32; ++i) tv[i] *= rscale[k0 + 2 * i + (lane >> 5)];
    }
#pragma unroll
    for (int i = 0; i < 32; ++i) scr[(2 * i + (lane >> 5)) * 33 + (lane & 31)] = tv[i];
    asm volatile("s_waitcnt lgkmcnt(0)" ::: "memory");
    const int c = lane & 7;
#pragma unroll
    for (int j = 0; j < 4; ++j) { const int n = (lane >> 3) + 8 * j; const LAS float* s = scr + (8 * c) * 33 + n;
        u32x4 o; o.x = cvtpk(s[0 * 33], s[1 * 33]); o.y = cvtpk(s[2 * 33], s[3 * 33]); o.z = cvtpk(s[4 * 33], s[5 * 33]); o.w = cvtpk(s[6 * 33], s[7 * 33]);
        *(u32x4*)(WT + (size_t)dst_row(n0 + n) * K + k0 + 8 * c) = o; }
    asm volatile("s_waitcnt lgkmcnt(0)" ::: "memory");
}
template <class Map>
__device__ __forceinline__ void transpose_item_q8(const float* W, int K, int N, unsigned char* WT, const float* rscale, const float* cmax, int cstride, float* wscale, LAS float* scr, int item, int lane, Map dst_row) {
    const int nblk = N / 32, kb = item / nblk, nb = item % nblk, k0 = 64 * kb, n0 = 32 * nb;
    float tv[32];
#pragma unroll
    for (int i = 0; i < 32; ++i) tv[i] = W[(size_t)(k0 + 2 * i + (lane >> 5)) * N + n0 + (lane & 31)];
    if (rscale) {
#pragma unroll
        for (int i = 0; i < 32; ++i) tv[i] *= rscale[k0 + 2 * i + (lane >> 5)];
    }
    float mx = 0.f;
#pragma unroll
    for (int c = 0; c < 8; ++c) mx = fmaxf(mx, cmax[c * cstride + n0 + (lane & 31)]);
    const float inv = mx > 0.f ? 127.0f / mx : 1.0f;
    if (kb == 0 && lane < 32) wscale[dst_row(n0 + lane)] = mx > 0.f ? mx * (1.0f / 127.0f) : 1.0f;
#pragma unroll
    for (int i = 0; i < 32; ++i) scr[(2 * i + (lane >> 5)) * 33 + (lane & 31)] = tv[i] * inv;
    asm volatile("s_waitcnt lgkmcnt(0)" ::: "memory");
    const int c = lane & 7;
#pragma unroll
    for (int j = 0; j < 4; ++j) { const int n = (lane >> 3) + 8 * j; const LAS float* s = scr + (8 * c) * 33 + n;
        u32x2 o; o.x = pack_i8x4(s[0 * 33], s[1 * 33], s[2 * 33], s[3 * 33]); o.y = pack_i8x4(s[4 * 33], s[5 * 33], s[6 * 33], s[7 * 33]);
        *(u32x2*)(WT + (size_t)dst_row(n0 + n) * K + k0 + 8 * c) = o; }
    asm volatile("s_waitcnt lgkmcnt(0)" ::: "memory");
}
struct MapIn { __device__ __forceinline__ int operator()(int o) const {
    if (o < 2048) { const int e = o & 127; if (e < 32) { const int i = e & 15, n = e >> 4; return (o & ~127) + 8 * (i >> 2) + 4 * n + (i & 3); } return o; }
    if (o < 4096) return o;
    const int e = o - 4096, n = e >> 5, i = e & 31; return 4096 + 32 * (i >> 4) + 8 * ((i >> 2) & 3) + 4 * n + (i & 3); } };
struct MapUq { __device__ __forceinline__ int operator()(int o) const {
    const int hd = o / 192, e = o - hd * 192; if (e < 128) return hd * 128 + e;
    const int r = e - 128, n = r >> 5, i = r & 31; return 1024 + hd * 64 + 32 * (i >> 4) + 8 * ((i >> 2) & 3) + 4 * n + (i & 3); } };
struct MapOff { int off; __device__ __forceinline__ int operator()(int o) const { return o + off; } };

#define WS_PTRS \
    const float* x = AR.in[0]; \
    float* mod = (float*)(ws + WS_MOD); \
    float* ropeA = (float*)(ws + WS_ROPEA); float* ropeB = (float*)(ws + WS_ROPEB); \
    bf16_t* Win_t = (bf16_t*)(ws + WS_WIN); bf16_t* Wuq_t = (bf16_t*)(ws + WS_WUQ); bf16_t* Wukv_t = (bf16_t*)(ws + WS_WUKV); \
    bf16_t* Wo_t = (bf16_t*)(ws + WS_WO); bf16_t* Wpq_t = (bf16_t*)(ws + WS_WPQ); \
    bf16_t* UT = (bf16_t*)(ws + WS_UT); bf16_t* VT = (bf16_t*)(ws + WS_VT); \
    unsigned char* HI8 = ws + WS_A; unsigned char* WT8 = ws + WS_WIN; unsigned char* WPQ8 = ws + WS_WPQ; unsigned char* WO8 = ws + WS_WO; unsigned char* O8 = ws + WS_A; float* OS = (float*)(ws + WS_OS); float* CMAX3 = (float*)(ws + WS_CMAX3); float* WS3 = (float*)(ws + WS_WS3); float* CMAX2 = (float*)(ws + WS_CMAX2); float* WS4 = (float*)(ws + WS_WS4); float* CMAX = (float*)(ws + WS_CMAX); float* WS1 = (float*)(ws + WS_WS1); float* HS1 = (float*)(ws + WS_HS1); \
    bf16_t* Hb = (bf16_t*)(ws + WS_A); bf16_t* So = (bf16_t*)(ws + WS_A); bf16_t* Qp = (bf16_t*)(ws + WS_A); \
    bf16_t* QA = (bf16_t*)(ws + WS_QA); bf16_t* KA = (bf16_t*)(ws + WS_KA); bf16_t* VA = (bf16_t*)(ws + WS_VA); \
    bf16_t* CQ = (bf16_t*)(ws + WS_CQ); bf16_t* CKV = (bf16_t*)(ws + WS_CKV); bf16_t* KR = (bf16_t*)(ws + WS_KR); \
    float* Y = (float*)(ws + WS_Y); bf16_t* MIXb = (bf16_t*)(ws + WS_Y); \
    bf16_t* Qn = (bf16_t*)(ws + WS_QN); bf16_t* Qr = (bf16_t*)(ws + WS_QR); bf16_t* Kn = (bf16_t*)(ws + WS_KN); bf16_t* Vb = (bf16_t*)(ws + WS_VB); \
    bf16_t* H2 = (bf16_t*)(ws + WS_H2); bf16_t* Ob = (bf16_t*)(ws + WS_O); \
    float* ssq_q = (float*)(ws + WS_SSQ_Q); float* ssq_kv = (float*)(ws + WS_SSQ_KV); float* ssq_o = (float*)(ws + WS_SSQ_O); \
    float* Sm = (float*)(ws + WS_SM); float* Sl = (float*)(ws + WS_SL); \
    bf16_t* K1b = (bf16_t*)(ws + WS_K1); bf16_t* K2b = (bf16_t*)(ws + WS_K2); \
    unsigned short* IDX = (unsigned short*)(ws + WS_IDX); float* Gt = (float*)(ws + WS_G); \
    float* SU = (float*)(ws + WS_SU); float* SH = (float*)(ws + WS_SH); \
    unsigned char* U8 = ws + WS_U8; unsigned char* H8 = ws + WS_H8; \
    float* PART = (float*)(ws + WS_PART); unsigned short* IDX2 = (unsigned short*)(ws + WS_IDX2); unsigned char* WTq = ws + WS_WT; float* WSC = (float*)(ws + WS_WT + 8 * MiB); \
    bf16_t* FFN = (bf16_t*)(ws + WS_FFN); bf16_t* X1b = (bf16_t*)(ws + WS_X1); unsigned char* H2S = ws + WS_H2S;

__global__ void __launch_bounds__(NWAVES * 64, 2) mega_fwd(Args args) {
    extern __shared__ __attribute__((aligned(16))) unsigned char lds_raw[];
    LAS unsigned char* lds = (LAS unsigned char*)lds_raw;
    const int G = gridDim.x, bid = blockIdx.x, NGW = G * NWAVES;
    const int wave0 = __builtin_amdgcn_readfirstlane((int)threadIdx.x >> 6);
#define PH_LOCALS const int lane = opaque((int)__builtin_amdgcn_mbcnt_hi(~0u, __builtin_amdgcn_mbcnt_lo(~0u, 0u))), wave = wave0, tid = wave * 64 + lane, gw = bid * NWAVES + wave; (void)gw; \
    const __attribute__((address_space(4))) Args* arp_ = (const __attribute__((address_space(4))) Args*)__builtin_amdgcn_kernarg_segment_ptr(); asm volatile("" : "+s"(arp_)); const __attribute__((address_space(4))) Args& AR = *arp_; unsigned char* ws = AR.ws; WS_PTRS
    unsigned char* ws0 = args.ws;
    const int lo = args.ph_lo, hi_ph = args.ph_hi;
    if (threadIdx.x < 4) ((LAS unsigned*)(lds + LDS_BYTES - 16))[threadIdx.x] = 0u;
    __syncthreads();
    XcdBarrier xbar = xcd_barrier_post((unsigned*)ws0, (volatile LAS unsigned*)(lds + LDS_BYTES - 16));
#ifdef ONLY_PH
#define IN(k) ((k) == ONLY_PH && lo <= (k) && (k) < hi_ph)
#else
#define IN(k) (lo <= (k) && (k) < hi_ph)
#endif
#if MK_N_LAUNCHES == 1
#define GRID_BAR(k) do { if (IN(k) && IN((k) + 1)) { if ((k) == 0) cg::this_grid().sync(); else xcd_barrier(xbar); } } while (0)
#else
#define GRID_BAR(k) do { } while (0)
#endif
    constexpr int TB_SPLIT = 12288;
#define TB_LOAD(BUF, rr) do { const int rr_ = (rr); RAW_ROW8(BUF, ((rr_ >> 14) ? AR.in[19] : AR.in[18]) + (size_t)(rr_ & (NE - 1)) * 2048, tbvo_); } while (0)
#define TB_Q(a) ((unsigned)((int)__builtin_rintf(fminf(fmaxf((a) * inv, -7.f), 7.f)) + 8))
#define TB_STEP(BUF, RR, NW, REND) do { const int r = (RR); \
                    const int tbl = r >> 14, e = r & (NE - 1); \
                    f32x4 v[8]; float mx = 0.f, sq = 0.f; \
                    RAW_TAKE8F("s_waitcnt vmcnt(13)", v, BUF); \
                    TB_LOAD(BUF, min(r + 2 * (NW), (REND) - 1));                            \
                    _Pragma("unroll") \
                    for (int i = 0; i < 8; ++i) { mx = fmaxf(fmaxf(mx, fmaxf(fabsf(v[i][0]), fabsf(v[i][1]))), fmaxf(fabsf(v[i][2]), fabsf(v[i][3]))); \
                        sq += (v[i][0] * v[i][0] + v[i][1] * v[i][1]) + (v[i][2] * v[i][2] + v[i][3] * v[i][3]); } \
                    mx = wmax(mx); \
                    const float rms = sqrtf(wsum(sq) * (1.0f / 2048.0f)); \
                    const float step = rms > 0.f ? fmaxf(0.335f * rms, mx * (1.0f / 64.0f)) : 1.0f; \
                    const float inv = 1.0f / step; \
                    if (lane == 0) SU[tbl * NE + e] = step; \
                    unsigned char* dst = U8 + (size_t)tbl * (32u << 20) + (size_t)e * 128 + (lane >> 1) * 4 + (size_t)(lane & 1) * (2u << 20); \
                    _Pragma("unroll") \
                    for (int jp = 0; jp < 4; ++jp) { \
                        const unsigned ha = TB_Q(v[2 * jp][0]) | (TB_Q(v[2 * jp][1]) << 4) | (TB_Q(v[2 * jp][2]) << 8) | (TB_Q(v[2 * jp][3]) << 12); \
                        const unsigned hb = TB_Q(v[2 * jp + 1][0]) | (TB_Q(v[2 * jp + 1][1]) << 4) | (TB_Q(v[2 * jp + 1][2]) << 8) | (TB_Q(v[2 * jp + 1][3]) << 12); \
                        const unsigned got = (unsigned)__builtin_amdgcn_update_dpp(0, (int)((lane & 1) ? ha : hb), 0xB1, 0xf, 0xf, false);     \
                        *(unsigned*)(dst + (size_t)(2 * jp) * (2u << 20)) = (lane & 1) ? (got | (hb << 16)) : (ha | (got << 16)); } \
    } while (0)
#define TABLE_CONVERT(W0, NW, RBEG, REND) do { \
            f32x4 nva[8], nvb[8]; const int r0_ = (RBEG) + (W0); const unsigned tbvo_ = (unsigned)lane * 16u; \
            TB_LOAD(nva, min(r0_, (REND) - 1)); TB_LOAD(nvb, min(r0_ + (NW), (REND) - 1)); \
            asm volatile("s_waitcnt vmcnt(0)" ::: "memory"); \
            int rr_ = r0_; \
            for (; rr_ + (NW) < (REND); rr_ += 2 * (NW)) { TB_STEP(nva, rr_, NW, REND); TB_STEP(nvb, rr_ + (NW), NW, REND); } \
            if (rr_ < (REND)) TB_STEP(nva, rr_, NW, REND); \
            { f32x4 t_[8]; RAW_TAKE8F("s_waitcnt vmcnt(0)", t_, nva); RAW_TAKE8F("s_nop 0", t_, nvb); }     \
    } while (0)
    for (int rep_ = 0; rep_ < (IN(0) ? 1 + ((REP_MASK >> 0) & 1) : 0); ++rep_) {
        PH_LOCALS;
        for (int cb = bid; cb < 192; cb += G) {
            LAS float* cact = (LAS float*)lds;
            const float* cin = AR.in[1];
            for (int i = tid; i < 16 * 2048; i += NWAVES * 64) { const float v = cin[i]; cact[i] = v / (1.0f + __expf(-v)); }
            __syncthreads();
            const int col = cb * 64 + lane;
            float acc[16];
#pragma unroll
            for (int b = 0; b < 16; ++b) acc[b] = 0.f;
            const float* wp = AR.in[2] + (size_t)(wave * 256) * 12288 + col;
            for (int k0 = 0; k0 < 256; k0 += 16) {
                float w[16];
#pragma unroll
                for (int i = 0; i < 16; ++i) w[i] = wp[(size_t)(k0 + i) * 12288];
#pragma unroll
                for (int b = 0; b < 16; ++b) {
#pragma unroll
                    for (int i4 = 0; i4 < 4; ++i4) { const f32x4 cv = *(const LAS f32x4*)(cact + b * 2048 + wave * 256 + k0 + 4 * i4);
                        acc[b] += cv[0] * w[4 * i4] + cv[1] * w[4 * i4 + 1] + cv[2] * w[4 * i4 + 2] + cv[3] * w[4 * i4 + 3]; }
                }
            }
            __syncthreads();
            LAS float* red = (LAS float*)lds;
#pragma unroll
            for (int b = 0; b < 16; ++b) red[(wave * 16 + b) * 64 + lane] = acc[b];
            __syncthreads();
            for (int o = tid; o < 1024; o += NWAVES * 64) { const int b = o >> 6, cl = o & 63; float s = 0.f;
#pragma unroll
                for (int w = 0; w < 8; ++w) s += red[(w * 16 + b) * 64 + cl];
                mod[(size_t)b * 12288 + cb * 64 + cl] = s + AR.in[3][cb * 64 + cl]; }
            __syncthreads();
        }
        {
            LAS float* scr = (LAS float*)(lds + wave * 16384);
            constexpr int I_IN = 8 * 65, I_UQ = 8 * 48, I_UK = 8 * 32, I_UV = 8 * 32, I_O = 8 * 32, I_PQ = 8 * 32;
            constexpr int NITEMS = I_IN + I_UQ + I_UK + I_UV + I_O + I_PQ;
            for (int it = gw; it < NITEMS; it += NGW) {
                int r = it;
                if (r < I_IN) {
                    const int kc = r / 65, nb = r % 65; const float* wp = AR.in[4] + (size_t)(kc * 256) * NPROJ + nb * 64 + lane; float mx = 0.f;
#pragma unroll 1
                    for (int k0 = 0; k0 < 256; k0 += 32) { float w[32];
#pragma unroll
                        for (int i = 0; i < 32; ++i) w[i] = wp[(size_t)(k0 + i) * NPROJ];
#pragma unroll
                        for (int i = 0; i < 32; ++i) mx = fmaxf(mx, fabsf(w[i])); }
                    CMAX[kc * NPROJ_PAD + nb * 64 + lane] = mx; continue; } r -= I_IN;
                if (r < I_UQ) { transpose_item(AR.in[7], 512, 1536, Wuq_t, AR.in[5], scr, r, lane, MapUq{}); continue; } r -= I_UQ;
                if (r < I_UK) { transpose_item(AR.in[8], 512, 1024, Wukv_t, AR.in[6], scr, r, lane, MapOff{0}); continue; } r -= I_UK;
                if (r < I_UV) { transpose_item(AR.in[9], 512, 1024, Wukv_t, AR.in[6], scr, r, lane, MapOff{1024}); continue; } r -= I_UV;
                if (r < I_O) {
                    const int kc = r >> 5, nb = r & 31; const float* wp = AR.in[12] + (size_t)(kc * 256) * 2048 + nb * 64 + lane;
                    const float* gp = (kc < 4 ? AR.in[10] : AR.in[11] - 1024) + kc * 256; float mx = 0.f;
#pragma unroll 1
                    for (int k0 = 0; k0 < 256; k0 += 32) { float w[32];
#pragma unroll
                        for (int i = 0; i < 32; ++i) w[i] = wp[(size_t)(k0 + i) * 2048];
#pragma unroll
                        for (int i = 0; i < 32; ++i) mx = fmaxf(mx, fabsf(w[i] * gp[k0 + i])); }
                    CMAX3[kc * 2048 + nb * 64 + lane] = mx; continue; } r -= I_O;
                {
                    const int kc = r >> 5, nb = r & 31; const float* wp = AR.in[15] + (size_t)(kc * 256) * 2048 + nb * 64 + lane; float mx = 0.f;
#pragma unroll 1
                    for (int k0 = 0; k0 < 256; k0 += 32) { float w[32];
#pragma unroll
                        for (int i = 0; i < 32; ++i) w[i] = wp[(size_t)(k0 + i) * 2048];
#pragma unroll
                        for (int i = 0; i < 32; ++i) mx = fmaxf(mx, fabsf(w[i])); }
                    CMAX2[kc * 2048 + nb * 64 + lane] = mx; }
            }
            for (size_t i = (size_t)gw * 64 + lane; i < (size_t)(NPROJ_PAD - NPROJ) * 2048 / 16; i += (size_t)NGW * 64)
                *(u32x4*)(WT8 + (size_t)NPROJ * 2048 + i * 16) = (u32x4){0u, 0u, 0u, 0u};
            if (gw == 0) for (int i = lane; i < NPROJ_PAD - NPROJ; i += 64) WS1[NPROJ + i] = 1.0f;
        }
#if defined(NAIVE_PEER)
        for (int r = gw; r < 2 * NE; r += NGW) {
            const float* src = (r < NE ? AR.in[18] : AR.in[19]) + (size_t)(r & (NE - 1)) * 2048;
            bf16_t* dst = (r < NE ? UT : VT) + (size_t)(r & (NE - 1)) * 2048;
            f32x4 v[8];
#pragma unroll
            for (int c = 0; c < 4; ++c) { const f32x4* p = (const f32x4*)(src + c * 512 + lane * 8); v[2 * c] = p[0]; v[2 * c + 1] = p[1]; }
#pragma unroll
            for (int c = 0; c < 4; ++c) pg8::store8(dst + c * 512 + lane * 8, v[2 * c], v[2 * c + 1]);
        }
#else
        TABLE_CONVERT(gw, NGW, TB_SPLIT, 2 * NE);
#endif
        for (int i = gw * 64 + lane; i < 2 * 16384; i += NGW * 64) {
            const float v = (i < 16384 ? AR.in[16] : AR.in[17])[i & 16383];
            (i < 16384 ? K1b : K2b)[i & 16383] = (bf16_t)(cvtpk(v, v) & 0xffffu);
        }
    }
    GRID_BAR(0);

    for (int rep_ = 0; rep_ < (IN(1) ? 1 + ((REP_MASK >> 1) & 1) : 0); ++rep_) {
        PH_LOCALS;
        const int nb_ = G >> 4, b = bid / nb_, r0 = (bid % nb_) * NWAVES + wave, rstep = nb_ * NWAVES;
        LAS float* psh = (LAS float*)lds; LAS float* psc = psh + 2048;
        __syncthreads();
        if (b < 16) { const float* mb = mod + (size_t)b * 12288;
            *(LAS f32x4*)(psh + 4 * tid) = *(const f32x4*)(mb + 4 * tid); *(LAS f32x4*)(psc + 4 * tid) = *(const f32x4*)(mb + 2048 + 4 * tid) + 1.0f; }
        __syncthreads();
        { LAS float* scr = (LAS float*)(lds + 16384 + wave * 8704);
          for (int it = gw; it < 32 * 130; it += NGW) transpose_item_q8(AR.in[4], 2048, NPROJ, WT8, (const float*)nullptr, CMAX, NPROJ_PAD, WS1, scr, it, lane, MapIn{});
          for (int it = gw; it < 32 * 64; it += NGW) transpose_item_q8(AR.in[15], 2048, 2048, WPQ8, (const float*)nullptr, CMAX2, 2048, WS4, scr, it, lane, MapOff{0});
          for (int it = gw; it < 32 * 64; it += NGW) { const int kb = it / 64; transpose_item_q8(AR.in[12], 2048, 2048, WO8, kb < 16 ? AR.in[10] : AR.in[11] - 1024, CMAX3, 2048, WS3, scr, it, lane, MapOff{0}); } }
        if (b < 16) {
            f32x4 nv[8];
            { const f32x4* xr = (const f32x4*)(x + ((size_t)b * 2048 + r0) * DM) + lane;
#pragma unroll
              for (int j = 0; j < 8; ++j) nv[j] = xr[64 * j]; }
            for (int r = r0; r < 2048; r += rstep) {
                const int row = b * 2048 + r;
                f32x4 v[8]; float s = 0.f;
#pragma unroll
                for (int j = 0; j < 8; ++j) { v[j] = nv[j]; s += (v[j][0] + v[j][1]) + (v[j][2] + v[j][3]); }
                if (r + rstep < 2048) { const f32x4* xr = (const f32x4*)(x + (size_t)(row + rstep) * DM) + lane;
#pragma unroll
                    for (int j = 0; j < 8; ++j) nv[j] = xr[64 * j]; }
                const float mean = wsum(s) * (1.0f / DM); float s2 = 0.f;
#pragma unroll
                for (int j = 0; j < 8; ++j) { v[j] = v[j] - mean; s2 += (v[j][0] * v[j][0] + v[j][1] * v[j][1]) + (v[j][2] * v[j][2] + v[j][3] * v[j][3]); }
                const float rstd = 1.0f / sqrtf(wsum(s2) * (1.0f / DM) + 1e-5f);
                float mx = 0.f;
#pragma unroll
                for (int j = 0; j < 8; ++j) { const int d = 4 * (lane + 64 * j);
                    const f32x4 sh = *(const LAS f32x4*)(psh + d), sc1 = *(const LAS f32x4*)(psc + d);
                    v[j] = v[j] * rstd * sc1 + sh; mx = fmaxf(fmaxf(mx, fmaxf(fabsf(v[j][0]), fabsf(v[j][1]))), fmaxf(fabsf(v[j][2]), fabsf(v[j][3]))); }
                mx = wmax(mx);
                const float qs = mx > 0.f ? 127.0f / mx : 1.0f;
                if (lane == 0) HS1[row] = mx > 0.f ? mx * (1.0f / 127.0f) : 1.0f;
#pragma unroll
                for (int j = 0; j < 8; ++j) { const int d = 4 * (lane + 64 * j); const f32x4 y = v[j] * qs;
                    *(unsigned*)(HI8 + (size_t)row * DM + d) = pack_i8x4(y[0], y[1], y[2], y[3]); }
            }
        }
    }
    GRID_BAR(1);

    for (int rep_ = 0; rep_ < (IN(2) ? 1 + ((REP_MASK >> 2) & 1) : 0); ++rep_) {
        PH_LOCALS;
        pg8::Gemm g{(const bf16_t*)HI8, (const bf16_t*)WT8, T, NPROJ_PAD, DM / 2}; pg8::StaticOrder S; S.init(T, NPROJ_PAD, G, bid);
        pg8::EpiProj E{QA, CQ, KR, ssq_q, HS1, WS1};
        pg8::gemm_phase(tid, lds, g, S, E);
#if !defined(NAIVE_PEER)
        {
            const int nun_ = (T / 256) * (NPROJ_PAD / 256), rem_ = nun_ % G;
            const int tw0_ = ((rem_ ? bid - rem_ : bid) * NWAVES + wave), tnw_ = (rem_ ? G - rem_ : G) * NWAVES;
            if (tw0_ >= 0) {
                TABLE_CONVERT(tw0_, tnw_, 0, TB_SPLIT);
            }
        }
#endif
    }
    GRID_BAR(2);

    for (int rep_ = 0; rep_ < (IN(3) ? 1 + ((REP_MASK >> 3) & 1) : 0); ++rep_) {
        PH_LOCALS;
        LAS float* tab = (LAS float*)(lds + pg8::STAGE_BYTES);
        { pg8::Gemm g{CQ, Wuq_t, T, 1536, 512}; pg8::StaticOrder S; S.init(T, 1536, G, bid);
          if (tid < 256) {
              float qv[4][8]; bool ok[4];
#pragma unroll
              for (int i = 0; i < 4; ++i) { pg8::Unit u; ok[i] = S.next(i, u); const int row = (ok[i] ? u.pm : 0) * 256 + tid;
#pragma unroll
                  for (int sl = 0; sl < 8; ++sl) qv[i][sl] = ssq_q[(size_t)sl * T + row]; }
#pragma unroll
              for (int i = 0; i < 4; ++i) if (ok[i]) { float q = 0.f;
#pragma unroll
                  for (int sl = 0; sl < 8; ++sl) q += qv[i][sl];
                  tab[i * 256 + tid] = 1.0f / sqrtf(q * (1.0f / 512.0f) + 1e-6f); } }
          __syncthreads();
          pg8::EpiQ E{Qn, Qr, tab}; pg8::gemm_phase(tid, lds, g, S, E); }
        __syncthreads();
        { pg8::Gemm g{CKV, Wukv_t, T, 2048, 512}; pg8::StaticOrder S; S.init(T, 2048, G, bid);
          if (tid < 256) {
              float qv[4][8]; bool ok[4];
#pragma unroll
              for (int i = 0; i < 4; ++i) { pg8::Unit u; ok[i] = S.next(i, u); const int row = (ok[i] ? u.pm : 0) * 256 + tid;
#pragma unroll
                  for (int sl = 0; sl < 8; ++sl) qv[i][sl] = ssq_kv[(size_t)sl * T + row]; }
#pragma unroll
              for (int i = 0; i < 4; ++i) if (ok[i]) { float q = 0.f;
#pragma unroll
                  for (int sl = 0; sl < 8; ++sl) q += qv[i][sl];
                  tab[i * 256 + tid] = 1.0f / sqrtf(q * (1.0f / 512.0f) + 1e-6f); } }
          __syncthreads();
          pg8::EpiKV E{Kn, Vb, tab}; pg8::gemm_phase(tid, lds, g, S, E); }
    }
    GRID_BAR(3);


#if defined(NAIVE_ATTN)
    for (int rep_ = 0; rep_ < (IN(4) ? 1 + ((REP_MASK >> 4) & 1) : 0); ++rep_) {
        PH_LOCALS;
        for (int it = gw; it < T * 8; it += NGW) {
            const int t = it >> 3, h = it & 7, b = t >> 11, s = t & 2047;
            {
                const unsigned qv = *(const unsigned*)(QA + (size_t)t * 1024 + h * 128 + 2 * lane);
                const float q0 = bf_lo(qv), q1 = bf_hi(qv);
                float m = -1e30f, l = 0.f, a0 = 0.f, a1 = 0.f;
                for (int br = 0; br < 3; ++br) { const int dil = br == 0 ? 1 : (br == 1 ? 4 : 16);
                    for (int j = 0; j <= 128; ++j) { const int sk = s - j * dil; if (sk < 0) break;
                        const size_t tk = (size_t)b * SEQ + sk;
                        const unsigned kv = *(const unsigned*)(KA + tk * 1024 + h * 128 + 2 * lane);
                        const unsigned vv = *(const unsigned*)(VA + tk * 1024 + h * 128 + 2 * lane);
                        const float sc = wave_sum(q0 * bf_lo(kv) + q1 * bf_hi(kv)) * 0.08838834764831845f;
                        const float mn = fmaxf(m, sc), corr = __expf(m - mn), pp = __expf(sc - mn);
                        l = l * corr + pp; a0 = a0 * corr + pp * bf_lo(vv); a1 = a1 * corr + pp * bf_hi(vv); m = mn; } }
                const float r0 = a0 / l, r1 = a1 / l;
                *(unsigned*)(Ob + (size_t)t * 2048 + h * 128 + 2 * lane) = cvtpk(r0, r1);
                const float sq = wave_sum(r0 * r0 + r1 * r1);
                if (lane == 0) ssq_o[(size_t)t * 16 + h] = sq;
            }
            {
                const unsigned qv = *(const unsigned*)(Qn + (size_t)t * 1024 + h * 128 + 2 * lane);
                const float q0 = bf_lo(qv), q1 = bf_hi(qv);
                const unsigned short qrv = Qr[(size_t)t * 512 + h * 64 + lane]; const float qr0 = __uint_as_float((unsigned)qrv << 16);
                float m = -1e30f, l = 0.f, a0 = 0.f, a1 = 0.f;
                for (int sk = 0; sk <= s; ++sk) { const size_t tk = (size_t)b * SEQ + sk;
                    const unsigned kv = *(const unsigned*)(Kn + tk * 1024 + h * 128 + 2 * lane);
                    const unsigned vv = *(const unsigned*)(Vb + tk * 1024 + h * 128 + 2 * lane);
                    const float krv = __uint_as_float((unsigned)KR[tk * 64 + lane] << 16);
                    const float sc = wave_sum(q0 * bf_lo(kv) + q1 * bf_hi(kv) + qr0 * krv) * 0.07216878364870322f;
                    const float mn = fmaxf(m, sc), corr = __expf(m - mn), pp = __expf(sc - mn);
                    l = l * corr + pp; a0 = a0 * corr + pp * bf_lo(vv); a1 = a1 * corr + pp * bf_hi(vv); m = mn; }
                const float r0 = a0 / l, r1 = a1 / l;
                *(unsigned*)(Ob + (size_t)t * 2048 + 1024 + h * 128 + 2 * lane) = cvtpk(r0, r1);
                const float sq = wave_sum(r0 * r0 + r1 * r1);
                if (lane == 0) ssq_o[(size_t)t * 16 + 8 + h] = sq;
            }
        }
    }
#else
    for (int rep_ = 0; rep_ < (IN(4) ? 1 + ((REP_MASK >> 4) & 1) : 0); ++rep_) {
        PH_LOCALS;
        att::Tens XA{QA, nullptr, KA, nullptr, VA, So, Sm, Sl, Ob, 0, ssq_o, 0};
        {
            LAS unsigned char* wl = lds + wave * 17408; LAS float* wsf = (LAS float*)(lds + 8 * 17408) + wave * 64;
            for (int repa = 0; repa < 1 + ((REP_MASK >> 16) & 1); ++repa)
            for (int u = bid; u < 512; u += G) {
                const int J = (u >> 3) & 3, bh = (u & 7) + 8 * (u >> 5), b = bh >> 3, h = bh & 7;
#pragma unroll 1
                for (int br = 0; br < 3; ++br) {
#pragma unroll 1
                    for (int k = 0; k < 2; ++k) { const int wu = wave + 8 * k;
                        att::WaveA P;
                        P.b = b; P.h = h; P.mode = br == 0 ? 0 : (br == 1 ? 1 : 3);
                        if (br == 0) { P.dil = 1; P.rho = 0; P.qpos0 = 512 * J + 32 * wu; }
                        else if (br == 1) { P.dil = 4; P.rho = wu >> 2; P.qpos0 = 128 * J + 32 * (wu & 3); }
                        else { P.dil = 16; P.rho = wu; P.qpos0 = 32 * J; }
                        att::attnA_wave(lane, P, wl, wsf, XA); }
                    asm volatile("s_waitcnt vmcnt(0)" ::: "memory");
                    __syncthreads();
                }
            }
            __syncthreads();
        }
        att::Tens XB{Qn, Qr, Kn, KR, Vb, nullptr, nullptr, nullptr, Ob, 1024, ssq_o, 8};
        for (int repb = 0; repb < 1 + ((REP_MASK >> 17) & 1); ++repb)
        for (int i = 0; i < 4 * ((1024 + 4 * G - 1) / (4 * G)); ++i) {
            const int v = bid + (i >> 2) * G; if (v >= 256) break;
            const int bh = (v & 7) + 8 * (v >> 4), s = (v >> 3) & 1, ii = i & 3;
            const int qt = ii == 0 ? 2 * s : (ii == 1 ? 2 * s + 1 : (ii == 2 ? 7 - 2 * s : 6 - 2 * s));
            att::UnitP P{bh >> 3, bh & 7, 1, 0, 1, 256 * qt, 0, 4 * (qt + 1), 1 << 28, 2};
            att::attn_unit<true>(tid, P, lds, XB);
        }
    }
    GRID_BAR(4);


#endif

    for (int rep_ = 0; rep_ < (IN(6) ? 1 + ((REP_MASK >> 6) & 1) : 0); ++rep_) {
        PH_LOCALS;
        u32x4 no[4]; f32x4 nq[4];
#define P6_LOAD(rr) do { _Pragma("unroll") for (int c = 0; c < 4; ++c) { no[c] = *(const u32x4*)(Ob + (size_t)(rr) * DM + c * 512 + lane * 8); nq[c] = *(const f32x4*)(ssq_o + (size_t)(rr) * 16 + 4 * c); } } while (0)
        P6_LOAD(gw);
        for (int row = gw; row < T; row += NGW) {
            const float sa = ((nq[0][0] + nq[0][1]) + (nq[0][2] + nq[0][3])) + ((nq[1][0] + nq[1][1]) + (nq[1][2] + nq[1][3]));
            const float sb = ((nq[2][0] + nq[2][1]) + (nq[2][2] + nq[2][3])) + ((nq[3][0] + nq[3][1]) + (nq[3][2] + nq[3][3]));
            const float ra = 1.0f / sqrtf(sa * (1.0f / 1024.0f) + 1e-6f), rb = 1.0f / sqrtf(sb * (1.0f / 1024.0f) + 1e-6f);
            float f[32]; float mx = 0.f;
#pragma unroll
            for (int c = 0; c < 4; ++c) { const u32x4 o4 = no[c]; const unsigned w0 = o4.x, w1 = o4.y, w2 = o4.z, w3 = o4.w; const float r_ = c < 2 ? ra : rb;
                f[8 * c + 0] = bf_lo(w0) * r_; f[8 * c + 1] = bf_hi(w0) * r_; f[8 * c + 2] = bf_lo(w1) * r_; f[8 * c + 3] = bf_hi(w1) * r_;
                f[8 * c + 4] = bf_lo(w2) * r_; f[8 * c + 5] = bf_hi(w2) * r_; f[8 * c + 6] = bf_lo(w3) * r_; f[8 * c + 7] = bf_hi(w3) * r_; }
            if (row + NGW < T) P6_LOAD(row + NGW);
#pragma unroll
            for (int i = 0; i < 32; ++i) mx = fmaxf(mx, fabsf(f[i]));
            mx = wmax(mx);
            const float qs = mx > 0.f ? 127.0f / mx : 1.0f;
            if (lane == 0) OS[row] = mx > 0.f ? mx * (1.0f / 127.0f) : 1.0f;
#pragma unroll
            for (int c = 0; c < 4; ++c) { u32x2 w; w.x = pack_i8x4(f[8 * c] * qs, f[8 * c + 1] * qs, f[8 * c + 2] * qs, f[8 * c + 3] * qs); w.y = pack_i8x4(f[8 * c + 4] * qs, f[8 * c + 5] * qs, f[8 * c + 6] * qs, f[8 * c + 7] * qs);
                *(u32x2*)(O8 + (size_t)row * DM + c * 512 + lane * 8) = w; }
        }
#undef P6_LOAD
    }
    GRID_BAR(6);

    for (int rep_ = 0; rep_ < (IN(7) ? 1 + ((REP_MASK >> 7) & 1) : 0); ++rep_) {
        PH_LOCALS;
        pg8::Gemm g{(const bf16_t*)O8, (const bf16_t*)WO8, T, DM, DM / 2}; pg8::StaticOrder S; S.init(T, DM, G, bid);
        pg8::EpiPlainQ8 E{MIXb, DM, OS, WS3}; pg8::gemm_phase(tid, lds, g, S, E);
    }
    GRID_BAR(7);

    for (int rep_ = 0; rep_ < (IN(8) ? 1 + ((REP_MASK >> 8) & 1) : 0); ++rep_) {
        PH_LOCALS;
        const int nb_ = G >> 4, b = bid / nb_, r0 = (bid % nb_) * NWAVES + wave, rstep = nb_ * NWAVES;
        LAS float* pg1 = (LAS float*)lds; LAS float* psh = pg1 + 2048; LAS float* psc = pg1 + 4096; LAS float* plg = pg1 + 6144; LAS float* plb = pg1 + 8192;
        __syncthreads();
        if (b < 16) { const float* mb = mod + (size_t)b * 12288;
            *(LAS f32x4*)(pg1 + 4 * tid) = *(const f32x4*)(mb + 4096 + 4 * tid) * DBG_MIX; *(LAS f32x4*)(psh + 4 * tid) = *(const f32x4*)(mb + 6144 + 4 * tid);
            *(LAS f32x4*)(psc + 4 * tid) = *(const f32x4*)(mb + 8192 + 4 * tid) + 1.0f;
            *(LAS f32x4*)(plg + 4 * tid) = *(const f32x4*)(AR.in[13] + 4 * tid); *(LAS f32x4*)(plb + 4 * tid) = *(const f32x4*)(AR.in[14] + 4 * tid); }
        __syncthreads();
        if (b < 16) {
        f32x4 nx[8]; u32x2 nm[8];
#define P8_LOAD(rr) do { const f32x4* xr_ = (const f32x4*)(x + (size_t)(rr) * DM) + lane; const u32x2* mr_ = (const u32x2*)(MIXb + (size_t)(rr) * DM) + lane; \
            _Pragma("unroll") for (int j = 0; j < 8; ++j) { nx[j] = xr_[64 * j]; nm[j] = mr_[64 * j]; } } while (0)
        P8_LOAD(b * 2048 + r0);
        for (int r = r0; r < 2048; r += rstep) {
            const int row = b * 2048 + r, le = opaque(lane);
            f32x4 v[8]; float s = 0.f;
#pragma unroll
            for (int j = 0; j < 8; ++j) { const f32x4 xv = nx[j], gv = *(const LAS f32x4*)(pg1 + 4 * (le + 64 * j)); const unsigned m0 = nm[j].x, m1 = nm[j].y;
                v[j][0] = xv[0] * DN_ALPHA + gv[0] * bf_lo(m0); v[j][1] = xv[1] * DN_ALPHA + gv[1] * bf_hi(m0);
                v[j][2] = xv[2] * DN_ALPHA + gv[2] * bf_lo(m1); v[j][3] = xv[3] * DN_ALPHA + gv[3] * bf_hi(m1);
                s += (v[j][0] + v[j][1]) + (v[j][2] + v[j][3]); }
            if (r + rstep < 2048) P8_LOAD(row + rstep);
            float mean = wsum(s) * (1.0f / DM); float s2 = 0.f;
#pragma unroll
            for (int j = 0; j < 8; ++j) { v[j] = v[j] - mean; s2 += (v[j][0] * v[j][0] + v[j][1] * v[j][1]) + (v[j][2] * v[j][2] + v[j][3] * v[j][3]); }
            float rstd = 1.0f / sqrtf(wsum(s2) * (1.0f / DM) + 1e-5f);
            s = 0.f;
#pragma unroll
            for (int j = 0; j < 8; ++j) { const int d = 4 * (le + 64 * j);
                v[j] = v[j] * rstd * *(const LAS f32x4*)(plg + d) + *(const LAS f32x4*)(plb + d);
#if defined(NAIVE_PEER)
                *(f32x4*)(AR.out + (size_t)row * DM + d) = v[j];
#else
                { u32x2 w1; w1.x = cvtpk(v[j][0], v[j][1]); w1.y = cvtpk(v[j][2], v[j][3]); *(u32x2*)(X1b + (size_t)row * DM + d) = w1; }
#endif
                s += (v[j][0] + v[j][1]) + (v[j][2] + v[j][3]); }
            mean = wsum(s) * (1.0f / DM); s2 = 0.f;
#pragma unroll
            for (int j = 0; j < 8; ++j) { v[j] = v[j] - mean; s2 += (v[j][0] * v[j][0] + v[j][1] * v[j][1]) + (v[j][2] * v[j][2] + v[j][3] * v[j][3]); }
            rstd = 1.0f / sqrtf(wsum(s2) * (1.0f / DM) + 1e-5f);
#pragma unroll
            for (int j = 0; j < 8; ++j) { const int d = 4 * (le + 64 * j);
                const f32x4 sh = *(const LAS f32x4*)(psh + d), sc1 = *(const LAS f32x4*)(psc + d);
                const f32x4 y = v[j] * rstd * sc1 + sh; v[j] = y; }
#if !defined(NAIVE_PEER)
            {
                float mx = 0.f;
#pragma unroll
                for (int j = 0; j < 8; ++j) mx = fmaxf(fmaxf(mx, fmaxf(fabsf(v[j][0]), fabsf(v[j][1]))), fmaxf(fabsf(v[j][2]), fabsf(v[j][3])));
                mx = wmax(mx);
                const float hs = mx > 0.f ? 127.0f / mx : 1.0f;
                if (lane == 0) SH[row] = mx > 0.f ? mx * (1.0f / 127.0f) : 1.0f;
#pragma unroll
                for (int j = 0; j < 8; ++j) { const int d = 4 * (le + 64 * j); const f32x4 y = v[j] * hs;
                    *(unsigned*)(H2S + (size_t)row * DM + d) = pack_i8x4(y[0], y[1], y[2], y[3]); }
            }
#endif
        }
        }
#undef P8_LOAD
    }
    GRID_BAR(8);

    for (int rep_ = 0; rep_ < (IN(9) ? 1 + ((REP_MASK >> 9) & 1) : 0); ++rep_) {
        PH_LOCALS;
        pg8::Gemm g{(const bf16_t*)H2S, (const bf16_t*)WPQ8, T, DM, DM / 2}; pg8::StaticOrder S; S.init(T, DM, G, bid);
        pg8::EpiPlainQ8 E{Qp, DM, SH, WS4}; pg8::gemm_phase(tid, lds, g, S, E);
    }
    GRID_BAR(9);


#if defined(NAIVE_TOPK)
    for (int rep_ = 0; rep_ < (IN(10) ? 1 + ((REP_MASK >> 10) & 1) : 0); ++rep_) {
        PH_LOCALS;
        LAS float* vs = (LAS float*)(lds + wave * 256);
        for (int it = gw; it < T * 8; it += NGW) {
            const int t = it >> 3, h = it & 7;
            float sA[2][2];
#pragma unroll
            for (int half = 0; half < 2; ++half) {
                const bf16_t* qp = Qp + (size_t)t * DM + h * 256 + half * 128;
                const float* kp = half ? AR.in[17] : AR.in[16];
                float s0 = 0.f, s1 = 0.f;
                for (int d = 0; d < 128; ++d) { const float qv = __uint_as_float((unsigned)qp[d] << 16); s0 += qv * kp[lane * 128 + d]; s1 += qv * kp[(lane + 64) * 128 + d]; }
                sA[half][0] = s0; sA[half][1] = s1;
            }
#pragma unroll
            for (int half = 0; half < 2; ++half) {
                float c0 = sA[half][0], c1 = sA[half][1];
                for (int r = 0; r < 16; ++r) {
                    float bv = fmaxf(c0, c1); int bi = (c0 >= c1) ? lane : lane + 64;
#pragma unroll
                    for (int o = 1; o < 64; o <<= 1) { const float ov = __shfl_xor(bv, o); const int oi = __shfl_xor(bi, o); if (ov > bv || (ov == bv && oi < bi)) { bv = ov; bi = oi; } }
                    if (lane == 0) { vs[half * 16 + r] = bv; ((LAS int*)vs)[32 + half * 16 + r] = bi; }
                    if (bi == lane) c0 = -INFINITY; if (bi == lane + 64) c1 = -INFINITY;
                }
            }
            asm volatile("s_waitcnt lgkmcnt(0)" ::: "memory");
            float cd[4];
#pragma unroll
            for (int m2 = 0; m2 < 4; ++m2) { const int c = lane + 64 * m2; cd[m2] = vs[c >> 4] + vs[16 + (c & 15)]; }
            float val[16]; int ci[16];
#pragma unroll
            for (int r = 0; r < 16; ++r) {
                float bv = cd[0]; int bi = lane;
#pragma unroll
                for (int m2 = 1; m2 < 4; ++m2) if (cd[m2] > bv) { bv = cd[m2]; bi = lane + 64 * m2; }
#pragma unroll
                for (int o = 1; o < 64; o <<= 1) { const float ov = __shfl_xor(bv, o); const int oi = __shfl_xor(bi, o); if (ov > bv || (ov == bv && oi < bi)) { bv = ov; bi = oi; } }
                val[r] = bv; ci[r] = bi;
#pragma unroll
                for (int m2 = 0; m2 < 4; ++m2) if (bi == lane + 64 * m2) cd[m2] = -INFINITY;
            }
            float se = 0.f, e[16];
#pragma unroll
            for (int r = 0; r < 16; ++r) { e[r] = __expf(val[r] - val[0]); se += e[r]; }
            if (lane < 16) {
                float ev = 0.f; int cc = 0;
#pragma unroll
                for (int r = 0; r < 16; ++r) if (lane == r) { ev = e[r]; cc = ci[r]; }
                const int i1 = ((LAS int*)vs)[32 + (cc >> 4)], i2 = ((LAS int*)vs)[48 + (cc & 15)];
                IDX[((size_t)t * 8 + h) * 16 + lane] = (unsigned short)(i1 * 128 + i2);
                Gt[((size_t)t * 8 + h) * 16 + lane] = ev / se;
            }
            asm volatile("s_waitcnt lgkmcnt(0)" ::: "memory");
        }
    }
#else
    for (int rep_ = 0; rep_ < (IN(10) ? 1 + ((REP_MASK >> 10) & 1) : 0); ++rep_) {
        PH_LOCALS;
        for (int i = tid; i < 2 * 128 * 16; i += NWAVES * 64) { const int t2 = i >> 11, rem = i & 2047, key = rem >> 4, ch = rem & 15;
            const bf16x8 v = *(const bf16x8*)((t2 ? K2b : K1b) + key * 128 + ch * 8);
            *(LAS bf16x8*)(lds + t2 * 32768 + KSWZ(key, ch * 16)) = v; }
        __syncthreads();
        const int r32 = lane & 31, hi = lane >> 5;
        LAS unsigned char* tb8 = lds + 65536 + wave * 2048 + lane * 32;
        for (int tg = bid; tg < T / 32; tg += G) {
            const int tok = tg * 32 + r32;
            int v12[2][16];
#pragma unroll
            for (int half = 0; half < 2; ++half) {
                const bf16_t* qp = Qp + (size_t)tok * DM + wave * 256 + half * 128 + hi * 8;
                bf16x8 qf[8];
#pragma unroll
                for (int d0 = 0; d0 < 8; ++d0) qf[d0] = *(const bf16x8*)(qp + d0 * 16);
                int best[16];
#pragma unroll
                for (int kb = 0; kb < 4; ++kb) {
                    f32x16 acc = f32x16{};
#pragma unroll
                    for (int d0 = 0; d0 < 8; ++d0) { const bf16x8 a = *(const LAS bf16x8*)(lds + half * 32768 + KSWZ(32 * kb + r32, (d0 * 16 + hi * 8) * 2));
                        acc = __builtin_amdgcn_mfma_f32_32x32x16_bf16(a, qf[d0], acc, 0, 0, 0); }
                    int cur[16];
#pragma unroll
                    for (int r = 0; r < 16; ++r) cur[r] = (pk::f2key(acc[r]) & ~127) | (32 * kb + (r & 3) + 8 * (r >> 2) + 4 * hi);
                    pk::sort16(cur);
                    if (kb == 0) {
#pragma unroll
                        for (int r = 0; r < 16; ++r) best[r] = cur[r];
                    } else pk::merge_top16(best, cur);
                }
                int oth[16], mine[16];
#pragma unroll
                for (int r = 0; r < 16; ++r) { auto sw = __builtin_amdgcn_permlane32_swap((unsigned)best[r], (unsigned)best[r], false, false); mine[r] = (int)sw[0]; oth[r] = (int)sw[1]; }
                pk::merge_top16(mine, oth);
#pragma unroll
                for (int r = 0; r < 16; ++r) v12[half][r] = mine[r];
            }
            {
                u32x4 w0, w1;
#pragma unroll
                for (int q = 0; q < 4; ++q) {
                    w0[q] = (unsigned)(v12[0][4 * q] & 127) | ((unsigned)(v12[0][4 * q + 1] & 127) << 8) | ((unsigned)(v12[0][4 * q + 2] & 127) << 16) | ((unsigned)(v12[0][4 * q + 3] & 127) << 24);
                    w1[q] = (unsigned)(v12[1][4 * q] & 127) | ((unsigned)(v12[1][4 * q + 1] & 127) << 8) | ((unsigned)(v12[1][4 * q + 2] & 127) << 16) | ((unsigned)(v12[1][4 * q + 3] & 127) << 24);
                }
                *(LAS u32x4*)(tb8) = w0; *(LAS u32x4*)(tb8 + 16) = w1;
            }
            float f1[16], f2[16];
#pragma unroll
            for (int r = 0; r < 16; ++r) { f1[r] = pk::key2f(v12[0][r]); f2[r] = pk::key2f(v12[1][r]); }
#define CAND(i, j) ((pk::f2key(f1[i] + f2[j]) & ~255) | ((i) * 16 + (j)))
            int M[16], Gb[16];
#pragma unroll
            for (int j = 0; j < 16; ++j) M[j] = CAND(0, j);
#pragma unroll
            for (int j = 0; j < 8; ++j) { Gb[j] = CAND(1, j); Gb[8 + j] = CAND(15 - j, 0); }
            pk::bmerge16(Gb); pk::merge_top16(M, Gb);
            Gb[0] = CAND(2, 0); Gb[1] = CAND(2, 1); Gb[2] = CAND(2, 2); Gb[3] = CAND(2, 3); Gb[4] = CAND(2, 4);
            Gb[5] = CAND(3, 0); Gb[6] = CAND(3, 1); Gb[7] = CAND(3, 2); Gb[8] = CAND(3, 3);
            Gb[9] = CAND(4, 0); Gb[10] = CAND(4, 1); Gb[11] = CAND(4, 2);
            Gb[12] = CAND(5, 0); Gb[13] = CAND(5, 1); Gb[14] = CAND(6, 0); Gb[15] = CAND(6, 1);
            pk::sort16(Gb); pk::merge_top16(M, Gb);
            Gb[0] = CAND(7, 0); Gb[1] = CAND(7, 1);
#pragma unroll
            for (int j = 2; j < 16; ++j) Gb[j] = (int)0x80000000;
            pk::merge_top16(M, Gb);
#undef CAND
            asm volatile("s_waitcnt lgkmcnt(0)" ::: "memory");
            float val[16], e[16]; float se = 0.f; unsigned short ex[16];
#pragma unroll
            for (int k = 0; k < 16; ++k) { val[k] = pk::key2f(M[k] & ~255); }
#pragma unroll
            for (int k = 0; k < 16; ++k) { e[k] = __expf(val[k] - val[0]); se += e[k];
                const int code = M[k] & 255; const unsigned i1 = *(const LAS unsigned char*)(tb8 + (code >> 4)), i2 = *(const LAS unsigned char*)(tb8 + 16 + (code & 15));
                ex[k] = (unsigned short)(i1 * 128 + i2); }
            const float inv = 1.0f / se;
#if defined(NAIVE_PEER)
            if (hi == 0) {
                u32x4 w0, w1;
#pragma unroll
                for (int q = 0; q < 4; ++q) { w0[q] = (unsigned)ex[2 * q] | ((unsigned)ex[2 * q + 1] << 16); w1[q] = (unsigned)ex[8 + 2 * q] | ((unsigned)ex[8 + 2 * q + 1] << 16); }
                u32x4* ip = (u32x4*)(IDX + ((size_t)tok * 8 + wave) * 16); ip[0] = w0; ip[1] = w1;
            } else {
                f32x4* gp = (f32x4*)(Gt + ((size_t)tok * 8 + wave) * 16);
#pragma unroll
                for (int q = 0; q < 4; ++q) gp[q] = (f32x4){e[4 * q] * inv, e[4 * q + 1] * inv, e[4 * q + 2] * inv, e[4 * q + 3] * inv};
            }
#else
            if (hi == 0) {
#pragma unroll
                for (int sl = 0; sl < 8; ++sl) *(unsigned*)(IDX2 + (size_t)tok * 128 + sl * 16 + wave * 2) = (unsigned)ex[sl] | ((unsigned)ex[sl + 8] << 16);
            } else {
#pragma unroll
                for (int sl = 0; sl < 8; ++sl) *(f32x2*)(Gt + (size_t)tok * 128 + sl * 16 + wave * 2) = (f32x2){e[sl] * inv, e[sl + 8] * inv};
            }
#endif
            asm volatile("s_waitcnt lgkmcnt(0)" ::: "memory");
        }
    }
#endif
    GRID_BAR(10);

#if defined(NAIVE_PEER)
    for (int rep_ = 0; rep_ < (IN(11) ? 1 + ((REP_MASK >> 11) & 1) : 0); ++rep_) {
        PH_LOCALS;
        const float* lg = AR.in[20]; const float* lb = AR.in[21];
        for (int t = gw; t < T; t += NGW) {
            const int b = t >> 11;
            u32x4 hv[4];
#pragma unroll
            for (int c = 0; c < 4; ++c) hv[c] = *(const u32x4*)(H2 + (size_t)t * DM + c * 512 + lane * 8);
            const unsigned idx2 = ((const unsigned*)IDX)[(size_t)t * 64 + lane];
            const f32x2 g2 = ((const f32x2*)Gt)[(size_t)t * 64 + lane];
            float a0 = 0.f, a1 = 0.f;
            for (int k = 0; k < 128; k += 4) {
                u32x4 uv[4][4];
#pragma unroll
                for (int j = 0; j < 4; ++j) { const unsigned pr = (unsigned)__builtin_amdgcn_readlane((int)idx2, (k + j) >> 1); const unsigned e = ((k + j) & 1) ? (pr >> 16) : (pr & 0xffffu);
                    const bf16_t* up = UT + (size_t)e * 2048 + lane * 8;
#pragma unroll
                    for (int c = 0; c < 4; ++c) uv[j][c] = *(const u32x4*)(up + c * 512); }
#pragma unroll
                for (int j = 0; j < 4; ++j) { float d = 0.f;
#pragma unroll
                    for (int c = 0; c < 4; ++c)
#pragma unroll
                        for (int q = 0; q < 4; ++q) { const unsigned ua = uv[j][c][q], ha = hv[c][q]; d = dot2bf(ua, ha, d); }
                    d = wave_sum(d);
                    if (lane == ((k + j) >> 1)) { if ((k + j) & 1) a1 = d; else a0 = d; } }
            }
            const float w0 = gelu_erf(a0) * g2[0], w1 = gelu_erf(a1) * g2[1];
            float acc[32];
#pragma unroll
            for (int i = 0; i < 32; ++i) acc[i] = 0.f;
            for (int k = 0; k < 128; k += 4) {
                u32x4 vv[4][4]; float wk[4];
#pragma unroll
                for (int j = 0; j < 4; ++j) { const unsigned pr = (unsigned)__builtin_amdgcn_readlane((int)idx2, (k + j) >> 1); const unsigned e = ((k + j) & 1) ? (pr >> 16) : (pr & 0xffffu);
                    wk[j] = __int_as_float(__builtin_amdgcn_readlane(__float_as_int(((k + j) & 1) ? w1 : w0), (k + j) >> 1));
                    const bf16_t* vp = VT + (size_t)e * 2048 + lane * 8;
#pragma unroll
                    for (int c = 0; c < 4; ++c) vv[j][c] = *(const u32x4*)(vp + c * 512); }
#pragma unroll
                for (int j = 0; j < 4; ++j)
#pragma unroll
                    for (int c = 0; c < 4; ++c)
#pragma unroll
                        for (int q = 0; q < 4; ++q) { acc[c * 8 + 2 * q] += wk[j] * bf_lo(vv[j][c][q]); acc[c * 8 + 2 * q + 1] += wk[j] * bf_hi(vv[j][c][q]); }
            }
            const float* mb = mod + (size_t)b * 12288 + 10240;
            float s = 0.f;
#pragma unroll
            for (int c = 0; c < 4; ++c) { const int d = c * 512 + lane * 8;
                const f32x4 x0 = *(const f32x4*)(AR.out + (size_t)t * DM + d), x1 = *(const f32x4*)(AR.out + (size_t)t * DM + d + 4);
                const f32x4 m0 = *(const f32x4*)(mb + d), m1 = *(const f32x4*)(mb + d + 4);
#pragma unroll
                for (int q = 0; q < 4; ++q) { acc[c * 8 + q] = x0[q] * DN_ALPHA + m0[q] * acc[c * 8 + q] * DBG_FFN; acc[c * 8 + 4 + q] = x1[q] * DN_ALPHA + m1[q] * acc[c * 8 + 4 + q] * DBG_FFN; }
#pragma unroll
                for (int q = 0; q < 8; ++q) s += acc[c * 8 + q]; }
            const float mean = wave_sum(s) * (1.0f / DM); float s2 = 0.f;
#pragma unroll
            for (int i = 0; i < 32; ++i) { acc[i] -= mean; s2 += acc[i] * acc[i]; }
            const float rstd = 1.0f / sqrtf(wave_sum(s2) * (1.0f / DM) + 1e-5f);
#pragma unroll
            for (int c = 0; c < 4; ++c) { const int d = c * 512 + lane * 8;
                const f32x4 g0 = *(const f32x4*)(lg + d), g1 = *(const f32x4*)(lg + d + 4), b0 = *(const f32x4*)(lb + d), b1 = *(const f32x4*)(lb + d + 4);
                f32x4 o0, o1;
#pragma unroll
                for (int q = 0; q < 4; ++q) { o0[q] = acc[c * 8 + q] * rstd * g0[q] + b0[q]; o1[q] = acc[c * 8 + 4 + q] * rstd * g1[q] + b1[q]; }
                *(f32x4*)(AR.out + (size_t)t * DM + d) = o0; *(f32x4*)(AR.out + (size_t)t * DM + d + 4) = o1; }
        }
    }
#else
    for (int rep_ = 0; rep_ < (IN(11) ? 1 + ((REP_MASK >> 11) & 1) : 0); ++rep_) {
        PH_LOCALS;
        typedef int v4i32 __attribute__((ext_vector_type(4)));
        const int xs = bid & 7, rank = bid >> 3, nrank = G >> 3;
        const int tstep = nrank * NWAVES, t0 = rank * NWAVES + wave;
        const int ntok = rank < nrank ? (T - t0 + tstep - 1) / tstep : 0;
        const int slice = xs;
        const unsigned char* Us = U8 + (size_t)slice * (2u << 20);
        LAS unsigned char* ring = lds + wave * 17408;
        const int r8d = lane >> 3, dcd = lane & 7;
        const unsigned dsw = (unsigned)((dcd ^ r8d) << 4);
        const int im = lane & 15, g = lane >> 4;
        int ura[2][2];
#pragma unroll
        for (int hi = 0; hi < 2; ++hi)
#pragma unroll
            for (int sx = 0; sx < 2; ++sx) { const int rgm = 4 * hi + (im >> 2), c = 4 * sx + g;
                ura[hi][sx] = (int)(uintptr_t)ring + (im & 3) * 1088 + rgm * 128 + ((c ^ rgm) << 4); }
#define U_GLD4(dst, sb, vo, imm) asm volatile("global_load_dwordx4 %0, %1, %2 offset:" #imm : "=v"(dst) : "v"(vo), "s"(sb) : "memory")
#define U_MISC(IA, IB, H, tt) do { const unsigned char* si_ = (const unsigned char*)IDX2 + (size_t)(tt) * 256; const unsigned char* sh_ = (const unsigned char*)H2S + (size_t)(tt) * 2048 + slice * 256; \
            U_GLD4(IA, si_, voI, 0); U_GLD4(IB, si_, voI, 16); U_GLD4(H[0], sh_, voH, 0); U_GLD4(H[1], sh_, voH, 16); U_GLD4(H[2], sh_, voH, 128); U_GLD4(H[3], sh_, voH, 144); } while (0)
#define U_MOV8(D, o, S0, S1, WAITSTR) asm volatile(WAITSTR "\n\tv_mov_b32 %0, %8\n\tv_mov_b32 %1, %9\n\tv_mov_b32 %2, %10\n\tv_mov_b32 %3, %11\n\tv_mov_b32 %4, %12\n\tv_mov_b32 %5, %13\n\tv_mov_b32 %6, %14\n\tv_mov_b32 %7, %15" \
                : "=&v"(D[o]), "=&v"(D[o + 1]), "=&v"(D[o + 2]), "=&v"(D[o + 3]), "=&v"(D[o + 4]), "=&v"(D[o + 5]), "=&v"(D[o + 6]), "=&v"(D[o + 7]) \
                : "v"(S0.x), "v"(S0.y), "v"(S0.z), "v"(S0.w), "v"(S1.x), "v"(S1.y), "v"(S1.z), "v"(S1.w) : "memory")
#define U_ROT(DI, DH, IA, IB, H, WAITSTR) do { U_MOV8(DI, 0, IA, IB, WAITSTR); U_MOV8(DH, 0, H[0], H[1], "s_nop 0"); U_MOV8(DH, 8, H[2], H[3], "s_nop 0"); } while (0)
        const unsigned voI = (unsigned)(r8d * 32), voH = (unsigned)(g * 32);
#define U_DMAQ(IX, b) do { _Pragma("unroll") for (int pc_ = 0; pc_ < 4; ++pc_) { const int m_ = 4 * (b) + pc_; const unsigned w_ = IX[m_ >> 1]; \
            const unsigned e_ = (m_ & 1) ? (w_ >> 16) : (w_ & 0xffffu); \
            __builtin_amdgcn_global_load_lds((const unsigned*)(Us + (e_ * 128u + dsw)), (LAS unsigned*)(ring + (b) * 4352 + pc_ * 1088), 16, 0, 0); } } while (0)
#define U_RD(dst, addr, off) asm volatile("ds_read_b128 %0, %1 offset:%2" : "=&v"(dst) : "v"(addr), "i"(off) : "memory")
#define U_MM(ACC, R, HH, o) do { const v4i32 lo_ = {(int)(R.x & 0x0F0F0F0Fu), (int)(R.y & 0x0F0F0F0Fu), (int)(R.z & 0x0F0F0F0Fu), (int)(R.w & 0x0F0F0F0Fu)}; \
            const v4i32 hi_ = {(int)((R.x >> 4) & 0x0F0F0F0Fu), (int)((R.y >> 4) & 0x0F0F0F0Fu), (int)((R.z >> 4) & 0x0F0F0F0Fu), (int)((R.w >> 4) & 0x0F0F0F0Fu)}; \
            const v4i32 be_ = {(int)HH[o], (int)HH[o + 1], (int)HH[o + 2], (int)HH[o + 3]}, bo_ = {(int)HH[o + 4], (int)HH[o + 5], (int)HH[o + 6], (int)HH[o + 7]}; \
            ACC = __builtin_amdgcn_mfma_i32_16x16x64_i8(lo_, be_, ACC, 0, 0, 0); ACC = __builtin_amdgcn_mfma_i32_16x16x64_i8(hi_, bo_, ACC, 0, 0, 0); } while (0)
#define U_QUARTER(b, HH) do { u32x4 r00_, r01_, r10_, r11_; \
            U_RD(r00_, ura[0][0], (b) * 4352); U_RD(r01_, ura[0][1], (b) * 4352); U_RD(r10_, ura[1][0], (b) * 4352); U_RD(r11_, ura[1][1], (b) * 4352); \
            asm volatile("s_waitcnt lgkmcnt(0)" ::: "memory"); __builtin_amdgcn_sched_barrier(0); \
            U_MM(acc[b][0], r00_, HH, 0); U_MM(acc[b][0], r01_, HH, 8); U_MM(acc[b][1], r10_, HH, 0); U_MM(acc[b][1], r11_, HH, 8); } while (0)
        if (ntok > 0) {
            u32x4 mia, mib, pia, pib, mh[4], ph[4];
            unsigned ci[8], ch[16], ni[8], nh[16];
            const int tlast = t0 + (ntok - 1) * tstep;
            U_MISC(mia, mib, mh, t0);
            { const int t1 = ntok > 1 ? t0 + tstep : t0; U_MISC(pia, pib, ph, t1); }
            U_ROT(ci, ch, mia, mib, mh, "s_waitcnt vmcnt(0)");
            U_ROT(ni, nh, pia, pib, ph, "s_nop 0");
            __builtin_amdgcn_sched_barrier(0);
            U_DMAQ(ci, 0); U_DMAQ(ci, 1); U_DMAQ(ci, 2); U_DMAQ(ci, 3);
            __builtin_amdgcn_sched_barrier(0);
            for (int i = 0; i < ntok; ++i) {
                const int t = t0 + i * tstep; const bool more = i + 1 < ntok;
                { const int tm = min(t + 2 * tstep, tlast); U_MISC(mia, mib, mh, tm); }
                __builtin_amdgcn_sched_barrier(0);
                v4i32 acc[4][2], accS = {0, 0, 0, 0};
                unsigned hx[16];
#pragma unroll
                for (int o_ = 0; o_ < 16; o_ += 8)
#pragma unroll
                    for (int q_ = 0; q_ < 4; ++q_) { hx[o_ + q_] = __builtin_amdgcn_perm(ch[o_ + 2 * q_ + 1], ch[o_ + 2 * q_], 0x06040200u); hx[o_ + 4 + q_] = __builtin_amdgcn_perm(ch[o_ + 2 * q_ + 1], ch[o_ + 2 * q_], 0x07050301u); }
#pragma unroll
                for (int b_ = 0; b_ < 4; ++b_) { acc[b_][0] = (v4i32){0, 0, 0, 0}; acc[b_][1] = (v4i32){0, 0, 0, 0}; }
#define U_WAITQ() do { if (!more) { asm volatile("s_waitcnt vmcnt(0)" ::: "memory"); } else if (i == 0) { asm volatile("s_waitcnt vmcnt(18)" ::: "memory"); } \
                       else { asm volatile("s_waitcnt vmcnt(20)" ::: "memory"); } __builtin_amdgcn_sched_barrier(0); } while (0)
                U_WAITQ(); U_QUARTER(0, hx); __builtin_amdgcn_sched_barrier(0); if (more) U_DMAQ(ni, 0); __builtin_amdgcn_sched_barrier(0);
                U_WAITQ(); U_QUARTER(1, hx); __builtin_amdgcn_sched_barrier(0); if (more) U_DMAQ(ni, 1); __builtin_amdgcn_sched_barrier(0);
                U_WAITQ(); U_QUARTER(2, hx); __builtin_amdgcn_sched_barrier(0); if (more) U_DMAQ(ni, 2); __builtin_amdgcn_sched_barrier(0);
                U_WAITQ(); U_QUARTER(3, hx); __builtin_amdgcn_sched_barrier(0); if (more) U_DMAQ(ni, 3); __builtin_amdgcn_sched_barrier(0);
#undef U_WAITQ
                { const v4i32 ones_ = {0x01010101, 0x01010101, 0x01010101, 0x01010101};
#pragma unroll
                  for (int o_ = 0; o_ < 16; o_ += 4) { const v4i32 hb_ = {(int)ch[o_], (int)ch[o_ + 1], (int)ch[o_ + 2], (int)ch[o_ + 3]};
                      accS = __builtin_amdgcn_mfma_i32_16x16x64_i8(ones_, hb_, accS, 0, 0, 0); } }
                { const int hoff = -8 * accS[0]; const bool hsel = (lane & 1) != 0; unsigned pw[8];
#pragma unroll
                  for (int b_ = 0; b_ < 4; ++b_) {
                      const int v0 = (hsel ? acc[b_][1][0] : acc[b_][0][0]) + hoff, v1 = (hsel ? acc[b_][1][1] : acc[b_][0][1]) + hoff;
                      const int v2 = (hsel ? acc[b_][1][2] : acc[b_][0][2]) + hoff, v3 = (hsel ? acc[b_][1][3] : acc[b_][0][3]) + hoff;
                      pw[2 * b_] = cvtpk((float)v0, (float)v1); pw[2 * b_ + 1] = cvtpk((float)v2, (float)v3); }
                  if (im < 2) { u32x4* dst_ = (u32x4*)((unsigned*)PART + ((size_t)slice * T + t) * 64 + (4 * (lane & 1) + g) * 8);
                      dst_[0] = (u32x4){pw[0], pw[1], pw[2], pw[3]}; dst_[1] = (u32x4){pw[4], pw[5], pw[6], pw[7]}; } }
                __builtin_amdgcn_sched_barrier(0);
#pragma unroll
                for (int k_ = 0; k_ < 8; ++k_) ci[k_] = ni[k_];
#pragma unroll
                for (int k_ = 0; k_ < 16; ++k_) ch[k_] = nh[k_];
                if (more) U_ROT(ni, nh, mia, mib, mh, "s_waitcnt vmcnt(18)"); else U_ROT(ni, nh, mia, mib, mh, "s_waitcnt vmcnt(0)");
                __builtin_amdgcn_sched_barrier(0);
            }
            asm volatile("s_waitcnt vmcnt(0)" ::: "memory");
        }
#undef U_GLD4
#undef U_MISC
#undef U_MOV8
#undef U_ROT
#undef U_DMAQ
#undef U_RD
#undef U_MM
#undef U_QUARTER
    }
    GRID_BAR(11);

    for (int rep_ = 0; rep_ < (IN(12) ? 1 + ((REP_MASK >> 12) & 1) : 0); ++rep_) {
        PH_LOCALS;
        unsigned nidx, npv[8]; f32x2 ng; float nhs, nsu0, nsu1, nsv0, nsv1;
#define P12_LOAD(tt) do { nidx = ((const unsigned*)IDX2)[(size_t)(tt) * 64 + lane]; ng = ((const f32x2*)Gt)[(size_t)(tt) * 64 + lane]; nhs = SH[(tt)]; \
            _Pragma("unroll") for (int sl = 0; sl < 8; ++sl) npv[sl] = ((const unsigned*)PART)[((size_t)sl * T + (tt)) * 64 + lane]; } while (0)
#define P12_SCALES() do { const unsigned e0_ = nidx & 0xffffu, e1_ = nidx >> 16; nsu0 = SU[e0_]; nsu1 = SU[e1_]; nsv0 = SU[NE + e0_]; nsv1 = SU[NE + e1_]; } while (0)
        if (gw < T) { P12_LOAD(gw); P12_SCALES(); }
        for (int t = gw; t < T; t += NGW) {
            const f32x2 g2 = ng; const float hs = nhs, su0 = nsu0, su1 = nsu1, sv0 = nsv0, sv1 = nsv1;
            f32x2 a = {0.f, 0.f};
#pragma unroll
            for (int sl = 0; sl < 8; ++sl) { const unsigned pv = npv[sl]; a[0] += bf_lo(pv); a[1] += bf_hi(pv); }
            if (t + NGW < T) P12_LOAD(t + NGW);
            const float w0 = gelu_erf(a[0] * hs * su0) * g2[0] * sv0, w1 = gelu_erf(a[1] * hs * su1) * g2[1] * sv1;
            const float wm = wmax(fmaxf(fabsf(w0), fabsf(w1)));
            const float qs = wm > 0.f ? 127.0f / wm : 1.0f;
            const int q0 = (int)__builtin_rintf(w0 * qs), q1 = (int)__builtin_rintf(w1 * qs);
            { const float wsc_ = wm > 0.f ? wm * (1.0f / 127.0f) : 1.0f, qsum = wsum((float)(q0 + q1));
              if (lane == 0) *(f32x2*)(WSC + 2 * (size_t)t) = (f32x2){wsc_, -8.0f * wsc_ * qsum}; }
            { const int j0 = 2 * lane, j1 = j0 + 1;
              WTq[(size_t)t * 128 + (j0 & 15) * 8 + (j0 >> 4)] = (unsigned char)((unsigned)q0 & 255u);
              WTq[(size_t)t * 128 + (j1 & 15) * 8 + (j1 >> 4)] = (unsigned char)((unsigned)q1 & 255u); }
            if (t + NGW < T) P12_SCALES();
        }
#undef P12_LOAD
#undef P12_SCALES
    }
    GRID_BAR(12);

    for (int rep_ = 0; rep_ < (IN(13) ? 1 + ((REP_MASK >> 13) & 1) : 0); ++rep_) {
        PH_LOCALS;
        typedef int v4i32 __attribute__((ext_vector_type(4)));
        const int xs = bid & 7, rank = bid >> 3, nrank = G >> 3;
        const int tstep = nrank * NWAVES, t0 = rank * NWAVES + wave;
        const int ntok = rank < nrank ? (T - t0 + tstep - 1) / tstep : 0;
        LAS unsigned char* ring = lds + wave * 17408;
        const int r8d = lane >> 3, dcd = lane & 7;
        const unsigned dsw = (unsigned)((dcd ^ r8d) << 4);
        const int g = lane >> 4, q4 = (lane >> 2) & 3, p4 = lane & 3;
        int tra[2][4];
#pragma unroll
        for (int hh = 0; hh < 2; ++hh)
#pragma unroll
            for (int nb = 0; nb < 4; ++nb) { const int r8 = 4 * hh + q4, c = 2 * nb + (p4 >> 1);
                tra[hh][nb] = (int)(uintptr_t)ring + g * 1088 + r8 * 128 + ((c ^ r8) << 4) + (p4 & 1) * 8; }
#define V_GLD4(dst, sb, vo, imm) asm volatile("global_load_dwordx4 %0, %1, %2 offset:" #imm : "=v"(dst) : "v"(vo), "s"(sb) : "memory")
#define V_GLD2(dst, sb, vo, imm) asm volatile("global_load_dwordx2 %0, %1, %2 offset:" #imm : "=v"(dst) : "v"(vo), "s"(sb) : "memory")
#define V_GLD1(dst, sb, vo)      asm volatile("global_load_dword %0, %1, %2" : "=v"(dst) : "v"(vo), "s"(sb) : "memory")
#define V_MISC(IA, IB, W, SC, tt) do { const unsigned char* si_ = (const unsigned char*)IDX2 + (size_t)(tt) * 256; const unsigned char* sw_ = (const unsigned char*)WTq + (size_t)(tt) * 128; \
            const float* sc_ = WSC + 2 * (size_t)(tt); V_GLD4(IA, si_, voI, 0); V_GLD4(IB, si_, voI, 16); V_GLD2(W[0], sw_, voW, 0); V_GLD2(W[1], sw_, voW, 32); V_GLD2(W[2], sw_, voW, 64); V_GLD2(W[3], sw_, voW, 96); \
            V_GLD2(SC, sc_, voZ, 0); } while (0)
#define V_ROT(DI, DW, DSC, IA, IB, W, SC, WAITSTR) do { \
            asm volatile(WAITSTR "\n\tv_mov_b32 %0, %8\n\tv_mov_b32 %1, %9\n\tv_mov_b32 %2, %10\n\tv_mov_b32 %3, %11\n\tv_mov_b32 %4, %12\n\tv_mov_b32 %5, %13\n\tv_mov_b32 %6, %14\n\tv_mov_b32 %7, %15" \
                : "=&v"(DI[0]), "=&v"(DI[1]), "=&v"(DI[2]), "=&v"(DI[3]), "=&v"(DI[4]), "=&v"(DI[5]), "=&v"(DI[6]), "=&v"(DI[7]) \
                : "v"(IA.x), "v"(IA.y), "v"(IA.z), "v"(IA.w), "v"(IB.x), "v"(IB.y), "v"(IB.z), "v"(IB.w) : "memory"); \
            asm volatile("v_mov_b32 %0, %10\n\tv_mov_b32 %1, %11\n\tv_mov_b32 %2, %12\n\tv_mov_b32 %3, %13\n\tv_mov_b32 %4, %14\n\tv_mov_b32 %5, %15\n\tv_mov_b32 %6, %16\n\tv_mov_b32 %7, %17\n\tv_mov_b32 %8, %18\n\tv_mov_b32 %9, %19" \
                : "=&v"(DW[0]), "=&v"(DW[1]), "=&v"(DW[2]), "=&v"(DW[3]), "=&v"(DW[4]), "=&v"(DW[5]), "=&v"(DW[6]), "=&v"(DW[7]), "=&v"(DSC[0]), "=&v"(DSC[1]) \
                : "v"(W[0].x), "v"(W[0].y), "v"(W[1].x), "v"(W[1].y), "v"(W[2].x), "v"(W[2].y), "v"(W[3].x), "v"(W[3].y), "v"(SC.x), "v"(SC.y) : "memory"); } while (0)
        const unsigned voI = (unsigned)(r8d * 32), voW = (unsigned)(g * 8), voZ = 0u;
#define V_DMAQ(IX, b) do { _Pragma("unroll") for (int pc_ = 0; pc_ < 4; ++pc_) { const int m_ = 4 * (b) + pc_; const unsigned w_ = IX[m_ >> 1]; \
            const unsigned e_ = (m_ & 1) ? (w_ >> 16) : (w_ & 0xffffu); \
            __builtin_amdgcn_global_load_lds((const unsigned*)(Vs + (e_ * 128u + dsw)), (LAS unsigned*)(ring + (b) * 4352 + pc_ * 1088), 16, 0, 0); } } while (0)
#define V_TR(dst, addr, off) asm volatile("ds_read_b64_tr_b16 %0, %1 offset:%2" : "=&v"(dst) : "v"(addr), "i"(off) : "memory")
#define V_QUARTER(b, W) do { \
            const unsigned wlo_ = W[2 * (b)], whi_ = W[2 * (b) + 1]; \
            const v4i32 a_ = {(int)__builtin_amdgcn_perm(wlo_, wlo_, sel0), (int)__builtin_amdgcn_perm(wlo_, wlo_, sel1), (int)__builtin_amdgcn_perm(whi_, whi_, sel0), (int)__builtin_amdgcn_perm(whi_, whi_, sel1)}; \
            u32x2 x0_, x1_, x2_, x3_, y0_, y1_, y2_, y3_; \
            V_TR(x0_, tra[0][0], (b) * 4352); V_TR(y0_, tra[1][0], (b) * 4352); V_TR(x1_, tra[0][1], (b) * 4352); V_TR(y1_, tra[1][1], (b) * 4352); \
            V_TR(x2_, tra[0][2], (b) * 4352); V_TR(y2_, tra[1][2], (b) * 4352); V_TR(x3_, tra[0][3], (b) * 4352); V_TR(y3_, tra[1][3], (b) * 4352); \
            asm volatile("s_waitcnt lgkmcnt(0)" ::: "memory"); __builtin_amdgcn_sched_barrier(0); \
            V_MM(0, x0_, y0_); V_MM(1, x1_, y1_); V_MM(2, x2_, y2_); V_MM(3, x3_, y3_); } while (0)
#define V_MM(nb, X, Y) do { const v4i32 lo_ = {(int)(X.x & 0x0F0F0F0Fu), (int)(X.y & 0x0F0F0F0Fu), (int)(Y.x & 0x0F0F0F0Fu), (int)(Y.y & 0x0F0F0F0Fu)}; \
            const v4i32 hi_ = {(int)((X.x >> 4) & 0x0F0F0F0Fu), (int)((X.y >> 4) & 0x0F0F0F0Fu), (int)((Y.x >> 4) & 0x0F0F0F0Fu), (int)((Y.y >> 4) & 0x0F0F0F0Fu)}; \
            aL[nb] = __builtin_amdgcn_mfma_i32_16x16x64_i8(a_, lo_, aL[nb], 0, 0, 0); aH[nb] = __builtin_amdgcn_mfma_i32_16x16x64_i8(a_, hi_, aH[nb], 0, 0, 0); } while (0)
        const unsigned sel0 = (lane & 1) ? 0x010C000Cu : 0x0C010C00u, sel1 = (lane & 1) ? 0x030C020Cu : 0x0C030C02u;
        {
            const int slice = xs;
            const unsigned char* Vs = U8 + (32u << 20) + (size_t)slice * (2u << 20);
            if (ntok > 0) {
                u32x4 mia, mib, pia, pib; u32x2 mwq[4], pwq[4]; f32x2 mwsc, pwsc;
                unsigned ci[8], cw[8], ni[8], nw[8]; float wsc[2], nsc[2];
                const int tlast = t0 + (ntok - 1) * tstep;
                V_MISC(mia, mib, mwq, mwsc, t0);
                { const int t1 = ntok > 1 ? t0 + tstep : t0; V_MISC(pia, pib, pwq, pwsc, t1); }
                V_ROT(ci, cw, wsc, mia, mib, mwq, mwsc, "s_waitcnt vmcnt(0)");
                V_ROT(ni, nw, nsc, pia, pib, pwq, pwsc, "s_nop 0");
                __builtin_amdgcn_sched_barrier(0);
                V_DMAQ(ci, 0); V_DMAQ(ci, 1); V_DMAQ(ci, 2); V_DMAQ(ci, 3);
                __builtin_amdgcn_sched_barrier(0);
                for (int i = 0; i < ntok; ++i) {
                    const int t = t0 + i * tstep; const bool more = i + 1 < ntok;
                    { const int tm = min(t + 2 * tstep, tlast); V_MISC(mia, mib, mwq, mwsc, tm); }
                    __builtin_amdgcn_sched_barrier(0);
                    v4i32 aL[4], aH[4];
#pragma unroll
                    for (int nb = 0; nb < 4; ++nb) { aL[nb] = (v4i32){0, 0, 0, 0}; aH[nb] = (v4i32){0, 0, 0, 0}; }
#define V_WAITQ() do { if (!more) { asm volatile("s_waitcnt vmcnt(0)" ::: "memory"); } else if (i == 0) { asm volatile("s_waitcnt vmcnt(19)" ::: "memory"); } \
                       else { asm volatile("s_waitcnt vmcnt(20)" ::: "memory"); } __builtin_amdgcn_sched_barrier(0); } while (0)
                    V_WAITQ(); V_QUARTER(0, cw); __builtin_amdgcn_sched_barrier(0); if (more) V_DMAQ(ni, 0); __builtin_amdgcn_sched_barrier(0);
                    V_WAITQ(); V_QUARTER(1, cw); __builtin_amdgcn_sched_barrier(0); if (more) V_DMAQ(ni, 1); __builtin_amdgcn_sched_barrier(0);
                    V_WAITQ(); V_QUARTER(2, cw); __builtin_amdgcn_sched_barrier(0); if (more) V_DMAQ(ni, 2); __builtin_amdgcn_sched_barrier(0);
                    V_WAITQ(); V_QUARTER(3, cw); __builtin_amdgcn_sched_barrier(0); if (more) V_DMAQ(ni, 3); __builtin_amdgcn_sched_barrier(0);
#undef V_WAITQ
                    { const int nbs = lane >> 4;
#define V_SEL(A, r) (nbs == 0 ? A[0][r] : (nbs == 1 ? A[1][r] : (nbs == 2 ? A[2][r] : A[3][r])))
                      const float d0 = (float)V_SEL(aL, 0) * wsc[0] + wsc[1], d1 = (float)V_SEL(aH, 0) * wsc[0] + wsc[1];
                      const float d2 = (float)V_SEL(aL, 1) * wsc[0] + wsc[1], d3 = (float)V_SEL(aH, 1) * wsc[0] + wsc[1];
#undef V_SEL
                      *(u32x2*)(FFN + (size_t)t * DM + slice * 256 + 4 * lane) = (u32x2){cvtpk(d0, d1), cvtpk(d2, d3)}; }
                    __builtin_amdgcn_sched_barrier(0);
#pragma unroll
                    for (int k_ = 0; k_ < 8; ++k_) { ci[k_] = ni[k_]; cw[k_] = nw[k_]; }
                    wsc[0] = nsc[0]; wsc[1] = nsc[1];
                    if (more) V_ROT(ni, nw, nsc, mia, mib, mwq, mwsc, "s_waitcnt vmcnt(17)"); else V_ROT(ni, nw, nsc, mia, mib, mwq, mwsc, "s_waitcnt vmcnt(0)");
                    __builtin_amdgcn_sched_barrier(0);
                }
                asm volatile("s_waitcnt vmcnt(0)" ::: "memory");
            }
        }
#undef V_GLD4
#undef V_GLD2
#undef V_GLD1
#undef V_MISC
#undef V_ROT
#undef V_DMAQ
#undef V_TR
#undef V_QUARTER
#undef V_MM
    }
    GRID_BAR(13);

    for (int rep_ = 0; rep_ < (IN(14) ? 1 + ((REP_MASK >> 14) & 1) : 0); ++rep_) {
        PH_LOCALS;
        const int nb_ = G >> 4, b = bid / nb_, r0 = (bid % nb_) * NWAVES + wave, rstep = nb_ * NWAVES;
        LAS float* pg2 = (LAS float*)lds; LAS float* plg = pg2 + 2048; LAS float* plb = pg2 + 4096;
        __syncthreads();
        if (b < 16) { *(LAS f32x4*)(pg2 + 4 * tid) = *(const f32x4*)(mod + (size_t)b * 12288 + 10240 + 4 * tid);
            *(LAS f32x4*)(plg + 4 * tid) = *(const f32x4*)(AR.in[20] + 4 * tid); *(LAS f32x4*)(plb + 4 * tid) = *(const f32x4*)(AR.in[21] + 4 * tid); }
        __syncthreads();
        if (b < 16) {
        u32x4 nx[4]; u32x4 nf[4];
#define P14_LOAD(tt) do { _Pragma("unroll") for (int c = 0; c < 4; ++c) { const int d_ = c * 512 + lane * 8; nf[c] = *(const u32x4*)(FFN + (size_t)(tt) * DM + d_); \
            nx[c] = *(const u32x4*)(X1b + (size_t)(tt) * DM + d_); } } while (0)
        P14_LOAD(b * 2048 + r0);
        for (int r = r0; r < 2048; r += rstep) {
            const int t = b * 2048 + r;
            float acc[32]; float s = 0.f;
#pragma unroll
            for (int c = 0; c < 4; ++c) { const int d = c * 512 + lane * 8;
                const u32x4 fv = nf[c]; const u32x4 xv = nx[c]; const unsigned xa = xv.x, xb = xv.y, xc = xv.z, xd = xv.w;
                const f32x4 x0 = {bf_lo(xa), bf_hi(xa), bf_lo(xb), bf_hi(xb)}, x1 = {bf_lo(xc), bf_hi(xc), bf_lo(xd), bf_hi(xd)};
                const f32x4 m0 = *(const LAS f32x4*)(pg2 + d), m1 = *(const LAS f32x4*)(pg2 + d + 4);
                const unsigned f0 = fv.x, f1 = fv.y, f2 = fv.z, f3 = fv.w;
                acc[c * 8 + 0] = x0[0] * DN_ALPHA + m0[0] * bf_lo(f0); acc[c * 8 + 1] = x0[1] * DN_ALPHA + m0[1] * bf_hi(f0);
                acc[c * 8 + 2] = x0[2] * DN_ALPHA + m0[2] * bf_lo(f1); acc[c * 8 + 3] = x0[3] * DN_ALPHA + m0[3] * bf_hi(f1);
                acc[c * 8 + 4] = x1[0] * DN_ALPHA + m1[0] * bf_lo(f2); acc[c * 8 + 5] = x1[1] * DN_ALPHA + m1[1] * bf_hi(f2);
                acc[c * 8 + 6] = x1[2] * DN_ALPHA + m1[2] * bf_lo(f3); acc[c * 8 + 7] = x1[3] * DN_ALPHA + m1[3] * bf_hi(f3);
#pragma unroll
                for (int q = 0; q < 8; ++q) s += acc[c * 8 + q]; }
            if (r + rstep < 2048) P14_LOAD(t + rstep);
            const float mean = wsum(s) * (1.0f / DM); float s2 = 0.f;
#pragma unroll
            for (int i = 0; i < 32; ++i) { acc[i] -= mean; s2 += acc[i] * acc[i]; }
            const float rstd = 1.0f / sqrtf(wsum(s2) * (1.0f / DM) + 1e-5f);
#pragma unroll
            for (int c = 0; c < 4; ++c) { const int d = c * 512 + lane * 8;
                const f32x4 g0 = *(const LAS f32x4*)(plg + d), g1 = *(const LAS f32x4*)(plg + d + 4), b0 = *(const LAS f32x4*)(plb + d), b1 = *(const LAS f32x4*)(plb + d + 4);
                f32x4 o0, o1;
#pragma unroll
                for (int q = 0; q < 4; ++q) { o0[q] = acc[c * 8 + q] * rstd * g0[q] + b0[q]; o1[q] = acc[c * 8 + 4 + q] * rstd * g1[q] + b1[q]; }
                *(f32x4*)(AR.out + (size_t)t * DM + d) = o0; *(f32x4*)(AR.out + (size_t)t * DM + d + 4) = o1; }
        }
        }
    }
#endif
#undef IN
#undef GRID_BAR
}

extern "C" void kernel_launch(void* const* d_in, const int* in_sizes, int n_in, void* d_out, int out_size, void* d_ws, size_t ws_size, hipStream_t stream) {
    static int grid = 0;
    if (grid == 0) {
        if (n_in != 22 || out_size != T * DM || ws_size < WS_END) { fprintf(stderr, "kernel_launch: unexpected shapes (n_in %d out %d ws %zu)\n", n_in, out_size, ws_size); grid = -1; return; }
        int dev = 0, cus = 0, per_cu = 0;
        if (hipGetDevice(&dev) != hipSuccess || hipDeviceGetAttribute(&cus, hipDeviceAttributeMultiprocessorCount, dev) != hipSuccess) { grid = -1; return; }
        if (hipFuncSetAttribute((const void*)mega_fwd, hipFuncAttributeMaxDynamicSharedMemorySize, LDS_BYTES) != hipSuccess) { fprintf(stderr, "kernel_launch: hipFuncSetAttribute failed\n"); grid = -1; return; }
        if (hipOccupancyMaxActiveBlocksPerMultiprocessor(&per_cu, (const void*)mega_fwd, NWAVES * 64, LDS_BYTES) != hipSuccess || per_cu < 1) { fprintf(stderr, "kernel_launch: occupancy query says %d\n", per_cu); grid = -1; (void)hipGetLastError(); return; }
        grid = cus;
    }
    if (grid < 0) return;
    (void)hipMemsetAsync(d_ws, 0, 16384, stream);
    Args a{};
    for (int i = 0; i < 22; ++i) a.in[i] = (const float*)d_in[i];
    a.out = (float*)d_out; a.ws = (unsigned char*)d_ws;
#if MK_N_LAUNCHES == 1
    a.ph_lo = 0; a.ph_hi = N_PHASES;
    void* kargs[] = {&a};
    hipError_t e = hipLaunchCooperativeKernel((const void*)mega_fwd, dim3(grid), dim3(NWAVES * 64), kargs, LDS_BYTES, stream);
    if (e != hipSuccess) fprintf(stderr, "kernel_launch: cooperative launch failed: %s (grid %d)\n", hipGetErrorString(e), grid);
#else
    for (int p = 0; p < N_PHASES; ++p) {
        a.ph_lo = p; a.ph_hi = p + 1;
        hipLaunchKernelGGL(mega_fwd, dim3(grid), dim3(NWAVES * 64), LDS_BYTES, stream, a);
    }
    const hipError_t le = hipPeekAtLastError();
    if (le != hipSuccess) fprintf(stderr, "kernel_launch: launch failed: %s\n", hipGetErrorName(le));
#endif
}
```

```cpp
#include <hip/hip_runtime.h>
#include <hip/hip_cooperative_groups.h>
#include <cstdio>
#include <cstdint>
namespace cg = cooperative_groups;

#ifndef MK_N_LAUNCHES
#define MK_N_LAUNCHES 1
#ifndef REP_MASK
#define REP_MASK 0
#endif
#define DBG_MIX 1.0f
#define DBG_FFN 1.0f
#endif

#define LAS __attribute__((address_space(3)))
typedef unsigned short bf16_t;
typedef short bf16x8 __attribute__((ext_vector_type(8)));
typedef short s16x4 __attribute__((ext_vector_type(4)));
typedef float f32x2 __attribute__((ext_vector_type(2)));
typedef float f32x4 __attribute__((ext_vector_type(4)));
typedef float f32x16 __attribute__((ext_vector_type(16)));
typedef unsigned u32x2 __attribute__((ext_vector_type(2)));
typedef unsigned u32x4 __attribute__((ext_vector_type(4)));
typedef int i32x4 __attribute__((ext_vector_type(4)));
typedef __bf16 bf16x2_t __attribute__((ext_vector_type(2)));

constexpr int NB = 16, SEQ = 2048, DM = 2048, T = NB * SEQ;
constexpr int NPROJ = 4160, NPROJ_PAD = 4352;
constexpr float DN_ALPHA = 1.189207115002721f;
constexpr int NE = 16384;

constexpr size_t MiB = 1u << 20;
constexpr size_t WS_MOD = 1 * MiB;
constexpr size_t WS_ROPEA = 2 * MiB;
constexpr size_t WS_ROPEB = 2 * MiB + 256 * 1024;
constexpr size_t WS_CQS = 2 * MiB;
constexpr size_t WS_CMQ = 2 * MiB + 262144;
constexpr size_t WS_WSQ = 2 * MiB + 327680;
constexpr size_t WS_SSQ_Q = 3 * MiB;
constexpr size_t WS_SSQ_KV = 4 * MiB;
constexpr size_t WS_SSQ_O = 5 * MiB;
constexpr size_t WS_SM = 7 * MiB;
constexpr size_t WS_SL = 8 * MiB;
constexpr size_t WS_K1 = 9 * MiB;
constexpr size_t WS_K2 = 9 * MiB + 32768;
constexpr size_t WS_WIN = 10 * MiB;
constexpr size_t WS_WUQ = 27 * MiB;
constexpr size_t WS_WUKV = 29 * MiB;
constexpr size_t WS_WO = 31 * MiB;
constexpr size_t WS_WPQ = 39 * MiB;
constexpr size_t WS_UT = 64 * MiB;
constexpr size_t WS_VT = 128 * MiB;
constexpr size_t WS_A = 192 * MiB;
constexpr size_t WS_QA = 320 * MiB, WS_KA = 384 * MiB, WS_VA = 448 * MiB, WS_CQ = 512 * MiB, WS_CKV = 544 * MiB, WS_KR = 576 * MiB;
constexpr size_t WS_Y = 320 * MiB;
constexpr size_t WS_QN = 580 * MiB, WS_QR = 644 * MiB, WS_KN = 676 * MiB, WS_VB = 740 * MiB;
constexpr size_t WS_H2 = 580 * MiB;
constexpr size_t WS_O = 804 * MiB;
constexpr size_t WS_IDX = 932 * MiB;
constexpr size_t WS_G = 940 * MiB;
constexpr size_t WS_END = 972 * MiB;
constexpr size_t WS_SU = 9 * MiB + 65536;
constexpr size_t WS_SH = 9 * MiB + 196608;
constexpr size_t WS_CMAX = 9 * MiB + 327680;
constexpr size_t WS_WS1 = 9 * MiB + 491520;
constexpr size_t WS_HS1 = 9 * MiB + 524288;
constexpr size_t WS_CMAX2 = 9 * MiB + 655360;
constexpr size_t WS_WS4 = 9 * MiB + 720896;
constexpr size_t WS_OS = 9 * MiB + 786432;
constexpr size_t WS_CMAX3 = 9 * MiB + 917504;
constexpr size_t WS_WS3 = 9 * MiB + 983040;
constexpr size_t WS_U8 = 64 * MiB;
constexpr size_t WS_V8 = 96 * MiB;
constexpr size_t WS_PART = 320 * MiB;
constexpr size_t WS_H8 = 804 * MiB;
constexpr size_t WS_IDX2 = 932 * MiB;
constexpr size_t WS_WT = 956 * MiB;
constexpr size_t WS_H2S = 128 * MiB;
constexpr size_t WS_X1 = 804 * MiB;
constexpr size_t WS_FFN = 192 * MiB;

constexpr int NWAVES = 8;
constexpr int LDS_BYTES = 147456;

__device__ __forceinline__ int opaque(int v) { asm volatile("" : "+v"(v)); return v; }
__device__ __forceinline__ unsigned cvtpk(float lo, float hi) { f32x2 v = {lo, hi}; bf16x2_t b = __builtin_convertvector(v, bf16x2_t); return __builtin_bit_cast(unsigned, b); }
__device__ __forceinline__ float dot2bf(unsigned a, unsigned b, float c) { return __builtin_amdgcn_fdot2_f32_bf16(__builtin_bit_cast(bf16x2_t, a), __builtin_bit_cast(bf16x2_t, b), c, false); }
__device__ __forceinline__ void fmac(float& d, float a, float b) { asm("v_fmac_f32_e32 %0, %1, %2" : "+v"(d) : "v"(a), "v"(b)); }
__device__ __forceinline__ float bf_lo(unsigned u) { return __uint_as_float(u << 16); }
__device__ __forceinline__ float bf_hi(unsigned u) { return __uint_as_float(u & 0xffff0000u); }
#define DPPF(v, ctrl) __builtin_bit_cast(float, __builtin_amdgcn_update_dpp(0, __builtin_bit_cast(int, (v)), (ctrl), 0xf, 0xf, false))
#define RLF(v, l) __builtin_bit_cast(float, __builtin_amdgcn_readlane(__builtin_bit_cast(int, (v)), (l)))
__device__ __forceinline__ float wsum(float v) {
    v += DPPF(v, 0xB1); v += DPPF(v, 0x4E); v += DPPF(v, 0x141); v += DPPF(v, 0x140);
    return (RLF(v, 0) + RLF(v, 16)) + (RLF(v, 32) + RLF(v, 48));
}
__device__ __forceinline__ float wmax(float v) {
    v = fmaxf(v, DPPF(v, 0xB1)); v = fmaxf(v, DPPF(v, 0x4E)); v = fmaxf(v, DPPF(v, 0x141)); v = fmaxf(v, DPPF(v, 0x140));
    return fmaxf(fmaxf(RLF(v, 0), RLF(v, 16)), fmaxf(RLF(v, 32), RLF(v, 48)));
}
__device__ __forceinline__ float wave_max(float v) {
#pragma unroll
    for (int o = 1; o < 64; o <<= 1) v = fmaxf(v, __shfl_xor(v, o));
    return v;
}
__device__ __forceinline__ unsigned pack_fp8x4(float a, float b, float c, float d) {
    int w = __builtin_amdgcn_cvt_pk_fp8_f32(a, b, 0, false); w = __builtin_amdgcn_cvt_pk_fp8_f32(c, d, w, true); return (unsigned)w;
}
__device__ __forceinline__ unsigned pack_i8x4(float a, float b, float c, float d) {
    const int ia = (int)__builtin_rintf(a), ib = (int)__builtin_rintf(b), ic = (int)__builtin_rintf(c), id = (int)__builtin_rintf(d);
    return ((unsigned)ia & 255u) | (((unsigned)ib & 255u) << 8) | (((unsigned)ic & 255u) << 16) | ((unsigned)id << 24);
}
__device__ __forceinline__ float wave_sum(float v) {
#pragma unroll
    for (int o = 1; o < 64; o <<= 1) v += __shfl_xor(v, o);
    return v;
}

namespace pg8 {
constexpr int BM = 256, BK = 64, HALF = 128, HTB = HALF * BK * 2, STAGE_BYTES = 8 * HTB, NXCD = 8, WGM = 8;
__host__ __device__ __forceinline__ int lds_byte(int r, int c) { const int st = (r >> 4) * 2 + (c >> 5), rr = r & 15, cc = c & 31, ob = rr * 64 + cc * 2; return st * 1024 + (ob ^ (((ob >> 9) & 1) << 5)); }
__host__ __device__ __forceinline__ void stage_rc(int b, int& R, int& C) { const int st = b / 1024, sb = b % 1024, swz = sb ^ (((sb >> 9) & 1) << 5); R = (st >> 1) * 16 + swz / 64; C = (st & 1) * 32 + (swz % 64) / 2; }
__host__ __device__ __forceinline__ int perm32(int rho) { const int n = rho >> 4, i = rho & 15; return 8 * (i >> 2) + 4 * n + (i & 3); }

struct Unit { int pm, pn; };
struct Gemm { const bf16_t* A; const bf16_t* Bt; int M, N, K; };

struct StaticOrder {
    int nM, nN, nwg, G, c;
    __host__ __device__ __forceinline__ void init(int M, int N, int G_, int c_) { nM = M / BM; nN = N / BM; nwg = nM * nN; G = G_; c = c_; }
    __host__ __device__ __forceinline__ bool next(int i, Unit& u) const {
        const long L = (long)i * G + c; if (L >= nwg) return false;
        int wgid = (int)L; { const int q = nwg / NXCD, r = nwg % NXCD, xcd = wgid % NXCD, off = wgid / NXCD; wgid = (xcd < r ? xcd * (q + 1) : r * (q + 1) + (xcd - r) * q) + off; }
        const int nig = WGM * nN, gid = wgid / nig, fm = gid * WGM, gsz = (nM - fm) < WGM ? (nM - fm) : WGM;
        u.pm = fm + ((wgid % nig) % gsz); u.pn = (wgid % nig) / gsz; return true;
    }
};

template <class Epi, class Sched>
__device__ __forceinline__ void gemm_phase(const int tid, LAS unsigned char* lds, const Gemm g, const Sched& S, const Epi& E) {
    const int wid = __builtin_amdgcn_readfirstlane(tid >> 6), lane = tid & 63, wr = wid >> 2, wc = wid & 3, fr = lane & 15, fq = lane >> 4;
    const int K = g.K, nt = K / BK;
    unsigned voffA[2], voffB[2];
#pragma unroll
    for (int i = 0; i < 2; ++i) { int R, C; stage_rc(tid * 16 + i * 8192, R, C); const int Rb = Epi::PERM ? ((R & ~31) + perm32(R & 31)) : R;
        voffA[i] = (unsigned)(R * K + C) * 2u; voffB[i] = (unsigned)(Rb * K + C) * 2u; }
    const size_t kstep = (size_t)(BK * 2);
    const size_t hstep = (size_t)HALF * K * 2;
    const size_t tstep = 2 * hstep;
    const unsigned ldsw = (unsigned)wid * 1024u;
    const int aoff = lds_byte(wr * 64 + fr, fq * 8), boff = lds_byte(wc * 32 + fr, fq * 8);
#define PG8_SA(b, h) (((b) * 2 + (h)) * HTB)
#define PG8_SB(b, h) ((4 + (b) * 2 + (h)) * HTB)
#define PG8_STAGE(bufoff, gbase, voff) do { _Pragma("unroll") for (int _i = 0; _i < 2; ++_i) \
        __builtin_amdgcn_global_load_lds((const unsigned*)((const char*)(gbase) + (voff)[_i]), (LAS unsigned*)(lds + (bufoff) + ldsw + _i * 8192), 16, 0, 0); } while (0)
#define PG8_LDA(dst, b, h) do { _Pragma("unroll") for (int m = 0; m < 4; ++m) _Pragma("unroll") for (int k = 0; k < 2; ++k) dst[m][k] = *(const LAS bf16x8*)(lds + PG8_SA(b, h) + aoff + m * 2048 + k * 1024); } while (0)
#define PG8_LDB(dst, b, h) do { _Pragma("unroll") for (int n = 0; n < 2; ++n) _Pragma("unroll") for (int k = 0; k < 2; ++k) dst[n][k] = *(const LAS bf16x8*)(lds + PG8_SB(b, h) + boff + n * 2048 + k * 1024); } while (0)
#define PG8_MMA(ai, bj, At, Bt) do { __builtin_amdgcn_s_setprio(1); _Pragma("unroll") for (int m = 0; m < 4; ++m) _Pragma("unroll") for (int n = 0; n < 2; ++n) _Pragma("unroll") for (int k = 0; k < 2; ++k) \
        { if constexpr (Epi::I8) acc[ai][bj][m][n] = __builtin_bit_cast(f32x4, __builtin_amdgcn_mfma_i32_16x16x64_i8(__builtin_bit_cast(i32x4, Bt[n][k]), __builtin_bit_cast(i32x4, At[m][k]), __builtin_bit_cast(i32x4, acc[ai][bj][m][n]), 0, 0, 0)); \
          else acc[ai][bj][m][n] = __builtin_amdgcn_mfma_f32_16x16x32_bf16(Bt[n][k], At[m][k], acc[ai][bj][m][n], 0, 0, 0); } __builtin_amdgcn_s_setprio(0); } while (0)
#define PG8_WAIT_V(n) asm volatile("s_waitcnt vmcnt(" #n ")" ::: "memory")
#define PG8_WAIT_L(n) asm volatile("s_waitcnt lgkmcnt(" #n ")" ::: "memory")
#define PG8_BAR __builtin_amdgcn_s_barrier()
#define PG8_SCHED __builtin_amdgcn_sched_barrier(0)
    Unit cur, nxt; int ui = 0;
    if (!S.next(0, cur)) return;
    f32x4 acc[2][2][4][2];
#pragma unroll
    for (int a = 0; a < 2; ++a)
#pragma unroll
        for (int b = 0; b < 2; ++b)
#pragma unroll
            for (int m = 0; m < 4; ++m)
#pragma unroll
                for (int n = 0; n < 2; ++n) acc[a][b][m][n] = (f32x4){0.f, 0.f, 0.f, 0.f};
    bf16x8 At[4][2], B0[2][2], B1[2][2];
    const char* cA = (const char*)g.A + (size_t)cur.pm * tstep; const char* cB = (const char*)g.Bt + (size_t)cur.pn * tstep;
    PG8_STAGE(PG8_SB(0, 0), cB, voffB); PG8_STAGE(PG8_SB(0, 1), cB + hstep, voffB); PG8_STAGE(PG8_SA(0, 0), cA, voffA); PG8_STAGE(PG8_SA(0, 1), cA + hstep, voffA);
    if (wr == 1) PG8_BAR;
    PG8_WAIT_V(2); PG8_BAR;
    PG8_STAGE(PG8_SB(1, 0), cB + kstep, voffB); PG8_STAGE(PG8_SA(1, 0), cA + kstep, voffA); PG8_STAGE(PG8_SB(1, 1), cB + hstep + kstep, voffB);
    PG8_WAIT_V(6); PG8_BAR;
    for (;;) {
        const bool has_next = S.next(ui + 1, nxt);
        const char* nA = has_next ? (const char*)g.A + (size_t)nxt.pm * tstep : cA; const char* nB = has_next ? (const char*)g.Bt + (size_t)nxt.pn * tstep : cB;
        for (int t = 0; t < nt; t += 2) {
            if constexpr (Epi::MID) { if (t == (nt >> 1)) E.mid(acc, cur, ui, tid); }
            const bool last = (t == nt - 2);
            const char* a1 = cA + (size_t)(t + 1) * kstep;
            const char* a2 = last ? nA : cA + (size_t)(t + 2) * kstep; const char* b2 = last ? nB : cB + (size_t)(t + 2) * kstep;
            const char* a3 = a2 + kstep; const char* b3 = b2 + kstep;
            PG8_LDB(B0, 0, 0); PG8_LDB(B1, 0, 1); PG8_SCHED; PG8_LDA(At, 0, 0); PG8_STAGE(PG8_SA(1, 1), a1 + hstep, voffA);
            PG8_WAIT_V(8); PG8_WAIT_L(0); PG8_BAR; PG8_MMA(0, 0, At, B0); PG8_MMA(0, 1, At, B1); PG8_BAR; PG8_SCHED;
            PG8_LDA(At, 0, 1); PG8_STAGE(PG8_SB(0, 0), b2, voffB); PG8_STAGE(PG8_SB(0, 1), b2 + hstep, voffB); PG8_STAGE(PG8_SA(0, 0), a2, voffA);
            PG8_WAIT_V(8); PG8_WAIT_L(0); PG8_BAR; PG8_MMA(1, 0, At, B0); PG8_MMA(1, 1, At, B1); PG8_BAR; PG8_SCHED;
            PG8_LDB(B0, 1, 0); PG8_LDB(B1, 1, 1); PG8_SCHED; PG8_LDA(At, 1, 0); PG8_STAGE(PG8_SA(0, 1), a2 + hstep, voffA);
            PG8_WAIT_V(8); PG8_WAIT_L(0); PG8_BAR; PG8_MMA(0, 0, At, B0); PG8_MMA(0, 1, At, B1); PG8_BAR; PG8_SCHED;
            PG8_LDA(At, 1, 1); PG8_STAGE(PG8_SB(1, 0), b3, voffB); PG8_STAGE(PG8_SB(1, 1), b3 + hstep, voffB); PG8_STAGE(PG8_SA(1, 0), a3, voffA);
            PG8_WAIT_V(8); PG8_WAIT_L(0); PG8_BAR; PG8_MMA(1, 0, At, B0); PG8_MMA(1, 1, At, B1); PG8_BAR; PG8_SCHED;
        }
        if (wr == 0) PG8_BAR;
        E(acc, cur, ui, tid);
        if (!has_next) break;
#pragma unroll
        for (int a = 0; a < 2; ++a)
#pragma unroll
            for (int b = 0; b < 2; ++b)
#pragma unroll
                for (int m = 0; m < 4; ++m)
#pragma unroll
                    for (int n = 0; n < 2; ++n) acc[a][b][m][n] = (f32x4){0.f, 0.f, 0.f, 0.f};
        cur = nxt; cA = nA; cB = nB; ++ui;
        if (wr == 1) PG8_BAR;
    }
    PG8_WAIT_V(0);
    PG8_BAR;
#undef PG8_SA
#undef PG8_SB
#undef PG8_STAGE
#undef PG8_LDA
#undef PG8_LDB
#undef PG8_MMA
#undef PG8_WAIT_V
#undef PG8_WAIT_L
#undef PG8_BAR
#undef PG8_SCHED
}

__device__ __forceinline__ void store8(bf16_t* p, f32x4 v0, f32x4 v1) {
    u32x4 w; w.x = cvtpk(v0[0], v0[1]); w.y = cvtpk(v0[2], v0[3]); w.z = cvtpk(v1[0], v1[1]); w.w = cvtpk(v1[2], v1[3]);
    *(u32x4*)p = w;
}


struct Rope4 { float f[4];
    __device__ __forceinline__ void init(int ibase, float kexp) {
#pragma unroll
        for (int j = 0; j < 4; ++j) f[j] = __builtin_amdgcn_exp2f(-(float)(ibase + j) * kexp) * 0.15915494309189535f; }
    __device__ __forceinline__ void sincos(int s, f32x4& cs, f32x4& sn) const {
#pragma unroll
        for (int j = 0; j < 4; ++j) { float rev = (float)s * f[j]; rev -= floorf(rev); sn[j] = __builtin_amdgcn_sinf(rev); cs[j] = __builtin_amdgcn_cosf(rev); } }
    __device__ __forceinline__ static void rot(f32x4& v0, f32x4& v1, const f32x4& cs, const f32x4& sn) {
        const f32x4 a = v0 * cs - v1 * sn, b = v1 * cs + v0 * sn; v0 = a; v1 = b; }
    __device__ __forceinline__ void apply(f32x4& v0, f32x4& v1, int s) const { f32x4 cs, sn; sincos(s, cs, sn); rot(v0, v1, cs, sn); }
};
constexpr float ROPE_KA = 18.931568569324174f / 16.0f, ROPE_KB = 18.931568569324174f / 32.0f;

struct EpiProj {
    static constexpr bool PERM = true, MID = false, I8 = true;
    bf16_t* QKV;
    bf16_t* CQKV;
    bf16_t* KR; float* ssq;
    const float* hs; const float* wsn;
    static __device__ __forceinline__ f32x4 i2f4(const f32x4 a) { const float a0 = a[0], a1 = a[1], a2 = a[2], a3 = a[3];
        return (f32x4){(float)__float_as_int(a0), (float)__float_as_int(a1), (float)__float_as_int(a2), (float)__float_as_int(a3)}; }
    __device__ __forceinline__ void mid(f32x4 (&)[2][2][4][2], const Unit&, int, int) const {}
    __device__ __forceinline__ void operator()(const f32x4 (&acc_)[2][2][4][2], const Unit& u, int ui, int tid_) const {
        const int tid = opaque(tid_), lane = tid & 63, wid = __builtin_amdgcn_readfirstlane(tid >> 6), wr = wid >> 2, wc = wid & 3, fr = lane & 15, fq = lane >> 4;
        const int pn = u.pn, row0 = u.pm * BM + wr * 64 + fr;
        f32x4 cs[2][2]; float rs[2][4];
        { const float* wp_ = wsn + pn * BM + wc * 32 + 8 * fq;
#pragma unroll
          for (int bj = 0; bj < 2; ++bj) { cs[bj][0] = *(const f32x4*)(wp_ + bj * HALF); cs[bj][1] = *(const f32x4*)(wp_ + bj * HALF + 4); }
#pragma unroll
          for (int ai = 0; ai < 2; ++ai)
#pragma unroll
              for (int m = 0; m < 4; ++m) rs[ai][m] = hs[row0 + ai * HALF + m * 16]; }
#define ACCF(ai, bj, m, n) (i2f4(acc_[ai][bj][m][n]) * rs[ai][m] * cs[bj][n])
        if (pn < 12) {
            bf16_t* base = QKV + (size_t)(pn >> 2) * (32u << 20);
            const int colt = (pn & 3) * 256 + wc * 32 + 8 * fq;
            const bool rope = (pn < 8) && (wc == 0);
            Rope4 R; R.init(4 * fq, ROPE_KA);
#pragma unroll
            for (int ai = 0; ai < 2; ++ai)
#pragma unroll
                for (int m = 0; m < 4; ++m) {
                    const int row = row0 + ai * HALF + m * 16; const int s = row & (SEQ - 1);
                    f32x4 rcs = {1.f, 1.f, 1.f, 1.f}, rsn = {0.f, 0.f, 0.f, 0.f};
                    if (rope) R.sincos(s, rcs, rsn);
#pragma unroll
                    for (int bj = 0; bj < 2; ++bj) {
                        f32x4 v0 = ACCF(ai, bj, m, 0), v1 = ACCF(ai, bj, m, 1);
                        if (rope) Rope4::rot(v0, v1, rcs, rsn);
                        if (pn < 4) store8(base + (size_t)row * 1024 + colt + bj * HALF, v0, v1);
                        else { u32x2 w; w.x = pack_fp8x4(v0[0], v0[1], v0[2], v0[3]); w.y = pack_fp8x4(v1[0], v1[1], v1[2], v1[3]);
                            *(u32x2*)((unsigned char*)base + (size_t)row * 1024 + colt + bj * HALF) = w; }
                    }
                }
        } else if (pn < 16) {
            bf16_t* base = CQKV + (size_t)((pn >> 1) & 1) * (16u << 20); float* sq = ssq + (size_t)((pn >> 1) & 1) * (256u << 10);
            const int colt = (pn & 1) * 256 + wc * 32 + 8 * fq; const int slot = (pn & 1) * 4 + wc;
#pragma unroll
            for (int ai = 0; ai < 2; ++ai)
#pragma unroll
                for (int m = 0; m < 4; ++m) {
                    const int row = row0 + ai * HALF + m * 16; float q = 0.f;
#pragma unroll
                    for (int bj = 0; bj < 2; ++bj) {
                        const f32x4 v0 = ACCF(ai, bj, m, 0), v1 = ACCF(ai, bj, m, 1);
                        q += (v0[0] * v0[0] + v0[1] * v0[1]) + (v0[2] * v0[2] + v0[3] * v0[3]) + (v1[0] * v1[0] + v1[1] * v1[1]) + (v1[2] * v1[2] + v1[3] * v1[3]);
                        store8(base + (size_t)row * 512 + colt + bj * HALF, v0 * 1.0f, v1 * 1.0f);
                    }
                    q += __shfl_xor(q, 16); q += __shfl_xor(q, 32);
                    if (fq == 0) sq[(size_t)slot * T + row] = q;
                }
        } else {
            if (wc < 2) {
                Rope4 R; R.init(16 * wc + 4 * fq, ROPE_KB);
#pragma unroll
                for (int ai = 0; ai < 2; ++ai)
#pragma unroll
                    for (int m = 0; m < 4; ++m) {
                        const int row = row0 + ai * HALF + m * 16; const int s = row & (SEQ - 1);
                        f32x4 v0 = ACCF(ai, 0, m, 0), v1 = ACCF(ai, 0, m, 1);
                        R.apply(v0, v1, s);
                        store8(KR + (size_t)row * 64 + wc * 32 + 8 * fq, v0, v1);
                    }
            }
        }
    }
};
#undef ACCF

struct EpiKr {
    static constexpr bool PERM = true, MID = false, I8 = false;
    bf16_t* KR;
    __device__ __forceinline__ void mid(f32x4 (&)[2][2][4][2], const Unit&, int, int) const {}
    __device__ __forceinline__ void operator()(const f32x4 (&acc)[2][2][4][2], const Unit& u, int ui, int tid_) const {
        const int tid = opaque(tid_), lane = tid & 63, wid = __builtin_amdgcn_readfirstlane(tid >> 6), wr = wid >> 2, wc = wid & 3, fr = lane & 15, fq = lane >> 4;
        const int row0 = u.pm * BM + wr * 64 + fr;
        if (wc < 2) {
            Rope4 R; R.init(16 * wc + 4 * fq, ROPE_KB);
#pragma unroll
            for (int ai = 0; ai < 2; ++ai)
#pragma unroll
                for (int m = 0; m < 4; ++m) {
                    const int row = row0 + ai * HALF + m * 16; const int s = row & (SEQ - 1);
                    f32x4 v0 = acc[ai][0][m][0] * 1.0f, v1 = acc[ai][0][m][1] * 1.0f;
                    R.apply(v0, v1, s);
                    store8(KR + (size_t)row * 64 + wc * 32 + 8 * fq, v0, v1);
                }
        }
    }
};

struct EpiQ {
    static constexpr bool PERM = true, MID = false, I8 = true;
    bf16_t *Qn, *Qr; const LAS float* tab; const float* wsn;
    __device__ __forceinline__ void mid(f32x4 (&)[2][2][4][2], const Unit&, int, int) const {}
    __device__ __forceinline__ void operator()(const f32x4 (&acc)[2][2][4][2], const Unit& u, int ui, int tid_) const {
        const int tid = opaque(tid_), lane = tid & 63, wid = __builtin_amdgcn_readfirstlane(tid >> 6), wr = wid >> 2, wc = wid & 3, fr = lane & 15, fq = lane >> 4;
        const int pn = u.pn, rl0 = wr * 64 + fr, row0 = u.pm * BM + rl0;
        Rope4 R; R.init(16 * (wc & 1) + 4 * fq, ROPE_KB);
        f32x4 cs[2][2];
#pragma unroll
        for (int bj = 0; bj < 2; ++bj) { const float* wp_ = wsn + pn * BM + bj * HALF + wc * 32 + 8 * fq; cs[bj][0] = *(const f32x4*)wp_; cs[bj][1] = *(const f32x4*)(wp_ + 4); }
#pragma unroll
        for (int ai = 0; ai < 2; ++ai)
#pragma unroll
            for (int m = 0; m < 4; ++m) {
                const int row = row0 + ai * HALF + m * 16; const int s = row & (SEQ - 1);
                const float rs = tab[ui * 256 + rl0 + ai * HALF + m * 16];
                if (pn < 4) {
#pragma unroll
                    for (int bj = 0; bj < 2; ++bj)
                        store8(Qn + (size_t)row * 1024 + pn * 256 + bj * HALF + wc * 32 + 8 * fq, EpiProj::i2f4(acc[ai][bj][m][0]) * rs * cs[bj][0], EpiProj::i2f4(acc[ai][bj][m][1]) * rs * cs[bj][1]);
                } else {
                    f32x4 rcs, rsn; R.sincos(s, rcs, rsn);
#pragma unroll
                    for (int bj = 0; bj < 2; ++bj) {
                        f32x4 v0 = EpiProj::i2f4(acc[ai][bj][m][0]) * rs * cs[bj][0], v1 = EpiProj::i2f4(acc[ai][bj][m][1]) * rs * cs[bj][1];
                        Rope4::rot(v0, v1, rcs, rsn);
                        store8(Qr + (size_t)row * 512 + (pn - 4) * 256 + bj * HALF + wc * 32 + 8 * fq, v0, v1);
                    }
                }
            }
    }
};

struct EpiKV {
    static constexpr bool PERM = true, MID = false, I8 = true;
    bf16_t *Kn, *Vb; const LAS float* tab; const float* wsn;
    __device__ __forceinline__ void mid(f32x4 (&)[2][2][4][2], const Unit&, int, int) const {}
    __device__ __forceinline__ void operator()(const f32x4 (&acc)[2][2][4][2], const Unit& u, int ui, int tid_) const {
        const int tid = opaque(tid_), lane = tid & 63, wid = __builtin_amdgcn_readfirstlane(tid >> 6), wr = wid >> 2, wc = wid & 3, fr = lane & 15, fq = lane >> 4;
        const int pn = u.pn, rl0 = wr * 64 + fr, row0 = u.pm * BM + rl0;
        bf16_t* base = pn < 4 ? Kn : Vb;
        f32x4 cs[2][2];
#pragma unroll
        for (int bj = 0; bj < 2; ++bj) { const float* wp_ = wsn + pn * BM + bj * HALF + wc * 32 + 8 * fq; cs[bj][0] = *(const f32x4*)wp_; cs[bj][1] = *(const f32x4*)(wp_ + 4); }
#pragma unroll
        for (int ai = 0; ai < 2; ++ai)
#pragma unroll
            for (int m = 0; m < 4; ++m) {
                const int row = row0 + ai * HALF + m * 16;
                const float rs = tab[ui * 256 + rl0 + ai * HALF + m * 16];
#pragma unroll
                for (int bj = 0; bj < 2; ++bj)
                    store8(base + (size_t)row * 1024 + (pn & 3) * 256 + bj * HALF + wc * 32 + 8 * fq, EpiProj::i2f4(acc[ai][bj][m][0]) * rs * cs[bj][0], EpiProj::i2f4(acc[ai][bj][m][1]) * rs * cs[bj][1]);
            }
    }
};

struct EpiMix {
    static constexpr bool PERM = true, MID = true, I8 = false;
    bf16_t* MIX; const LAS float* tab;
    __device__ __forceinline__ void mid(f32x4 (&acc)[2][2][4][2], const Unit& u, int ui, int tid_) const {
        const int tid = opaque(tid_), lane = tid & 63, wid = __builtin_amdgcn_readfirstlane(tid >> 6), wr = wid >> 2, wc = wid & 3, fr = lane & 15, fq = lane >> 4;
        const int rl0 = wr * 64 + fr;
#pragma unroll
        for (int ai = 0; ai < 2; ++ai)
#pragma unroll
            for (int m = 0; m < 4; ++m) {
                const float ratio = tab[(ui * 256 + rl0 + ai * HALF + m * 16) * 2];
#pragma unroll
                for (int bj = 0; bj < 2; ++bj) { acc[ai][bj][m][0] *= ratio; acc[ai][bj][m][1] *= ratio; }
            }
    }
    __device__ __forceinline__ void operator()(const f32x4 (&acc)[2][2][4][2], const Unit& u, int ui, int tid_) const {
        const int tid = opaque(tid_), lane = tid & 63, wid = __builtin_amdgcn_readfirstlane(tid >> 6), wr = wid >> 2, wc = wid & 3, fr = lane & 15, fq = lane >> 4;
        const int rl0 = wr * 64 + fr, row0 = u.pm * BM + rl0;
#pragma unroll
        for (int ai = 0; ai < 2; ++ai)
#pragma unroll
            for (int m = 0; m < 4; ++m) {
                const int row = row0 + ai * HALF + m * 16;
                const float rb = tab[(ui * 256 + rl0 + ai * HALF + m * 16) * 2 + 1];
#pragma unroll
                for (int bj = 0; bj < 2; ++bj)
                    store8(MIX + (size_t)row * DM + u.pn * BM + bj * HALF + wc * 32 + 8 * fq, acc[ai][bj][m][0] * rb, acc[ai][bj][m][1] * rb);
            }
    }
};

struct EpiPlainQ8 {
    static constexpr bool PERM = true, MID = false, I8 = true;
    bf16_t* O; int ldc; const float* hs; const float* wsn;
    __device__ __forceinline__ void mid(f32x4 (&)[2][2][4][2], const Unit&, int, int) const {}
    __device__ __forceinline__ void operator()(const f32x4 (&acc)[2][2][4][2], const Unit& u, int ui, int tid_) const {
        const int tid = opaque(tid_), lane = tid & 63, wid = __builtin_amdgcn_readfirstlane(tid >> 6), wr = wid >> 2, wc = wid & 3, fr = lane & 15, fq = lane >> 4;
        const int row0 = u.pm * BM + wr * 64 + fr, col0 = u.pn * BM + wc * 32 + 8 * fq;
        f32x4 cs[2][2];
#pragma unroll
        for (int bj = 0; bj < 2; ++bj) { cs[bj][0] = *(const f32x4*)(wsn + col0 + bj * HALF); cs[bj][1] = *(const f32x4*)(wsn + col0 + bj * HALF + 4); }
#pragma unroll
        for (int ai = 0; ai < 2; ++ai)
#pragma unroll
            for (int m = 0; m < 4; ++m) {
                const int row = row0 + ai * HALF + m * 16; const float rs = hs[row];
#pragma unroll
                for (int bj = 0; bj < 2; ++bj)
                    store8(O + (size_t)row * ldc + col0 + bj * HALF, EpiProj::i2f4(acc[ai][bj][m][0]) * rs * cs[bj][0], EpiProj::i2f4(acc[ai][bj][m][1]) * rs * cs[bj][1]);
            }
    }
};

struct EpiPlain {
    static constexpr bool PERM = true, MID = false, I8 = false;
    bf16_t* O; int ldc;
    __device__ __forceinline__ void mid(f32x4 (&)[2][2][4][2], const Unit&, int, int) const {}
    __device__ __forceinline__ void operator()(const f32x4 (&acc)[2][2][4][2], const Unit& u, int ui, int tid_) const {
        const int tid = opaque(tid_), lane = tid & 63, wid = __builtin_amdgcn_readfirstlane(tid >> 6), wr = wid >> 2, wc = wid & 3, fr = lane & 15, fq = lane >> 4;
        const int row0 = u.pm * BM + wr * 64 + fr;
#pragma unroll
        for (int ai = 0; ai < 2; ++ai)
#pragma unroll
            for (int m = 0; m < 4; ++m) {
                const int row = row0 + ai * HALF + m * 16;
#pragma unroll
                for (int bj = 0; bj < 2; ++bj)
                    store8(O + (size_t)row * ldc + u.pn * BM + bj * HALF + wc * 32 + 8 * fq, acc[ai][bj][m][0], acc[ai][bj][m][1]);
            }
    }
};
}

namespace att {
#define KSWZ(row, colB) ((row) * 256 + ((colB) ^ (((row) & 7) << 4)))
#define SBAR() __builtin_amdgcn_sched_barrier(0)
__device__ __forceinline__ int crow(int r, int hi) { return (r & 3) + 8 * (r >> 2) + 4 * hi; }
constexpr int L_KN = 0, L_KR = 32768, L_V = 49152, L_WS = 81920, L_QR = 83968, L_END = 83968 + 32768;
__device__ __forceinline__ int v_st(int k, int c) { const int kk = (k & ~0xC) | ((k & 4) << 1) | ((k & 8) >> 1); return ((kk >> 3) * 4 + (c >> 5)) * 512 + ((kk & 7) * 32 + (c & 31)) * 2; }
__device__ __forceinline__ int v_rd_base(int lane) { return ((lane & 3) << 3) | (((lane >> 2) & 3) << 6) | (((lane >> 4) & 1) << 5) | (((lane >> 5) & 1) << 8); }
constexpr int v_rd_off(int d0, int ks, int half) { return d0 * 512 + ks * 4096 + half * 2048; }
template <int OFF> __device__ __forceinline__ s16x4 tr_read(int vb) {
    s16x4 r; asm volatile("ds_read_b64_tr_b16 %0, %1 offset:%2" : "=&v"(r) : "v"(vb), "i"(OFF) : "memory"); return r;
}
template <int D0> __device__ __forceinline__ void pv_one(f32x16& od, int vb, bf16x8 pa0, bf16x8 pa1, bf16x8 pa2, bf16x8 pa3) {
    const s16x4 l0 = tr_read<v_rd_off(D0, 0, 0)>(vb), h0 = tr_read<v_rd_off(D0, 0, 1)>(vb), l1 = tr_read<v_rd_off(D0, 1, 0)>(vb), h1 = tr_read<v_rd_off(D0, 1, 1)>(vb);
    const s16x4 l2 = tr_read<v_rd_off(D0, 2, 0)>(vb), h2 = tr_read<v_rd_off(D0, 2, 1)>(vb), l3 = tr_read<v_rd_off(D0, 3, 0)>(vb), h3 = tr_read<v_rd_off(D0, 3, 1)>(vb);
    asm volatile("s_waitcnt lgkmcnt(0)" ::: "memory"); SBAR();
#define PK(L, H) (bf16x8){L[0], L[1], L[2], L[3], H[0], H[1], H[2], H[3]}
    od = __builtin_amdgcn_mfma_f32_32x32x16_bf16(pa0, PK(l0, h0), od, 0, 0, 0);
    od = __builtin_amdgcn_mfma_f32_32x32x16_bf16(pa1, PK(l1, h1), od, 0, 0, 0);
    od = __builtin_amdgcn_mfma_f32_32x32x16_bf16(pa2, PK(l2, h2), od, 0, 0, 0);
    od = __builtin_amdgcn_mfma_f32_32x32x16_bf16(pa3, PK(l3, h3), od, 0, 0, 0);
#undef PK
}

struct UnitP { int b, h, dil, rho0, ngrp, qbase, kfirst, tpg, W, mode; };
struct Tens { const bf16_t *Qm, *Qr, *Km, *Kr, *Vm; bf16_t* So; float *Sm, *Sl; bf16_t* Oout; int ocol0; float* ssq; int ssq0; };

template <bool MLA>
__device__ __forceinline__ void attn_unit(const int tid_in, const UnitP P, LAS unsigned char* lds, const Tens& X) {
    const int tid = opaque(tid_in);
    constexpr float SCALE = MLA ? 0.07216878364870322f : 0.08838834764831845f;
    constexpr float C = SCALE * 1.4426950408889634f;
    constexpr float THRS = 8.f / SCALE;
    constexpr int NQ = 8;
    const int wid = __builtin_amdgcn_readfirstlane(tid >> 6), lane = tid & 63, r32 = lane & 31, hi = lane >> 5;
    const int g = (P.ngrp == 2) ? (wid >> 2) : 0, wq = (P.ngrp == 2) ? (wid & 3) : wid;
    const int qpos0 = P.qbase + 32 * wq, rho_w = P.rho0 + g;
    const long tb = (long)P.b * SEQ;
    const long qtok = tb + (long)(qpos0 + r32) * P.dil + rho_w;
    LAS float* wsf = (LAS float*)(lds + L_WS) + wid * 64;
    bf16x8 qr[NQ];
    { const bf16_t* qp = X.Qm + qtok * 1024 + P.h * 128 + hi * 8;
#pragma unroll
      for (int d0 = 0; d0 < 8; ++d0) qr[d0] = *(const bf16x8*)(qp + d0 * 16); }
    LAS unsigned char* qrp = lds + L_QR + wid * 4096 + lane * 16;
    if constexpr (MLA) { const bf16_t* qp = X.Qr + qtok * 512 + P.h * 64 + hi * 8;
#pragma unroll
      for (int d0 = 0; d0 < 4; ++d0) *(LAS bf16x8*)(qrp + d0 * 1024) = *(const bf16x8*)(qp + d0 * 16); }
    float m_reg = -1e30f, l_reg = 0.f; f32x16 o[4];
#pragma unroll
    for (int d = 0; d < 4; ++d) o[d] = f32x16{};
    LAS unsigned char* stg = lds + wid * 8704;
    if (P.mode & 1) {
        m_reg = X.Sm[qtok * 8 + P.h]; l_reg = X.Sl[qtok * 8 + P.h];
#pragma unroll 2
        for (int i = 0; i < 8; ++i) { const int le = opaque(lane), row = i * 4 + (le >> 4), ch = le & 15; const long tr = tb + (long)(qpos0 + row) * P.dil + rho_w;
            *(LAS u32x4*)(stg + row * 272 + ch * 16) = *(const u32x4*)(X.So + tr * 1024 + P.h * 128 + ch * 8); }
        asm volatile("s_waitcnt lgkmcnt(0)" ::: "memory");
#pragma unroll
        for (int r = 0; r < 16; ++r)
#pragma unroll
            for (int d = 0; d < 4; ++d) o[d][r] = __uint_as_float((unsigned)(*(const LAS unsigned short*)(stg + crow(r, hi) * 272 + (32 * d + r32) * 2)) << 16);
        asm volatile("s_waitcnt lgkmcnt(0)" ::: "memory");
        __syncthreads();
    }
    const int sr = tid >> 4, sc = (tid & 15) * 8;
    const int rr = tid >> 3, rc = tid & 7;
    const int NT = P.ngrp * P.tpg;
    const int vb0 = (int)(uintptr_t)(lds + L_V) + v_rd_base(lane);
    bf16x8 ks0, ks1, vs0, vs1, krs;
#define LOADT(jt) do { const int gj_ = (jt) / P.tpg; const int kp_ = P.kfirst + 64 * ((jt) - gj_ * P.tpg); const int rho_ = P.rho0 + gj_; \
        const long t0_ = tb + (long)(kp_ + sr) * P.dil + rho_, t1_ = tb + (long)(kp_ + 32 + sr) * P.dil + rho_; \
        ks0 = *(const bf16x8*)(X.Km + t0_ * 1024 + P.h * 128 + sc); ks1 = *(const bf16x8*)(X.Km + t1_ * 1024 + P.h * 128 + sc); \
        vs0 = *(const bf16x8*)(X.Vm + t0_ * 1024 + P.h * 128 + sc); vs1 = *(const bf16x8*)(X.Vm + t1_ * 1024 + P.h * 128 + sc); \
        if constexpr (MLA) { const long t2_ = tb + (long)(kp_ + rr) * P.dil + rho_; krs = *(const bf16x8*)(X.Kr + t2_ * 64 + rc * 8); } } while (0)
#define WRITET(buf) do { *(LAS bf16x8*)(lds + L_KN + (buf) * 16384 + KSWZ(sr, sc * 2)) = ks0; *(LAS bf16x8*)(lds + L_KN + (buf) * 16384 + KSWZ(32 + sr, sc * 2)) = ks1; \
        *(LAS bf16x8*)(lds + L_V + (buf) * 16384 + v_st(sr, sc)) = vs0; *(LAS bf16x8*)(lds + L_V + (buf) * 16384 + v_st(32 + sr, sc)) = vs1; \
        if constexpr (MLA) { *(LAS bf16x8*)(lds + L_KR + (buf) * 8192 + rr * 128 + ((rc ^ ((rr >> 1) & 7)) << 4)) = krs; } } while (0)
    LOADT(0);
    if (wid >= 4) __builtin_amdgcn_s_setprio(1);
    for (int jt = 0; jt < NT; ++jt) {
        const int buf = jt & 1;
        WRITET(buf);
        if (jt + 1 < NT) LOADT(jt + 1);
        __syncthreads();
        const int gj = jt / P.tpg, kpos0 = P.kfirst + 64 * (jt - gj * P.tpg);
        const bool active = (gj == g) && (kpos0 <= qpos0 + 31) && (kpos0 + 63 >= qpos0 - P.W);
        if (active) {
            f32x16 p0 = f32x16{}, p1 = f32x16{};
            { const LAS unsigned char* kb = lds + L_KN + buf * 16384;
#pragma unroll
              for (int d0 = 0; d0 < 8; ++d0) { const int cb = (d0 * 16 + hi * 8) * 2;
                const bf16x8 b0 = *(const LAS bf16x8*)(kb + KSWZ(r32, cb)), b1 = *(const LAS bf16x8*)(kb + KSWZ(32 + r32, cb));
                p0 = __builtin_amdgcn_mfma_f32_32x32x16_bf16(b0, qr[d0], p0, 0, 0, 0);
                p1 = __builtin_amdgcn_mfma_f32_32x32x16_bf16(b1, qr[d0], p1, 0, 0, 0); } }
            if constexpr (MLA) { const LAS unsigned char* kb = lds + L_KR + buf * 8192;
#pragma unroll
              for (int d0 = 0; d0 < 4; ++d0) { const int ch = 2 * d0 + hi; const int off = ((ch ^ ((r32 >> 1) & 7)) << 4);
                const bf16x8 b0 = *(const LAS bf16x8*)(kb + r32 * 128 + off), b1 = *(const LAS bf16x8*)(kb + (32 + r32) * 128 + off);
                const bf16x8 qf = *(const LAS bf16x8*)(qrp + d0 * 1024);
                p0 = __builtin_amdgcn_mfma_f32_32x32x16_bf16(b0, qf, p0, 0, 0, 0);
                p1 = __builtin_amdgcn_mfma_f32_32x32x16_bf16(b1, qf, p1, 0, 0, 0); } }
            const bool full = (kpos0 + 63 <= qpos0) && (kpos0 >= qpos0 + 31 - P.W);
            if (!full) { const int qp = qpos0 + r32;
#pragma unroll
                for (int r = 0; r < 16; ++r) { const int dq0 = qp - (kpos0 + crow(r, hi)), dq1 = dq0 - 32;
                    if (dq0 < 0 || dq0 > P.W) p0[r] = -INFINITY; if (dq1 < 0 || dq1 > P.W) p1[r] = -INFINITY; } }
            float pmax = p0[0];
#pragma unroll
            for (int r = 1; r < 16; ++r) pmax = fmaxf(pmax, p0[r]);
#pragma unroll
            for (int r = 0; r < 16; ++r) pmax = fmaxf(pmax, p1[r]);
            { auto sw = __builtin_amdgcn_permlane32_swap(__float_as_uint(pmax), __float_as_uint(pmax), false, false); pmax = fmaxf(__uint_as_float(sw[0]), __uint_as_float(sw[1])); }
            float mn, alpha;
            if (__builtin_expect(__all(pmax - m_reg <= THRS), 1)) { mn = m_reg; alpha = 1.f; }
            else { mn = fmaxf(m_reg, pmax); alpha = __builtin_amdgcn_exp2f((m_reg - mn) * C); m_reg = mn; }
            const float mnC = -mn * C;
#pragma unroll
            for (int r = 0; r < 16; ++r) { p0[r] = __builtin_amdgcn_exp2f(fmaf(p0[r], C, mnC)); p1[r] = __builtin_amdgcn_exp2f(fmaf(p1[r], C, mnC)); }
            if (__any(alpha < 1.f)) { if (hi == 0) wsf[r32] = alpha; asm volatile("s_waitcnt lgkmcnt(0)" ::: "memory");
#pragma unroll
                for (int r = 0; r < 16; ++r) { const float al = wsf[crow(r, hi)];
#pragma unroll
                    for (int d = 0; d < 4; ++d) o[d][r] *= al; }
                asm volatile("s_waitcnt lgkmcnt(0)" ::: "memory"); }
            float ps = 0.f;
#pragma unroll
            for (int r = 0; r < 16; ++r) ps += p0[r];
#pragma unroll
            for (int r = 0; r < 16; ++r) ps += p1[r];
            { auto sw = __builtin_amdgcn_permlane32_swap(__float_as_uint(ps), __float_as_uint(ps), false, false); ps = __uint_as_float(sw[0]) + __uint_as_float(sw[1]); }
            l_reg = l_reg * alpha + ps;
            bf16x8 pa0, pa1, pa2, pa3;
#define PK4(Pv, BASE, OUT) do { unsigned a0 = cvtpk(Pv[BASE + 0], Pv[BASE + 1]), a1 = cvtpk(Pv[BASE + 2], Pv[BASE + 3]);   \
    unsigned b0 = cvtpk(Pv[BASE + 4], Pv[BASE + 5]), b1 = cvtpk(Pv[BASE + 6], Pv[BASE + 7]);                              \
    auto r0 = __builtin_amdgcn_permlane32_swap(a0, b0, false, false); auto r1 = __builtin_amdgcn_permlane32_swap(a1, b1, false, false); \
    u32x4 w = {r0[0], r1[0], r0[1], r1[1]}; OUT = __builtin_bit_cast(bf16x8, w); } while (0)
            PK4(p0, 0, pa0); PK4(p0, 8, pa1); PK4(p1, 0, pa2); PK4(p1, 8, pa3);
#undef PK4
            SBAR();
            const int vb = vb0 + buf * 16384;
            pv_one<0>(o[0], vb, pa0, pa1, pa2, pa3); pv_one<1>(o[1], vb, pa0, pa1, pa2, pa3); pv_one<2>(o[2], vb, pa0, pa1, pa2, pa3); pv_one<3>(o[3], vb, pa0, pa1, pa2, pa3);
        }
    }
#undef LOADT
#undef WRITET
    __builtin_amdgcn_s_setprio(0);
    asm volatile("s_waitcnt lgkmcnt(0)" ::: "memory");
    __syncthreads();
    if (P.mode & 2) {
        if (hi == 0) wsf[32 + r32] = l_reg; asm volatile("s_waitcnt lgkmcnt(0)" ::: "memory");
#pragma unroll
        for (int r = 0; r < 16; ++r) { const int qrow = crow(r, hi); const float rl = 1.0f / wsf[32 + qrow];
            const long tr = tb + (long)(qpos0 + qrow) * P.dil + rho_w; float sq = 0.f;
#pragma unroll
            for (int d = 0; d < 4; ++d) { const float v = o[d][r] * rl; sq += v * v; *(LAS unsigned short*)(stg + qrow * 272 + (32 * d + r32) * 2) = (unsigned short)(cvtpk(v, v) & 0xffffu); }
            sq += __shfl_xor(sq, 1); sq += __shfl_xor(sq, 2); sq += __shfl_xor(sq, 4); sq += __shfl_xor(sq, 8); sq += __shfl_xor(sq, 16);
            if (r32 == 0) X.ssq[tr * 16 + X.ssq0 + P.h] = sq; }
        asm volatile("s_waitcnt lgkmcnt(0)" ::: "memory");
#pragma unroll 2
        for (int i = 0; i < 8; ++i) { const int le = opaque(lane), row = i * 4 + (le >> 4), ch = le & 15; const long tr = tb + (long)(qpos0 + row) * P.dil + rho_w;
            *(u32x4*)(X.Oout + tr * 2048 + X.ocol0 + P.h * 128 + ch * 8) = *(const LAS u32x4*)(stg + row * 272 + ch * 16); }
    } else {
        if (hi == 0) { X.Sm[qtok * 8 + P.h] = m_reg; X.Sl[qtok * 8 + P.h] = l_reg; }
#pragma unroll
        for (int r = 0; r < 16; ++r)
#pragma unroll
            for (int d = 0; d < 4; ++d) { const float v = o[d][r]; *(LAS unsigned short*)(stg + crow(r, hi) * 272 + (32 * d + r32) * 2) = (unsigned short)(cvtpk(v, v) & 0xffffu); }
        asm volatile("s_waitcnt lgkmcnt(0)" ::: "memory");
#pragma unroll 2
        for (int i = 0; i < 8; ++i) { const int le = opaque(lane), row = i * 4 + (le >> 4), ch = le & 15; const long tr = tb + (long)(qpos0 + row) * P.dil + rho_w;
            *(u32x4*)(X.So + tr * 1024 + P.h * 128 + ch * 8) = *(const LAS u32x4*)(stg + row * 272 + ch * 16); }
    }
    asm volatile("s_waitcnt lgkmcnt(0)" ::: "memory");
    __syncthreads();
}

struct WaveA { int b, h, dil, rho, qpos0, mode; };
__device__ __forceinline__ void attnA_wave(const int lane_in, const WaveA P, LAS unsigned char* wl  , LAS float* wsf, const Tens& X) {
    constexpr float SCALE = 0.08838834764831845f, C = SCALE * 1.4426950408889634f, THRS = 8.f / SCALE;
    const int lane = opaque(lane_in), r32 = lane & 31, hi = lane >> 5;
    const long tb = (long)P.b * SEQ;
    const long qtok = tb + (long)(P.qpos0 + r32) * P.dil + P.rho;
    LAS unsigned char* vbuf = wl; LAS unsigned char* stg = wl + 8192;
    bf16x8 qr[8];
    { const bf16_t* qp = X.Qm + qtok * 1024 + P.h * 128 + hi * 64;
#pragma unroll
      for (int d0 = 0; d0 < 8; ++d0) qr[d0] = *(const bf16x8*)(qp + d0 * 8); }
    float m_reg = -1e30f, l_reg = 0.f; f32x16 o[4];
#pragma unroll
    for (int d = 0; d < 4; ++d) o[d] = f32x16{};
    if (P.mode & 1) {
        m_reg = X.Sm[qtok * 8 + P.h]; l_reg = X.Sl[qtok * 8 + P.h];
#pragma unroll 2
        for (int i = 0; i < 8; ++i) { const int le = opaque(lane), row = i * 4 + (le >> 4), ch = le & 15; const long tr = tb + (long)(P.qpos0 + row) * P.dil + P.rho;
            *(LAS u32x4*)(stg + row * 272 + ch * 16) = *(const u32x4*)(X.So + tr * 1024 + P.h * 128 + ch * 8); }
        asm volatile("s_waitcnt lgkmcnt(0)" ::: "memory");
#pragma unroll
        for (int r = 0; r < 16; ++r)
#pragma unroll
            for (int d = 0; d < 4; ++d) o[d][r] = __uint_as_float((unsigned)(*(const LAS unsigned short*)(stg + crow(r, hi) * 272 + (32 * d + r32) * 2)) << 16);
    }
    const int kfirst = P.qpos0 >= 128 ? P.qpos0 - 128 : 0;
    const int vrow = lane >> 3, vcol = (lane & 7) * 16;
    const int vb = (int)(uintptr_t)vbuf + v_rd_base(lane);
    const unsigned char* K8 = (const unsigned char*)X.Km; const unsigned char* V8 = (const unsigned char*)X.Vm;
    u32x4 nk[4], nv[4];
#define A_LOAD(kc) do { const long tk_ = tb + (long)((kc) + r32) * P.dil + P.rho; const unsigned char* kp_ = K8 + tk_ * 1024 + P.h * 128 + hi * 64; \
        _Pragma("unroll") for (int j = 0; j < 4; ++j) nk[j] = *(const u32x4*)(kp_ + j * 16); \
        _Pragma("unroll") for (int i = 0; i < 4; ++i) { const long tv_ = tb + (long)((kc) + vrow + 8 * i) * P.dil + P.rho; nv[i] = *(const u32x4*)(V8 + tv_ * 1024 + P.h * 128 + vcol); } } while (0)
#define A_CVT8(lo, hi_) ({ const f32x2 a_ = __builtin_amdgcn_cvt_pk_f32_fp8((int)(lo), false), b_ = __builtin_amdgcn_cvt_pk_f32_fp8((int)(lo), true), \
        c_ = __builtin_amdgcn_cvt_pk_f32_fp8((int)(hi_), false), d_ = __builtin_amdgcn_cvt_pk_f32_fp8((int)(hi_), true); \
        u32x4 w_ = {cvtpk(a_[0], a_[1]), cvtpk(b_[0], b_[1]), cvtpk(c_[0], c_[1]), cvtpk(d_[0], d_[1])}; __builtin_bit_cast(bf16x8, w_); })
    A_LOAD(kfirst);
    for (int kc0 = kfirst; kc0 <= P.qpos0; kc0 += 32) {
        bf16x8 kf[8];
#pragma unroll
        for (int j = 0; j < 4; ++j) { const unsigned x0 = nk[j][0], x1 = nk[j][1], x2 = nk[j][2], x3 = nk[j][3]; kf[2 * j] = A_CVT8(x0, x1); kf[2 * j + 1] = A_CVT8(x2, x3); }
#pragma unroll
        for (int i = 0; i < 4; ++i) { const unsigned x0 = nv[i][0], x1 = nv[i][1], x2 = nv[i][2], x3 = nv[i][3];
            *(LAS bf16x8*)(vbuf + v_st(vrow + 8 * i, vcol)) = A_CVT8(x0, x1); *(LAS bf16x8*)(vbuf + v_st(vrow + 8 * i, vcol + 8)) = A_CVT8(x2, x3); }
        if (kc0 + 32 <= P.qpos0) A_LOAD(kc0 + 32);
        f32x16 p0 = f32x16{};
#pragma unroll
        for (int d0 = 0; d0 < 8; ++d0) p0 = __builtin_amdgcn_mfma_f32_32x32x16_bf16(kf[d0], qr[d0], p0, 0, 0, 0);
        const bool full = (kc0 + 31 <= P.qpos0) && (kc0 >= P.qpos0 + 31 - 128);
        if (!full) { const int qp = P.qpos0 + r32;
#pragma unroll
            for (int r = 0; r < 16; ++r) { const int dq = qp - (kc0 + crow(r, hi)); if (dq < 0 || dq > 128) p0[r] = -INFINITY; } }
        float pmax = p0[0];
#pragma unroll
        for (int r = 1; r < 16; ++r) pmax = fmaxf(pmax, p0[r]);
        { auto sw = __builtin_amdgcn_permlane32_swap(__float_as_uint(pmax), __float_as_uint(pmax), false, false); pmax = fmaxf(__uint_as_float(sw[0]), __uint_as_float(sw[1])); }
        float mn, alpha;
        if (__builtin_expect(__all(pmax - m_reg <= THRS), 1)) { mn = m_reg; alpha = 1.f; }
        else { mn = fmaxf(m_reg, pmax); alpha = __builtin_amdgcn_exp2f((m_reg - mn) * C); m_reg = mn; }
        const float mnC = -mn * C;
#pragma unroll
        for (int r = 0; r < 16; ++r) p0[r] = __builtin_amdgcn_exp2f(fmaf(p0[r], C, mnC));
        if (__any(alpha < 1.f)) { if (hi == 0) wsf[r32] = alpha; asm volatile("s_waitcnt lgkmcnt(0)" ::: "memory");
#pragma unroll
            for (int r = 0; r < 16; ++r) { const float al = wsf[crow(r, hi)];
#pragma unroll
                for (int d = 0; d < 4; ++d) o[d][r] *= al; }
            asm volatile("s_waitcnt lgkmcnt(0)" ::: "memory"); }
        float ps = 0.f;
#pragma unroll
        for (int r = 0; r < 16; ++r) ps += p0[r];
        { auto sw = __builtin_amdgcn_permlane32_swap(__float_as_uint(ps), __float_as_uint(ps), false, false); ps = __uint_as_float(sw[0]) + __uint_as_float(sw[1]); }
        l_reg = l_reg * alpha + ps;
        bf16x8 pa0, pa1;
#define PK4(Pv, BASE, OUT) do { unsigned a0 = cvtpk(Pv[BASE + 0], Pv[BASE + 1]), a1 = cvtpk(Pv[BASE + 2], Pv[BASE + 3]);   \
    unsigned b0 = cvtpk(Pv[BASE + 4], Pv[BASE + 5]), b1 = cvtpk(Pv[BASE + 6], Pv[BASE + 7]);                              \
    auto r0 = __builtin_amdgcn_permlane32_swap(a0, b0, false, false); auto r1 = __builtin_amdgcn_permlane32_swap(a1, b1, false, false); \
    u32x4 w = {r0[0], r1[0], r0[1], r1[1]}; OUT = __builtin_bit_cast(bf16x8, w); } while (0)
        PK4(p0, 0, pa0); PK4(p0, 8, pa1);
#undef PK4
        SBAR();
#define A_PV(D0) do { const s16x4 l0 = tr_read<v_rd_off(D0, 0, 0)>(vb), h0 = tr_read<v_rd_off(D0, 0, 1)>(vb), l1 = tr_read<v_rd_off(D0, 1, 0)>(vb), h1 = tr_read<v_rd_off(D0, 1, 1)>(vb); \
        asm volatile("s_waitcnt lgkmcnt(0)" ::: "memory"); SBAR(); \
        o[D0] = __builtin_amdgcn_mfma_f32_32x32x16_bf16(pa0, (bf16x8){l0[0], l0[1], l0[2], l0[3], h0[0], h0[1], h0[2], h0[3]}, o[D0], 0, 0, 0); \
        o[D0] = __builtin_amdgcn_mfma_f32_32x32x16_bf16(pa1, (bf16x8){l1[0], l1[1], l1[2], l1[3], h1[0], h1[1], h1[2], h1[3]}, o[D0], 0, 0, 0); } while (0)
        A_PV(0); A_PV(1); A_PV(2); A_PV(3);
#undef A_PV
        asm volatile("s_waitcnt lgkmcnt(0)" ::: "memory");
    }
#undef A_LOAD
#undef A_CVT8
    if (P.mode & 2) {
        if (hi == 0) wsf[32 + r32] = l_reg; asm volatile("s_waitcnt lgkmcnt(0)" ::: "memory");
#pragma unroll
        for (int r = 0; r < 16; ++r) { const int qrow = crow(r, hi); const float rl = 1.0f / wsf[32 + qrow];
            const long tr = tb + (long)(P.qpos0 + qrow) * P.dil + P.rho; float sq = 0.f;
#pragma unroll
            for (int d = 0; d < 4; ++d) { const float v = o[d][r] * rl; sq += v * v; *(LAS unsigned short*)(stg + qrow * 272 + (32 * d + r32) * 2) = (unsigned short)(cvtpk(v, v) & 0xffffu); }
            sq += __shfl_xor(sq, 1); sq += __shfl_xor(sq, 2); sq += __shfl_xor(sq, 4); sq += __shfl_xor(sq, 8); sq += __shfl_xor(sq, 16);
            if (r32 == 0) X.ssq[tr * 16 + X.ssq0 + P.h] = sq; }
        asm volatile("s_waitcnt lgkmcnt(0)" ::: "memory");
#pragma unroll 2
        for (int i = 0; i < 8; ++i) { const int le = opaque(lane), row = i * 4 + (le >> 4), ch = le & 15; const long tr = tb + (long)(P.qpos0 + row) * P.dil + P.rho;
            *(u32x4*)(X.Oout + tr * 2048 + X.ocol0 + P.h * 128 + ch * 8) = *(const LAS u32x4*)(stg + row * 272 + ch * 16); }
    } else {
        if (hi == 0) { X.Sm[qtok * 8 + P.h] = m_reg; X.Sl[qtok * 8 + P.h] = l_reg; }
#pragma unroll
        for (int r = 0; r < 16; ++r)
#pragma unroll
            for (int d = 0; d < 4; ++d) { const float v = o[d][r]; *(LAS unsigned short*)(stg + crow(r, hi) * 272 + (32 * d + r32) * 2) = (unsigned short)(cvtpk(v, v) & 0xffffu); }
        asm volatile("s_waitcnt lgkmcnt(0)" ::: "memory");
#pragma unroll 2
        for (int i = 0; i < 8; ++i) { const int le = opaque(lane), row = i * 4 + (le >> 4), ch = le & 15; const long tr = tb + (long)(P.qpos0 + row) * P.dil + P.rho;
            *(u32x4*)(X.So + tr * 1024 + P.h * 128 + ch * 8) = *(const LAS u32x4*)(stg + row * 272 + ch * 16); }
    }
    asm volatile("s_waitcnt lgkmcnt(0)" ::: "memory");
}
}

namespace pk {
__device__ __forceinline__ void ce(int& a, int& b) { const int hi = max(a, b), lo = min(a, b); a = hi; b = lo; }
__device__ __forceinline__ void sort16(int (&v)[16]) {
#pragma unroll
    for (int k = 2; k <= 16; k <<= 1)
#pragma unroll
        for (int j = k >> 1; j > 0; j >>= 1)
#pragma unroll
            for (int i = 0; i < 16; ++i) { const int l = i ^ j; if (l > i) { if ((i & k) == 0) ce(v[i], v[l]); else ce(v[l], v[i]); } }
}
__device__ __forceinline__ void bmerge16(int (&c)[16]) {
#pragma unroll
    for (int j = 8; j > 0; j >>= 1)
#pragma unroll
        for (int i = 0; i < 16; ++i) { const int l = i ^ j; if (l > i) ce(c[i], c[l]); }
}
__device__ __forceinline__ void merge_top16(int (&a)[16], const int (&b)[16]) {
#pragma unroll
    for (int i = 0; i < 16; ++i) a[i] = max(a[i], b[15 - i]);
    bmerge16(a);
}
__device__ __forceinline__ int f2key(float f) { const int b = __float_as_int(f); return b ^ ((b >> 31) & 0x7fffffff); }
__device__ __forceinline__ float key2f(int k) { return __int_as_float(k ^ ((k >> 31) & 0x7fffffff)); }
}

#define XB_TMO      128
#define XB_XCNT(j)  (256  + 64 * (j))
#define XB_XSUB(j)  (1280 + 64 * (j))
#define XB_XGEN(j)  (2304 + 64 * (j))
#define XB_TOP      3328
#define XB_TOPGEN   3392
#define XCD_BAR_WORDS 3456
#define XB_SPIN_CAP (1u << 22)
__device__ __forceinline__ unsigned xb_ld(unsigned* p)              { return __hip_atomic_load(p, __ATOMIC_RELAXED, __HIP_MEMORY_SCOPE_AGENT); }
__device__ __forceinline__ unsigned xb_add(unsigned* p, unsigned v) { return __hip_atomic_fetch_add(p, v, __ATOMIC_RELAXED, __HIP_MEMORY_SCOPE_AGENT); }
__device__ __forceinline__ unsigned xb_xcc_id() { return (unsigned)__builtin_amdgcn_s_getreg((3 << 11) | 20) & 0xFu; }
#define XB_SPIN(cond, bar) do { unsigned _sp = 0; while (cond) { __builtin_amdgcn_s_sleep(1); \
    if ((++_sp & 255u) == 0u) { if (xb_ld(&(bar)[XB_TMO])) break; if (_sp > XB_SPIN_CAP) { atomicAdd(&(bar)[XB_TMO], 1u); break; } } } } while (0)
struct XcdBarrier { unsigned* bar; unsigned x; volatile LAS unsigned* st; };
__device__ __forceinline__ XcdBarrier xcd_barrier_post(unsigned* bar, volatile LAS unsigned* st) {
    XcdBarrier b; b.bar = bar; b.x = xb_xcc_id(); b.st = st;
    if (threadIdx.x == 0) (void)xb_add(&bar[XB_XCNT(b.x)], 1u);
    return b;
}
__device__ __forceinline__ void xcd_barrier_complete(unsigned* bar, unsigned x, unsigned& nloc, unsigned& nx) {
    const unsigned G = gridDim.x * gridDim.y * gridDim.z;
    unsigned sum, cnt, mine, sp = 0u;
    for (;;) {
        sum = 0u; cnt = 0u; mine = 0u;
#pragma unroll
        for (unsigned j = 0; j < 16; ++j) { const unsigned c = xb_ld(&bar[XB_XCNT(j)]); sum += c; cnt += (c > 0u) ? 1u : 0u; mine = (j == x) ? c : mine; }
        if (sum == G) break;
        __builtin_amdgcn_s_sleep(1);
        if ((++sp & 255u) == 0u) { if (xb_ld(&bar[XB_TMO])) break; if (sp > XB_SPIN_CAP) { atomicAdd(&bar[XB_TMO], 1u); break; } }
    }
    nloc = mine > 0u ? mine : 1u; nx = cnt > 0u ? cnt : 1u;
}
__device__ __forceinline__ void xcd_barrier(const XcdBarrier& b) {
    asm volatile("s_waitcnt vmcnt(0)" ::: "memory");
    __syncthreads();
    if (threadIdx.x == 0) {
        unsigned* bar = b.bar;
        __builtin_amdgcn_s_waitcnt(0);
        unsigned nloc = b.st[0], nx = b.st[1];
        if (nloc == 0u) { xcd_barrier_complete(bar, b.x, nloc, nx); b.st[0] = nloc; b.st[1] = nx; }
        const unsigned old = xb_add(&bar[XB_XSUB(b.x)], 1u);
        const unsigned gen = old / nloc;
        if (old + 1u == (gen + 1u) * nloc) {
            __builtin_amdgcn_fence(__ATOMIC_RELEASE, "agent");
            asm volatile("s_waitcnt vmcnt(0)" ::: "memory");
            const unsigned og = xb_add(&bar[XB_TOP], 1u);
            const unsigned tg = og / nx;
            if (og + 1u == (tg + 1u) * nx) xb_add(&bar[XB_TOPGEN], 1u);
            else XB_SPIN(xb_ld(&bar[XB_TOPGEN]) == tg, bar);
            __builtin_amdgcn_fence(__ATOMIC_ACQUIRE, "agent");
            xb_add(&bar[XB_XGEN(b.x)], 1u);
            asm volatile("s_waitcnt vmcnt(0)" ::: "memory");
        } else {
            XB_SPIN(xb_ld(&bar[XB_XGEN(b.x)]) == gen, bar);
            __builtin_amdgcn_fence(__ATOMIC_ACQUIRE, "agent");
            asm volatile("s_waitcnt vmcnt(0)" ::: "memory");
        }
    }
    __syncthreads();
}

struct Args { const float* in[22]; float* out; unsigned char* ws; int ph_lo, ph_hi; };
#if defined(NAIVE_PEER)
constexpr int N_PHASES = 12;
#else
constexpr int N_PHASES = 15;
#endif

__device__ __forceinline__ float gelu_erf(float v) { return 0.5f * v * (1.0f + erff(v * 0.70710678118654752f)); }

template <class Map>
__device__ __forceinline__ void transpose_item(const float* W, int K, int N, bf16_t* WT, const float* rscale, LAS float* scr, int item, int lane, Map dst_row) {
    const int nblk = N / 32, kb = item / nblk, nb = item % nblk, k0 = 64 * kb, n0 = 32 * nb;
    float tv[32];
#pragma unroll
    for (int i = 0; i < 32; ++i) tv[i] = W[(size_t)(k0 + 2 * i + (lane >> 5)) * N + n0 + (lane & 31)];
    if (rscale) {
#pragma unroll
        for (int i = 0; i < 32; ++i) tv[i] *= rscale[k0 + 2 * i + (lane >> 5)];
    }
#pragma unroll
    for (int i = 0; i < 32; ++i) scr[(2 * i + (lane >> 5)) * 33 + (lane & 31)] = tv[i];
    asm volatile("s_waitcnt lgkmcnt(0)" ::: "memory");
    const int c = lane & 7;
#pragma unroll
    for (int j = 0; j < 4; ++j) { const int n = (lane >> 3) + 8 * j; const LAS float* s = scr + (8 * c) * 33 + n;
        u32x4 o; o.x = cvtpk(s[0 * 33], s[1 * 33]); o.y = cvtpk(s[2 * 33], s[3 * 33]); o.z = cvtpk(s[4 * 33], s[5 * 33]); o.w = cvtpk(s[6 * 33], s[7 * 33]);
        *(u32x4*)(WT + (size_t)dst_row(n0 + n) * K + k0 + 8 * c) = o; }
    asm volatile("s_waitcnt lgkmcnt(0)" ::: "memory");
}
template <class Map>
__device__ __forceinline__ void transpose_item_q8(const float* W, int K, int N, unsigned char* WT, const float* rscale, const float* cmax, int ncm, int cstride, float* wscale, LAS float* scr, int item, int lane, Map dst_row) {
    const int nblk = N / 32, kb = item / nblk, nb = item % nblk, k0 = 64 * kb, n0 = 32 * nb;
    float tv[32];
#pragma unroll
    for (int i = 0; i < 32; ++i) tv[i] = W[(size_t)(k0 + 2 * i + (lane >> 5)) * N + n0 + (lane & 31)];
    if (rscale) {
#pragma unroll
        for (int i = 0; i < 32; ++i) tv[i] *= rscale[k0 + 2 * i + (lane >> 5)];
    }
    float mx = 0.f;
#pragma unroll
    for (int c = 0; c < 8; ++c) if (c < ncm) mx = fmaxf(mx, cmax[c * cstride + n0 + (lane & 31)]);
    const float inv = mx > 0.f ? 127.0f / mx : 1.0f;
    if (kb == 0 && lane < 32) wscale[dst_row(n0 + lane)] = mx > 0.f ? mx * (1.0f / 127.0f) : 1.0f;
#pragma unroll
    for (int i = 0; i < 32; ++i) scr[(2 * i + (lane >> 5)) * 33 + (lane & 31)] = tv[i] * inv;
    asm volatile("s_waitcnt lgkmcnt(0)" ::: "memory");
    const int c = lane & 7;
#pragma unroll
    for (int j = 0; j < 4; ++j) { const int n = (lane >> 3) + 8 * j; const LAS float* s = scr + (8 * c) * 33 + n;
        u32x2 o; o.x = pack_i8x4(s[0 * 33], s[1 * 33], s[2 * 33], s[3 * 33]); o.y = pack_i8x4(s[4 * 33], s[5 * 33], s[6 * 33], s[7 * 33]);
        *(u32x2*)(WT + (size_t)dst_row(n0 + n) * K + k0 + 8 * c) = o; }
    asm volatile("s_waitcnt lgkmcnt(0)" ::: "memory");
}
struct MapIn { __device__ __forceinline__ int operator()(int o) const {
    if (o < 2048) { const int e = o & 127; if (e < 32) { const int i = e & 15, n = e >> 4; return (o & ~127) + 8 * (i >> 2) + 4 * n + (i & 3); } return o; }
    if (o < 4096) return o;
    const int e = o - 4096, n = e >> 5, i = e & 31; return 4096 + 32 * (i >> 4) + 8 * ((i >> 2) & 3) + 4 * n + (i & 3); } };
struct MapUq { __device__ __forceinline__ int operator()(int o) const {
    const int hd = o / 192, e = o - hd * 192; if (e < 128) return hd * 128 + e;
    const int r = e - 128, n = r >> 5, i = r & 31; return 1024 + hd * 64 + 32 * (i >> 4) + 8 * ((i >> 2) & 3) + 4 * n + (i & 3); } };
struct MapOff { int off; __device__ __forceinline__ int operator()(int o) const { return o + off; } };

#define WS_PTRS \
    const float* x = AR.in[0]; \
    float* mod = (float*)(ws + WS_MOD); \
    float* ropeA = (float*)(ws + WS_ROPEA); float* ropeB = (float*)(ws + WS_ROPEB); \
    bf16_t* Win_t = (bf16_t*)(ws + WS_WIN); bf16_t* Wuq_t = (bf16_t*)(ws + WS_WUQ); bf16_t* Wukv_t = (bf16_t*)(ws + WS_WUKV); \
    bf16_t* Wo_t = (bf16_t*)(ws + WS_WO); bf16_t* Wpq_t = (bf16_t*)(ws + WS_WPQ); \
    bf16_t* UT = (bf16_t*)(ws + WS_UT); bf16_t* VT = (bf16_t*)(ws + WS_VT); \
    unsigned char* HI8 = ws + WS_A; unsigned char* WT8 = ws + WS_WIN; unsigned char* WPQ8 = ws + WS_WPQ; unsigned char* WUQ8 = ws + WS_WUQ; unsigned char* WUKV8 = ws + WS_WUKV; unsigned char* CQ8 = ws + WS_A; unsigned char* CKV8 = ws + WS_A + 16 * MiB; float* CQS = (float*)(ws + WS_CQS); float* CKVS = CQS + 32768; float* CMQ = (float*)(ws + WS_CMQ); float* CMKV = CMQ + 4096; float* WSQ = (float*)(ws + WS_WSQ); float* WSKV = WSQ + 2048; unsigned char* WO8 = ws + WS_WO; unsigned char* O8 = ws + WS_A; float* OS = (float*)(ws + WS_OS); float* CMAX3 = (float*)(ws + WS_CMAX3); float* WS3 = (float*)(ws + WS_WS3); float* CMAX2 = (float*)(ws + WS_CMAX2); float* WS4 = (float*)(ws + WS_WS4); float* CMAX = (float*)(ws + WS_CMAX); float* WS1 = (float*)(ws + WS_WS1); float* HS1 = (float*)(ws + WS_HS1); \
    bf16_t* Hb = (bf16_t*)(ws + WS_A); bf16_t* So = (bf16_t*)(ws + WS_A); bf16_t* Qp = (bf16_t*)(ws + WS_A); \
    bf16_t* QA = (bf16_t*)(ws + WS_QA); bf16_t* KA = (bf16_t*)(ws + WS_KA); bf16_t* VA = (bf16_t*)(ws + WS_VA); \
    bf16_t* CQ = (bf16_t*)(ws + WS_CQ); bf16_t* CKV = (bf16_t*)(ws + WS_CKV); bf16_t* KR = (bf16_t*)(ws + WS_KR); \
    float* Y = (float*)(ws + WS_Y); bf16_t* MIXb = (bf16_t*)(ws + WS_Y); \
    bf16_t* Qn = (bf16_t*)(ws + WS_QN); bf16_t* Qr = (bf16_t*)(ws + WS_QR); bf16_t* Kn = (bf16_t*)(ws + WS_KN); bf16_t* Vb = (bf16_t*)(ws + WS_VB); \
    bf16_t* H2 = (bf16_t*)(ws + WS_H2); bf16_t* Ob = (bf16_t*)(ws + WS_O); \
    float* ssq_q = (float*)(ws + WS_SSQ_Q); float* ssq_kv = (float*)(ws + WS_SSQ_KV); float* ssq_o = (float*)(ws + WS_SSQ_O); \
    float* Sm = (float*)(ws + WS_SM); float* Sl = (float*)(ws + WS_SL); \
    bf16_t* K1b = (bf16_t*)(ws + WS_K1); bf16_t* K2b = (bf16_t*)(ws + WS_K2); \
    unsigned short* IDX = (unsigned short*)(ws + WS_IDX); float* Gt = (float*)(ws + WS_G); \
    float* SU = (float*)(ws + WS_SU); float* SH = (float*)(ws + WS_SH); \
    unsigned char* U8 = ws + WS_U8; unsigned char* H8 = ws + WS_H8; \
    float* PART = (float*)(ws + WS_PART); unsigned short* IDX2 = (unsigned short*)(ws + WS_IDX2); unsigned char* WTq = ws + WS_WT; float* WSC = (float*)(ws + WS_WT + 8 * MiB); \
    bf16_t* FFN = (bf16_t*)(ws + WS_FFN); bf16_t* X1b = (bf16_t*)(ws + WS_X1); unsigned char* H2S = ws + WS_H2S;

__global__ void __launch_bounds__(NWAVES * 64, 2) mega_fwd(Args args) {
    extern __shared__ __attribute__((aligned(16))) unsigned char lds_raw[];
    LAS unsigned char* lds = (LAS unsigned char*)lds_raw;
    const int G = gridDim.x, bid = blockIdx.x, NGW = G * NWAVES;
    const int wave0 = __builtin_amdgcn_readfirstlane((int)threadIdx.x >> 6);
#define PH_LOCALS const int lane = opaque((int)__builtin_amdgcn_mbcnt_hi(~0u, __builtin_amdgcn_mbcnt_lo(~0u, 0u))), wave = wave0, tid = wave * 64 + lane, gw = bid * NWAVES + wave; (void)gw; \
    const __attribute__((address_space(4))) Args* arp_ = (const __attribute__((address_space(4))) Args*)__builtin_amdgcn_kernarg_segment_ptr(); asm volatile("" : "+s"(arp_)); const __attribute__((address_space(4))) Args& AR = *arp_; unsigned char* ws = AR.ws; WS_PTRS
    unsigned char* ws0 = args.ws;
    const int lo = args.ph_lo, hi_ph = args.ph_hi;
    if (threadIdx.x < 4) ((LAS unsigned*)(lds + LDS_BYTES - 16))[threadIdx.x] = 0u;
    __syncthreads();
    XcdBarrier xbar = xcd_barrier_post((unsigned*)ws0, (volatile LAS unsigned*)(lds + LDS_BYTES - 16));
#ifdef ONLY_PH
#define IN(k) ((k) == ONLY_PH && lo <= (k) && (k) < hi_ph)
#else
#define IN(k) (lo <= (k) && (k) < hi_ph)
#endif
#if MK_N_LAUNCHES == 1
#define GRID_BAR(k) do { if (IN(k) && IN((k) + 1)) { if ((k) == 0) cg::this_grid().sync(); else xcd_barrier(xbar); } } while (0)
#else
#define GRID_BAR(k) do { } while (0)
#endif
    constexpr int TB_SPLIT = 12288;
#define TB_LOAD(BUF, rr) do { const float* src_ = (((rr) >> 14) ? AR.in[19] : AR.in[18]) + (size_t)((rr) & (NE - 1)) * 2048; \
                    _Pragma("unroll") for (int c = 0; c < 4; ++c) { const f32x4* p_ = (const f32x4*)(src_ + c * 512 + lane * 8); BUF[2 * c] = p_[0]; BUF[2 * c + 1] = p_[1]; } } while (0)
#define TB_STEP(BUF, RR, NW, REND) do { const int r = (RR); \
                    const int tbl = r >> 14, e = r & (NE - 1); \
                    f32x4 v[8]; float mx = 0.f, sq = 0.f; \
_Pragma("unroll") \
                    for (int i = 0; i < 8; ++i) { v[i] = BUF[i]; mx = fmaxf(fmaxf(mx, fmaxf(fabsf(v[i][0]), fabsf(v[i][1]))), fmaxf(fabsf(v[i][2]), fabsf(v[i][3]))); \
                        sq += (v[i][0] * v[i][0] + v[i][1] * v[i][1]) + (v[i][2] * v[i][2] + v[i][3] * v[i][3]); } \
                    if (r + 2 * (NW) < (REND)) TB_LOAD(BUF, r + 2 * (NW)); \
                    mx = wmax(mx); \
                    if (tbl == 0) { \
                          \
                          \
                        const float rms = sqrtf(wsum(sq) * (1.0f / 2048.0f)); \
                        const float step = rms > 0.f ? fmaxf(0.335f * rms, mx * (1.0f / 64.0f)) : 1.0f; \
                        const float inv = 1.0f / step; \
                        if (lane == 0) SU[e] = step; \
                        unsigned char* dst = U8 + (size_t)e * 128 + (lane & 31) * 4; \
_Pragma("unroll") \
                        for (int c = 0; c < 4; ++c) { unsigned w = 0u; \
_Pragma("unroll") \
                            for (int i = 0; i < 4; ++i) { const float a = v[2 * c][i] * inv, b = v[2 * c + 1][i] * inv; \
                                const int qa = (int)__builtin_rintf(fminf(fmaxf(a, -7.f), 7.f)) + 8, qb = (int)__builtin_rintf(fminf(fmaxf(b, -7.f), 7.f)) + 8; \
                                w |= ((unsigned)qa | ((unsigned)qb << 4)) << (8 * i); } \
                            *(unsigned*)(dst + (size_t)(c * 2 + (lane >> 5)) * (2u << 20)) = w; } \
                    } else { \
                          \
                        const float rms = sqrtf(wsum(sq) * (1.0f / 2048.0f)); \
                        const float step = rms > 0.f ? fmaxf(0.335f * rms, mx * (1.0f / 64.0f)) : 1.0f; \
                        const float inv = 1.0f / step; \
                        if (lane == 0) SU[NE + e] = step; \
                        unsigned char* dst = U8 + (size_t)(32u << 20) + (size_t)e * 128 + (lane & 31) * 4; \
_Pragma("unroll") \
                        for (int c = 0; c < 4; ++c) { unsigned w = 0u; \
_Pragma("unroll") \
                            for (int i = 0; i < 4; ++i) { const float a = (i < 2 ? v[2 * c][2 * i] : v[2 * c + 1][2 * i - 4]) * inv, b = (i < 2 ? v[2 * c][2 * i + 1] : v[2 * c + 1][2 * i - 3]) * inv; \
                                const int qa = (int)__builtin_rintf(fminf(fmaxf(a, -7.f), 7.f)) + 8, qb = (int)__builtin_rintf(fminf(fmaxf(b, -7.f), 7.f)) + 8; \
                                w |= ((unsigned)qa | ((unsigned)qb << 4)) << (8 * i); } \
                            *(unsigned*)(dst + (size_t)(c * 2 + (lane >> 5)) * (2u << 20)) = w; } \
                    } \
    } while (0)
#define TABLE_CONVERT(W0, NW, RBEG, REND) do { \
            f32x4 nva[8], nvb[8]; const int r0_ = (RBEG) + (W0); \
            if (r0_ < (REND)) TB_LOAD(nva, r0_); \
            if (r0_ + (NW) < (REND)) TB_LOAD(nvb, r0_ + (NW)); \
            for (int rr_ = r0_; rr_ < (REND); rr_ += 2 * (NW)) { \
                TB_STEP(nva, rr_, NW, REND); \
                if (rr_ + (NW) < (REND)) TB_STEP(nvb, rr_ + (NW), NW, REND); \
            } \
    } while (0)
    for (int rep_ = 0; rep_ < (IN(0) ? 1 + ((REP_MASK >> 0) & 1) : 0); ++rep_) {
        PH_LOCALS;
        for (int cb = bid; cb < 192; cb += G) {
            LAS float* cact = (LAS float*)lds;
            const float* cin = AR.in[1];
            for (int i = tid; i < 16 * 2048; i += NWAVES * 64) { const float v = cin[i]; cact[i] = v / (1.0f + __expf(-v)); }
            __syncthreads();
            const int col = cb * 64 + lane;
            float acc[16];
#pragma unroll
            for (int b = 0; b < 16; ++b) acc[b] = 0.f;
            const float* wp = AR.in[2] + (size_t)(wave * 256) * 12288 + col;
            for (int k0 = 0; k0 < 256; k0 += 16) {
                float w[16];
#pragma unroll
                for (int i = 0; i < 16; ++i) w[i] = wp[(size_t)(k0 + i) * 12288];
#pragma unroll
                for (int b = 0; b < 16; ++b) {
#pragma unroll
                    for (int i4 = 0; i4 < 4; ++i4) { const f32x4 cv = *(const LAS f32x4*)(cact + b * 2048 + wave * 256 + k0 + 4 * i4);
                        acc[b] += cv[0] * w[4 * i4] + cv[1] * w[4 * i4 + 1] + cv[2] * w[4 * i4 + 2] + cv[3] * w[4 * i4 + 3]; }
                }
            }
            __syncthreads();
            LAS float* red = (LAS float*)lds;
#pragma unroll
            for (int b = 0; b < 16; ++b) red[(wave * 16 + b) * 64 + lane] = acc[b];
            __syncthreads();
            for (int o = tid; o < 1024; o += NWAVES * 64) { const int b = o >> 6, cl = o & 63; float s = 0.f;
#pragma unroll
                for (int w = 0; w < 8; ++w) s += red[(w * 16 + b) * 64 + cl];
                mod[(size_t)b * 12288 + cb * 64 + cl] = s + AR.in[3][cb * 64 + cl]; }
            __syncthreads();
        }
        {
            LAS float* scr = (LAS float*)(lds + wave * 16384);
            constexpr int I_IN = 8 * 65, I_UQ = 2 * 24, I_UK = 2 * 16, I_UV = 2 * 16, I_O = 8 * 32, I_PQ = 8 * 32;
            constexpr int NITEMS = I_IN + I_UQ + I_UK + I_UV + I_O + I_PQ;
            for (int it = gw; it < NITEMS; it += NGW) {
                int r = it;
                if (r < I_IN) {
                    const int kc = r / 65, nb = r % 65; const float* wp = AR.in[4] + (size_t)(kc * 256) * NPROJ + nb * 64 + lane; float mx = 0.f;
#pragma unroll 1
                    for (int k0 = 0; k0 < 256; k0 += 32) { float w[32];
#pragma unroll
                        for (int i = 0; i < 32; ++i) w[i] = wp[(size_t)(k0 + i) * NPROJ];
#pragma unroll
                        for (int i = 0; i < 32; ++i) mx = fmaxf(mx, fabsf(w[i])); }
                    CMAX[kc * NPROJ_PAD + nb * 64 + lane] = mx; continue; } r -= I_IN;
                if (r < I_UQ + I_UK + I_UV) {
                    const int t3 = r < I_UQ ? 0 : (r < I_UQ + I_UK ? 1 : 2), rr = r - (t3 == 0 ? 0 : (t3 == 1 ? I_UQ : I_UQ + I_UK));
                    const int N3 = t3 == 0 ? 1536 : 1024, nb3 = N3 / 64, kc = rr / nb3, nb = rr % nb3;
                    const float* wp = (t3 == 0 ? AR.in[7] : (t3 == 1 ? AR.in[8] : AR.in[9])) + (size_t)(kc * 256) * N3 + nb * 64 + lane;
                    const float* gp = (t3 == 0 ? AR.in[5] : AR.in[6]) + kc * 256; float mx = 0.f;
#pragma unroll 1
                    for (int k0 = 0; k0 < 256; k0 += 32) { float w[32];
#pragma unroll
                        for (int i = 0; i < 32; ++i) w[i] = wp[(size_t)(k0 + i) * N3];
#pragma unroll
                        for (int i = 0; i < 32; ++i) mx = fmaxf(mx, fabsf(w[i] * gp[k0 + i])); }
                    (t3 == 0 ? CMQ + kc * 1536 : CMKV + kc * 2048 + (t3 == 2 ? 1024 : 0))[nb * 64 + lane] = mx; continue; } r -= I_UQ + I_UK + I_UV;
                if (r < I_O) {
                    const int kc = r >> 5, nb = r & 31; const float* wp = AR.in[12] + (size_t)(kc * 256) * 2048 + nb * 64 + lane;
                    const float* gp = (kc < 4 ? AR.in[10] : AR.in[11] - 1024) + kc * 256; float mx = 0.f;
#pragma unroll 1
                    for (int k0 = 0; k0 < 256; k0 += 32) { float w[32];
#pragma unroll
                        for (int i = 0; i < 32; ++i) w[i] = wp[(size_t)(k0 + i) * 2048];
#pragma unroll
                        for (int i = 0; i < 32; ++i) mx = fmaxf(mx, fabsf(w[i] * gp[k0 + i])); }
                    CMAX3[kc * 2048 + nb * 64 + lane] = mx; continue; } r -= I_O;
                {
                    const int kc = r >> 5, nb = r & 31; const float* wp = AR.in[15] + (size_t)(kc * 256) * 2048 + nb * 64 + lane; float mx = 0.f;
#pragma unroll 1
                    for (int k0 = 0; k0 < 256; k0 += 32) { float w[32];
#pragma unroll
                        for (int i = 0; i < 32; ++i) w[i] = wp[(size_t)(k0 + i) * 2048];
#pragma unroll
                        for (int i = 0; i < 32; ++i) mx = fmaxf(mx, fabsf(w[i])); }
                    CMAX2[kc * 2048 + nb * 64 + lane] = mx; }
            }
            for (size_t i = (size_t)gw * 64 + lane; i < (size_t)(NPROJ_PAD - NPROJ) * 2048 / 16; i += (size_t)NGW * 64)
                *(u32x4*)(WT8 + (size_t)NPROJ * 2048 + i * 16) = (u32x4){0u, 0u, 0u, 0u};
            if (gw == 0) for (int i = lane; i < NPROJ_PAD - NPROJ; i += 64) WS1[NPROJ + i] = 1.0f;
        }
#if defined(NAIVE_PEER)
        for (int r = gw; r < 2 * NE; r += NGW) {
            const float* src = (r < NE ? AR.in[18] : AR.in[19]) + (size_t)(r & (NE - 1)) * 2048;
            bf16_t* dst = (r < NE ? UT : VT) + (size_t)(r & (NE - 1)) * 2048;
            f32x4 v[8];
#pragma unroll
            for (int c = 0; c < 4; ++c) { const f32x4* p = (const f32x4*)(src + c * 512 + lane * 8); v[2 * c] = p[0]; v[2 * c + 1] = p[1]; }
#pragma unroll
            for (int c = 0; c < 4; ++c) pg8::store8(dst + c * 512 + lane * 8, v[2 * c], v[2 * c + 1]);
        }
#else
        TABLE_CONVERT(gw, NGW, TB_SPLIT, 2 * NE);
#endif
        for (int i = gw * 64 + lane; i < 2 * 16384; i += NGW * 64) {
            const float v = (i < 16384 ? AR.in[16] : AR.in[17])[i & 16383];
            (i < 16384 ? K1b : K2b)[i & 16383] = (bf16_t)(cvtpk(v, v) & 0xffffu);
        }
    }
    GRID_BAR(0);

    for (int rep_ = 0; rep_ < (IN(1) ? 1 + ((REP_MASK >> 1) & 1) : 0); ++rep_) {
        PH_LOCALS;
        const int nb_ = G >> 4, b = bid / nb_, r0 = (bid % nb_) * NWAVES + wave, rstep = nb_ * NWAVES;
        LAS float* psh = (LAS float*)lds; LAS float* psc = psh + 2048;
        __syncthreads();
        if (b < 16) { const float* mb = mod + (size_t)b * 12288;
            *(LAS f32x4*)(psh + 4 * tid) = *(const f32x4*)(mb + 4 * tid); *(LAS f32x4*)(psc + 4 * tid) = *(const f32x4*)(mb + 2048 + 4 * tid) + 1.0f; }
        __syncthreads();
        { LAS float* scr = (LAS float*)(lds + 16384 + wave * 8704);
          for (int it = gw; it < 32 * 130; it += NGW) transpose_item_q8(AR.in[4], 2048, NPROJ, WT8, (const float*)nullptr, CMAX, 8, NPROJ_PAD, WS1, scr, it, lane, MapIn{});
          for (int it = gw; it < 32 * 64; it += NGW) transpose_item_q8(AR.in[15], 2048, 2048, WPQ8, (const float*)nullptr, CMAX2, 8, 2048, WS4, scr, it, lane, MapOff{0});
          for (int it = gw; it < 32 * 64; it += NGW) { const int kb = it / 64; transpose_item_q8(AR.in[12], 2048, 2048, WO8, kb < 16 ? AR.in[10] : AR.in[11] - 1024, CMAX3, 8, 2048, WS3, scr, it, lane, MapOff{0}); }
          for (int it = gw; it < 8 * 48; it += NGW) transpose_item_q8(AR.in[7], 512, 1536, WUQ8, AR.in[5], CMQ, 2, 1536, WSQ, scr, it, lane, MapUq{});
          for (int it = gw; it < 8 * 32; it += NGW) transpose_item_q8(AR.in[8], 512, 1024, WUKV8, AR.in[6], CMKV, 2, 2048, WSKV, scr, it, lane, MapOff{0});
          for (int it = gw; it < 8 * 32; it += NGW) transpose_item_q8(AR.in[9], 512, 1024, WUKV8, AR.in[6], CMKV + 1024, 2, 2048, WSKV, scr, it, lane, MapOff{1024}); }
        if (b < 16) {
            f32x4 nv[8];
            { const f32x4* xr = (const f32x4*)(x + ((size_t)b * 2048 + r0) * DM) + lane;
#pragma unroll
              for (int j = 0; j < 8; ++j) nv[j] = xr[64 * j]; }
            for (int r = r0; r < 2048; r += rstep) {
                const int row = b * 2048 + r;
                f32x4 v[8]; float s = 0.f;
#pragma unroll
                for (int j = 0; j < 8; ++j) { v[j] = nv[j]; s += (v[j][0] + v[j][1]) + (v[j][2] + v[j][3]); }
                if (r + rstep < 2048) { const f32x4* xr = (const f32x4*)(x + (size_t)(row + rstep) * DM) + lane;
#pragma unroll
                    for (int j = 0; j < 8; ++j) nv[j] = xr[64 * j]; }
                const float mean = wsum(s) * (1.0f / DM); float s2 = 0.f;
#pragma unroll
                for (int j = 0; j < 8; ++j) { v[j] = v[j] - mean; s2 += (v[j][0] * v[j][0] + v[j][1] * v[j][1]) + (v[j][2] * v[j][2] + v[j][3] * v[j][3]); }
                const float rstd = 1.0f / sqrtf(wsum(s2) * (1.0f / DM) + 1e-5f);
                float mx = 0.f;
#pragma unroll
                for (int j = 0; j < 8; ++j) { const int d = 4 * (lane + 64 * j);
                    const f32x4 sh = *(const LAS f32x4*)(psh + d), sc1 = *(const LAS f32x4*)(psc + d);
                    v[j] = v[j] * rstd * sc1 + sh; mx = fmaxf(fmaxf(mx, fmaxf(fabsf(v[j][0]), fabsf(v[j][1]))), fmaxf(fabsf(v[j][2]), fabsf(v[j][3]))); }
                mx = wmax(mx);
                const float qs = mx > 0.f ? 127.0f / mx : 1.0f;
                if (lane == 0) HS1[row] = mx > 0.f ? mx * (1.0f / 127.0f) : 1.0f;
#pragma unroll
                for (int j = 0; j < 8; ++j) { const int d = 4 * (lane + 64 * j); const f32x4 y = v[j] * qs;
                    *(unsigned*)(HI8 + (size_t)row * DM + d) = pack_i8x4(y[0], y[1], y[2], y[3]); }
            }
        }
    }
    GRID_BAR(1);

    for (int rep_ = 0; rep_ < (IN(2) ? 1 + ((REP_MASK >> 2) & 1) : 0); ++rep_) {
        PH_LOCALS;
        pg8::Gemm g{(const bf16_t*)HI8, (const bf16_t*)WT8, T, NPROJ_PAD, DM / 2}; pg8::StaticOrder S; S.init(T, NPROJ_PAD, G, bid);
        pg8::EpiProj E{QA, CQ, KR, ssq_q, HS1, WS1};
        pg8::gemm_phase(tid, lds, g, S, E);
#if !defined(NAIVE_PEER)
        {
            const int nun_ = (T / 256) * (NPROJ_PAD / 256), rem_ = nun_ % G;
            const int tw0_ = ((rem_ ? bid - rem_ : bid) * NWAVES + wave), tnw_ = (rem_ ? G - rem_ : G) * NWAVES;
            if (tw0_ >= 0) {
                TABLE_CONVERT(tw0_, tnw_, 0, TB_SPLIT);
            }
        }
#endif
    }
    GRID_BAR(2);

    for (int rep_ = 0; rep_ < (IN(5) ? 1 + ((REP_MASK >> 5) & 1) : 0); ++rep_) {
        PH_LOCALS;
        for (int t = gw; t < T; t += NGW) {
            const u32x4 cq = *(const u32x4*)(CQ + (size_t)t * 512 + lane * 8), ck = *(const u32x4*)(CKV + (size_t)t * 512 + lane * 8);
            float sq_ = 0.f, sk_ = 0.f;
#pragma unroll
            for (int sl = 0; sl < 8; ++sl) { sq_ += ssq_q[(size_t)sl * T + t]; sk_ += ssq_kv[(size_t)sl * T + t]; }
            const float rq = 1.0f / sqrtf(sq_ * (1.0f / 512.0f) + 1e-6f), rk = 1.0f / sqrtf(sk_ * (1.0f / 512.0f) + 1e-6f);
            float fq_[8], fk_[8]; float mq = 0.f, mk = 0.f;
            { const unsigned a0 = cq.x, a1 = cq.y, a2 = cq.z, a3 = cq.w, b0 = ck.x, b1 = ck.y, b2 = ck.z, b3 = ck.w;
              fq_[0] = bf_lo(a0) * rq; fq_[1] = bf_hi(a0) * rq; fq_[2] = bf_lo(a1) * rq; fq_[3] = bf_hi(a1) * rq; fq_[4] = bf_lo(a2) * rq; fq_[5] = bf_hi(a2) * rq; fq_[6] = bf_lo(a3) * rq; fq_[7] = bf_hi(a3) * rq;
              fk_[0] = bf_lo(b0) * rk; fk_[1] = bf_hi(b0) * rk; fk_[2] = bf_lo(b1) * rk; fk_[3] = bf_hi(b1) * rk; fk_[4] = bf_lo(b2) * rk; fk_[5] = bf_hi(b2) * rk; fk_[6] = bf_lo(b3) * rk; fk_[7] = bf_hi(b3) * rk; }
#pragma unroll
            for (int i = 0; i < 8; ++i) { mq = fmaxf(mq, fabsf(fq_[i])); mk = fmaxf(mk, fabsf(fk_[i])); }
            mq = wmax(mq); mk = wmax(mk);
            const float qq = mq > 0.f ? 127.0f / mq : 1.0f, qk = mk > 0.f ? 127.0f / mk : 1.0f;
            if (lane == 0) { CQS[t] = mq > 0.f ? mq * (1.0f / 127.0f) : 1.0f; CKVS[t] = mk > 0.f ? mk * (1.0f / 127.0f) : 1.0f; }
            { u32x2 w; w.x = pack_i8x4(fq_[0] * qq, fq_[1] * qq, fq_[2] * qq, fq_[3] * qq); w.y = pack_i8x4(fq_[4] * qq, fq_[5] * qq, fq_[6] * qq, fq_[7] * qq); *(u32x2*)(CQ8 + (size_t)t * 512 + lane * 8) = w; }
            { u32x2 w; w.x = pack_i8x4(fk_[0] * qk, fk_[1] * qk, fk_[2] * qk, fk_[3] * qk); w.y = pack_i8x4(fk_[4] * qk, fk_[5] * qk, fk_[6] * qk, fk_[7] * qk); *(u32x2*)(CKV8 + (size_t)t * 512 + lane * 8) = w; }
        }
    }
    GRID_BAR(5);

    for (int rep_ = 0; rep_ < (IN(3) ? 1 + ((REP_MASK >> 3) & 1) : 0); ++rep_) {
        PH_LOCALS;
        LAS float* tab = (LAS float*)(lds + pg8::STAGE_BYTES);
        { pg8::Gemm g{(const bf16_t*)CQ8, (const bf16_t*)WUQ8, T, 1536, 256}; pg8::StaticOrder S; S.init(T, 1536, G, bid);
          if (tid < 256) {
#pragma unroll
              for (int i = 0; i < 4; ++i) { pg8::Unit u; if (S.next(i, u)) tab[i * 256 + tid] = CQS[u.pm * 256 + tid]; } }
          __syncthreads();
          pg8::EpiQ E{Qn, Qr, tab, WSQ}; pg8::gemm_phase(tid, lds, g, S, E); }
        __syncthreads();
        { pg8::Gemm g{(const bf16_t*)CKV8, (const bf16_t*)WUKV8, T, 2048, 256}; pg8::StaticOrder S; S.init(T, 2048, G, bid);
          if (tid < 256) {
#pragma unroll
              for (int i = 0; i < 4; ++i) { pg8::Unit u; if (S.next(i, u)) tab[i * 256 + tid] = CKVS[u.pm * 256 + tid]; } }
          __syncthreads();
          pg8::EpiKV E{Kn, Vb, tab, WSKV}; pg8::gemm_phase(tid, lds, g, S, E); }
    }
    GRID_BAR(3);


#if defined(NAIVE_ATTN)
    for (int rep_ = 0; rep_ < (IN(4) ? 1 + ((REP_MASK >> 4) & 1) : 0); ++rep_) {
        PH_LOCALS;
        for (int it = gw; it < T * 8; it += NGW) {
            const int t = it >> 3, h = it & 7, b = t >> 11, s = t & 2047;
            {
                const unsigned qv = *(const unsigned*)(QA + (size_t)t * 1024 + h * 128 + 2 * lane);
                const float q0 = bf_lo(qv), q1 = bf_hi(qv);
                float m = -1e30f, l = 0.f, a0 = 0.f, a1 = 0.f;
                for (int br = 0; br < 3; ++br) { const int dil = br == 0 ? 1 : (br == 1 ? 4 : 16);
                    for (int j = 0; j <= 128; ++j) { const int sk = s - j * dil; if (sk < 0) break;
                        const size_t tk = (size_t)b * SEQ + sk;
                        const unsigned kv = *(const unsigned*)(KA + tk * 1024 + h * 128 + 2 * lane);
                        const unsigned vv = *(const unsigned*)(VA + tk * 1024 + h * 128 + 2 * lane);
                        const float sc = wave_sum(q0 * bf_lo(kv) + q1 * bf_hi(kv)) * 0.08838834764831845f;
                        const float mn = fmaxf(m, sc), corr = __expf(m - mn), pp = __expf(sc - mn);
                        l = l * corr + pp; a0 = a0 * corr + pp * bf_lo(vv); a1 = a1 * corr + pp * bf_hi(vv); m = mn; } }
                const float r0 = a0 / l, r1 = a1 / l;
                *(unsigned*)(Ob + (size_t)t * 2048 + h * 128 + 2 * lane) = cvtpk(r0, r1);
                const float sq = wave_sum(r0 * r0 + r1 * r1);
                if (lane == 0) ssq_o[(size_t)t * 16 + h] = sq;
            }
            {
                const unsigned qv = *(const unsigned*)(Qn + (size_t)t * 1024 + h * 128 + 2 * lane);
                const float q0 = bf_lo(qv), q1 = bf_hi(qv);
                const unsigned short qrv = Qr[(size_t)t * 512 + h * 64 + lane]; const float qr0 = __uint_as_float((unsigned)qrv << 16);
                float m = -1e30f, l = 0.f, a0 = 0.f, a1 = 0.f;
                for (int sk = 0; sk <= s; ++sk) { const size_t tk = (size_t)b * SEQ + sk;
                    const unsigned kv = *(const unsigned*)(Kn + tk * 1024 + h * 128 + 2 * lane);
                    const unsigned vv = *(const unsigned*)(Vb + tk * 1024 + h * 128 + 2 * lane);
                    const float krv = __uint_as_float((unsigned)KR[tk * 64 + lane] << 16);
                    const float sc = wave_sum(q0 * bf_lo(kv) + q1 * bf_hi(kv) + qr0 * krv) * 0.07216878364870322f;
                    const float mn = fmaxf(m, sc), corr = __expf(m - mn), pp = __expf(sc - mn);
                    l = l * corr + pp; a0 = a0 * corr + pp * bf_lo(vv); a1 = a1 * corr + pp * bf_hi(vv); m = mn; }
                const float r0 = a0 / l, r1 = a1 / l;
                *(unsigned*)(Ob + (size_t)t * 2048 + 1024 + h * 128 + 2 * lane) = cvtpk(r0, r1);
                const float sq = wave_sum(r0 * r0 + r1 * r1);
                if (lane == 0) ssq_o[(size_t)t * 16 + 8 + h] = sq;
            }
        }
    }
#else
    for (int rep_ = 0; rep_ < (IN(4) ? 1 + ((REP_MASK >> 4) & 1) : 0); ++rep_) {
        PH_LOCALS;
        att::Tens XA{QA, nullptr, KA, nullptr, VA, So, Sm, Sl, Ob, 0, ssq_o, 0};
        {
            LAS unsigned char* wl = lds + wave * 17408; LAS float* wsf = (LAS float*)(lds + 8 * 17408) + wave * 64;
            for (int repa = 0; repa < 1 + ((REP_MASK >> 16) & 1); ++repa)
            for (int u = bid; u < 512; u += G) {
                const int J = (u >> 3) & 3, bh = (u & 7) + 8 * (u >> 5), b = bh >> 3, h = bh & 7;
#pragma unroll 1
                for (int br = 0; br < 3; ++br) {
#pragma unroll 1
                    for (int k = 0; k < 2; ++k) { const int wu = wave + 8 * k;
                        att::WaveA P;
                        P.b = b; P.h = h; P.mode = br == 0 ? 0 : (br == 1 ? 1 : 3);
                        if (br == 0) { P.dil = 1; P.rho = 0; P.qpos0 = 512 * J + 32 * wu; }
                        else if (br == 1) { P.dil = 4; P.rho = wu >> 2; P.qpos0 = 128 * J + 32 * (wu & 3); }
                        else { P.dil = 16; P.rho = wu; P.qpos0 = 32 * J; }
                        att::attnA_wave(lane, P, wl, wsf, XA); }
                    asm volatile("s_waitcnt vmcnt(0)" ::: "memory");
                    __syncthreads();
                }
            }
            __syncthreads();
        }
        att::Tens XB{Qn, Qr, Kn, KR, Vb, nullptr, nullptr, nullptr, Ob, 1024, ssq_o, 8};
        for (int repb = 0; repb < 1 + ((REP_MASK >> 17) & 1); ++repb)
        for (int i = 0; i < 4 * ((1024 + 4 * G - 1) / (4 * G)); ++i) {
            const int v = bid + (i >> 2) * G; if (v >= 256) break;
            const int bh = (v & 7) + 8 * (v >> 4), s = (v >> 3) & 1, ii = i & 3;
            const int qt = ii == 0 ? 2 * s : (ii == 1 ? 2 * s + 1 : (ii == 2 ? 7 - 2 * s : 6 - 2 * s));
            att::UnitP P{bh >> 3, bh & 7, 1, 0, 1, 256 * qt, 0, 4 * (qt + 1), 1 << 28, 2};
            att::attn_unit<true>(tid, P, lds, XB);
        }
    }
    GRID_BAR(4);


#endif

    for (int rep_ = 0; rep_ < (IN(6) ? 1 + ((REP_MASK >> 6) & 1) : 0); ++rep_) {
        PH_LOCALS;
        u32x4 no[4]; f32x4 nq[4];
#define P6_LOAD(rr) do { _Pragma("unroll") for (int c = 0; c < 4; ++c) { no[c] = *(const u32x4*)(Ob + (size_t)(rr) * DM + c * 512 + lane * 8); nq[c] = *(const f32x4*)(ssq_o + (size_t)(rr) * 16 + 4 * c); } } while (0)
        P6_LOAD(gw);
        for (int row = gw; row < T; row += NGW) {
            const float sa = ((nq[0][0] + nq[0][1]) + (nq[0][2] + nq[0][3])) + ((nq[1][0] + nq[1][1]) + (nq[1][2] + nq[1][3]));
            const float sb = ((nq[2][0] + nq[2][1]) + (nq[2][2] + nq[2][3])) + ((nq[3][0] + nq[3][1]) + (nq[3][2] + nq[3][3]));
            const float ra = 1.0f / sqrtf(sa * (1.0f / 1024.0f) + 1e-6f), rb = 1.0f / sqrtf(sb * (1.0f / 1024.0f) + 1e-6f);
            float f[32]; float mx = 0.f;
#pragma unroll
            for (int c = 0; c < 4; ++c) { const u32x4 o4 = no[c]; const unsigned w0 = o4.x, w1 = o4.y, w2 = o4.z, w3 = o4.w; const float r_ = c < 2 ? ra : rb;
                f[8 * c + 0] = bf_lo(w0) * r_; f[8 * c + 1] = bf_hi(w0) * r_; f[8 * c + 2] = bf_lo(w1) * r_; f[8 * c + 3] = bf_hi(w1) * r_;
                f[8 * c + 4] = bf_lo(w2) * r_; f[8 * c + 5] = bf_hi(w2) * r_; f[8 * c + 6] = bf_lo(w3) * r_; f[8 * c + 7] = bf_hi(w3) * r_; }
            if (row + NGW < T) P6_LOAD(row + NGW);
#pragma unroll
            for (int i = 0; i < 32; ++i) mx = fmaxf(mx, fabsf(f[i]));
            mx = wmax(mx);
            const float qs = mx > 0.f ? 127.0f / mx : 1.0f;
            if (lane == 0) OS[row] = mx > 0.f ? mx * (1.0f / 127.0f) : 1.0f;
#pragma unroll
            for (int c = 0; c < 4; ++c) { u32x2 w; w.x = pack_i8x4(f[8 * c] * qs, f[8 * c + 1] * qs, f[8 * c + 2] * qs, f[8 * c + 3] * qs); w.y = pack_i8x4(f[8 * c + 4] * qs, f[8 * c + 5] * qs, f[8 * c + 6] * qs, f[8 * c + 7] * qs);
                *(u32x2*)(O8 + (size_t)row * DM + c * 512 + lane * 8) = w; }
        }
#undef P6_LOAD
    }
    GRID_BAR(6);

    for (int rep_ = 0; rep_ < (IN(7) ? 1 + ((REP_MASK >> 7) & 1) : 0); ++rep_) {
        PH_LOCALS;
        pg8::Gemm g{(const bf16_t*)O8, (const bf16_t*)WO8, T, DM, DM / 2}; pg8::StaticOrder S; S.init(T, DM, G, bid);
        pg8::EpiPlainQ8 E{MIXb, DM, OS, WS3}; pg8::gemm_phase(tid, lds, g, S, E);
    }
    GRID_BAR(7);

    for (int rep_ = 0; rep_ < (IN(8) ? 1 + ((REP_MASK >> 8) & 1) : 0); ++rep_) {
        PH_LOCALS;
        const int nb_ = G >> 4, b = bid / nb_, r0 = (bid % nb_) * NWAVES + wave, rstep = nb_ * NWAVES;
        LAS float* pg1 = (LAS float*)lds; LAS float* psh = pg1 + 2048; LAS float* psc = pg1 + 4096; LAS float* plg = pg1 + 6144; LAS float* plb = pg1 + 8192;
        __syncthreads();
        if (b < 16) { const float* mb = mod + (size_t)b * 12288;
            *(LAS f32x4*)(pg1 + 4 * tid) = *(const f32x4*)(mb + 4096 + 4 * tid) * DBG_MIX; *(LAS f32x4*)(psh + 4 * tid) = *(const f32x4*)(mb + 6144 + 4 * tid);
            *(LAS f32x4*)(psc + 4 * tid) = *(const f32x4*)(mb + 8192 + 4 * tid) + 1.0f;
            *(LAS f32x4*)(plg + 4 * tid) = *(const f32x4*)(AR.in[13] + 4 * tid); *(LAS f32x4*)(plb + 4 * tid) = *(const f32x4*)(AR.in[14] + 4 * tid); }
        __syncthreads();
        if (b < 16) {
        f32x4 nx[8]; u32x2 nm[8];
#define P8_LOAD(rr) do { const f32x4* xr_ = (const f32x4*)(x + (size_t)(rr) * DM) + lane; const u32x2* mr_ = (const u32x2*)(MIXb + (size_t)(rr) * DM) + lane; \
            _Pragma("unroll") for (int j = 0; j < 8; ++j) { nx[j] = xr_[64 * j]; nm[j] = mr_[64 * j]; } } while (0)
        P8_LOAD(b * 2048 + r0);
        for (int r = r0; r < 2048; r += rstep) {
            const int row = b * 2048 + r, le = opaque(lane);
            f32x4 v[8]; float s = 0.f;
#pragma unroll
            for (int j = 0; j < 8; ++j) { const f32x4 xv = nx[j], gv = *(const LAS f32x4*)(pg1 + 4 * (le + 64 * j)); const unsigned m0 = nm[j].x, m1 = nm[j].y;
                v[j][0] = xv[0] * DN_ALPHA + gv[0] * bf_lo(m0); v[j][1] = xv[1] * DN_ALPHA + gv[1] * bf_hi(m0);
                v[j][2] = xv[2] * DN_ALPHA + gv[2] * bf_lo(m1); v[j][3] = xv[3] * DN_ALPHA + gv[3] * bf_hi(m1);
                s += (v[j][0] + v[j][1]) + (v[j][2] + v[j][3]); }
            if (r + rstep < 2048) P8_LOAD(row + rstep);
            float mean = wsum(s) * (1.0f / DM); float s2 = 0.f;
#pragma unroll
            for (int j = 0; j < 8; ++j) { v[j] = v[j] - mean; s2 += (v[j][0] * v[j][0] + v[j][1] * v[j][1]) + (v[j][2] * v[j][2] + v[j][3] * v[j][3]); }
            float rstd = 1.0f / sqrtf(wsum(s2) * (1.0f / DM) + 1e-5f);
            s = 0.f;
#pragma unroll
            for (int j = 0; j < 8; ++j) { const int d = 4 * (le + 64 * j);
                v[j] = v[j] * rstd * *(const LAS f32x4*)(plg + d) + *(const LAS f32x4*)(plb + d);
#if defined(NAIVE_PEER)
                *(f32x4*)(AR.out + (size_t)row * DM + d) = v[j];
#else
                { u32x2 w1; w1.x = cvtpk(v[j][0], v[j][1]); w1.y = cvtpk(v[j][2], v[j][3]); *(u32x2*)(X1b + (size_t)row * DM + d) = w1; }
#endif
                s += (v[j][0] + v[j][1]) + (v[j][2] + v[j][3]); }
            mean = wsum(s) * (1.0f / DM); s2 = 0.f;
#pragma unroll
            for (int j = 0; j < 8; ++j) { v[j] = v[j] - mean; s2 += (v[j][0] * v[j][0] + v[j][1] * v[j][1]) + (v[j][2] * v[j][2] + v[j][3] * v[j][3]); }
            rstd = 1.0f / sqrtf(wsum(s2) * (1.0f / DM) + 1e-5f);
#pragma unroll
            for (int j = 0; j < 8; ++j) { const int d = 4 * (le + 64 * j);
                const f32x4 sh = *(const LAS f32x4*)(psh + d), sc1 = *(const LAS f32x4*)(psc + d);
                const f32x4 y = v[j] * rstd * sc1 + sh; v[j] = y; }
#if !defined(NAIVE_PEER)
            {
                float mx = 0.f;
#pragma unroll
                for (int j = 0; j < 8; ++j) mx = fmaxf(fmaxf(mx, fmaxf(fabsf(v[j][0]), fabsf(v[j][1]))), fmaxf(fabsf(v[j][2]), fabsf(v[j][3])));
                mx = wmax(mx);
                const float hs = mx > 0.f ? 127.0f / mx : 1.0f;
                if (lane == 0) SH[row] = mx > 0.f ? mx * (1.0f / 127.0f) : 1.0f;
#pragma unroll
                for (int j = 0; j < 8; ++j) { const int d = 4 * (le + 64 * j); const f32x4 y = v[j] * hs;
                    *(unsigned*)(H2S + (size_t)row * DM + d) = pack_i8x4(y[0], y[1], y[2], y[3]); }
            }
#endif
        }
        }
#undef P8_LOAD
    }
    GRID_BAR(8);

    for (int rep_ = 0; rep_ < (IN(9) ? 1 + ((REP_MASK >> 9) & 1) : 0); ++rep_) {
        PH_LOCALS;
        pg8::Gemm g{(const bf16_t*)H2S, (const bf16_t*)WPQ8, T, DM, DM / 2}; pg8::StaticOrder S; S.init(T, DM, G, bid);
        pg8::EpiPlainQ8 E{Qp, DM, SH, WS4}; pg8::gemm_phase(tid, lds, g, S, E);
    }
    GRID_BAR(9);


#if defined(NAIVE_TOPK)
    for (int rep_ = 0; rep_ < (IN(10) ? 1 + ((REP_MASK >> 10) & 1) : 0); ++rep_) {
        PH_LOCALS;
        LAS float* vs = (LAS float*)(lds + wave * 256);
        for (int it = gw; it < T * 8; it += NGW) {
            const int t = it >> 3, h = it & 7;
            float sA[2][2];
#pragma unroll
            for (int half = 0; half < 2; ++half) {
                const bf16_t* qp = Qp + (size_t)t * DM + h * 256 + half * 128;
                const float* kp = half ? AR.in[17] : AR.in[16];
                float s0 = 0.f, s1 = 0.f;
                for (int d = 0; d < 128; ++d) { const float qv = __uint_as_float((unsigned)qp[d] << 16); s0 += qv * kp[lane * 128 + d]; s1 += qv * kp[(lane + 64) * 128 + d]; }
                sA[half][0] = s0; sA[half][1] = s1;
            }
#pragma unroll
            for (int half = 0; half < 2; ++half) {
                float c0 = sA[half][0], c1 = sA[half][1];
                for (int r = 0; r < 16; ++r) {
                    float bv = fmaxf(c0, c1); int bi = (c0 >= c1) ? lane : lane + 64;
#pragma unroll
                    for (int o = 1; o < 64; o <<= 1) { const float ov = __shfl_xor(bv, o); const int oi = __shfl_xor(bi, o); if (ov > bv || (ov == bv && oi < bi)) { bv = ov; bi = oi; } }
                    if (lane == 0) { vs[half * 16 + r] = bv; ((LAS int*)vs)[32 + half * 16 + r] = bi; }
                    if (bi == lane) c0 = -INFINITY; if (bi == lane + 64) c1 = -INFINITY;
                }
            }
            asm volatile("s_waitcnt lgkmcnt(0)" ::: "memory");
            float cd[4];
#pragma unroll
            for (int m2 = 0; m2 < 4; ++m2) { const int c = lane + 64 * m2; cd[m2] = vs[c >> 4] + vs[16 + (c & 15)]; }
            float val[16]; int ci[16];
#pragma unroll
            for (int r = 0; r < 16; ++r) {
                float bv = cd[0]; int bi = lane;
#pragma unroll
                for (int m2 = 1; m2 < 4; ++m2) if (cd[m2] > bv) { bv = cd[m2]; bi = lane + 64 * m2; }
#pragma unroll
                for (int o = 1; o < 64; o <<= 1) { const float ov = __shfl_xor(bv, o); const int oi = __shfl_xor(bi, o); if (ov > bv || (ov == bv && oi < bi)) { bv = ov; bi = oi; } }
                val[r] = bv; ci[r] = bi;
#pragma unroll
                for (int m2 = 0; m2 < 4; ++m2) if (bi == lane + 64 * m2) cd[m2] = -INFINITY;
            }
            float se = 0.f, e[16];
#pragma unroll
            for (int r = 0; r < 16; ++r) { e[r] = __expf(val[r] - val[0]); se += e[r]; }
            if (lane < 16) {
                float ev = 0.f; int cc = 0;
#pragma unroll
                for (int r = 0; r < 16; ++r) if (lane == r) { ev = e[r]; cc = ci[r]; }
                const int i1 = ((LAS int*)vs)[32 + (cc >> 4)], i2 = ((LAS int*)vs)[48 + (cc & 15)];
                IDX[((size_t)t * 8 + h) * 16 + lane] = (unsigned short)(i1 * 128 + i2);
                Gt[((size_t)t * 8 + h) * 16 + lane] = ev / se;
            }
            asm volatile("s_waitcnt lgkmcnt(0)" ::: "memory");
        }
    }
#else
    for (int rep_ = 0; rep_ < (IN(10) ? 1 + ((REP_MASK >> 10) & 1) : 0); ++rep_) {
        PH_LOCALS;
        for (int i = tid; i < 2 * 128 * 16; i += NWAVES * 64) { const int t2 = i >> 11, rem = i & 2047, key = rem >> 4, ch = rem & 15;
            const bf16x8 v = *(const bf16x8*)((t2 ? K2b : K1b) + key * 128 + ch * 8);
            *(LAS bf16x8*)(lds + t2 * 32768 + KSWZ(key, ch * 16)) = v; }
        __syncthreads();
        const int r32 = lane & 31, hi = lane >> 5;
        LAS unsigned char* tb8 = lds + 65536 + wave * 2048 + lane * 32;
        for (int tg = bid; tg < T / 32; tg += G) {
            const int tok = tg * 32 + r32;
            int v12[2][16];
#pragma unroll
            for (int half = 0; half < 2; ++half) {
                const bf16_t* qp = Qp + (size_t)tok * DM + wave * 256 + half * 128 + hi * 8;
                bf16x8 qf[8];
#pragma unroll
                for (int d0 = 0; d0 < 8; ++d0) qf[d0] = *(const bf16x8*)(qp + d0 * 16);
                int best[16];
#pragma unroll
                for (int kb = 0; kb < 4; ++kb) {
                    f32x16 acc = f32x16{};
#pragma unroll
                    for (int d0 = 0; d0 < 8; ++d0) { const bf16x8 a = *(const LAS bf16x8*)(lds + half * 32768 + KSWZ(32 * kb + r32, (d0 * 16 + hi * 8) * 2));
                        acc = __builtin_amdgcn_mfma_f32_32x32x16_bf16(a, qf[d0], acc, 0, 0, 0); }
                    int cur[16];
#pragma unroll
                    for (int r = 0; r < 16; ++r) cur[r] = (pk::f2key(acc[r]) & ~127) | (32 * kb + (r & 3) + 8 * (r >> 2) + 4 * hi);
                    pk::sort16(cur);
                    if (kb == 0) {
#pragma unroll
                        for (int r = 0; r < 16; ++r) best[r] = cur[r];
                    } else pk::merge_top16(best, cur);
                }
                int oth[16], mine[16];
#pragma unroll
                for (int r = 0; r < 16; ++r) { auto sw = __builtin_amdgcn_permlane32_swap((unsigned)best[r], (unsigned)best[r], false, false); mine[r] = (int)sw[0]; oth[r] = (int)sw[1]; }
                pk::merge_top16(mine, oth);
#pragma unroll
                for (int r = 0; r < 16; ++r) v12[half][r] = mine[r];
            }
            {
                u32x4 w0, w1;
#pragma unroll
                for (int q = 0; q < 4; ++q) {
                    w0[q] = (unsigned)(v12[0][4 * q] & 127) | ((unsigned)(v12[0][4 * q + 1] & 127) << 8) | ((unsigned)(v12[0][4 * q + 2] & 127) << 16) | ((unsigned)(v12[0][4 * q + 3] & 127) << 24);
                    w1[q] = (unsigned)(v12[1][4 * q] & 127) | ((unsigned)(v12[1][4 * q + 1] & 127) << 8) | ((unsigned)(v12[1][4 * q + 2] & 127) << 16) | ((unsigned)(v12[1][4 * q + 3] & 127) << 24);
                }
                *(LAS u32x4*)(tb8) = w0; *(LAS u32x4*)(tb8 + 16) = w1;
            }
            float f1[16], f2[16];
#pragma unroll
            for (int r = 0; r < 16; ++r) { f1[r] = pk::key2f(v12[0][r]); f2[r] = pk::key2f(v12[1][r]); }
#define CAND(i, j) ((pk::f2key(f1[i] + f2[j]) & ~255) | ((i) * 16 + (j)))
            int M[16], Gb[16];
#pragma unroll
            for (int j = 0; j < 16; ++j) M[j] = CAND(0, j);
#pragma unroll
            for (int j = 0; j < 8; ++j) { Gb[j] = CAND(1, j); Gb[8 + j] = CAND(15 - j, 0); }
            pk::bmerge16(Gb); pk::merge_top16(M, Gb);
            Gb[0] = CAND(2, 0); Gb[1] = CAND(2, 1); Gb[2] = CAND(2, 2); Gb[3] = CAND(2, 3); Gb[4] = CAND(2, 4);
            Gb[5] = CAND(3, 0); Gb[6] = CAND(3, 1); Gb[7] = CAND(3, 2); Gb[8] = CAND(3, 3);
            Gb[9] = CAND(4, 0); Gb[10] = CAND(4, 1); Gb[11] = CAND(4, 2);
            Gb[12] = CAND(5, 0); Gb[13] = CAND(5, 1); Gb[14] = CAND(6, 0); Gb[15] = CAND(6, 1);
            pk::sort16(Gb); pk::merge_top16(M, Gb);
            Gb[0] = CAND(7, 0); Gb[1] = CAND(7, 1);
#pragma unroll
            for (int j = 2; j < 16; ++j) Gb[j] = (int)0x80000000;
            pk::merge_top16(M, Gb);
#undef CAND
            asm volatile("s_waitcnt lgkmcnt(0)" ::: "memory");
            float val[16], e[16]; float se = 0.f; unsigned short ex[16];
#pragma unroll
            for (int k = 0; k < 16; ++k) { val[k] = pk::key2f(M[k] & ~255); }
#pragma unroll
            for (int k = 0; k < 16; ++k) { e[k] = __expf(val[k] - val[0]); se += e[k];
                const int code = M[k] & 255; const unsigned i1 = *(const LAS unsigned char*)(tb8 + (code >> 4)), i2 = *(const LAS unsigned char*)(tb8 + 16 + (code & 15));
                ex[k] = (unsigned short)(i1 * 128 + i2); }
            const float inv = 1.0f / se;
#if defined(NAIVE_PEER)
            if (hi == 0) {
                u32x4 w0, w1;
#pragma unroll
                for (int q = 0; q < 4; ++q) { w0[q] = (unsigned)ex[2 * q] | ((unsigned)ex[2 * q + 1] << 16); w1[q] = (unsigned)ex[8 + 2 * q] | ((unsigned)ex[8 + 2 * q + 1] << 16); }
                u32x4* ip = (u32x4*)(IDX + ((size_t)tok * 8 + wave) * 16); ip[0] = w0; ip[1] = w1;
            } else {
                f32x4* gp = (f32x4*)(Gt + ((size_t)tok * 8 + wave) * 16);
#pragma unroll
                for (int q = 0; q < 4; ++q) gp[q] = (f32x4){e[4 * q] * inv, e[4 * q + 1] * inv, e[4 * q + 2] * inv, e[4 * q + 3] * inv};
            }
#else
            if (hi == 0) {
#pragma unroll
                for (int sl = 0; sl < 8; ++sl) *(unsigned*)(IDX2 + (size_t)tok * 128 + sl * 16 + wave * 2) = (unsigned)ex[sl] | ((unsigned)ex[sl + 8] << 16);
            } else {
#pragma unroll
                for (int sl = 0; sl < 8; ++sl) *(f32x2*)(Gt + (size_t)tok * 128 + sl * 16 + wave * 2) = (f32x2){e[sl] * inv, e[sl + 8] * inv};
            }
#endif
            asm volatile("s_waitcnt lgkmcnt(0)" ::: "memory");
        }
    }
#endif
    GRID_BAR(10);

#if defined(NAIVE_PEER)
    for (int rep_ = 0; rep_ < (IN(11) ? 1 + ((REP_MASK >> 11) & 1) : 0); ++rep_) {
        PH_LOCALS;
        const float* lg = AR.in[20]; const float* lb = AR.in[21];
        for (int t = gw; t < T; t += NGW) {
            const int b = t >> 11;
            u32x4 hv[4];
#pragma unroll
            for (int c = 0; c < 4; ++c) hv[c] = *(const u32x4*)(H2 + (size_t)t * DM + c * 512 + lane * 8);
            const unsigned idx2 = ((const unsigned*)IDX)[(size_t)t * 64 + lane];
            const f32x2 g2 = ((const f32x2*)Gt)[(size_t)t * 64 + lane];
            float a0 = 0.f, a1 = 0.f;
            for (int k = 0; k < 128; k += 4) {
                u32x4 uv[4][4];
#pragma unroll
                for (int j = 0; j < 4; ++j) { const unsigned pr = (unsigned)__builtin_amdgcn_readlane((int)idx2, (k + j) >> 1); const unsigned e = ((k + j) & 1) ? (pr >> 16) : (pr & 0xffffu);
                    const bf16_t* up = UT + (size_t)e * 2048 + lane * 8;
#pragma unroll
                    for (int c = 0; c < 4; ++c) uv[j][c] = *(const u32x4*)(up + c * 512); }
#pragma unroll
                for (int j = 0; j < 4; ++j) { float d = 0.f;
#pragma unroll
                    for (int c = 0; c < 4; ++c)
#pragma unroll
                        for (int q = 0; q < 4; ++q) { const unsigned ua = uv[j][c][q], ha = hv[c][q]; d = dot2bf(ua, ha, d); }
                    d = wave_sum(d);
                    if (lane == ((k + j) >> 1)) { if ((k + j) & 1) a1 = d; else a0 = d; } }
            }
            const float w0 = gelu_erf(a0) * g2[0], w1 = gelu_erf(a1) * g2[1];
            float acc[32];
#pragma unroll
            for (int i = 0; i < 32; ++i) acc[i] = 0.f;
            for (int k = 0; k < 128; k += 4) {
                u32x4 vv[4][4]; float wk[4];
#pragma unroll
                for (int j = 0; j < 4; ++j) { const unsigned pr = (unsigned)__builtin_amdgcn_readlane((int)idx2, (k + j) >> 1); const unsigned e = ((k + j) & 1) ? (pr >> 16) : (pr & 0xffffu);
                    wk[j] = __int_as_float(__builtin_amdgcn_readlane(__float_as_int(((k + j) & 1) ? w1 : w0), (k + j) >> 1));
                    const bf16_t* vp = VT + (size_t)e * 2048 + lane * 8;
#pragma unroll
                    for (int c = 0; c < 4; ++c) vv[j][c] = *(const u32x4*)(vp + c * 512); }
#pragma unroll
                for (int j = 0; j < 4; ++j)
#pragma unroll
                    for (int c = 0; c < 4; ++c)
#pragma unroll
                        for (int q = 0; q < 4; ++q) { acc[c * 8 + 2 * q] += wk[j] * bf_lo(vv[j][c][q]); acc[c * 8 + 2 * q + 1] += wk[j] * bf_hi(vv[j][c][q]); }
            }
            const float* mb = mod + (size_t)b * 12288 + 10240;
            float s = 0.f;
#pragma unroll
            for (int c = 0; c < 4; ++c) { const int d = c * 512 + lane * 8;
                const f32x4 x0 = *(const f32x4*)(AR.out + (size_t)t * DM + d), x1 = *(const f32x4*)(AR.out + (size_t)t * DM + d + 4);
                const f32x4 m0 = *(const f32x4*)(mb + d), m1 = *(const f32x4*)(mb + d + 4);
#pragma unroll
                for (int q = 0; q < 4; ++q) { acc[c * 8 + q] = x0[q] * DN_ALPHA + m0[q] * acc[c * 8 + q] * DBG_FFN; acc[c * 8 + 4 + q] = x1[q] * DN_ALPHA + m1[q] * acc[c * 8 + 4 + q] * DBG_FFN; }
#pragma unroll
                for (int q = 0; q < 8; ++q) s += acc[c * 8 + q]; }
            const float mean = wave_sum(s) * (1.0f / DM); float s2 = 0.f;
#pragma unroll
            for (int i = 0; i < 32; ++i) { acc[i] -= mean; s2 += acc[i] * acc[i]; }
            const float rstd = 1.0f / sqrtf(wave_sum(s2) * (1.0f / DM) + 1e-5f);
#pragma unroll
            for (int c = 0; c < 4; ++c) { const int d = c * 512 + lane * 8;
                const f32x4 g0 = *(const f32x4*)(lg + d), g1 = *(const f32x4*)(lg + d + 4), b0 = *(const f32x4*)(lb + d), b1 = *(const f32x4*)(lb + d + 4);
                f32x4 o0, o1;
#pragma unroll
                for (int q = 0; q < 4; ++q) { o0[q] = acc[c * 8 + q] * rstd * g0[q] + b0[q]; o1[q] = acc[c * 8 + 4 + q] * rstd * g1[q] + b1[q]; }
                *(f32x4*)(AR.out + (size_t)t * DM + d) = o0; *(f32x4*)(AR.out + (size_t)t * DM + d + 4) = o1; }
        }
    }
#else
    for (int rep_ = 0; rep_ < (IN(11) ? 1 + ((REP_MASK >> 11) & 1) : 0); ++rep_) {
        PH_LOCALS;
        typedef int v4i32 __attribute__((ext_vector_type(4)));
        const int xs = bid & 7, rank = bid >> 3, nrank = G >> 3;
        const int tstep = nrank * NWAVES, t0 = rank * NWAVES + wave;
        const int ntok = rank < nrank ? (T - t0 + tstep - 1) / tstep : 0;
        const int slice = xs;
        const unsigned char* Us = U8 + (size_t)slice * (2u << 20);
        LAS unsigned char* ring = lds + wave * 17408;
        const int r8d = lane >> 3, dcd = lane & 7;
        const unsigned dsw = (unsigned)((dcd ^ r8d) << 4);
        const int im = lane & 15, g = lane >> 4;
        int ura[2][2];
#pragma unroll
        for (int hi = 0; hi < 2; ++hi)
#pragma unroll
            for (int sx = 0; sx < 2; ++sx) { const int rgm = 4 * hi + (im >> 2), c = 4 * sx + g;
                ura[hi][sx] = (int)(uintptr_t)ring + (im & 3) * 1088 + rgm * 128 + ((c ^ rgm) << 4); }
#define U_GLD4(dst, sb, vo, imm) asm volatile("global_load_dwordx4 %0, %1, %2 offset:" #imm : "=v"(dst) : "v"(vo), "s"(sb) : "memory")
#define U_MISC(IA, IB, H, tt) do { const unsigned char* si_ = (const unsigned char*)IDX2 + (size_t)(tt) * 256; const unsigned char* sh_ = (const unsigned char*)H2S + (size_t)(tt) * 2048 + slice * 256; \
            U_GLD4(IA, si_, voI, 0); U_GLD4(IB, si_, voI, 16); U_GLD4(H[0], sh_, voH, 0); U_GLD4(H[1], sh_, voH, 16); U_GLD4(H[2], sh_, voH, 128); U_GLD4(H[3], sh_, voH, 144); } while (0)
#define U_MOV8(D, o, S0, S1, WAITSTR) asm volatile(WAITSTR "\n\tv_mov_b32 %0, %8\n\tv_mov_b32 %1, %9\n\tv_mov_b32 %2, %10\n\tv_mov_b32 %3, %11\n\tv_mov_b32 %4, %12\n\tv_mov_b32 %5, %13\n\tv_mov_b32 %6, %14\n\tv_mov_b32 %7, %15" \
                : "=&v"(D[o]), "=&v"(D[o + 1]), "=&v"(D[o + 2]), "=&v"(D[o + 3]), "=&v"(D[o + 4]), "=&v"(D[o + 5]), "=&v"(D[o + 6]), "=&v"(D[o + 7]) \
                : "v"(S0.x), "v"(S0.y), "v"(S0.z), "v"(S0.w), "v"(S1.x), "v"(S1.y), "v"(S1.z), "v"(S1.w) : "memory")
#define U_ROT(DI, DH, IA, IB, H, WAITSTR) do { U_MOV8(DI, 0, IA, IB, WAITSTR); U_MOV8(DH, 0, H[0], H[1], "s_nop 0"); U_MOV8(DH, 8, H[2], H[3], "s_nop 0"); } while (0)
        const unsigned voI = (unsigned)(r8d * 32), voH = (unsigned)(g * 32);
#define U_DMAQ(IX, b) do { _Pragma("unroll") for (int pc_ = 0; pc_ < 4; ++pc_) { const int m_ = 4 * (b) + pc_; const unsigned w_ = IX[m_ >> 1]; \
            const unsigned e_ = (m_ & 1) ? (w_ >> 16) : (w_ & 0xffffu); \
            __builtin_amdgcn_global_load_lds((const unsigned*)(Us + (e_ * 128u + dsw)), (LAS unsigned*)(ring + (b) * 4352 + pc_ * 1088), 16, 0, 0); } } while (0)
#define U_RD(dst, addr, off) asm volatile("ds_read_b128 %0, %1 offset:%2" : "=&v"(dst) : "v"(addr), "i"(off) : "memory")
#define U_MM(ACC, R, HH, o) do { const v4i32 lo_ = {(int)(R.x & 0x0F0F0F0Fu), (int)(R.y & 0x0F0F0F0Fu), (int)(R.z & 0x0F0F0F0Fu), (int)(R.w & 0x0F0F0F0Fu)}; \
            const v4i32 hi_ = {(int)((R.x >> 4) & 0x0F0F0F0Fu), (int)((R.y >> 4) & 0x0F0F0F0Fu), (int)((R.z >> 4) & 0x0F0F0F0Fu), (int)((R.w >> 4) & 0x0F0F0F0Fu)}; \
            const v4i32 be_ = {(int)HH[o], (int)HH[o + 2], (int)HH[o + 4], (int)HH[o + 6]}, bo_ = {(int)HH[o + 1], (int)HH[o + 3], (int)HH[o + 5], (int)HH[o + 7]}; \
            ACC = __builtin_amdgcn_mfma_i32_16x16x64_i8(lo_, be_, ACC, 0, 0, 0); ACC = __builtin_amdgcn_mfma_i32_16x16x64_i8(hi_, bo_, ACC, 0, 0, 0); } while (0)
#define U_QUARTER(b, HH) do { u32x4 r00_, r01_, r10_, r11_; \
            U_RD(r00_, ura[0][0], (b) * 4352); U_RD(r01_, ura[0][1], (b) * 4352); U_RD(r10_, ura[1][0], (b) * 4352); U_RD(r11_, ura[1][1], (b) * 4352); \
            asm volatile("s_waitcnt lgkmcnt(0)" ::: "memory"); __builtin_amdgcn_sched_barrier(0); \
            U_MM(acc[b][0], r00_, HH, 0); U_MM(acc[b][0], r01_, HH, 8); U_MM(acc[b][1], r10_, HH, 0); U_MM(acc[b][1], r11_, HH, 8); } while (0)
        if (ntok > 0) {
            u32x4 mia, mib, pia, pib, mh[4], ph[4];
            unsigned ci[8], ch[16], ni[8], nh[16];
            const int tlast = t0 + (ntok - 1) * tstep;
            U_MISC(mia, mib, mh, t0);
            { const int t1 = ntok > 1 ? t0 + tstep : t0; U_MISC(pia, pib, ph, t1); }
            U_ROT(ci, ch, mia, mib, mh, "s_waitcnt vmcnt(0)");
            U_ROT(ni, nh, pia, pib, ph, "s_nop 0");
            __builtin_amdgcn_sched_barrier(0);
            U_DMAQ(ci, 0); U_DMAQ(ci, 1); U_DMAQ(ci, 2); U_DMAQ(ci, 3);
            __builtin_amdgcn_sched_barrier(0);
            for (int i = 0; i < ntok; ++i) {
                const int t = t0 + i * tstep; const bool more = i + 1 < ntok;
                { const int tm = min(t + 2 * tstep, tlast); U_MISC(mia, mib, mh, tm); }
                __builtin_amdgcn_sched_barrier(0);
                v4i32 acc[4][2], accS = {0, 0, 0, 0};
#pragma unroll
                for (int b_ = 0; b_ < 4; ++b_) { acc[b_][0] = (v4i32){0, 0, 0, 0}; acc[b_][1] = (v4i32){0, 0, 0, 0}; }
#define U_WAITQ() do { if (!more) { asm volatile("s_waitcnt vmcnt(0)" ::: "memory"); } else if (i == 0) { asm volatile("s_waitcnt vmcnt(18)" ::: "memory"); } \
                       else { asm volatile("s_waitcnt vmcnt(20)" ::: "memory"); } __builtin_amdgcn_sched_barrier(0); } while (0)
                U_WAITQ(); U_QUARTER(0, ch); __builtin_amdgcn_sched_barrier(0); if (more) U_DMAQ(ni, 0); __builtin_amdgcn_sched_barrier(0);
                U_WAITQ(); U_QUARTER(1, ch); __builtin_amdgcn_sched_barrier(0); if (more) U_DMAQ(ni, 1); __builtin_amdgcn_sched_barrier(0);
                U_WAITQ(); U_QUARTER(2, ch); __builtin_amdgcn_sched_barrier(0); if (more) U_DMAQ(ni, 2); __builtin_amdgcn_sched_barrier(0);
                U_WAITQ(); U_QUARTER(3, ch); __builtin_amdgcn_sched_barrier(0); if (more) U_DMAQ(ni, 3); __builtin_amdgcn_sched_barrier(0);
#undef U_WAITQ
                { const v4i32 ones_ = {0x01010101, 0x01010101, 0x01010101, 0x01010101};
#pragma unroll
                  for (int o_ = 0; o_ < 16; o_ += 4) { const v4i32 hb_ = {(int)ch[o_], (int)ch[o_ + 1], (int)ch[o_ + 2], (int)ch[o_ + 3]};
                      accS = __builtin_amdgcn_mfma_i32_16x16x64_i8(ones_, hb_, accS, 0, 0, 0); } }
                { const int hoff = -8 * accS[0]; const bool hsel = (lane & 1) != 0; unsigned pw[8];
#pragma unroll
                  for (int b_ = 0; b_ < 4; ++b_) {
                      const int v0 = (hsel ? acc[b_][1][0] : acc[b_][0][0]) + hoff, v1 = (hsel ? acc[b_][1][1] : acc[b_][0][1]) + hoff;
                      const int v2 = (hsel ? acc[b_][1][2] : acc[b_][0][2]) + hoff, v3 = (hsel ? acc[b_][1][3] : acc[b_][0][3]) + hoff;
                      pw[2 * b_] = cvtpk((float)v0, (float)v1); pw[2 * b_ + 1] = cvtpk((float)v2, (float)v3); }
                  if (im < 2) { u32x4* dst_ = (u32x4*)((unsigned*)PART + ((size_t)slice * T + t) * 64 + (4 * (lane & 1) + g) * 8);
                      dst_[0] = (u32x4){pw[0], pw[1], pw[2], pw[3]}; dst_[1] = (u32x4){pw[4], pw[5], pw[6], pw[7]}; } }
                __builtin_amdgcn_sched_barrier(0);
#pragma unroll
                for (int k_ = 0; k_ < 8; ++k_) ci[k_] = ni[k_];
#pragma unroll
                for (int k_ = 0; k_ < 16; ++k_) ch[k_] = nh[k_];
                if (more) U_ROT(ni, nh, mia, mib, mh, "s_waitcnt vmcnt(18)"); else U_ROT(ni, nh, mia, mib, mh, "s_waitcnt vmcnt(0)");
                __builtin_amdgcn_sched_barrier(0);
            }
            asm volatile("s_waitcnt vmcnt(0)" ::: "memory");
        }
#undef U_GLD4
#undef U_MISC
#undef U_MOV8
#undef U_ROT
#undef U_DMAQ
#undef U_RD
#undef U_MM
#undef U_QUARTER
    }
    GRID_BAR(11);

    for (int rep_ = 0; rep_ < (IN(12) ? 1 + ((REP_MASK >> 12) & 1) : 0); ++rep_) {
        PH_LOCALS;
        unsigned nidx, npv[8]; f32x2 ng; float nhs, nsu0, nsu1, nsv0, nsv1;
#define P12_LOAD(tt) do { nidx = ((const unsigned*)IDX2)[(size_t)(tt) * 64 + lane]; ng = ((const f32x2*)Gt)[(size_t)(tt) * 64 + lane]; nhs = SH[(tt)]; \
            _Pragma("unroll") for (int sl = 0; sl < 8; ++sl) npv[sl] = ((const unsigned*)PART)[((size_t)sl * T + (tt)) * 64 + lane]; } while (0)
#define P12_SCALES() do { const unsigned e0_ = nidx & 0xffffu, e1_ = nidx >> 16; nsu0 = SU[e0_]; nsu1 = SU[e1_]; nsv0 = SU[NE + e0_]; nsv1 = SU[NE + e1_]; } while (0)
        if (gw < T) { P12_LOAD(gw); P12_SCALES(); }
        for (int t = gw; t < T; t += NGW) {
            const f32x2 g2 = ng; const float hs = nhs, su0 = nsu0, su1 = nsu1, sv0 = nsv0, sv1 = nsv1;
            f32x2 a = {0.f, 0.f};
#pragma unroll
            for (int sl = 0; sl < 8; ++sl) { const unsigned pv = npv[sl]; a[0] += bf_lo(pv); a[1] += bf_hi(pv); }
            if (t + NGW < T) P12_LOAD(t + NGW);
            const float w0 = gelu_erf(a[0] * hs * su0) * g2[0] * sv0, w1 = gelu_erf(a[1] * hs * su1) * g2[1] * sv1;
            const float wm = wmax(fmaxf(fabsf(w0), fabsf(w1)));
            const float qs = wm > 0.f ? 127.0f / wm : 1.0f;
            const int q0 = (int)__builtin_rintf(w0 * qs), q1 = (int)__builtin_rintf(w1 * qs);
            { const float wsc_ = wm > 0.f ? wm * (1.0f / 127.0f) : 1.0f, qsum = wsum((float)(q0 + q1));
              if (lane == 0) *(f32x2*)(WSC + 2 * (size_t)t) = (f32x2){wsc_, -8.0f * wsc_ * qsum}; }
            { const int j0 = 2 * lane, j1 = j0 + 1;
              WTq[(size_t)t * 128 + (j0 & 15) * 8 + (j0 >> 4)] = (unsigned char)((unsigned)q0 & 255u);
              WTq[(size_t)t * 128 + (j1 & 15) * 8 + (j1 >> 4)] = (unsigned char)((unsigned)q1 & 255u); }
            if (t + NGW < T) P12_SCALES();
        }
#undef P12_LOAD
#undef P12_SCALES
    }
    GRID_BAR(12);

    for (int rep_ = 0; rep_ < (IN(13) ? 1 + ((REP_MASK >> 13) & 1) : 0); ++rep_) {
        PH_LOCALS;
        typedef int v4i32 __attribute__((ext_vector_type(4)));
        const int xs = bid & 7, rank = bid >> 3, nrank = G >> 3;
        const int tstep = nrank * NWAVES, t0 = rank * NWAVES + wave;
        const int ntok = rank < nrank ? (T - t0 + tstep - 1) / tstep : 0;
        LAS unsigned char* ring = lds + wave * 17408;
        const int r8d = lane >> 3, dcd = lane & 7;
        const unsigned dsw = (unsigned)((dcd ^ r8d) << 4);
        const int g = lane >> 4, q4 = (lane >> 2) & 3, p4 = lane & 3;
        int tra[2][4];
#pragma unroll
        for (int hh = 0; hh < 2; ++hh)
#pragma unroll
            for (int nb = 0; nb < 4; ++nb) { const int r8 = 4 * hh + q4, c = 2 * nb + (p4 >> 1);
                tra[hh][nb] = (int)(uintptr_t)ring + g * 1088 + r8 * 128 + ((c ^ r8) << 4) + (p4 & 1) * 8; }
#define V_GLD4(dst, sb, vo, imm) asm volatile("global_load_dwordx4 %0, %1, %2 offset:" #imm : "=v"(dst) : "v"(vo), "s"(sb) : "memory")
#define V_GLD2(dst, sb, vo, imm) asm volatile("global_load_dwordx2 %0, %1, %2 offset:" #imm : "=v"(dst) : "v"(vo), "s"(sb) : "memory")
#define V_GLD1(dst, sb, vo)      asm volatile("global_load_dword %0, %1, %2" : "=v"(dst) : "v"(vo), "s"(sb) : "memory")
#define V_MISC(IA, IB, W, SC, tt) do { const unsigned char* si_ = (const unsigned char*)IDX2 + (size_t)(tt) * 256; const unsigned char* sw_ = (const unsigned char*)WTq + (size_t)(tt) * 128; \
            const float* sc_ = WSC + 2 * (size_t)(tt); V_GLD4(IA, si_, voI, 0); V_GLD4(IB, si_, voI, 16); V_GLD2(W[0], sw_, voW, 0); V_GLD2(W[1], sw_, voW, 32); V_GLD2(W[2], sw_, voW, 64); V_GLD2(W[3], sw_, voW, 96); \
            V_GLD2(SC, sc_, voZ, 0); } while (0)
#define V_ROT(DI, DW, DSC, IA, IB, W, SC, WAITSTR) do { \
            asm volatile(WAITSTR "\n\tv_mov_b32 %0, %8\n\tv_mov_b32 %1, %9\n\tv_mov_b32 %2, %10\n\tv_mov_b32 %3, %11\n\tv_mov_b32 %4, %12\n\tv_mov_b32 %5, %13\n\tv_mov_b32 %6, %14\n\tv_mov_b32 %7, %15" \
                : "=&v"(DI[0]), "=&v"(DI[1]), "=&v"(DI[2]), "=&v"(DI[3]), "=&v"(DI[4]), "=&v"(DI[5]), "=&v"(DI[6]), "=&v"(DI[7]) \
                : "v"(IA.x), "v"(IA.y), "v"(IA.z), "v"(IA.w), "v"(IB.x), "v"(IB.y), "v"(IB.z), "v"(IB.w) : "memory"); \
            asm volatile("v_mov_b32 %0, %10\n\tv_mov_b32 %1, %11\n\tv_mov_b32 %2, %12\n\tv_mov_b32 %3, %13\n\tv_mov_b32 %4, %14\n\tv_mov_b32 %5, %15\n\tv_mov_b32 %6, %16\n\tv_mov_b32 %7, %17\n\tv_mov_b32 %8, %18\n\tv_mov_b32 %9, %19" \
                : "=&v"(DW[0]), "=&v"(DW[1]), "=&v"(DW[2]), "=&v"(DW[3]), "=&v"(DW[4]), "=&v"(DW[5]), "=&v"(DW[6]), "=&v"(DW[7]), "=&v"(DSC[0]), "=&v"(DSC[1]) \
                : "v"(W[0].x), "v"(W[0].y), "v"(W[1].x), "v"(W[1].y), "v"(W[2].x), "v"(W[2].y), "v"(W[3].x), "v"(W[3].y), "v"(SC.x), "v"(SC.y) : "memory"); } while (0)
        const unsigned voI = (unsigned)(r8d * 32), voW = (unsigned)(g * 8), voZ = 0u;
#define V_DMAQ(IX, b) do { _Pragma("unroll") for (int pc_ = 0; pc_ < 4; ++pc_) { const int m_ = 4 * (b) + pc_; const unsigned w_ = IX[m_ >> 1]; \
            const unsigned e_ = (m_ & 1) ? (w_ >> 16) : (w_ & 0xffffu); \
            __builtin_amdgcn_global_load_lds((const unsigned*)(Vs + (e_ * 128u + dsw)), (LAS unsigned*)(ring + (b) * 4352 + pc_ * 1088), 16, 0, 0); } } while (0)
#define V_TR(dst, addr, off) asm volatile("ds_read_b64_tr_b16 %0, %1 offset:%2" : "=&v"(dst) : "v"(addr), "i"(off) : "memory")
#define V_QUARTER(b, W) do { \
            const unsigned wlo_ = W[2 * (b)], whi_ = W[2 * (b) + 1]; \
            const v4i32 a_ = {(int)__builtin_amdgcn_perm(wlo_, wlo_, sel0), (int)__builtin_amdgcn_perm(wlo_, wlo_, sel1), (int)__builtin_amdgcn_perm(whi_, whi_, sel0), (int)__builtin_amdgcn_perm(whi_, whi_, sel1)}; \
            u32x2 x0_, x1_, x2_, x3_, y0_, y1_, y2_, y3_; \
            V_TR(x0_, tra[0][0], (b) * 4352); V_TR(y0_, tra[1][0], (b) * 4352); V_TR(x1_, tra[0][1], (b) * 4352); V_TR(y1_, tra[1][1], (b) * 4352); \
            V_TR(x2_, tra[0][2], (b) * 4352); V_TR(y2_, tra[1][2], (b) * 4352); V_TR(x3_, tra[0][3], (b) * 4352); V_TR(y3_, tra[1][3], (b) * 4352); \
            asm volatile("s_waitcnt lgkmcnt(0)" ::: "memory"); __builtin_amdgcn_sched_barrier(0); \
            V_MM(0, x0_, y0_); V_MM(1, x1_, y1_); V_MM(2, x2_, y2_); V_MM(3, x3_, y3_); } while (0)
#define V_MM(nb, X, Y) do { const v4i32 lo_ = {(int)(X.x & 0x0F0F0F0Fu), (int)(X.y & 0x0F0F0F0Fu), (int)(Y.x & 0x0F0F0F0Fu), (int)(Y.y & 0x0F0F0F0Fu)}; \
            const v4i32 hi_ = {(int)((X.x >> 4) & 0x0F0F0F0Fu), (int)((X.y >> 4) & 0x0F0F0F0Fu), (int)((Y.x >> 4) & 0x0F0F0F0Fu), (int)((Y.y >> 4) & 0x0F0F0F0Fu)}; \
            aL[nb] = __builtin_amdgcn_mfma_i32_16x16x64_i8(a_, lo_, aL[nb], 0, 0, 0); aH[nb] = __builtin_amdgcn_mfma_i32_16x16x64_i8(a_, hi_, aH[nb], 0, 0, 0); } while (0)
        const unsigned sel0 = (lane & 1) ? 0x010C000Cu : 0x0C010C00u, sel1 = (lane & 1) ? 0x030C020Cu : 0x0C030C02u;
        {
            const int slice = xs;
            const unsigned char* Vs = U8 + (32u << 20) + (size_t)slice * (2u << 20);
            if (ntok > 0) {
                u32x4 mia, mib, pia, pib; u32x2 mwq[4], pwq[4]; f32x2 mwsc, pwsc;
                unsigned ci[8], cw[8], ni[8], nw[8]; float wsc[2], nsc[2];
                const int tlast = t0 + (ntok - 1) * tstep;
                V_MISC(mia, mib, mwq, mwsc, t0);
                { const int t1 = ntok > 1 ? t0 + tstep : t0; V_MISC(pia, pib, pwq, pwsc, t1); }
                V_ROT(ci, cw, wsc, mia, mib, mwq, mwsc, "s_waitcnt vmcnt(0)");
                V_ROT(ni, nw, nsc, pia, pib, pwq, pwsc, "s_nop 0");
                __builtin_amdgcn_sched_barrier(0);
                V_DMAQ(ci, 0); V_DMAQ(ci, 1); V_DMAQ(ci, 2); V_DMAQ(ci, 3);
                __builtin_amdgcn_sched_barrier(0);
                for (int i = 0; i < ntok; ++i) {
                    const int t = t0 + i * tstep; const bool more = i + 1 < ntok;
                    { const int tm = min(t + 2 * tstep, tlast); V_MISC(mia, mib, mwq, mwsc, tm); }
                    __builtin_amdgcn_sched_barrier(0);
                    v4i32 aL[4], aH[4];
#pragma unroll
                    for (int nb = 0; nb < 4; ++nb) { aL[nb] = (v4i32){0, 0, 0, 0}; aH[nb] = (v4i32){0, 0, 0, 0}; }
#define V_WAITQ() do { if (!more) { asm volatile("s_waitcnt vmcnt(0)" ::: "memory"); } else if (i == 0) { asm volatile("s_waitcnt vmcnt(19)" ::: "memory"); } \
                       else { asm volatile("s_waitcnt vmcnt(20)" ::: "memory"); } __builtin_amdgcn_sched_barrier(0); } while (0)
                    V_WAITQ(); V_QUARTER(0, cw); __builtin_amdgcn_sched_barrier(0); if (more) V_DMAQ(ni, 0); __builtin_amdgcn_sched_barrier(0);
                    V_WAITQ(); V_QUARTER(1, cw); __builtin_amdgcn_sched_barrier(0); if (more) V_DMAQ(ni, 1); __builtin_amdgcn_sched_barrier(0);
                    V_WAITQ(); V_QUARTER(2, cw); __builtin_amdgcn_sched_barrier(0); if (more) V_DMAQ(ni, 2); __builtin_amdgcn_sched_barrier(0);
                    V_WAITQ(); V_QUARTER(3, cw); __builtin_amdgcn_sched_barrier(0); if (more) V_DMAQ(ni, 3); __builtin_amdgcn_sched_barrier(0);
#undef V_WAITQ
                    { const int nbs = lane >> 4;
#define V_SEL(A, r) (nbs == 0 ? A[0][r] : (nbs == 1 ? A[1][r] : (nbs == 2 ? A[2][r] : A[3][r])))
                      const float d0 = (float)V_SEL(aL, 0) * wsc[0] + wsc[1], d1 = (float)V_SEL(aH, 0) * wsc[0] + wsc[1];
                      const float d2 = (float)V_SEL(aL, 1) * wsc[0] + wsc[1], d3 = (float)V_SEL(aH, 1) * wsc[0] + wsc[1];
#undef V_SEL
                      *(u32x2*)(FFN + (size_t)t * DM + slice * 256 + 4 * lane) = (u32x2){cvtpk(d0, d1), cvtpk(d2, d3)}; }
                    __builtin_amdgcn_sched_barrier(0);
#pragma unroll
                    for (int k_ = 0; k_ < 8; ++k_) { ci[k_] = ni[k_]; cw[k_] = nw[k_]; }
                    wsc[0] = nsc[0]; wsc[1] = nsc[1];
                    if (more) V_ROT(ni, nw, nsc, mia, mib, mwq, mwsc, "s_waitcnt vmcnt(17)"); else V_ROT(ni, nw, nsc, mia, mib, mwq, mwsc, "s_waitcnt vmcnt(0)");
                    __builtin_amdgcn_sched_barrier(0);
                }
                asm volatile("s_waitcnt vmcnt(0)" ::: "memory");
            }
        }
#undef V_GLD4
#undef V_GLD2
#undef V_GLD1
#undef V_MISC
#undef V_ROT
#undef V_DMAQ
#undef V_TR
#undef V_QUARTER
#undef V_MM
    }
    GRID_BAR(13);

    for (int rep_ = 0; rep_ < (IN(14) ? 1 + ((REP_MASK >> 14) & 1) : 0); ++rep_) {
        PH_LOCALS;
        const int nb_ = G >> 4, b = bid / nb_, r0 = (bid % nb_) * NWAVES + wave, rstep = nb_ * NWAVES;
        LAS float* pg2 = (LAS float*)lds; LAS float* plg = pg2 + 2048; LAS float* plb = pg2 + 4096;
        __syncthreads();
        if (b < 16) { *(LAS f32x4*)(pg2 + 4 * tid) = *(const f32x4*)(mod + (size_t)b * 12288 + 10240 + 4 * tid);
            *(LAS f32x4*)(plg + 4 * tid) = *(const f32x4*)(AR.in[20] + 4 * tid); *(LAS f32x4*)(plb + 4 * tid) = *(const f32x4*)(AR.in[21] + 4 * tid); }
        __syncthreads();
        if (b < 16) {
        u32x4 nx[4]; u32x4 nf[4];
#define P14_LOAD(tt) do { _Pragma("unroll") for (int c = 0; c < 4; ++c) { const int d_ = c * 512 + lane * 8; nf[c] = *(const u32x4*)(FFN + (size_t)(tt) * DM + d_); \
            nx[c] = *(const u32x4*)(X1b + (size_t)(tt) * DM + d_); } } while (0)
        P14_LOAD(b * 2048 + r0);
        for (int r = r0; r < 2048; r += rstep) {
            const int t = b * 2048 + r;
            float acc[32]; float s = 0.f;
#pragma unroll
            for (int c = 0; c < 4; ++c) { const int d = c * 512 + lane * 8;
                const u32x4 fv = nf[c]; const u32x4 xv = nx[c]; const unsigned xa = xv.x, xb = xv.y, xc = xv.z, xd = xv.w;
                const f32x4 x0 = {bf_lo(xa), bf_hi(xa), bf_lo(xb), bf_hi(xb)}, x1 = {bf_lo(xc), bf_hi(xc), bf_lo(xd), bf_hi(xd)};
                const f32x4 m0 = *(const LAS f32x4*)(pg2 + d), m1 = *(const LAS f32x4*)(pg2 + d + 4);
                const unsigned f0 = fv.x, f1 = fv.y, f2 = fv.z, f3 = fv.w;
                acc[c * 8 + 0] = x0[0] * DN_ALPHA + m0[0] * bf_lo(f0); acc[c * 8 + 1] = x0[1] * DN_ALPHA + m0[1] * bf_hi(f0);
                acc[c * 8 + 2] = x0[2] * DN_ALPHA + m0[2] * bf_lo(f1); acc[c * 8 + 3] = x0[3] * DN_ALPHA + m0[3] * bf_hi(f1);
                acc[c * 8 + 4] = x1[0] * DN_ALPHA + m1[0] * bf_lo(f2); acc[c * 8 + 5] = x1[1] * DN_ALPHA + m1[1] * bf_hi(f2);
                acc[c * 8 + 6] = x1[2] * DN_ALPHA + m1[2] * bf_lo(f3); acc[c * 8 + 7] = x1[3] * DN_ALPHA + m1[3] * bf_hi(f3);
#pragma unroll
                for (int q = 0; q < 8; ++q) s += acc[c * 8 + q]; }
            if (r + rstep < 2048) P14_LOAD(t + rstep);
            const float mean = wsum(s) * (1.0f / DM); float s2 = 0.f;
#pragma unroll
            for (int i = 0; i < 32; ++i) { acc[i] -= mean; s2 += acc[i] * acc[i]; }
            const float rstd = 1.0f / sqrtf(wsum(s2) * (1.0f / DM) + 1e-5f);
#pragma unroll
            for (int c = 0; c < 4; ++c) { const int d = c * 512 + lane * 8;
                const f32x4 g0 = *(const LAS f32x4*)(plg + d), g1 = *(const LAS f32x4*)(plg + d + 4), b0 = *(const LAS f32x4*)(plb + d), b1 = *(const LAS f32x4*)(plb + d + 4);
                f32x4 o0, o1;
#pragma unroll
                for (int q = 0; q < 4; ++q) { o0[q] = acc[c * 8 + q] * rstd * g0[q] + b0[q]; o1[q] = acc[c * 8 + 4 + q] * rstd * g1[q] + b1[q]; }
                *(f32x4*)(AR.out + (size_t)t * DM + d) = o0; *(f32x4*)(AR.out + (size_t)t * DM + d + 4) = o1; }
        }
        }
    }
#endif
#undef IN
#undef GRID_BAR
}

extern "C" void kernel_launch(void* const* d_in, const int* in_sizes, int n_in, void* d_out, int out_size, void* d_ws, size_t ws_size, hipStream_t stream) {
    static int grid = 0;
    if (grid == 0) {
        if (n_in != 22 || out_size != T * DM || ws_size < WS_END) { fprintf(stderr, "kernel_launch: unexpected shapes (n_in %d out %d ws %zu)\n", n_in, out_size, ws_size); grid = -1; return; }
        int dev = 0, cus = 0, per_cu = 0;
        if (hipGetDevice(&dev) != hipSuccess || hipDeviceGetAttribute(&cus, hipDeviceAttributeMultiprocessorCount, dev) != hipSuccess) { grid = -1; return; }
        if (hipFuncSetAttribute((const void*)mega_fwd, hipFuncAttributeMaxDynamicSharedMemorySize, LDS_BYTES) != hipSuccess) { fprintf(stderr, "kernel_launch: hipFuncSetAttribute failed\n"); grid = -1; return; }
        if (hipOccupancyMaxActiveBlocksPerMultiprocessor(&per_cu, (const void*)mega_fwd, NWAVES * 64, LDS_BYTES) != hipSuccess || per_cu < 1) { fprintf(stderr, "kernel_launch: occupancy query says %d\n", per_cu); grid = -1; (void)hipGetLastError(); return; }
        grid = cus;
    }
    if (grid < 0) return;
    (void)hipMemsetAsync(d_ws, 0, 16384, stream);
    Args a{};
    for (int i = 0; i < 22; ++i) a.in[i] = (const float*)d_in[i];
    a.out = (float*)d_out; a.ws = (unsigned char*)d_ws;
#if MK_N_LAUNCHES == 1
    a.ph_lo = 0; a.ph_hi = N_PHASES;
    void* kargs[] = {&a};
    hipError_t e = hipLaunchCooperativeKernel((const void*)mega_fwd, dim3(grid), dim3(NWAVES * 64), kargs, LDS_BYTES, stream);
    if (e != hipSuccess) fprintf(stderr, "kernel_launch: cooperative launch failed: %s (grid %d)\n", hipGetErrorString(e), grid);
#else
    for (int p = 0; p < N_PHASES; ++p) {
        a.ph_lo = p; a.ph_hi = p + 1;
        hipLaunchKernelGGL(mega_fwd, dim3(grid), dim3(NWAVES * 64), LDS_BYTES, stream, a);
    }
    const hipError_t le = hipPeekAtLastError();
    if (le != hipSuccess) fprintf(stderr, "kernel_launch: launch failed: %s\n", hipGetErrorName(le));
#endif
}
```

```cpp
#include <hip/hip_runtime.h>
#include <hip/hip_cooperative_groups.h>
#include <cstdio>
#include <cstdint>
namespace cg = cooperative_groups;

#ifndef MK_N_LAUNCHES
#define MK_N_LAUNCHES 1
#ifndef REP_MASK
#define REP_MASK 0
#endif
#define DBG_MIX 1.0f
#define DBG_FFN 1.0f
#endif

#define LAS __attribute__((address_space(3)))
typedef unsigned short bf16_t;
typedef short bf16x8 __attribute__((ext_vector_type(8)));
typedef short s16x4 __attribute__((ext_vector_type(4)));
typedef float f32x2 __attribute__((ext_vector_type(2)));
typedef float f32x4 __attribute__((ext_vector_type(4)));
typedef float f32x16 __attribute__((ext_vector_type(16)));
typedef unsigned u32x2 __attribute__((ext_vector_type(2)));
typedef unsigned u32x4 __attribute__((ext_vector_type(4)));
typedef int i32x4 __attribute__((ext_vector_type(4)));
typedef __bf16 bf16x2_t __attribute__((ext_vector_type(2)));

constexpr int NB = 16, SEQ = 2048, DM = 2048, T = NB * SEQ;
constexpr int NPROJ = 4160, NPROJ_PAD = 4352;
constexpr float DN_ALPHA = 1.189207115002721f;
constexpr int NE = 16384;

constexpr size_t MiB = 1u << 20;
constexpr size_t WS_MOD = 1 * MiB;
constexpr size_t WS_ROPEA = 2 * MiB;
constexpr size_t WS_ROPEB = 2 * MiB + 256 * 1024;
constexpr size_t WS_CQS = 2 * MiB;
constexpr size_t WS_CMQ = 2 * MiB + 262144;
constexpr size_t WS_WSQ = 2 * MiB + 327680;
constexpr size_t WS_SSQ_Q = 3 * MiB;
constexpr size_t WS_SSQ_KV = 4 * MiB;
constexpr size_t WS_SSQ_O = 5 * MiB;
constexpr size_t WS_SM = 7 * MiB;
constexpr size_t WS_SL = 8 * MiB;
constexpr size_t WS_K1 = 9 * MiB;
constexpr size_t WS_K2 = 9 * MiB + 32768;
constexpr size_t WS_WIN = 10 * MiB;
constexpr size_t WS_WUQ = 27 * MiB;
constexpr size_t WS_WUKV = 29 * MiB;
constexpr size_t WS_WO = 31 * MiB;
constexpr size_t WS_WPQ = 39 * MiB;
constexpr size_t WS_UT = 64 * MiB;
constexpr size_t WS_VT = 128 * MiB;
constexpr size_t WS_A = 192 * MiB;
constexpr size_t WS_QA = 320 * MiB, WS_KA = 384 * MiB, WS_VA = 448 * MiB, WS_CQ = 512 * MiB, WS_CKV = 544 * MiB, WS_KR = 576 * MiB;
constexpr size_t WS_Y = 320 * MiB;
constexpr size_t WS_QN = 580 * MiB, WS_QR = 644 * MiB, WS_KN = 676 * MiB, WS_VB = 740 * MiB;
constexpr size_t WS_H2 = 580 * MiB;
constexpr size_t WS_O = 804 * MiB;
constexpr size_t WS_IDX = 932 * MiB;
constexpr size_t WS_G = 940 * MiB;
constexpr size_t WS_END = 972 * MiB;
constexpr size_t WS_SU = 9 * MiB + 65536;
constexpr size_t WS_SH = 9 * MiB + 196608;
constexpr size_t WS_CMAX = 9 * MiB + 327680;
constexpr size_t WS_WS1 = 9 * MiB + 491520;
constexpr size_t WS_HS1 = 9 * MiB + 524288;
constexpr size_t WS_CMAX2 = 9 * MiB + 655360;
constexpr size_t WS_WS4 = 9 * MiB + 720896;
constexpr size_t WS_OS = 9 * MiB + 786432;
constexpr size_t WS_CMAX3 = 9 * MiB + 917504;
constexpr size_t WS_WS3 = 9 * MiB + 983040;
constexpr size_t WS_U8 = 64 * MiB;
constexpr size_t WS_V8 = 96 * MiB;
constexpr size_t WS_PART = 320 * MiB;
constexpr size_t WS_H8 = 804 * MiB;
constexpr size_t WS_IDX2 = 932 * MiB;
constexpr size_t WS_WT = 956 * MiB;
constexpr size_t WS_H2S = 128 * MiB;
constexpr size_t WS_X1 = 804 * MiB;
constexpr size_t WS_FFN = 192 * MiB;

constexpr int NWAVES = 8;
constexpr int LDS_BYTES = 147456;

__device__ __forceinline__ int opaque(int v) { asm volatile("" : "+v"(v)); return v; }
__device__ __forceinline__ unsigned cvtpk(float lo, float hi) { f32x2 v = {lo, hi}; bf16x2_t b = __builtin_convertvector(v, bf16x2_t); return __builtin_bit_cast(unsigned, b); }
__device__ __forceinline__ float dot2bf(unsigned a, unsigned b, float c) { return __builtin_amdgcn_fdot2_f32_bf16(__builtin_bit_cast(bf16x2_t, a), __builtin_bit_cast(bf16x2_t, b), c, false); }
__device__ __forceinline__ void fmac(float& d, float a, float b) { asm("v_fmac_f32_e32 %0, %1, %2" : "+v"(d) : "v"(a), "v"(b)); }
__device__ __forceinline__ float bf_lo(unsigned u) { return __uint_as_float(u << 16); }
__device__ __forceinline__ float bf_hi(unsigned u) { return __uint_as_float(u & 0xffff0000u); }
#define DPPF(v, ctrl) __builtin_bit_cast(float, __builtin_amdgcn_update_dpp(0, __builtin_bit_cast(int, (v)), (ctrl), 0xf, 0xf, false))
#define RLF(v, l) __builtin_bit_cast(float, __builtin_amdgcn_readlane(__builtin_bit_cast(int, (v)), (l)))
__device__ __forceinline__ float wsum(float v) {
    v += DPPF(v, 0xB1); v += DPPF(v, 0x4E); v += DPPF(v, 0x141); v += DPPF(v, 0x140);
    return (RLF(v, 0) + RLF(v, 16)) + (RLF(v, 32) + RLF(v, 48));
}
__device__ __forceinline__ float wmax(float v) {
    v = fmaxf(v, DPPF(v, 0xB1)); v = fmaxf(v, DPPF(v, 0x4E)); v = fmaxf(v, DPPF(v, 0x141)); v = fmaxf(v, DPPF(v, 0x140));
    return fmaxf(fmaxf(RLF(v, 0), RLF(v, 16)), fmaxf(RLF(v, 32), RLF(v, 48)));
}
__device__ __forceinline__ float wave_max(float v) {
#pragma unroll
    for (int o = 1; o < 64; o <<= 1) v = fmaxf(v, __shfl_xor(v, o));
    return v;
}
__device__ __forceinline__ unsigned pack_fp8x4(float a, float b, float c, float d) {
    int w = __builtin_amdgcn_cvt_pk_fp8_f32(a, b, 0, false); w = __builtin_amdgcn_cvt_pk_fp8_f32(c, d, w, true); return (unsigned)w;
}
__device__ __forceinline__ unsigned pack_i8x4(float a, float b, float c, float d) {
    const int ia = (int)__builtin_rintf(a), ib = (int)__builtin_rintf(b), ic = (int)__builtin_rintf(c), id = (int)__builtin_rintf(d);
    return ((unsigned)ia & 255u) | (((unsigned)ib & 255u) << 8) | (((unsigned)ic & 255u) << 16) | ((unsigned)id << 24);
}
__device__ __forceinline__ float wave_sum(float v) {
#pragma unroll
    for (int o = 1; o < 64; o <<= 1) v += __shfl_xor(v, o);
    return v;
}

namespace pg8 {
constexpr int BM = 256, BK = 64, HALF = 128, HTB = HALF * BK * 2, STAGE_BYTES = 8 * HTB, NXCD = 8, WGM = 8;
__host__ __device__ __forceinline__ int lds_byte(int r, int c) { const int st = (r >> 4) * 2 + (c >> 5), rr = r & 15, cc = c & 31, ob = rr * 64 + cc * 2; return st * 1024 + (ob ^ (((ob >> 9) & 1) << 5)); }
__host__ __device__ __forceinline__ void stage_rc(int b, int& R, int& C) { const int st = b / 1024, sb = b % 1024, swz = sb ^ (((sb >> 9) & 1) << 5); R = (st >> 1) * 16 + swz / 64; C = (st & 1) * 32 + (swz % 64) / 2; }
__host__ __device__ __forceinline__ int perm32(int rho) { const int n = rho >> 4, i = rho & 15; return 8 * (i >> 2) + 4 * n + (i & 3); }

struct Unit { int pm, pn; };
struct Gemm { const bf16_t* A; const bf16_t* Bt; int M, N, K; };

struct StaticOrder {
    int nM, nN, nwg, G, c;
    __host__ __device__ __forceinline__ void init(int M, int N, int G_, int c_) { nM = M / BM; nN = N / BM; nwg = nM * nN; G = G_; c = c_; }
    __host__ __device__ __forceinline__ bool next(int i, Unit& u) const {
        const long L = (long)i * G + c; if (L >= nwg) return false;
        int wgid = (int)L; { const int q = nwg / NXCD, r = nwg % NXCD, xcd = wgid % NXCD, off = wgid / NXCD; wgid = (xcd < r ? xcd * (q + 1) : r * (q + 1) + (xcd - r) * q) + off; }
        const int nig = WGM * nN, gid = wgid / nig, fm = gid * WGM, gsz = (nM - fm) < WGM ? (nM - fm) : WGM;
        u.pm = fm + ((wgid % nig) % gsz); u.pn = (wgid % nig) / gsz; return true;
    }
};

template <class Epi, class Sched>
__device__ __forceinline__ void gemm_phase(const int tid, LAS unsigned char* lds, const Gemm g, const Sched& S, const Epi& E) {
    const int wid = __builtin_amdgcn_readfirstlane(tid >> 6), lane = tid & 63, wr = wid >> 2, wc = wid & 3, fr = lane & 15, fq = lane >> 4;
    const int K = g.K, nt = K / BK;
    unsigned voffA[2], voffB[2];
#pragma unroll
    for (int i = 0; i < 2; ++i) { int R, C; stage_rc(tid * 16 + i * 8192, R, C); const int Rb = Epi::PERM ? ((R & ~31) + perm32(R & 31)) : R;
        voffA[i] = (unsigned)(R * K + C) * 2u; voffB[i] = (unsigned)(Rb * K + C) * 2u; }
    const size_t kstep = (size_t)(BK * 2);
    const size_t hstep = (size_t)HALF * K * 2;
    const size_t tstep = 2 * hstep;
    const unsigned ldsw = (unsigned)wid * 1024u;
    const int aoff = lds_byte(wr * 64 + fr, fq * 8), boff = lds_byte(wc * 32 + fr, fq * 8);
#define PG8_SA(b, h) (((b) * 2 + (h)) * HTB)
#define PG8_SB(b, h) ((4 + (b) * 2 + (h)) * HTB)
#define PG8_STAGE(bufoff, gbase, voff) do { _Pragma("unroll") for (int _i = 0; _i < 2; ++_i) \
        __builtin_amdgcn_global_load_lds((const unsigned*)((const char*)(gbase) + (voff)[_i]), (LAS unsigned*)(lds + (bufoff) + ldsw + _i * 8192), 16, 0, 0); } while (0)
#define PG8_LDA(dst, b, h) do { _Pragma("unroll") for (int m = 0; m < 4; ++m) _Pragma("unroll") for (int k = 0; k < 2; ++k) dst[m][k] = *(const LAS bf16x8*)(lds + PG8_SA(b, h) + aoff + m * 2048 + k * 1024); } while (0)
#define PG8_LDB(dst, b, h) do { _Pragma("unroll") for (int n = 0; n < 2; ++n) _Pragma("unroll") for (int k = 0; k < 2; ++k) dst[n][k] = *(const LAS bf16x8*)(lds + PG8_SB(b, h) + boff + n * 2048 + k * 1024); } while (0)
#define PG8_MMA(ai, bj, At, Bt) do { __builtin_amdgcn_s_setprio(1); _Pragma("unroll") for (int m = 0; m < 4; ++m) _Pragma("unroll") for (int n = 0; n < 2; ++n) _Pragma("unroll") for (int k = 0; k < 2; ++k) \
        { if constexpr (Epi::I8) acc[ai][bj][m][n] = __builtin_bit_cast(f32x4, __builtin_amdgcn_mfma_i32_16x16x64_i8(__builtin_bit_cast(i32x4, Bt[n][k]), __builtin_bit_cast(i32x4, At[m][k]), __builtin_bit_cast(i32x4, acc[ai][bj][m][n]), 0, 0, 0)); \
          else acc[ai][bj][m][n] = __builtin_amdgcn_mfma_f32_16x16x32_bf16(Bt[n][k], At[m][k], acc[ai][bj][m][n], 0, 0, 0); } __builtin_amdgcn_s_setprio(0); } while (0)
#define PG8_WAIT_V(n) asm volatile("s_waitcnt vmcnt(" #n ")" ::: "memory")
#define PG8_WAIT_L(n) asm volatile("s_waitcnt lgkmcnt(" #n ")" ::: "memory")
#define PG8_BAR __builtin_amdgcn_s_barrier()
#define PG8_SCHED __builtin_amdgcn_sched_barrier(0)
    Unit cur, nxt; int ui = 0;
    if (!S.next(0, cur)) return;
    f32x4 acc[2][2][4][2];
#pragma unroll
    for (int a = 0; a < 2; ++a)
#pragma unroll
        for (int b = 0; b < 2; ++b)
#pragma unroll
            for (int m = 0; m < 4; ++m)
#pragma unroll
                for (int n = 0; n < 2; ++n) acc[a][b][m][n] = (f32x4){0.f, 0.f, 0.f, 0.f};
    bf16x8 At[4][2], B0[2][2], B1[2][2];
    const char* cA = (const char*)g.A + (size_t)cur.pm * tstep; const char* cB = (const char*)g.Bt + (size_t)cur.pn * tstep;
    PG8_STAGE(PG8_SB(0, 0), cB, voffB); PG8_STAGE(PG8_SB(0, 1), cB + hstep, voffB); PG8_STAGE(PG8_SA(0, 0), cA, voffA); PG8_STAGE(PG8_SA(0, 1), cA + hstep, voffA);
    if (wr == 1) PG8_BAR;
    PG8_WAIT_V(2); PG8_BAR;
    PG8_STAGE(PG8_SB(1, 0), cB + kstep, voffB); PG8_STAGE(PG8_SA(1, 0), cA + kstep, voffA); PG8_STAGE(PG8_SB(1, 1), cB + hstep + kstep, voffB);
    PG8_WAIT_V(6); PG8_BAR;
    for (;;) {
        const bool has_next = S.next(ui + 1, nxt);
        const char* nA = has_next ? (const char*)g.A + (size_t)nxt.pm * tstep : cA; const char* nB = has_next ? (const char*)g.Bt + (size_t)nxt.pn * tstep : cB;
        for (int t = 0; t < nt; t += 2) {
            if constexpr (Epi::MID) { if (t == (nt >> 1)) E.mid(acc, cur, ui, tid); }
            const bool last = (t == nt - 2);
            const char* a1 = cA + (size_t)(t + 1) * kstep;
            const char* a2 = last ? nA : cA + (size_t)(t + 2) * kstep; const char* b2 = last ? nB : cB + (size_t)(t + 2) * kstep;
            const char* a3 = a2 + kstep; const char* b3 = b2 + kstep;
            PG8_LDB(B0, 0, 0); PG8_LDB(B1, 0, 1); PG8_SCHED; PG8_LDA(At, 0, 0); PG8_STAGE(PG8_SA(1, 1), a1 + hstep, voffA);
            PG8_WAIT_V(8); PG8_WAIT_L(0); PG8_BAR; PG8_MMA(0, 0, At, B0); PG8_MMA(0, 1, At, B1); PG8_BAR; PG8_SCHED;
            PG8_LDA(At, 0, 1); PG8_STAGE(PG8_SB(0, 0), b2, voffB); PG8_STAGE(PG8_SB(0, 1), b2 + hstep, voffB); PG8_STAGE(PG8_SA(0, 0), a2, voffA);
            PG8_WAIT_V(8); PG8_WAIT_L(0); PG8_BAR; PG8_MMA(1, 0, At, B0); PG8_MMA(1, 1, At, B1); PG8_BAR; PG8_SCHED;
            PG8_LDB(B0, 1, 0); PG8_LDB(B1, 1, 1); PG8_SCHED; PG8_LDA(At, 1, 0); PG8_STAGE(PG8_SA(0, 1), a2 + hstep, voffA);
            PG8_WAIT_V(8); PG8_WAIT_L(0); PG8_BAR; PG8_MMA(0, 0, At, B0); PG8_MMA(0, 1, At, B1); PG8_BAR; PG8_SCHED;
            PG8_LDA(At, 1, 1); PG8_STAGE(PG8_SB(1, 0), b3, voffB); PG8_STAGE(PG8_SB(1, 1), b3 + hstep, voffB); PG8_STAGE(PG8_SA(1, 0), a3, voffA);
            PG8_WAIT_V(8); PG8_WAIT_L(0); PG8_BAR; PG8_MMA(1, 0, At, B0); PG8_MMA(1, 1, At, B1); PG8_BAR; PG8_SCHED;
        }
        if (wr == 0) PG8_BAR;
        E(acc, cur, ui, tid);
        if (!has_next) break;
#pragma unroll
        for (int a = 0; a < 2; ++a)
#pragma unroll
            for (int b = 0; b < 2; ++b)
#pragma unroll
                for (int m = 0; m < 4; ++m)
#pragma unroll
                    for (int n = 0; n < 2; ++n) acc[a][b][m][n] = (f32x4){0.f, 0.f, 0.f, 0.f};
        cur = nxt; cA = nA; cB = nB; ++ui;
        if (wr == 1) PG8_BAR;
    }
    PG8_WAIT_V(0);
    PG8_BAR;
#undef PG8_SA
#undef PG8_SB
#undef PG8_STAGE
#undef PG8_LDA
#undef PG8_LDB
#undef PG8_MMA
#undef PG8_WAIT_V
#undef PG8_WAIT_L
#undef PG8_BAR
#undef PG8_SCHED
}

__device__ __forceinline__ void store8(bf16_t* p, f32x4 v0, f32x4 v1) {
    u32x4 w; w.x = cvtpk(v0[0], v0[1]); w.y = cvtpk(v0[2], v0[3]); w.z = cvtpk(v1[0], v1[1]); w.w = cvtpk(v1[2], v1[3]);
    *(u32x4*)p = w;
}


struct Rope4 { float f[4];
    __device__ __forceinline__ void init(int ibase, float kexp) {
#pragma unroll
        for (int j = 0; j < 4; ++j) f[j] = __builtin_amdgcn_exp2f(-(float)(ibase + j) * kexp) * 0.15915494309189535f; }
    __device__ __forceinline__ void sincos(int s, f32x4& cs, f32x4& sn) const {
#pragma unroll
        for (int j = 0; j < 4; ++j) { float rev = (float)s * f[j]; rev -= floorf(rev); sn[j] = __builtin_amdgcn_sinf(rev); cs[j] = __builtin_amdgcn_cosf(rev); } }
    __device__ __forceinline__ static void rot(f32x4& v0, f32x4& v1, const f32x4& cs, const f32x4& sn) {
        const f32x4 a = v0 * cs - v1 * sn, b = v1 * cs + v0 * sn; v0 = a; v1 = b; }
    __device__ __forceinline__ void apply(f32x4& v0, f32x4& v1, int s) const { f32x4 cs, sn; sincos(s, cs, sn); rot(v0, v1, cs, sn); }
};
constexpr float ROPE_KA = 18.931568569324174f / 16.0f, ROPE_KB = 18.931568569324174f / 32.0f;

struct EpiProj {
    static constexpr bool PERM = true, MID = false, I8 = true;
    bf16_t* QKV;
    bf16_t* CQKV;
    bf16_t* KR; float* ssq;
    const float* hs; const float* wsn;
    static __device__ __forceinline__ f32x4 i2f4(const f32x4 a) { const float a0 = a[0], a1 = a[1], a2 = a[2], a3 = a[3];
        return (f32x4){(float)__float_as_int(a0), (float)__float_as_int(a1), (float)__float_as_int(a2), (float)__float_as_int(a3)}; }
    __device__ __forceinline__ void mid(f32x4 (&)[2][2][4][2], const Unit&, int, int) const {}
    __device__ __forceinline__ void operator()(const f32x4 (&acc_)[2][2][4][2], const Unit& u, int ui, int tid_) const {
        const int tid = opaque(tid_), lane = tid & 63, wid = __builtin_amdgcn_readfirstlane(tid >> 6), wr = wid >> 2, wc = wid & 3, fr = lane & 15, fq = lane >> 4;
        const int pn = u.pn, row0 = u.pm * BM + wr * 64 + fr;
        f32x4 cs[2][2]; float rs[2][4];
        { const float* wp_ = wsn + pn * BM + wc * 32 + 8 * fq;
#pragma unroll
          for (int bj = 0; bj < 2; ++bj) { cs[bj][0] = *(const f32x4*)(wp_ + bj * HALF); cs[bj][1] = *(const f32x4*)(wp_ + bj * HALF + 4); }
#pragma unroll
          for (int ai = 0; ai < 2; ++ai)
#pragma unroll
              for (int m = 0; m < 4; ++m) rs[ai][m] = hs[row0 + ai * HALF + m * 16]; }
#define ACCF(ai, bj, m, n) (i2f4(acc_[ai][bj][m][n]) * rs[ai][m] * cs[bj][n])
        if (pn < 12) {
            bf16_t* base = QKV + (size_t)(pn >> 2) * (32u << 20);
            const int colt = (pn & 3) * 256 + wc * 32 + 8 * fq;
            const bool rope = (pn < 8) && (wc == 0);
            Rope4 R; R.init(4 * fq, ROPE_KA);
#pragma unroll
            for (int ai = 0; ai < 2; ++ai)
#pragma unroll
                for (int m = 0; m < 4; ++m) {
                    const int row = row0 + ai * HALF + m * 16; const int s = row & (SEQ - 1);
                    f32x4 rcs = {1.f, 1.f, 1.f, 1.f}, rsn = {0.f, 0.f, 0.f, 0.f};
                    if (rope) R.sincos(s, rcs, rsn);
#pragma unroll
                    for (int bj = 0; bj < 2; ++bj) {
                        f32x4 v0 = ACCF(ai, bj, m, 0), v1 = ACCF(ai, bj, m, 1);
                        if (rope) Rope4::rot(v0, v1, rcs, rsn);
                        if (pn < 4) store8(base + (size_t)row * 1024 + colt + bj * HALF, v0, v1);
                        else { u32x2 w; w.x = pack_fp8x4(v0[0], v0[1], v0[2], v0[3]); w.y = pack_fp8x4(v1[0], v1[1], v1[2], v1[3]);
                            *(u32x2*)((unsigned char*)base + (size_t)row * 1024 + colt + bj * HALF) = w; }
                    }
                }
        } else if (pn < 16) {
            bf16_t* base = CQKV + (size_t)((pn >> 1) & 1) * (16u << 20); float* sq = ssq + (size_t)((pn >> 1) & 1) * (256u << 10);
            const int colt = (pn & 1) * 256 + wc * 32 + 8 * fq; const int slot = (pn & 1) * 4 + wc;
#pragma unroll
            for (int ai = 0; ai < 2; ++ai)
#pragma unroll
                for (int m = 0; m < 4; ++m) {
                    const int row = row0 + ai * HALF + m * 16; float q = 0.f;
#pragma unroll
                    for (int bj = 0; bj < 2; ++bj) {
                        const f32x4 v0 = ACCF(ai, bj, m, 0), v1 = ACCF(ai, bj, m, 1);
                        q += (v0[0] * v0[0] + v0[1] * v0[1]) + (v0[2] * v0[2] + v0[3] * v0[3]) + (v1[0] * v1[0] + v1[1] * v1[1]) + (v1[2] * v1[2] + v1[3] * v1[3]);
                        store8(base + (size_t)row * 512 + colt + bj * HALF, v0 * 1.0f, v1 * 1.0f);
                    }
                    q += __shfl_xor(q, 16); q += __shfl_xor(q, 32);
                    if (fq == 0) sq[(size_t)slot * T + row] = q;
                }
        } else {
            if (wc < 2) {
                Rope4 R; R.init(16 * wc + 4 * fq, ROPE_KB);
#pragma unroll
                for (int ai = 0; ai < 2; ++ai)
#pragma unroll
                    for (int m = 0; m < 4; ++m) {
                        const int row = row0 + ai * HALF + m * 16; const int s = row & (SEQ - 1);
                        f32x4 v0 = ACCF(ai, 0, m, 0), v1 = ACCF(ai, 0, m, 1);
                        R.apply(v0, v1, s);
                        store8(KR + (size_t)row * 64 + wc * 32 + 8 * fq, v0, v1);
                    }
            }
        }
    }
};
#undef ACCF

struct EpiKr {
    static constexpr bool PERM = true, MID = false, I8 = false;
    bf16_t* KR;
    __device__ __forceinline__ void mid(f32x4 (&)[2][2][4][2], const Unit&, int, int) const {}
    __device__ __forceinline__ void operator()(const f32x4 (&acc)[2][2][4][2], const Unit& u, int ui, int tid_) const {
        const int tid = opaque(tid_), lane = tid & 63, wid = __builtin_amdgcn_readfirstlane(tid >> 6), wr = wid >> 2, wc = wid & 3, fr = lane & 15, fq = lane >> 4;
        const int row0 = u.pm * BM + wr * 64 + fr;
        if (wc < 2) {
            Rope4 R; R.init(16 * wc + 4 * fq, ROPE_KB);
#pragma unroll
            for (int ai = 0; ai < 2; ++ai)
#pragma unroll
                for (int m = 0; m < 4; ++m) {
                    const int row = row0 + ai * HALF + m * 16; const int s = row & (SEQ - 1);
                    f32x4 v0 = acc[ai][0][m][0] * 1.0f, v1 = acc[ai][0][m][1] * 1.0f;
                    R.apply(v0, v1, s);
                    store8(KR + (size_t)row * 64 + wc * 32 + 8 * fq, v0, v1);
                }
        }
    }
};

struct EpiQ {
    static constexpr bool PERM = true, MID = false, I8 = true;
    bf16_t *Qn, *Qr; const LAS float* tab; const float* wsn;
    __device__ __forceinline__ void mid(f32x4 (&)[2][2][4][2], const Unit&, int, int) const {}
    __device__ __forceinline__ void operator()(const f32x4 (&acc)[2][2][4][2], const Unit& u, int ui, int tid_) const {
        const int tid = opaque(tid_), lane = tid & 63, wid = __builtin_amdgcn_readfirstlane(tid >> 6), wr = wid >> 2, wc = wid & 3, fr = lane & 15, fq = lane >> 4;
        const int pn = u.pn, rl0 = wr * 64 + fr, row0 = u.pm * BM + rl0;
        Rope4 R; R.init(16 * (wc & 1) + 4 * fq, ROPE_KB);
        f32x4 cs[2][2];
#pragma unroll
        for (int bj = 0; bj < 2; ++bj) { const float* wp_ = wsn + pn * BM + bj * HALF + wc * 32 + 8 * fq; cs[bj][0] = *(const f32x4*)wp_; cs[bj][1] = *(const f32x4*)(wp_ + 4); }
#pragma unroll
        for (int ai = 0; ai < 2; ++ai)
#pragma unroll
            for (int m = 0; m < 4; ++m) {
                const int row = row0 + ai * HALF + m * 16; const int s = row & (SEQ - 1);
                const float rs = tab[ui * 256 + rl0 + ai * HALF + m * 16];
                if (pn < 4) {
#pragma unroll
                    for (int bj = 0; bj < 2; ++bj)
                        store8(Qn + (size_t)row * 1024 + pn * 256 + bj * HALF + wc * 32 + 8 * fq, EpiProj::i2f4(acc[ai][bj][m][0]) * rs * cs[bj][0], EpiProj::i2f4(acc[ai][bj][m][1]) * rs * cs[bj][1]);
                } else {
                    f32x4 rcs, rsn; R.sincos(s, rcs, rsn);
#pragma unroll
                    for (int bj = 0; bj < 2; ++bj) {
                        f32x4 v0 = EpiProj::i2f4(acc[ai][bj][m][0]) * rs * cs[bj][0], v1 = EpiProj::i2f4(acc[ai][bj][m][1]) * rs * cs[bj][1];
                        Rope4::rot(v0, v1, rcs, rsn);
                        store8(Qr + (size_t)row * 512 + (pn - 4) * 256 + bj * HALF + wc * 32 + 8 * fq, v0, v1);
                    }
                }
            }
    }
};

struct EpiKV {
    static constexpr bool PERM = true, MID = false, I8 = true;
    bf16_t *Kn, *Vb; const LAS float* tab; const float* wsn;
    __device__ __forceinline__ void mid(f32x4 (&)[2][2][4][2], const Unit&, int, int) const {}
    __device__ __forceinline__ void operator()(const f32x4 (&acc)[2][2][4][2], const Unit& u, int ui, int tid_) const {
        const int tid = opaque(tid_), lane = tid & 63, wid = __builtin_amdgcn_readfirstlane(tid >> 6), wr = wid >> 2, wc = wid & 3, fr = lane & 15, fq = lane >> 4;
        const int pn = u.pn, rl0 = wr * 64 + fr, row0 = u.pm * BM + rl0;
        bf16_t* base = pn < 4 ? Kn : Vb;
        f32x4 cs[2][2];
#pragma unroll
        for (int bj = 0; bj < 2; ++bj) { const float* wp_ = wsn + pn * BM + bj * HALF + wc * 32 + 8 * fq; cs[bj][0] = *(const f32x4*)wp_; cs[bj][1] = *(const f32x4*)(wp_ + 4); }
#pragma unroll
        for (int ai = 0; ai < 2; ++ai)
#pragma unroll
            for (int m = 0; m < 4; ++m) {
                const int row = row0 + ai * HALF + m * 16;
                const float rs = tab[ui * 256 + rl0 + ai * HALF + m * 16];
#pragma unroll
                for (int bj = 0; bj < 2; ++bj)
                    store8(base + (size_t)row * 1024 + (pn & 3) * 256 + bj * HALF + wc * 32 + 8 * fq, EpiProj::i2f4(acc[ai][bj][m][0]) * rs * cs[bj][0], EpiProj::i2f4(acc[ai][bj][m][1]) * rs * cs[bj][1]);
            }
    }
};

struct EpiMix {
    static constexpr bool PERM = true, MID = true, I8 = false;
    bf16_t* MIX; const LAS float* tab;
    __device__ __forceinline__ void mid(f32x4 (&acc)[2][2][4][2], const Unit& u, int ui, int tid_) const {
        const int tid = opaque(tid_), lane = tid & 63, wid = __builtin_amdgcn_readfirstlane(tid >> 6), wr = wid >> 2, wc = wid & 3, fr = lane & 15, fq = lane >> 4;
        const int rl0 = wr * 64 + fr;
#pragma unroll
        for (int ai = 0; ai < 2; ++ai)
#pragma unroll
            for (int m = 0; m < 4; ++m) {
                const float ratio = tab[(ui * 256 + rl0 + ai * HALF + m * 16) * 2];
#pragma unroll
                for (int bj = 0; bj < 2; ++bj) { acc[ai][bj][m][0] *= ratio; acc[ai][bj][m][1] *= ratio; }
            }
    }
    __device__ __forceinline__ void operator()(const f32x4 (&acc)[2][2][4][2], const Unit& u, int ui, int tid_) const {
        const int tid = opaque(tid_), lane = tid & 63, wid = __builtin_amdgcn_readfirstlane(tid >> 6), wr = wid >> 2, wc = wid & 3, fr = lane & 15, fq = lane >> 4;
        const int rl0 = wr * 64 + fr, row0 = u.pm * BM + rl0;
#pragma unroll
        for (int ai = 0; ai < 2; ++ai)
#pragma unroll
            for (int m = 0; m < 4; ++m) {
                const int row = row0 + ai * HALF + m * 16;
                const float rb = tab[(ui * 256 + rl0 + ai * HALF + m * 16) * 2 + 1];
#pragma unroll
                for (int bj = 0; bj < 2; ++bj)
                    store8(MIX + (size_t)row * DM + u.pn * BM + bj * HALF + wc * 32 + 8 * fq, acc[ai][bj][m][0] * rb, acc[ai][bj][m][1] * rb);
            }
    }
};

struct EpiPlainQ8 {
    static constexpr bool PERM = true, MID = false, I8 = true;
    bf16_t* O; int ldc; const float* hs; const float* wsn;
    __device__ __forceinline__ void mid(f32x4 (&)[2][2][4][2], const Unit&, int, int) const {}
    __device__ __forceinline__ void operator()(const f32x4 (&acc)[2][2][4][2], const Unit& u, int ui, int tid_) const {
        const int tid = opaque(tid_), lane = tid & 63, wid = __builtin_amdgcn_readfirstlane(tid >> 6), wr = wid >> 2, wc = wid & 3, fr = lane & 15, fq = lane >> 4;
        const int row0 = u.pm * BM + wr * 64 + fr, col0 = u.pn * BM + wc * 32 + 8 * fq;
        f32x4 cs[2][2];
#pragma unroll
        for (int bj = 0; bj < 2; ++bj) { cs[bj][0] = *(const f32x4*)(wsn + col0 + bj * HALF); cs[bj][1] = *(const f32x4*)(wsn + col0 + bj * HALF + 4); }
#pragma unroll
        for (int ai = 0; ai < 2; ++ai)
#pragma unroll
            for (int m = 0; m < 4; ++m) {
                const int row = row0 + ai * HALF + m * 16; const float rs = hs[row];
#pragma unroll
                for (int bj = 0; bj < 2; ++bj)
                    store8(O + (size_t)row * ldc + col0 + bj * HALF, EpiProj::i2f4(acc[ai][bj][m][0]) * rs * cs[bj][0], EpiProj::i2f4(acc[ai][bj][m][1]) * rs * cs[bj][1]);
            }
    }
};

struct EpiPlain {
    static constexpr bool PERM = true, MID = false, I8 = false;
    bf16_t* O; int ldc;
    __device__ __forceinline__ void mid(f32x4 (&)[2][2][4][2], const Unit&, int, int) const {}
    __device__ __forceinline__ void operator()(const f32x4 (&acc)[2][2][4][2], const Unit& u, int ui, int tid_) const {
        const int tid = opaque(tid_), lane = tid & 63, wid = __builtin_amdgcn_readfirstlane(tid >> 6), wr = wid >> 2, wc = wid & 3, fr = lane & 15, fq = lane >> 4;
        const int row0 = u.pm * BM + wr * 64 + fr;
#pragma unroll
        for (int ai = 0; ai < 2; ++ai)
#pragma unroll
            for (int m = 0; m < 4; ++m) {
                const int row = row0 + ai * HALF + m * 16;
#pragma unroll
                for (int bj = 0; bj < 2; ++bj)
                    store8(O + (size_t)row * ldc + u.pn * BM + bj * HALF + wc * 32 + 8 * fq, acc[ai][bj][m][0], acc[ai][bj][m][1]);
            }
    }
};
}

namespace att {
#define KSWZ(row, colB) ((row) * 256 + ((colB) ^ (((row) & 7) << 4)))
#define SBAR() __builtin_amdgcn_sched_barrier(0)
__device__ __forceinline__ int crow(int r, int hi) { return (r & 3) + 8 * (r >> 2) + 4 * hi; }
constexpr int L_KN = 0, L_KR = 32768, L_V = 49152, L_WS = 81920, L_QR = 83968, L_END = 83968 + 32768;
__device__ __forceinline__ int v_st(int k, int c) { const int kk = (k & ~0xC) | ((k & 4) << 1) | ((k & 8) >> 1); return ((kk >> 3) * 4 + (c >> 5)) * 512 + ((kk & 7) * 32 + (c & 31)) * 2; }
__device__ __forceinline__ int v_rd_base(int lane) { return ((lane & 3) << 3) | (((lane >> 2) & 3) << 6) | (((lane >> 4) & 1) << 5) | (((lane >> 5) & 1) << 8); }
constexpr int v_rd_off(int d0, int ks, int half) { return d0 * 512 + ks * 4096 + half * 2048; }
template <int OFF> __device__ __forceinline__ s16x4 tr_read(int vb) {
    s16x4 r; asm volatile("ds_read_b64_tr_b16 %0, %1 offset:%2" : "=&v"(r) : "v"(vb), "i"(OFF) : "memory"); return r;
}
template <int D0> __device__ __forceinline__ void pv_one(f32x16& od, int vb, bf16x8 pa0, bf16x8 pa1, bf16x8 pa2, bf16x8 pa3) {
    const s16x4 l0 = tr_read<v_rd_off(D0, 0, 0)>(vb), h0 = tr_read<v_rd_off(D0, 0, 1)>(vb), l1 = tr_read<v_rd_off(D0, 1, 0)>(vb), h1 = tr_read<v_rd_off(D0, 1, 1)>(vb);
    const s16x4 l2 = tr_read<v_rd_off(D0, 2, 0)>(vb), h2 = tr_read<v_rd_off(D0, 2, 1)>(vb), l3 = tr_read<v_rd_off(D0, 3, 0)>(vb), h3 = tr_read<v_rd_off(D0, 3, 1)>(vb);
    asm volatile("s_waitcnt lgkmcnt(0)" ::: "memory"); SBAR();
#define PK(L, H) (bf16x8){L[0], L[1], L[2], L[3], H[0], H[1], H[2], H[3]}
    od = __builtin_amdgcn_mfma_f32_32x32x16_bf16(pa0, PK(l0, h0), od, 0, 0, 0);
    od = __builtin_amdgcn_mfma_f32_32x32x16_bf16(pa1, PK(l1, h1), od, 0, 0, 0);
    od = __builtin_amdgcn_mfma_f32_32x32x16_bf16(pa2, PK(l2, h2), od, 0, 0, 0);
    od = __builtin_amdgcn_mfma_f32_32x32x16_bf16(pa3, PK(l3, h3), od, 0, 0, 0);
#undef PK
}

struct UnitP { int b, h, dil, rho0, ngrp, qbase, kfirst, tpg, W, mode; };
struct Tens { const bf16_t *Qm, *Qr, *Km, *Kr, *Vm; bf16_t* So; float *Sm, *Sl; bf16_t* Oout; int ocol0; float* ssq; int ssq0; };

template <bool MLA>
__device__ __forceinline__ void attn_unit(const int tid_in, const UnitP P, LAS unsigned char* lds, const Tens& X) {
    const int tid = opaque(tid_in);
    constexpr float SCALE = MLA ? 0.07216878364870322f : 0.08838834764831845f;
    constexpr float C = SCALE * 1.4426950408889634f;
    constexpr float THRS = 8.f / SCALE;
    constexpr int NQ = 8;
    const int wid = __builtin_amdgcn_readfirstlane(tid >> 6), lane = tid & 63, r32 = lane & 31, hi = lane >> 5;
    const int g = (P.ngrp == 2) ? (wid >> 2) : 0, wq = (P.ngrp == 2) ? (wid & 3) : wid;
    const int qpos0 = P.qbase + 32 * wq, rho_w = P.rho0 + g;
    const long tb = (long)P.b * SEQ;
    const long qtok = tb + (long)(qpos0 + r32) * P.dil + rho_w;
    LAS float* wsf = (LAS float*)(lds + L_WS) + wid * 64;
    bf16x8 qr[NQ];
    { const bf16_t* qp = X.Qm + qtok * 1024 + P.h * 128 + hi * 8;
#pragma unroll
      for (int d0 = 0; d0 < 8; ++d0) qr[d0] = *(const bf16x8*)(qp + d0 * 16); }
    LAS unsigned char* qrp = lds + L_QR + wid * 4096 + lane * 16;
    if constexpr (MLA) { const bf16_t* qp = X.Qr + qtok * 512 + P.h * 64 + hi * 8;
#pragma unroll
      for (int d0 = 0; d0 < 4; ++d0) *(LAS bf16x8*)(qrp + d0 * 1024) = *(const bf16x8*)(qp + d0 * 16); }
    float m_reg = -1e30f, l_reg = 0.f; f32x16 o[4];
#pragma unroll
    for (int d = 0; d < 4; ++d) o[d] = f32x16{};
    LAS unsigned char* stg = lds + wid * 8704;
    if (P.mode & 1) {
        m_reg = X.Sm[qtok * 8 + P.h]; l_reg = X.Sl[qtok * 8 + P.h];
#pragma unroll 2
        for (int i = 0; i < 8; ++i) { const int le = opaque(lane), row = i * 4 + (le >> 4), ch = le & 15; const long tr = tb + (long)(qpos0 + row) * P.dil + rho_w;
            *(LAS u32x4*)(stg + row * 272 + ch * 16) = *(const u32x4*)(X.So + tr * 1024 + P.h * 128 + ch * 8); }
        asm volatile("s_waitcnt lgkmcnt(0)" ::: "memory");
#pragma unroll
        for (int r = 0; r < 16; ++r)
#pragma unroll
            for (int d = 0; d < 4; ++d) o[d][r] = __uint_as_float((unsigned)(*(const LAS unsigned short*)(stg + crow(r, hi) * 272 + (32 * d + r32) * 2)) << 16);
        asm volatile("s_waitcnt lgkmcnt(0)" ::: "memory");
        __syncthreads();
    }
    const int sr = tid >> 4, sc = (tid & 15) * 8;
    const int rr = tid >> 3, rc = tid & 7;
    const int NT = P.ngrp * P.tpg;
    const int vb0 = (int)(uintptr_t)(lds + L_V) + v_rd_base(lane);
    bf16x8 ks0, ks1, vs0, vs1, krs;
#define LOADT(jt) do { const int gj_ = (jt) / P.tpg; const int kp_ = P.kfirst + 64 * ((jt) - gj_ * P.tpg); const int rho_ = P.rho0 + gj_; \
        const long t0_ = tb + (long)(kp_ + sr) * P.dil + rho_, t1_ = tb + (long)(kp_ + 32 + sr) * P.dil + rho_; \
        ks0 = *(const bf16x8*)(X.Km + t0_ * 1024 + P.h * 128 + sc); ks1 = *(const bf16x8*)(X.Km + t1_ * 1024 + P.h * 128 + sc); \
        vs0 = *(const bf16x8*)(X.Vm + t0_ * 1024 + P.h * 128 + sc); vs1 = *(const bf16x8*)(X.Vm + t1_ * 1024 + P.h * 128 + sc); \
        if constexpr (MLA) { const long t2_ = tb + (long)(kp_ + rr) * P.dil + rho_; krs = *(const bf16x8*)(X.Kr + t2_ * 64 + rc * 8); } } while (0)
#define WRITET(buf) do { *(LAS bf16x8*)(lds + L_KN + (buf) * 16384 + KSWZ(sr, sc * 2)) = ks0; *(LAS bf16x8*)(lds + L_KN + (buf) * 16384 + KSWZ(32 + sr, sc * 2)) = ks1; \
        *(LAS bf16x8*)(lds + L_V + (buf) * 16384 + v_st(sr, sc)) = vs0; *(LAS bf16x8*)(lds + L_V + (buf) * 16384 + v_st(32 + sr, sc)) = vs1; \
        if constexpr (MLA) { *(LAS bf16x8*)(lds + L_KR + (buf) * 8192 + rr * 128 + ((rc ^ ((rr >> 1) & 7)) << 4)) = krs; } } while (0)
    LOADT(0);
    if (wid >= 4) __builtin_amdgcn_s_setprio(1);
    for (int jt = 0; jt < NT; ++jt) {
        const int buf = jt & 1;
        WRITET(buf);
        if (jt + 1 < NT) LOADT(jt + 1);
        __syncthreads();
        const int gj = jt / P.tpg, kpos0 = P.kfirst + 64 * (jt - gj * P.tpg);
        const bool active = (gj == g) && (kpos0 <= qpos0 + 31) && (kpos0 + 63 >= qpos0 - P.W);
        if (active) {
            f32x16 p0 = f32x16{}, p1 = f32x16{};
            { const LAS unsigned char* kb = lds + L_KN + buf * 16384;
#pragma unroll
              for (int d0 = 0; d0 < 8; ++d0) { const int cb = (d0 * 16 + hi * 8) * 2;
                const bf16x8 b0 = *(const LAS bf16x8*)(kb + KSWZ(r32, cb)), b1 = *(const LAS bf16x8*)(kb + KSWZ(32 + r32, cb));
                p0 = __builtin_amdgcn_mfma_f32_32x32x16_bf16(b0, qr[d0], p0, 0, 0, 0);
                p1 = __builtin_amdgcn_mfma_f32_32x32x16_bf16(b1, qr[d0], p1, 0, 0, 0); } }
            if constexpr (MLA) { const LAS unsigned char* kb = lds + L_KR + buf * 8192;
#pragma unroll
              for (int d0 = 0; d0 < 4; ++d0) { const int ch = 2 * d0 + hi; const int off = ((ch ^ ((r32 >> 1) & 7)) << 4);
                const bf16x8 b0 = *(const LAS bf16x8*)(kb + r32 * 128 + off), b1 = *(const LAS bf16x8*)(kb + (32 + r32) * 128 + off);
                const bf16x8 qf = *(const LAS bf16x8*)(qrp + d0 * 1024);
                p0 = __builtin_amdgcn_mfma_f32_32x32x16_bf16(b0, qf, p0, 0, 0, 0);
                p1 = __builtin_amdgcn_mfma_f32_32x32x16_bf16(b1, qf, p1, 0, 0, 0); } }
            const bool full = (kpos0 + 63 <= qpos0) && (kpos0 >= qpos0 + 31 - P.W);
            if (!full) { const int qp = qpos0 + r32;
#pragma unroll
                for (int r = 0; r < 16; ++r) { const int dq0 = qp - (kpos0 + crow(r, hi)), dq1 = dq0 - 32;
                    if (dq0 < 0 || dq0 > P.W) p0[r] = -INFINITY; if (dq1 < 0 || dq1 > P.W) p1[r] = -INFINITY; } }
            float pmax = p0[0];
#pragma unroll
            for (int r = 1; r < 16; ++r) pmax = fmaxf(pmax, p0[r]);
#pragma unroll
            for (int r = 0; r < 16; ++r) pmax = fmaxf(pmax, p1[r]);
            { auto sw = __builtin_amdgcn_permlane32_swap(__float_as_uint(pmax), __float_as_uint(pmax), false, false); pmax = fmaxf(__uint_as_float(sw[0]), __uint_as_float(sw[1])); }
            float mn, alpha;
            if (__builtin_expect(__all(pmax - m_reg <= THRS), 1)) { mn = m_reg; alpha = 1.f; }
            else { mn = fmaxf(m_reg, pmax); alpha = __builtin_amdgcn_exp2f((m_reg - mn) * C); m_reg = mn; }
            const float mnC = -mn * C;
#pragma unroll
            for (int r = 0; r < 16; ++r) { p0[r] = __builtin_amdgcn_exp2f(fmaf(p0[r], C, mnC)); p1[r] = __builtin_amdgcn_exp2f(fmaf(p1[r], C, mnC)); }
            if (__any(alpha < 1.f)) { if (hi == 0) wsf[r32] = alpha; asm volatile("s_waitcnt lgkmcnt(0)" ::: "memory");
#pragma unroll
                for (int r = 0; r < 16; ++r) { const float al = wsf[crow(r, hi)];
#pragma unroll
                    for (int d = 0; d < 4; ++d) o[d][r] *= al; }
                asm volatile("s_waitcnt lgkmcnt(0)" ::: "memory"); }
            float ps = 0.f;
#pragma unroll
            for (int r = 0; r < 16; ++r) ps += p0[r];
#pragma unroll
            for (int r = 0; r < 16; ++r) ps += p1[r];
            { auto sw = __builtin_amdgcn_permlane32_swap(__float_as_uint(ps), __float_as_uint(ps), false, false); ps = __uint_as_float(sw[0]) + __uint_as_float(sw[1]); }
            l_reg = l_reg * alpha + ps;
            bf16x8 pa0, pa1, pa2, pa3;
#define PK4(Pv, BASE, OUT) do { unsigned a0 = cvtpk(Pv[BASE + 0], Pv[BASE + 1]), a1 = cvtpk(Pv[BASE + 2], Pv[BASE + 3]);   \
    unsigned b0 = cvtpk(Pv[BASE + 4], Pv[BASE + 5]), b1 = cvtpk(Pv[BASE + 6], Pv[BASE + 7]);                              \
    auto r0 = __builtin_amdgcn_permlane32_swap(a0, b0, false, false); auto r1 = __builtin_amdgcn_permlane32_swap(a1, b1, false, false); \
    u32x4 w = {r0[0], r1[0], r0[1], r1[1]}; OUT = __builtin_bit_cast(bf16x8, w); } while (0)
            PK4(p0, 0, pa0); PK4(p0, 8, pa1); PK4(p1, 0, pa2); PK4(p1, 8, pa3);
#undef PK4
            SBAR();
            const int vb = vb0 + buf * 16384;
            pv_one<0>(o[0], vb, pa0, pa1, pa2, pa3); pv_one<1>(o[1], vb, pa0, pa1, pa2, pa3); pv_one<2>(o[2], vb, pa0, pa1, pa2, pa3); pv_one<3>(o[3], vb, pa0, pa1, pa2, pa3);
        }
    }
#undef LOADT
#undef WRITET
    __builtin_amdgcn_s_setprio(0);
    asm volatile("s_waitcnt lgkmcnt(0)" ::: "memory");
    __syncthreads();
    if (P.mode & 2) {
        if (hi == 0) wsf[32 + r32] = l_reg; asm volatile("s_waitcnt lgkmcnt(0)" ::: "memory");
#pragma unroll
        for (int r = 0; r < 16; ++r) { const int qrow = crow(r, hi); const float rl = 1.0f / wsf[32 + qrow];
            const long tr = tb + (long)(qpos0 + qrow) * P.dil + rho_w; float sq = 0.f;
#pragma unroll
            for (int d = 0; d < 4; ++d) { const float v = o[d][r] * rl; sq += v * v; *(LAS unsigned short*)(stg + qrow * 272 + (32 * d + r32) * 2) = (unsigned short)(cvtpk(v, v) & 0xffffu); }
            sq += __shfl_xor(sq, 1); sq += __shfl_xor(sq, 2); sq += __shfl_xor(sq, 4); sq += __shfl_xor(sq, 8); sq += __shfl_xor(sq, 16);
            if (r32 == 0) X.ssq[tr * 16 + X.ssq0 + P.h] = sq; }
        asm volatile("s_waitcnt lgkmcnt(0)" ::: "memory");
#pragma unroll 2
        for (int i = 0; i < 8; ++i) { const int le = opaque(lane), row = i * 4 + (le >> 4), ch = le & 15; const long tr = tb + (long)(qpos0 + row) * P.dil + rho_w;
            *(u32x4*)(X.Oout + tr * 2048 + X.ocol0 + P.h * 128 + ch * 8) = *(const LAS u32x4*)(stg + row * 272 + ch * 16); }
    } else {
        if (hi == 0) { X.Sm[qtok * 8 + P.h] = m_reg; X.Sl[qtok * 8 + P.h] = l_reg; }
#pragma unroll
        for (int r = 0; r < 16; ++r)
#pragma unroll
            for (int d = 0; d < 4; ++d) { const float v = o[d][r]; *(LAS unsigned short*)(stg + crow(r, hi) * 272 + (32 * d + r32) * 2) = (unsigned short)(cvtpk(v, v) & 0xffffu); }
        asm volatile("s_waitcnt lgkmcnt(0)" ::: "memory");
#pragma unroll 2
        for (int i = 0; i < 8; ++i) { const int le = opaque(lane), row = i * 4 + (le >> 4), ch = le & 15; const long tr = tb + (long)(qpos0 + row) * P.dil + rho_w;
            *(u32x4*)(X.So + tr * 1024 + P.h * 128 + ch * 8) = *(const LAS u32x4*)(stg + row * 272 + ch * 16); }
    }
    asm volatile("s_waitcnt lgkmcnt(0)" ::: "memory");
    __syncthreads();
}

struct WaveA { int b, h, dil, rho, qpos0, mode; };
__device__ __forceinline__ void attnA_wave(const int lane_in, const WaveA P, LAS unsigned char* wl  , LAS float* wsf, const Tens& X) {
    constexpr float SCALE = 0.08838834764831845f, C = SCALE * 1.4426950408889634f, THRS = 8.f / SCALE;
    const int lane = opaque(lane_in), r32 = lane & 31, hi = lane >> 5;
    const long tb = (long)P.b * SEQ;
    const long qtok = tb + (long)(P.qpos0 + r32) * P.dil + P.rho;
    LAS unsigned char* vbuf = wl; LAS unsigned char* stg = wl + 8192;
    bf16x8 qr[8];
    { const bf16_t* qp = X.Qm + qtok * 1024 + P.h * 128 + hi * 64;
#pragma unroll
      for (int d0 = 0; d0 < 8; ++d0) qr[d0] = *(const bf16x8*)(qp + d0 * 8); }
    float m_reg = -1e30f, l_reg = 0.f; f32x16 o[4];
#pragma unroll
    for (int d = 0; d < 4; ++d) o[d] = f32x16{};
    if (P.mode & 1) {
        m_reg = X.Sm[qtok * 8 + P.h]; l_reg = X.Sl[qtok * 8 + P.h];
#pragma unroll 2
        for (int i = 0; i < 8; ++i) { const int le = opaque(lane), row = i * 4 + (le >> 4), ch = le & 15; const long tr = tb + (long)(P.qpos0 + row) * P.dil + P.rho;
            *(LAS u32x4*)(stg + row * 272 + ch * 16) = *(const u32x4*)(X.So + tr * 1024 + P.h * 128 + ch * 8); }
        asm volatile("s_waitcnt lgkmcnt(0)" ::: "memory");
#pragma unroll
        for (int r = 0; r < 16; ++r)
#pragma unroll
            for (int d = 0; d < 4; ++d) o[d][r] = __uint_as_float((unsigned)(*(const LAS unsigned short*)(stg + crow(r, hi) * 272 + (32 * d + r32) * 2)) << 16);
    }
    const int kfirst = P.qpos0 >= 128 ? P.qpos0 - 128 : 0;
    const int vrow = lane >> 3, vcol = (lane & 7) * 16;
    const int vb = (int)(uintptr_t)vbuf + v_rd_base(lane);
    const unsigned char* K8 = (const unsigned char*)X.Km; const unsigned char* V8 = (const unsigned char*)X.Vm;
    u32x4 nk[4], nv[4];
#define A_LOAD(kc) do { const long tk_ = tb + (long)((kc) + r32) * P.dil + P.rho; const unsigned char* kp_ = K8 + tk_ * 1024 + P.h * 128 + hi * 64; \
        _Pragma("unroll") for (int j = 0; j < 4; ++j) nk[j] = *(const u32x4*)(kp_ + j * 16); \
        _Pragma("unroll") for (int i = 0; i < 4; ++i) { const long tv_ = tb + (long)((kc) + vrow + 8 * i) * P.dil + P.rho; nv[i] = *(const u32x4*)(V8 + tv_ * 1024 + P.h * 128 + vcol); } } while (0)
#define A_CVT8(lo, hi_) ({ const f32x2 a_ = __builtin_amdgcn_cvt_pk_f32_fp8((int)(lo), false), b_ = __builtin_amdgcn_cvt_pk_f32_fp8((int)(lo), true), \
        c_ = __builtin_amdgcn_cvt_pk_f32_fp8((int)(hi_), false), d_ = __builtin_amdgcn_cvt_pk_f32_fp8((int)(hi_), true); \
        u32x4 w_ = {cvtpk(a_[0], a_[1]), cvtpk(b_[0], b_[1]), cvtpk(c_[0], c_[1]), cvtpk(d_[0], d_[1])}; __builtin_bit_cast(bf16x8, w_); })
    A_LOAD(kfirst);
    for (int kc0 = kfirst; kc0 <= P.qpos0; kc0 += 32) {
        bf16x8 kf[8];
#pragma unroll
        for (int j = 0; j < 4; ++j) { const unsigned x0 = nk[j][0], x1 = nk[j][1], x2 = nk[j][2], x3 = nk[j][3]; kf[2 * j] = A_CVT8(x0, x1); kf[2 * j + 1] = A_CVT8(x2, x3); }
#pragma unroll
        for (int i = 0; i < 4; ++i) { const unsigned x0 = nv[i][0], x1 = nv[i][1], x2 = nv[i][2], x3 = nv[i][3];
            *(LAS bf16x8*)(vbuf + v_st(vrow + 8 * i, vcol)) = A_CVT8(x0, x1); *(LAS bf16x8*)(vbuf + v_st(vrow + 8 * i, vcol + 8)) = A_CVT8(x2, x3); }
        if (kc0 + 32 <= P.qpos0) A_LOAD(kc0 + 32);
        f32x16 p0 = f32x16{};
#pragma unroll
        for (int d0 = 0; d0 < 8; ++d0) p0 = __builtin_amdgcn_mfma_f32_32x32x16_bf16(kf[d0], qr[d0], p0, 0, 0, 0);
        const bool full = (kc0 + 31 <= P.qpos0) && (kc0 >= P.qpos0 + 31 - 128);
        if (!full) { const int qp = P.qpos0 + r32;
#pragma unroll
            for (int r = 0; r < 16; ++r) { const int dq = qp - (kc0 + crow(r, hi)); if (dq < 0 || dq > 128) p0[r] = -INFINITY; } }
        float pmax = p0[0];
#pragma unroll
        for (int r = 1; r < 16; ++r) pmax = fmaxf(pmax, p0[r]);
        { auto sw = __builtin_amdgcn_permlane32_swap(__float_as_uint(pmax), __float_as_uint(pmax), false, false); pmax = fmaxf(__uint_as_float(sw[0]), __uint_as_float(sw[1])); }
        float mn, alpha;
        if (__builtin_expect(__all(pmax - m_reg <= THRS), 1)) { mn = m_reg; alpha = 1.f; }
        else { mn = fmaxf(m_reg, pmax); alpha = __builtin_amdgcn_exp2f((m_reg - mn) * C); m_reg = mn; }
        const float mnC = -mn * C;
#pragma unroll
        for (int r = 0; r < 16; ++r) p0[r] = __builtin_amdgcn_exp2f(fmaf(p0[r], C, mnC));
        if (__any(alpha < 1.f)) { if (hi == 0) wsf[r32] = alpha; asm volatile("s_waitcnt lgkmcnt(0)" ::: "memory");
#pragma unroll
            for (int r = 0; r < 16; ++r) { const float al = wsf[crow(r, hi)];
#pragma unroll
                for (int d = 0; d < 4; ++d) o[d][r] *= al; }
            asm volatile("s_waitcnt lgkmcnt(0)" ::: "memory"); }
        float ps = 0.f;
#pragma unroll
        for (int r = 0; r < 16; ++r) ps += p0[r];
        { auto sw = __builtin_amdgcn_permlane32_swap(__float_as_uint(ps), __float_as_uint(ps), false, false); ps = __uint_as_float(sw[0]) + __uint_as_float(sw[1]); }
        l_reg = l_reg * alpha + ps;
        bf16x8 pa0, pa1;
#define PK4(Pv, BASE, OUT) do { unsigned a0 = cvtpk(Pv[BASE + 0], Pv[BASE + 1]), a1 = cvtpk(Pv[BASE + 2], Pv[BASE + 3]);   \
    unsigned b0 = cvtpk(Pv[BASE + 4], Pv[BASE + 5]), b1 = cvtpk(Pv[BASE + 6], Pv[BASE + 7]);                              \
    auto r0 = __builtin_amdgcn_permlane32_swap(a0, b0, false, false); auto r1 = __builtin_amdgcn_permlane32_swap(a1, b1, false, false); \
    u32x4 w = {r0[0], r1[0], r0[1], r1[1]}; OUT = __builtin_bit_cast(bf16x8, w); } while (0)
        PK4(p0, 0, pa0); PK4(p0, 8, pa1);
#undef PK4
        SBAR();
#define A_PV(D0) do { const s16x4 l0 = tr_read<v_rd_off(D0, 0, 0)>(vb), h0 = tr_read<v_rd_off(D0, 0, 1)>(vb), l1 = tr_read<v_rd_off(D0, 1, 0)>(vb), h1 = tr_read<v_rd_off(D0, 1, 1)>(vb); \
        asm volatile("s_waitcnt lgkmcnt(0)" ::: "memory"); SBAR(); \
        o[D0] = __builtin_amdgcn_mfma_f32_32x32x16_bf16(pa0, (bf16x8){l0[0], l0[1], l0[2], l0[3], h0[0], h0[1], h0[2], h0[3]}, o[D0], 0, 0, 0); \
        o[D0] = __builtin_amdgcn_mfma_f32_32x32x16_bf16(pa1, (bf16x8){l1[0], l1[1], l1[2], l1[3], h1[0], h1[1], h1[2], h1[3]}, o[D0], 0, 0, 0); } while (0)
        A_PV(0); A_PV(1); A_PV(2); A_PV(3);
#undef A_PV
        asm volatile("s_waitcnt lgkmcnt(0)" ::: "memory");
    }
#undef A_LOAD
#undef A_CVT8
    if (P.mode & 2) {
        if (hi == 0) wsf[32 + r32] = l_reg; asm volatile("s_waitcnt lgkmcnt(0)" ::: "memory");
#pragma unroll
        for (int r = 0; r < 16; ++r) { const int qrow = crow(r, hi); const float rl = 1.0f / wsf[32 + qrow];
            const long tr = tb + (long)(P.qpos0 + qrow) * P.dil + P.rho; float sq = 0.f;
#pragma unroll
            for (int d = 0; d < 4; ++d) { const float v = o[d][r] * rl; sq += v * v; *(LAS unsigned short*)(stg + qrow * 272 + (32 * d + r32) * 2) = (unsigned short)(cvtpk(v, v) & 0xffffu); }
            sq += __shfl_xor(sq, 1); sq += __shfl_xor(sq, 2); sq += __shfl_xor(sq, 4); sq += __shfl_xor(sq, 8); sq += __shfl_xor(sq, 16);
            if (r32 == 0) X.ssq[tr * 16 + X.ssq0 + P.h] = sq; }
        asm volatile("s_waitcnt lgkmcnt(0)" ::: "memory");
#pragma unroll 2
        for (int i = 0; i < 8; ++i) { const int le = opaque(lane), row = i * 4 + (le >> 4), ch = le & 15; const long tr = tb + (long)(P.qpos0 + row) * P.dil + P.rho;
            *(u32x4*)(X.Oout + tr * 2048 + X.ocol0 + P.h * 128 + ch * 8) = *(const LAS u32x4*)(stg + row * 272 + ch * 16); }
    } else {
        if (hi == 0) { X.Sm[qtok * 8 + P.h] = m_reg; X.Sl[qtok * 8 + P.h] = l_reg; }
#pragma unroll
        for (int r = 0; r < 16; ++r)
#pragma unroll
            for (int d = 0; d < 4; ++d) { const float v = o[d][r]; *(LAS unsigned short*)(stg + crow(r, hi) * 272 + (32 * d + r32) * 2) = (unsigned short)(cvtpk(v, v) & 0xffffu); }
        asm volatile("s_waitcnt lgkmcnt(0)" ::: "memory");
#pragma unroll 2
        for (int i = 0; i < 8; ++i) { const int le = opaque(lane), row = i * 4 + (le >> 4), ch = le & 15; const long tr = tb + (long)(P.qpos0 + row) * P.dil + P.rho;
            *(u32x4*)(X.So + tr * 1024 + P.h * 128 + ch * 8) = *(const LAS u32x4*)(stg + row * 272 + ch * 16); }
    }
    asm volatile("s_waitcnt lgkmcnt(0)" ::: "memory");
}
}

namespace pk {
__device__ __forceinline__ void ce(int& a, int& b) { const int hi = max(a, b), lo = min(a, b); a = hi; b = lo; }
__device__ __forceinline__ void sort16(int (&v)[16]) {
#pragma unroll
    for (int k = 2; k <= 16; k <<= 1)
#pragma unroll
        for (int j = k >> 1; j > 0; j >>= 1)
#pragma unroll
            for (int i = 0; i < 16; ++i) { const int l = i ^ j; if (l > i) { if ((i & k) == 0) ce(v[i], v[l]); else ce(v[l], v[i]); } }
}
__device__ __forceinline__ void bmerge16(int (&c)[16]) {
#pragma unroll
    for (int j = 8; j > 0; j >>= 1)
#pragma unroll
        for (int i = 0; i < 16; ++i) { const int l = i ^ j; if (l > i) ce(c[i], c[l]); }
}
__device__ __forceinline__ void merge_top16(int (&a)[16], const int (&b)[16]) {
#pragma unroll
    for (int i = 0; i < 16; ++i) a[i] = max(a[i], b[15 - i]);
    bmerge16(a);
}
__device__ __forceinline__ int f2key(float f) { const int b = __float_as_int(f); return b ^ ((b >> 31) & 0x7fffffff); }
__device__ __forceinline__ float key2f(int k) { return __int_as_float(k ^ ((k >> 31) & 0x7fffffff)); }
}

#define XB_TMO      128
#define XB_XCNT(j)  (256  + 64 * (j))
#define XB_XSUB(j)  (1280 + 64 * (j))
#define XB_XGEN(j)  (2304 + 64 * (j))
#define XB_TOP      3328
#define XB_TOPGEN   3392
#define XCD_BAR_WORDS 3456
#define XB_SPIN_CAP (1u << 22)
__device__ __forceinline__ unsigned xb_ld(unsigned* p)              { return __hip_atomic_load(p, __ATOMIC_RELAXED, __HIP_MEMORY_SCOPE_AGENT); }
__device__ __forceinline__ unsigned xb_add(unsigned* p, unsigned v) { return __hip_atomic_fetch_add(p, v, __ATOMIC_RELAXED, __HIP_MEMORY_SCOPE_AGENT); }
__device__ __forceinline__ unsigned xb_xcc_id() { return (unsigned)__builtin_amdgcn_s_getreg((3 << 11) | 20) & 0xFu; }
#define XB_SPIN(cond, bar) do { unsigned _sp = 0; while (cond) { __builtin_amdgcn_s_sleep(1); \
    if ((++_sp & 255u) == 0u) { if (xb_ld(&(bar)[XB_TMO])) break; if (_sp > XB_SPIN_CAP) { atomicAdd(&(bar)[XB_TMO], 1u); break; } } } } while (0)
struct XcdBarrier { unsigned* bar; unsigned x; volatile LAS unsigned* st; };
__device__ __forceinline__ XcdBarrier xcd_barrier_post(unsigned* bar, volatile LAS unsigned* st) {
    XcdBarrier b; b.bar = bar; b.x = xb_xcc_id(); b.st = st;
    if (threadIdx.x == 0) (void)xb_add(&bar[XB_XCNT(b.x)], 1u);
    return b;
}
__device__ __forceinline__ void xcd_barrier_complete(unsigned* bar, unsigned x, unsigned& nloc, unsigned& nx) {
    const unsigned G = gridDim.x * gridDim.y * gridDim.z;
    unsigned sum, cnt, mine, sp = 0u;
    for (;;) {
        sum = 0u; cnt = 0u; mine = 0u;
#pragma unroll
        for (unsigned j = 0; j < 16; ++j) { const unsigned c = xb_ld(&bar[XB_XCNT(j)]); sum += c; cnt += (c > 0u) ? 1u : 0u; mine = (j == x) ? c : mine; }
        if (sum == G) break;
        __builtin_amdgcn_s_sleep(1);
        if ((++sp & 255u) == 0u) { if (xb_ld(&bar[XB_TMO])) break; if (sp > XB_SPIN_CAP) { atomicAdd(&bar[XB_TMO], 1u); break; } }
    }
    nloc = mine > 0u ? mine : 1u; nx = cnt > 0u ? cnt : 1u;
}
__device__ __forceinline__ void xcd_barrier(const XcdBarrier& b) {
    asm volatile("s_waitcnt vmcnt(0)" ::: "memory");
    __syncthreads();
    if (threadIdx.x == 0) {
        unsigned* bar = b.bar;
        __builtin_amdgcn_s_waitcnt(0);
        unsigned nloc = b.st[0], nx = b.st[1];
        if (nloc == 0u) { xcd_barrier_complete(bar, b.x, nloc, nx); b.st[0] = nloc; b.st[1] = nx; }
        const unsigned old = xb_add(&bar[XB_XSUB(b.x)], 1u);
        const unsigned gen = old / nloc;
        if (old + 1u == (gen + 1u) * nloc) {
            __builtin_amdgcn_fence(__ATOMIC_RELEASE, "agent");
            asm volatile("s_waitcnt vmcnt(0)" ::: "memory");
            const unsigned og = xb_add(&bar[XB_TOP], 1u);
            const unsigned tg = og / nx;
            if (og + 1u == (tg + 1u) * nx) xb_add(&bar[XB_TOPGEN], 1u);
            else XB_SPIN(xb_ld(&bar[XB_TOPGEN]) == tg, bar);
            __builtin_amdgcn_fence(__ATOMIC_ACQUIRE, "agent");
            xb_add(&bar[XB_XGEN(b.x)], 1u);
            asm volatile("s_waitcnt vmcnt(0)" ::: "memory");
        } else {
            XB_SPIN(xb_ld(&bar[XB_XGEN(b.x)]) == gen, bar);
            __builtin_amdgcn_fence(__ATOMIC_ACQUIRE, "agent");
            asm volatile("s_waitcnt vmcnt(0)" ::: "memory");
        }
    }
    __syncthreads();
}

struct Args { const float* in[22]; float* out; unsigned char* ws; int ph_lo, ph_hi; };
#if defined(NAIVE_PEER)
constexpr int N_PHASES = 12;
#else
constexpr int N_PHASES = 15;
#endif

__device__ __forceinline__ float gelu_erf(float v) { return 0.5f * v * (1.0f + erff(v * 0.70710678118654752f)); }

template <class Map>
__device__ __forceinline__ void transpose_item(const float* W, int K, int N, bf16_t* WT, const float* rscale, LAS float* scr, int item, int lane, Map dst_row) {
    const int nblk = N / 32, kb = item / nblk, nb = item % nblk, k0 = 64 * kb, n0 = 32 * nb;
    float tv[32];
#pragma unroll
    for (int i = 0; i < 32; ++i) tv[i] = W[(size_t)(k0 + 2 * i + (lane >> 5)) * N + n0 + (lane & 31)];
    if (rscale) {
#pragma unroll
        for (int i = 0; i < 32; ++i) tv[i] *= rscale[k0 + 2 * i + (lane >> 5)];
    }
#pragma unroll
    for (int i = 0; i < 32; ++i) scr[(2 * i + (lane >> 5)) * 33 + (lane & 31)] = tv[i];
    asm volatile("s_waitcnt lgkmcnt(0)" ::: "memory");
    const int c = lane & 7;
#pragma unroll
    for (int j = 0; j < 4; ++j) { const int n = (lane >> 3) + 8 * j; const LAS float* s = scr + (8 * c) * 33 + n;
        u32x4 o; o.x = cvtpk(s[0 * 33], s[1 * 33]); o.y = cvtpk(s[2 * 33], s[3 * 33]); o.z = cvtpk(s[4 * 33], s[5 * 33]); o.w = cvtpk(s[6 * 33], s[7 * 33]);
        *(u32x4*)(WT + (size_t)dst_row(n0 + n) * K + k0 + 8 * c) = o; }
    asm volatile("s_waitcnt lgkmcnt(0)" ::: "memory");
}
template <class Map>
__device__ __forceinline__ void transpose_item_q8(const float* W, int K, int N, unsigned char* WT, const float* rscale, const float* cmax, int ncm, int cstride, float* wscale, LAS float* scr, int item, int lane, Map dst_row) {
    const int nblk = N / 32, kb = item / nblk, nb = item % nblk, k0 = 64 * kb, n0 = 32 * nb;
    float tv[32];
#pragma unroll
    for (int i = 0; i < 32; ++i) tv[i] = W[(size_t)(k0 + 2 * i + (lane >> 5)) * N + n0 + (lane & 31)];
    if (rscale) {
#pragma unroll
        for (int i = 0; i < 32; ++i) tv[i] *= rscale[k0 + 2 * i + (lane >> 5)];
    }
    float mx = 0.f;
#pragma unroll
    for (int c = 0; c < 8; ++c) if (c < ncm) mx = fmaxf(mx, cmax[c * cstride + n0 + (lane & 31)]);
    const float inv = mx > 0.f ? 127.0f / mx : 1.0f;
    if (kb == 0 && lane < 32) wscale[dst_row(n0 + lane)] = mx > 0.f ? mx * (1.0f / 127.0f) : 1.0f;
#pragma unroll
    for (int i = 0; i < 32; ++i) scr[(2 * i + (lane >> 5)) * 33 + (lane & 31)] = tv[i] * inv;
    asm volatile("s_waitcnt lgkmcnt(0)" ::: "memory");
    const int c = lane & 7;
#pragma unroll
    for (int j = 0; j < 4; ++j) { const int n = (lane >> 3) + 8 * j; const LAS float* s = scr + (8 * c) * 33 + n;
        u32x2 o; o.x = pack_i8x4(s[0 * 33], s[1 * 33], s[2 * 33], s[3 * 33]); o.y = pack_i8x4(s[4 * 33], s[5 * 33], s[6 * 33], s[7 * 33]);
        *(u32x2*)(WT + (size_t)dst_row(n0 + n) * K + k0 + 8 * c) = o; }
    asm volatile("s_waitcnt lgkmcnt(0)" ::: "memory");
}
struct MapIn { __device__ __forceinline__ int operator()(int o) const {
    if (o < 2048) { const int e = o & 127; if (e < 32) { const int i = e & 15, n = e >> 4; return (o & ~127) + 8 * (i >> 2) + 4 * n + (i & 3); } return o; }
    if (o < 4096) return o;
    const int e = o - 4096, n = e >> 5, i = e & 31; return 4096 + 32 * (i >> 4) + 8 * ((i >> 2) & 3) + 4 * n + (i & 3); } };
struct MapUq { __device__ __forceinline__ int operator()(int o) const {
    const int hd = o / 192, e = o - hd * 192; if (e < 128) return hd * 128 + e;
    const int r = e - 128, n = r >> 5, i = r & 31; return 1024 + hd * 64 + 32 * (i >> 4) + 8 * ((i >> 2) & 3) + 4 * n + (i & 3); } };
struct MapOff { int off; __device__ __forceinline__ int operator()(int o) const { return o + off; } };

#define WS_PTRS \
    const float* x = AR.in[0]; \
    float* mod = (float*)(ws + WS_MOD); \
    float* ropeA = (float*)(ws + WS_ROPEA); float* ropeB = (float*)(ws + WS_ROPEB); \
    bf16_t* Win_t = (bf16_t*)(ws + WS_WIN); bf16_t* Wuq_t = (bf16_t*)(ws + WS_WUQ); bf16_t* Wukv_t = (bf16_t*)(ws + WS_WUKV); \
    bf16_t* Wo_t = (bf16_t*)(ws + WS_WO); bf16_t* Wpq_t = (bf16_t*)(ws + WS_WPQ); \
    bf16_t* UT = (bf16_t*)(ws + WS_UT); bf16_t* VT = (bf16_t*)(ws + WS_VT); \
    unsigned char* HI8 = ws + WS_A; unsigned char* WT8 = ws + WS_WIN; unsigned char* WPQ8 = ws + WS_WPQ; unsigned char* WUQ8 = ws + WS_WUQ; unsigned char* WUKV8 = ws + WS_WUKV; unsigned char* CQ8 = ws + WS_A; unsigned char* CKV8 = ws + WS_A + 16 * MiB; float* CQS = (float*)(ws + WS_CQS); float* CKVS = CQS + 32768; float* CMQ = (float*)(ws + WS_CMQ); float* CMKV = CMQ + 4096; float* WSQ = (float*)(ws + WS_WSQ); float* WSKV = WSQ + 2048; unsigned char* WO8 = ws + WS_WO; unsigned char* O8 = ws + WS_A; float* OS = (float*)(ws + WS_OS); float* CMAX3 = (float*)(ws + WS_CMAX3); float* WS3 = (float*)(ws + WS_WS3); float* CMAX2 = (float*)(ws + WS_CMAX2); float* WS4 = (float*)(ws + WS_WS4); float* CMAX = (float*)(ws + WS_CMAX); float* WS1 = (float*)(ws + WS_WS1); float* HS1 = (float*)(ws + WS_HS1); \
    bf16_t* Hb = (bf16_t*)(ws + WS_A); bf16_t* So = (bf16_t*)(ws + WS_A); bf16_t* Qp = (bf16_t*)(ws + WS_A); \
    bf16_t* QA = (bf16_t*)(ws + WS_QA); bf16_t* KA = (bf16_t*)(ws + WS_KA); bf16_t* VA = (bf16_t*)(ws + WS_VA); \
    bf16_t* CQ = (bf16_t*)(ws + WS_CQ); bf16_t* CKV = (bf16_t*)(ws + WS_CKV); bf16_t* KR = (bf16_t*)(ws + WS_KR); \
    float* Y = (float*)(ws + WS_Y); bf16_t* MIXb = (bf16_t*)(ws + WS_Y); \
    bf16_t* Qn = (bf16_t*)(ws + WS_QN); bf16_t* Qr = (bf16_t*)(ws + WS_QR); bf16_t* Kn = (bf16_t*)(ws + WS_KN); bf16_t* Vb = (bf16_t*)(ws + WS_VB); \
    bf16_t* H2 = (bf16_t*)(ws + WS_H2); bf16_t* Ob = (bf16_t*)(ws + WS_O); \
    float* ssq_q = (float*)(ws + WS_SSQ_Q); float* ssq_kv = (float*)(ws + WS_SSQ_KV); float* ssq_o = (float*)(ws + WS_SSQ_O); \
    float* Sm = (float*)(ws + WS_SM); float* Sl = (float*)(ws + WS_SL); \
    bf16_t* K1b = (bf16_t*)(ws + WS_K1); bf16_t* K2b = (bf16_t*)(ws + WS_K2); \
    unsigned short* IDX = (unsigned short*)(ws + WS_IDX); float* Gt = (float*)(ws + WS_G); \
    float* SU = (float*)(ws + WS_SU); float* SH = (float*)(ws + WS_SH); \
    unsigned char* U8 = ws + WS_U8; unsigned char* H8 = ws + WS_H8; \
    float* PART = (float*)(ws + WS_PART); unsigned short* IDX2 = (unsigned short*)(ws + WS_IDX2); unsigned char* WTq = ws + WS_WT; float* WSC = (float*)(ws + WS_WT + 8 * MiB); \
    bf16_t* FFN = (bf16_t*)(ws + WS_FFN); bf16_t* X1b = (bf16_t*)(ws + WS_X1); unsigned char* H2S = ws + WS_H2S;

__global__ void __launch_bounds__(NWAVES * 64, 2) mega_fwd(Args args) {
    extern __shared__ __attribute__((aligned(16))) unsigned char lds_raw[];
    LAS unsigned char* lds = (LAS unsigned char*)lds_raw;
    const int G = gridDim.x, bid = blockIdx.x, NGW = G * NWAVES;
    const int wave0 = __builtin_amdgcn_readfirstlane((int)threadIdx.x >> 6);
#define PH_LOCALS const int lane = opaque((int)__builtin_amdgcn_mbcnt_hi(~0u, __builtin_amdgcn_mbcnt_lo(~0u, 0u))), wave = wave0, tid = wave * 64 + lane, gw = bid * NWAVES + wave; (void)gw; \
    const __attribute__((address_space(4))) Args* arp_ = (const __attribute__((address_space(4))) Args*)__builtin_amdgcn_kernarg_segment_ptr(); asm volatile("" : "+s"(arp_)); const __attribute__((address_space(4))) Args& AR = *arp_; unsigned char* ws = AR.ws; WS_PTRS
    unsigned char* ws0 = args.ws;
    const int lo = args.ph_lo, hi_ph = args.ph_hi;
    if (threadIdx.x < 4) ((LAS unsigned*)(lds + LDS_BYTES - 16))[threadIdx.x] = 0u;
    __syncthreads();
    XcdBarrier xbar = xcd_barrier_post((unsigned*)ws0, (volatile LAS unsigned*)(lds + LDS_BYTES - 16));
#ifdef ONLY_PH
#define IN(k) ((k) == ONLY_PH && lo <= (k) && (k) < hi_ph)
#else
#define IN(k) (lo <= (k) && (k) < hi_ph)
#endif
#if MK_N_LAUNCHES == 1
#define GRID_BAR(k) do { if (IN(k) && IN((k) + 1)) { if ((k) == 0) cg::this_grid().sync(); else xcd_barrier(xbar); } } while (0)
#else
#define GRID_BAR(k) do { } while (0)
#endif
    constexpr int TB_SPLIT = 12288;
#define TB_LOAD(BUF, rr) do { const float* src_ = (((rr) >> 14) ? AR.in[19] : AR.in[18]) + (size_t)((rr) & (NE - 1)) * 2048; \
                    _Pragma("unroll") for (int c = 0; c < 4; ++c) { const f32x4* p_ = (const f32x4*)(src_ + c * 512 + lane * 8); BUF[2 * c] = p_[0]; BUF[2 * c + 1] = p_[1]; } } while (0)
#define TB_STEP(BUF, RR, NW, REND) do { const int r = (RR); \
                    const int tbl = r >> 14, e = r & (NE - 1); \
                    f32x4 v[8]; float mx = 0.f, sq = 0.f; \
_Pragma("unroll") \
                    for (int i = 0; i < 8; ++i) { v[i] = BUF[i]; mx = fmaxf(fmaxf(mx, fmaxf(fabsf(v[i][0]), fabsf(v[i][1]))), fmaxf(fabsf(v[i][2]), fabsf(v[i][3]))); \
                        sq += (v[i][0] * v[i][0] + v[i][1] * v[i][1]) + (v[i][2] * v[i][2] + v[i][3] * v[i][3]); } \
                    if (r + 2 * (NW) < (REND)) TB_LOAD(BUF, r + 2 * (NW)); \
                    mx = wmax(mx); \
                    if (tbl == 0) { \
                          \
                          \
                        const float rms = sqrtf(wsum(sq) * (1.0f / 2048.0f)); \
                        const float step = rms > 0.f ? fmaxf(0.335f * rms, mx * (1.0f / 64.0f)) : 1.0f; \
                        const float inv = 1.0f / step; \
                        if (lane == 0) SU[e] = step; \
                        unsigned char* dst = U8 + (size_t)e * 128 + (lane & 31) * 4; \
_Pragma("unroll") \
                        for (int c = 0; c < 4; ++c) { unsigned w = 0u; \
_Pragma("unroll") \
                            for (int i = 0; i < 4; ++i) { const float a = v[2 * c][i] * inv, b = v[2 * c + 1][i] * inv; \
                                const int qa = (int)__builtin_rintf(fminf(fmaxf(a, -7.f), 7.f)) + 8, qb = (int)__builtin_rintf(fminf(fmaxf(b, -7.f), 7.f)) + 8; \
                                w |= ((unsigned)qa | ((unsigned)qb << 4)) << (8 * i); } \
                            *(unsigned*)(dst + (size_t)(c * 2 + (lane >> 5)) * (2u << 20)) = w; } \
                    } else { \
                          \
                        const float rms = sqrtf(wsum(sq) * (1.0f / 2048.0f)); \
                        const float step = rms > 0.f ? fmaxf(0.335f * rms, mx * (1.0f / 64.0f)) : 1.0f; \
                        const float inv = 1.0f / step; \
                        if (lane == 0) SU[NE + e] = step; \
                        unsigned char* dst = U8 + (size_t)(32u << 20) + (size_t)e * 128 + (lane & 31) * 4; \
_Pragma("unroll") \
                        for (int c = 0; c < 4; ++c) { unsigned w = 0u; \
_Pragma("unroll") \
                            for (int i = 0; i < 4; ++i) { const float a = (i < 2 ? v[2 * c][2 * i] : v[2 * c + 1][2 * i - 4]) * inv, b = (i < 2 ? v[2 * c][2 * i + 1] : v[2 * c + 1][2 * i - 3]) * inv; \
                                const int qa = (int)__builtin_rintf(fminf(fmaxf(a, -7.f), 7.f)) + 8, qb = (int)__builtin_rintf(fminf(fmaxf(b, -7.f), 7.f)) + 8; \
                                w |= ((unsigned)qa | ((unsigned)qb << 4)) << (8 * i); } \
                            *(unsigned*)(dst + (size_t)(c * 2 + (lane >> 5)) * (2u << 20)) = w; } \
                    } \
    } while (0)
#define TABLE_CONVERT(W0, NW, RBEG, REND) do { \
            f32x4 nva[8], nvb[8]; const int r0_ = (RBEG) + (W0); \
            if (r0_ < (REND)) TB_LOAD(nva, r0_); \
            if (r0_ + (NW) < (REND)) TB_LOAD(nvb, r0_ + (NW)); \
            for (int rr_ = r0_; rr_ < (REND); rr_ += 2 * (NW)) { \
                TB_STEP(nva, rr_, NW, REND); \
                if (rr_ + (NW) < (REND)) TB_STEP(nvb, rr_ + (NW), NW, REND); \
            } \
    } while (0)
    for (int rep_ = 0; rep_ < (IN(0) ? 1 + ((REP_MASK >> 0) & 1) : 0); ++rep_) {
        PH_LOCALS;
        for (int cb = bid; cb < 192; cb += G) {
            LAS float* cact = (LAS float*)lds;
            const float* cin = AR.in[1];
            for (int i = tid; i < 16 * 2048; i += NWAVES * 64) { const float v = cin[i]; cact[i] = v / (1.0f + __expf(-v)); }
            __syncthreads();
            const int col = cb * 64 + lane;
            float acc[16];
#pragma unroll
            for (int b = 0; b < 16; ++b) acc[b] = 0.f;
            const float* wp = AR.in[2] + (size_t)(wave * 256) * 12288 + col;
            for (int k0 = 0; k0 < 256; k0 += 16) {
                float w[16];
#pragma unroll
                for (int i = 0; i < 16; ++i) w[i] = wp[(size_t)(k0 + i) * 12288];
#pragma unroll
                for (int b = 0; b < 16; ++b) {
#pragma unroll
                    for (int i4 = 0; i4 < 4; ++i4) { const f32x4 cv = *(const LAS f32x4*)(cact + b * 2048 + wave * 256 + k0 + 4 * i4);
                        acc[b] += cv[0] * w[4 * i4] + cv[1] * w[4 * i4 + 1] + cv[2] * w[4 * i4 + 2] + cv[3] * w[4 * i4 + 3]; }
                }
            }
            __syncthreads();
            LAS float* red = (LAS float*)lds;
#pragma unroll
            for (int b = 0; b < 16; ++b) red[(wave * 16 + b) * 64 + lane] = acc[b];
            __syncthreads();
            for (int o = tid; o < 1024; o += NWAVES * 64) { const int b = o >> 6, cl = o & 63; float s = 0.f;
#pragma unroll
                for (int w = 0; w < 8; ++w) s += red[(w * 16 + b) * 64 + cl];
                mod[(size_t)b * 12288 + cb * 64 + cl] = s + AR.in[3][cb * 64 + cl]; }
            __syncthreads();
        }
        {
            LAS float* scr = (LAS float*)(lds + wave * 16384);
            constexpr int I_IN = 8 * 65, I_UQ = 2 * 24, I_UK = 2 * 16, I_UV = 2 * 16, I_O = 8 * 32, I_PQ = 8 * 32;
            constexpr int NITEMS = I_IN + I_UQ + I_UK + I_UV + I_O + I_PQ;
            for (int it = gw; it < NITEMS; it += NGW) {
                int r = it;
                if (r < I_IN) {
                    const int kc = r / 65, nb = r % 65; const float* wp = AR.in[4] + (size_t)(kc * 256) * NPROJ + nb * 64 + lane; float mx = 0.f;
#pragma unroll 1
                    for (int k0 = 0; k0 < 256; k0 += 32) { float w[32];
#pragma unroll
                        for (int i = 0; i < 32; ++i) w[i] = wp[(size_t)(k0 + i) * NPROJ];
#pragma unroll
                        for (int i = 0; i < 32; ++i) mx = fmaxf(mx, fabsf(w[i])); }
                    CMAX[kc * NPROJ_PAD + nb * 64 + lane] = mx; continue; } r -= I_IN;
                if (r < I_UQ + I_UK + I_UV) {
                    const int t3 = r < I_UQ ? 0 : (r < I_UQ + I_UK ? 1 : 2), rr = r - (t3 == 0 ? 0 : (t3 == 1 ? I_UQ : I_UQ + I_UK));
                    const int N3 = t3 == 0 ? 1536 : 1024, nb3 = N3 / 64, kc = rr / nb3, nb = rr % nb3;
                    const float* wp = (t3 == 0 ? AR.in[7] : (t3 == 1 ? AR.in[8] : AR.in[9])) + (size_t)(kc * 256) * N3 + nb * 64 + lane;
                    const float* gp = (t3 == 0 ? AR.in[5] : AR.in[6]) + kc * 256; float mx = 0.f;
#pragma unroll 1
                    for (int k0 = 0; k0 < 256; k0 += 32) { float w[32];
#pragma unroll
                        for (int i = 0; i < 32; ++i) w[i] = wp[(size_t)(k0 + i) * N3];
#pragma unroll
                        for (int i = 0; i < 32; ++i) mx = fmaxf(mx, fabsf(w[i] * gp[k0 + i])); }
                    (t3 == 0 ? CMQ + kc * 1536 : CMKV + kc * 2048 + (t3 == 2 ? 1024 : 0))[nb * 64 + lane] = mx; continue; } r -= I_UQ + I_UK + I_UV;
                if (r < I_O) {
                    const int kc = r >> 5, nb = r & 31; const float* wp = AR.in[12] + (size_t)(kc * 256) * 2048 + nb * 64 + lane;
                    const float* gp = (kc < 4 ? AR.in[10] : AR.in[11] - 1024) + kc * 256; float mx = 0.f;
#pragma unroll 1
                    for (int k0 = 0; k0 < 256; k0 += 32) { float w[32];
#pragma unroll
                        for (int i = 0; i < 32; ++i) w[i] = wp[(size_t)(k0 + i) * 2048];
#pragma unroll
                        for (int i = 0; i < 32; ++i) mx = fmaxf(mx, fabsf(w[i] * gp[k0 + i])); }
                    CMAX3[kc * 2048 + nb * 64 + lane] = mx; continue; } r -= I_O;
                {
                    const int kc = r >> 5, nb = r & 31; const float* wp = AR.in[15] + (size_t)(kc * 256) * 2048 + nb * 64 + lane; float mx = 0.f;
#pragma unroll 1
                    for (int k0 = 0; k0 < 256; k0 += 32) { float w[32];
#pragma unroll
                        for (int i = 0; i < 32; ++i) w[i] = wp[(size_t)(k0 + i) * 2048];
#pragma unroll
                        for (int i = 0; i < 32; ++i) mx = fmaxf(mx, fabsf(w[i])); }
                    CMAX2[kc * 2048 + nb * 64 + lane] = mx; }
            }
            for (size_t i = (size_t)gw * 64 + lane; i < (size_t)(NPROJ_PAD - NPROJ) * 2048 / 16; i += (size_t)NGW * 64)
                *(u32x4*)(WT8 + (size_t)NPROJ * 2048 + i * 16) = (u32x4){0u, 0u, 0u, 0u};
            if (gw == 0) for (int i = lane; i < NPROJ_PAD - NPROJ; i += 64) WS1[NPROJ + i] = 1.0f;
        }
#if defined(NAIVE_PEER)
        for (int r = gw; r < 2 * NE; r += NGW) {
            const float* src = (r < NE ? AR.in[18] : AR.in[19]) + (size_t)(r & (NE - 1)) * 2048;
            bf16_t* dst = (r < NE ? UT : VT) + (size_t)(r & (NE - 1)) * 2048;
            f32x4 v[8];
#pragma unroll
            for (int c = 0; c < 4; ++c) { const f32x4* p = (const f32x4*)(src + c * 512 + lane * 8); v[2 * c] = p[0]; v[2 * c + 1] = p[1]; }
#pragma unroll
            for (int c = 0; c < 4; ++c) pg8::store8(dst + c * 512 + lane * 8, v[2 * c], v[2 * c + 1]);
        }
#else
        TABLE_CONVERT(gw, NGW, TB_SPLIT, 2 * NE);
#endif
        for (int i = gw * 64 + lane; i < 2 * 16384; i += NGW * 64) {
            const float v = (i < 16384 ? AR.in[16] : AR.in[17])[i & 16383];
            (i < 16384 ? K1b : K2b)[i & 16383] = (bf16_t)(cvtpk(v, v) & 0xffffu);
        }
    }
    GRID_BAR(0);

    for (int rep_ = 0; rep_ < (IN(1) ? 1 + ((REP_MASK >> 1) & 1) : 0); ++rep_) {
        PH_LOCALS;
        const int nb_ = G >> 4, b = bid / nb_, r0 = (bid % nb_) * NWAVES + wave, rstep = nb_ * NWAVES;
        LAS float* psh = (LAS float*)lds; LAS float* psc = psh + 2048;
        __syncthreads();
        if (b < 16) { const float* mb = mod + (size_t)b * 12288;
            *(LAS f32x4*)(psh + 4 * tid) = *(const f32x4*)(mb + 4 * tid); *(LAS f32x4*)(psc + 4 * tid) = *(const f32x4*)(mb + 2048 + 4 * tid) + 1.0f; }
        __syncthreads();
        { LAS float* scr = (LAS float*)(lds + 16384 + wave * 8704);
          for (int it = gw; it < 32 * 130; it += NGW) transpose_item_q8(AR.in[4], 2048, NPROJ, WT8, (const float*)nullptr, CMAX, 8, NPROJ_PAD, WS1, scr, it, lane, MapIn{});
          for (int it = gw; it < 32 * 64; it += NGW) transpose_item_q8(AR.in[15], 2048, 2048, WPQ8, (const float*)nullptr, CMAX2, 8, 2048, WS4, scr, it, lane, MapOff{0});
          for (int it = gw; it < 32 * 64; it += NGW) { const int kb = it / 64; transpose_item_q8(AR.in[12], 2048, 2048, WO8, kb < 16 ? AR.in[10] : AR.in[11] - 1024, CMAX3, 8, 2048, WS3, scr, it, lane, MapOff{0}); }
          for (int it = gw; it < 8 * 48; it += NGW) transpose_item_q8(AR.in[7], 512, 1536, WUQ8, AR.in[5], CMQ, 2, 1536, WSQ, scr, it, lane, MapUq{});
          for (int it = gw; it < 8 * 32; it += NGW) transpose_item_q8(AR.in[8], 512, 1024, WUKV8, AR.in[6], CMKV, 2, 2048, WSKV, scr, it, lane, MapOff{0});
          for (int it = gw; it < 8 * 32; it += NGW) transpose_item_q8(AR.in[9], 512, 1024, WUKV8, AR.in[6], CMKV + 1024, 2, 2048, WSKV, scr, it, lane, MapOff{1024}); }
        if (b < 16) {
            f32x4 nv[8];
            { const f32x4* xr = (const f32x4*)(x + ((size_t)b * 2048 + r0) * DM) + lane;
#pragma unroll
              for (int j = 0; j < 8; ++j) nv[j] = xr[64 * j]; }
            for (int r = r0; r < 2048; r += rstep) {
                const int row = b * 2048 + r;
                f32x4 v[8]; float s = 0.f;
#pragma unroll
                for (int j = 0; j < 8; ++j) { v[j] = nv[j]; s += (v[j][0] + v[j][1]) + (v[j][2] + v[j][3]); }
                if (r + rstep < 2048) { const f32x4* xr = (const f32x4*)(x + (size_t)(row + rstep) * DM) + lane;
#pragma unroll
                    for (int j = 0; j < 8; ++j) nv[j] = xr[64 * j]; }
                const float mean = wsum(s) * (1.0f / DM); float s2 = 0.f;
#pragma unroll
                for (int j = 0; j < 8; ++j) { v[j] = v[j] - mean; s2 += (v[j][0] * v[j][0] + v[j][1] * v[j][1]) + (v[j][2] * v[j][2] + v[j][3] * v[j][3]); }
                const float rstd = 1.0f / sqrtf(wsum(s2) * (1.0f / DM) + 1e-5f);
                float mx = 0.f;
#pragma unroll
                for (int j = 0; j < 8; ++j) { const int d = 4 * (lane + 64 * j);
                    const f32x4 sh = *(const LAS f32x4*)(psh + d), sc1 = *(const LAS f32x4*)(psc + d);
                    v[j] = v[j] * rstd * sc1 + sh; mx = fmaxf(fmaxf(mx, fmaxf(fabsf(v[j][0]), fabsf(v[j][1]))), fmaxf(fabsf(v[j][2]), fabsf(v[j][3]))); }
                mx = wmax(mx);
                const float qs = mx > 0.f ? 127.0f / mx : 1.0f;
                if (lane == 0) HS1[row] = mx > 0.f ? mx * (1.0f / 127.0f) : 1.0f;
#pragma unroll
                for (int j = 0; j < 8; ++j) { const int d = 4 * (lane + 64 * j); const f32x4 y = v[j] * qs;
                    *(unsigned*)(HI8 + (size_t)row * DM + d) = pack_i8x4(y[0], y[1], y[2], y[3]); }
            }
        }
    }
    GRID_BAR(1);

    for (int rep_ = 0; rep_ < (IN(2) ? 1 + ((REP_MASK >> 2) & 1) : 0); ++rep_) {
        PH_LOCALS;
        pg8::Gemm g{(const bf16_t*)HI8, (const bf16_t*)WT8, T, NPROJ_PAD, DM / 2}; pg8::StaticOrder S; S.init(T, NPROJ_PAD, G, bid);
        pg8::EpiProj E{QA, CQ, KR, ssq_q, HS1, WS1};
        pg8::gemm_phase(tid, lds, g, S, E);
#if !defined(NAIVE_PEER)
        {
            const int nun_ = (T / 256) * (NPROJ_PAD / 256), rem_ = nun_ % G;
            const int tw0_ = ((rem_ ? bid - rem_ : bid) * NWAVES + wave), tnw_ = (rem_ ? G - rem_ : G) * NWAVES;
            if (tw0_ >= 0) {
                TABLE_CONVERT(tw0_, tnw_, 0, TB_SPLIT);
            }
        }
#endif
    }
    GRID_BAR(2);

    for (int rep_ = 0; rep_ < (IN(5) ? 1 + ((REP_MASK >> 5) & 1) : 0); ++rep_) {
        PH_LOCALS;
        u32x4 ncq, nck; float nsq[8], nsk[8];
#define P5_LOAD(tt) do { ncq = *(const u32x4*)(CQ + (size_t)(tt) * 512 + lane * 8); nck = *(const u32x4*)(CKV + (size_t)(tt) * 512 + lane * 8); \
            _Pragma("unroll") for (int sl = 0; sl < 8; ++sl) { nsq[sl] = ssq_q[(size_t)sl * T + (tt)]; nsk[sl] = ssq_kv[(size_t)sl * T + (tt)]; } } while (0)
        P5_LOAD(gw);
        for (int t = gw; t < T; t += NGW) {
            const u32x4 cq = ncq, ck = nck;
            float sq_ = 0.f, sk_ = 0.f;
#pragma unroll
            for (int sl = 0; sl < 8; ++sl) { sq_ += nsq[sl]; sk_ += nsk[sl]; }
            P5_LOAD(min(t + NGW, T - 1));
            const float rq = 1.0f / sqrtf(sq_ * (1.0f / 512.0f) + 1e-6f), rk = 1.0f / sqrtf(sk_ * (1.0f / 512.0f) + 1e-6f);
            float fq_[8], fk_[8]; float mq = 0.f, mk = 0.f;
            { const unsigned a0 = cq.x, a1 = cq.y, a2 = cq.z, a3 = cq.w, b0 = ck.x, b1 = ck.y, b2 = ck.z, b3 = ck.w;
              fq_[0] = bf_lo(a0) * rq; fq_[1] = bf_hi(a0) * rq; fq_[2] = bf_lo(a1) * rq; fq_[3] = bf_hi(a1) * rq; fq_[4] = bf_lo(a2) * rq; fq_[5] = bf_hi(a2) * rq; fq_[6] = bf_lo(a3) * rq; fq_[7] = bf_hi(a3) * rq;
              fk_[0] = bf_lo(b0) * rk; fk_[1] = bf_hi(b0) * rk; fk_[2] = bf_lo(b1) * rk; fk_[3] = bf_hi(b1) * rk; fk_[4] = bf_lo(b2) * rk; fk_[5] = bf_hi(b2) * rk; fk_[6] = bf_lo(b3) * rk; fk_[7] = bf_hi(b3) * rk; }
#pragma unroll
            for (int i = 0; i < 8; ++i) { mq = fmaxf(mq, fabsf(fq_[i])); mk = fmaxf(mk, fabsf(fk_[i])); }
            mq = wmax(mq); mk = wmax(mk);
            const float qq = mq > 0.f ? 127.0f / mq : 1.0f, qk = mk > 0.f ? 127.0f / mk : 1.0f;
            if (lane == 0) { CQS[t] = mq > 0.f ? mq * (1.0f / 127.0f) : 1.0f; CKVS[t] = mk > 0.f ? mk * (1.0f / 127.0f) : 1.0f; }
            { u32x2 w; w.x = pack_i8x4(fq_[0] * qq, fq_[1] * qq, fq_[2] * qq, fq_[3] * qq); w.y = pack_i8x4(fq_[4] * qq, fq_[5] * qq, fq_[6] * qq, fq_[7] * qq); *(u32x2*)(CQ8 + (size_t)t * 512 + lane * 8) = w; }
            { u32x2 w; w.x = pack_i8x4(fk_[0] * qk, fk_[1] * qk, fk_[2] * qk, fk_[3] * qk); w.y = pack_i8x4(fk_[4] * qk, fk_[5] * qk, fk_[6] * qk, fk_[7] * qk); *(u32x2*)(CKV8 + (size_t)t * 512 + lane * 8) = w; }
        }
#undef P5_LOAD
    }
    GRID_BAR(5);

    for (int rep_ = 0; rep_ < (IN(3) ? 1 + ((REP_MASK >> 3) & 1) : 0); ++rep_) {
        PH_LOCALS;
        LAS float* tab = (LAS float*)(lds + pg8::STAGE_BYTES);
        { pg8::Gemm g{(const bf16_t*)CQ8, (const bf16_t*)WUQ8, T, 1536, 256}; pg8::StaticOrder S; S.init(T, 1536, G, bid);
          if (tid < 256) {
#pragma unroll
              for (int i = 0; i < 4; ++i) { pg8::Unit u; if (S.next(i, u)) tab[i * 256 + tid] = CQS[u.pm * 256 + tid]; } }
          __syncthreads();
          pg8::EpiQ E{Qn, Qr, tab, WSQ}; pg8::gemm_phase(tid, lds, g, S, E); }
        __syncthreads();
        { pg8::Gemm g{(const bf16_t*)CKV8, (const bf16_t*)WUKV8, T, 2048, 256}; pg8::StaticOrder S; S.init(T, 2048, G, bid);
          if (tid < 256) {
#pragma unroll
              for (int i = 0; i < 4; ++i) { pg8::Unit u; if (S.next(i, u)) tab[i * 256 + tid] = CKVS[u.pm * 256 + tid]; } }
          __syncthreads();
          pg8::EpiKV E{Kn, Vb, tab, WSKV}; pg8::gemm_phase(tid, lds, g, S, E); }
    }
    GRID_BAR(3);


#if defined(NAIVE_ATTN)
    for (int rep_ = 0; rep_ < (IN(4) ? 1 + ((REP_MASK >> 4) & 1) : 0); ++rep_) {
        PH_LOCALS;
        for (int it = gw; it < T * 8; it += NGW) {
            const int t = it >> 3, h = it & 7, b = t >> 11, s = t & 2047;
            {
                const unsigned qv = *(const unsigned*)(QA + (size_t)t * 1024 + h * 128 + 2 * lane);
                const float q0 = bf_lo(qv), q1 = bf_hi(qv);
                float m = -1e30f, l = 0.f, a0 = 0.f, a1 = 0.f;
                for (int br = 0; br < 3; ++br) { const int dil = br == 0 ? 1 : (br == 1 ? 4 : 16);
                    for (int j = 0; j <= 128; ++j) { const int sk = s - j * dil; if (sk < 0) break;
                        const size_t tk = (size_t)b * SEQ + sk;
                        const unsigned kv = *(const unsigned*)(KA + tk * 1024 + h * 128 + 2 * lane);
                        const unsigned vv = *(const unsigned*)(VA + tk * 1024 + h * 128 + 2 * lane);
                        const float sc = wave_sum(q0 * bf_lo(kv) + q1 * bf_hi(kv)) * 0.08838834764831845f;
                        const float mn = fmaxf(m, sc), corr = __expf(m - mn), pp = __expf(sc - mn);
                        l = l * corr + pp; a0 = a0 * corr + pp * bf_lo(vv); a1 = a1 * corr + pp * bf_hi(vv); m = mn; } }
                const float r0 = a0 / l, r1 = a1 / l;
                *(unsigned*)(Ob + (size_t)t * 2048 + h * 128 + 2 * lane) = cvtpk(r0, r1);
                const float sq = wave_sum(r0 * r0 + r1 * r1);
                if (lane == 0) ssq_o[(size_t)t * 16 + h] = sq;
            }
            {
                const unsigned qv = *(const unsigned*)(Qn + (size_t)t * 1024 + h * 128 + 2 * lane);
                const float q0 = bf_lo(qv), q1 = bf_hi(qv);
                const unsigned short qrv = Qr[(size_t)t * 512 + h * 64 + lane]; const float qr0 = __uint_as_float((unsigned)qrv << 16);
                float m = -1e30f, l = 0.f, a0 = 0.f, a1 = 0.f;
                for (int sk = 0; sk <= s; ++sk) { const size_t tk = (size_t)b * SEQ + sk;
                    const unsigned kv = *(const unsigned*)(Kn + tk * 1024 + h * 128 + 2 * lane);
                    const unsigned vv = *(const unsigned*)(Vb + tk * 1024 + h * 128 + 2 * lane);
                    const float krv = __uint_as_float((unsigned)KR[tk * 64 + lane] << 16);
                    const float sc = wave_sum(q0 * bf_lo(kv) + q1 * bf_hi(kv) + qr0 * krv) * 0.07216878364870322f;
                    const float mn = fmaxf(m, sc), corr = __expf(m - mn), pp = __expf(sc - mn);
                    l = l * corr + pp; a0 = a0 * corr + pp * bf_lo(vv); a1 = a1 * corr + pp * bf_hi(vv); m = mn; }
                const float r0 = a0 / l, r1 = a1 / l;
                *(unsigned*)(Ob + (size_t)t * 2048 + 1024 + h * 128 + 2 * lane) = cvtpk(r0, r1);
                const float sq = wave_sum(r0 * r0 + r1 * r1);
                if (lane == 0) ssq_o[(size_t)t * 16 + 8 + h] = sq;
            }
        }
    }
#else
    for (int rep_ = 0; rep_ < (IN(4) ? 1 + ((REP_MASK >> 4) & 1) : 0); ++rep_) {
        PH_LOCALS;
        att::Tens XA{QA, nullptr, KA, nullptr, VA, So, Sm, Sl, Ob, 0, ssq_o, 0};
        {
            LAS unsigned char* wl = lds + wave * 17408; LAS float* wsf = (LAS float*)(lds + 8 * 17408) + wave * 64;
            for (int repa = 0; repa < 1 + ((REP_MASK >> 16) & 1); ++repa)
            for (int u = bid; u < 512; u += G) {
                const int J = (u >> 3) & 3, bh = (u & 7) + 8 * (u >> 5), b = bh >> 3, h = bh & 7;
#pragma unroll 1
                for (int br = 0; br < 3; ++br) {
#pragma unroll 1
                    for (int k = 0; k < 2; ++k) { const int wu = wave + 8 * k;
                        att::WaveA P;
                        P.b = b; P.h = h; P.mode = br == 0 ? 0 : (br == 1 ? 1 : 3);
                        if (br == 0) { P.dil = 1; P.rho = 0; P.qpos0 = 512 * J + 32 * wu; }
                        else if (br == 1) { P.dil = 4; P.rho = wu >> 2; P.qpos0 = 128 * J + 32 * (wu & 3); }
                        else { P.dil = 16; P.rho = wu; P.qpos0 = 32 * J; }
                        att::attnA_wave(lane, P, wl, wsf, XA); }
                    asm volatile("s_waitcnt vmcnt(0)" ::: "memory");
                    __syncthreads();
                }
            }
            __syncthreads();
        }
        att::Tens XB{Qn, Qr, Kn, KR, Vb, nullptr, nullptr, nullptr, Ob, 1024, ssq_o, 8};
        for (int repb = 0; repb < 1 + ((REP_MASK >> 17) & 1); ++repb)
        for (int i = 0; i < 4 * ((1024 + 4 * G - 1) / (4 * G)); ++i) {
            const int v = bid + (i >> 2) * G; if (v >= 256) break;
            const int bh = (v & 7) + 8 * (v >> 4), s = (v >> 3) & 1, ii = i & 3;
            const int qt = ii == 0 ? 2 * s : (ii == 1 ? 2 * s + 1 : (ii == 2 ? 7 - 2 * s : 6 - 2 * s));
            att::UnitP P{bh >> 3, bh & 7, 1, 0, 1, 256 * qt, 0, 4 * (qt + 1), 1 << 28, 2};
            att::attn_unit<true>(tid, P, lds, XB);
        }
    }
    GRID_BAR(4);


#endif

    for (int rep_ = 0; rep_ < (IN(6) ? 1 + ((REP_MASK >> 6) & 1) : 0); ++rep_) {
        PH_LOCALS;
        u32x4 no[4]; f32x4 nq[4];
#define P6_LOAD(rr) do { _Pragma("unroll") for (int c = 0; c < 4; ++c) { no[c] = *(const u32x4*)(Ob + (size_t)(rr) * DM + c * 512 + lane * 8); nq[c] = *(const f32x4*)(ssq_o + (size_t)(rr) * 16 + 4 * c); } } while (0)
        P6_LOAD(gw);
        for (int row = gw; row < T; row += NGW) {
            const float sa = ((nq[0][0] + nq[0][1]) + (nq[0][2] + nq[0][3])) + ((nq[1][0] + nq[1][1]) + (nq[1][2] + nq[1][3]));
            const float sb = ((nq[2][0] + nq[2][1]) + (nq[2][2] + nq[2][3])) + ((nq[3][0] + nq[3][1]) + (nq[3][2] + nq[3][3]));
            const float ra = 1.0f / sqrtf(sa * (1.0f / 1024.0f) + 1e-6f), rb = 1.0f / sqrtf(sb * (1.0f / 1024.0f) + 1e-6f);
            float f[32]; float mx = 0.f;
#pragma unroll
            for (int c = 0; c < 4; ++c) { const u32x4 o4 = no[c]; const unsigned w0 = o4.x, w1 = o4.y, w2 = o4.z, w3 = o4.w; const float r_ = c < 2 ? ra : rb;
                f[8 * c + 0] = bf_lo(w0) * r_; f[8 * c + 1] = bf_hi(w0) * r_; f[8 * c + 2] = bf_lo(w1) * r_; f[8 * c + 3] = bf_hi(w1) * r_;
                f[8 * c + 4] = bf_lo(w2) * r_; f[8 * c + 5] = bf_hi(w2) * r_; f[8 * c + 6] = bf_lo(w3) * r_; f[8 * c + 7] = bf_hi(w3) * r_; }
            if (row + NGW < T) P6_LOAD(row + NGW);
#pragma unroll
            for (int i = 0; i < 32; ++i) mx = fmaxf(mx, fabsf(f[i]));
            mx = wmax(mx);
            const float qs = mx > 0.f ? 127.0f / mx : 1.0f;
            if (lane == 0) OS[row] = mx > 0.f ? mx * (1.0f / 127.0f) : 1.0f;
#pragma unroll
            for (int c = 0; c < 4; ++c) { u32x2 w; w.x = pack_i8x4(f[8 * c] * qs, f[8 * c + 1] * qs, f[8 * c + 2] * qs, f[8 * c + 3] * qs); w.y = pack_i8x4(f[8 * c + 4] * qs, f[8 * c + 5] * qs, f[8 * c + 6] * qs, f[8 * c + 7] * qs);
                *(u32x2*)(O8 + (size_t)row * DM + c * 512 + lane * 8) = w; }
        }
#undef P6_LOAD
    }
    GRID_BAR(6);

    for (int rep_ = 0; rep_ < (IN(7) ? 1 + ((REP_MASK >> 7) & 1) : 0); ++rep_) {
        PH_LOCALS;
        pg8::Gemm g{(const bf16_t*)O8, (const bf16_t*)WO8, T, DM, DM / 2}; pg8::StaticOrder S; S.init(T, DM, G, bid);
        pg8::EpiPlainQ8 E{MIXb, DM, OS, WS3}; pg8::gemm_phase(tid, lds, g, S, E);
    }
    GRID_BAR(7);

    for (int rep_ = 0; rep_ < (IN(8) ? 1 + ((REP_MASK >> 8) & 1) : 0); ++rep_) {
        PH_LOCALS;
        const int nb_ = G >> 4, b = bid / nb_, r0 = (bid % nb_) * NWAVES + wave, rstep = nb_ * NWAVES;
        LAS float* pg1 = (LAS float*)lds; LAS float* psh = pg1 + 2048; LAS float* psc = pg1 + 4096; LAS float* plg = pg1 + 6144; LAS float* plb = pg1 + 8192;
        __syncthreads();
        if (b < 16) { const float* mb = mod + (size_t)b * 12288;
            *(LAS f32x4*)(pg1 + 4 * tid) = *(const f32x4*)(mb + 4096 + 4 * tid) * DBG_MIX; *(LAS f32x4*)(psh + 4 * tid) = *(const f32x4*)(mb + 6144 + 4 * tid);
            *(LAS f32x4*)(psc + 4 * tid) = *(const f32x4*)(mb + 8192 + 4 * tid) + 1.0f;
            *(LAS f32x4*)(plg + 4 * tid) = *(const f32x4*)(AR.in[13] + 4 * tid); *(LAS f32x4*)(plb + 4 * tid) = *(const f32x4*)(AR.in[14] + 4 * tid); }
        __syncthreads();
        if (b < 16) {
        f32x4 nx[8]; u32x2 nm[8];
#define P8_LOAD(rr) do { const f32x4* xr_ = (const f32x4*)(x + (size_t)(rr) * DM) + lane; const u32x2* mr_ = (const u32x2*)(MIXb + (size_t)(rr) * DM) + lane; \
            _Pragma("unroll") for (int j = 0; j < 8; ++j) { nx[j] = xr_[64 * j]; nm[j] = mr_[64 * j]; } } while (0)
        P8_LOAD(b * 2048 + r0);
        for (int r = r0; r < 2048; r += rstep) {
            const int row = b * 2048 + r, le = opaque(lane);
            f32x4 v[8]; float s = 0.f;
#pragma unroll
            for (int j = 0; j < 8; ++j) { const f32x4 xv = nx[j], gv = *(const LAS f32x4*)(pg1 + 4 * (le + 64 * j)); const unsigned m0 = nm[j].x, m1 = nm[j].y;
                v[j][0] = xv[0] * DN_ALPHA + gv[0] * bf_lo(m0); v[j][1] = xv[1] * DN_ALPHA + gv[1] * bf_hi(m0);
                v[j][2] = xv[2] * DN_ALPHA + gv[2] * bf_lo(m1); v[j][3] = xv[3] * DN_ALPHA + gv[3] * bf_hi(m1);
                s += (v[j][0] + v[j][1]) + (v[j][2] + v[j][3]); }
            if (r + rstep < 2048) P8_LOAD(row + rstep);
            float mean = wsum(s) * (1.0f / DM); float s2 = 0.f;
#pragma unroll
            for (int j = 0; j < 8; ++j) { v[j] = v[j] - mean; s2 += (v[j][0] * v[j][0] + v[j][1] * v[j][1]) + (v[j][2] * v[j][2] + v[j][3] * v[j][3]); }
            float rstd = 1.0f / sqrtf(wsum(s2) * (1.0f / DM) + 1e-5f);
            s = 0.f;
#pragma unroll
            for (int j = 0; j < 8; ++j) { const int d = 4 * (le + 64 * j);
                v[j] = v[j] * rstd * *(const LAS f32x4*)(plg + d) + *(const LAS f32x4*)(plb + d);
#if defined(NAIVE_PEER)
                *(f32x4*)(AR.out + (size_t)row * DM + d) = v[j];
#else
                { u32x2 w1; w1.x = cvtpk(v[j][0], v[j][1]); w1.y = cvtpk(v[j][2], v[j][3]); *(u32x2*)(X1b + (size_t)row * DM + d) = w1; }
#endif
                s += (v[j][0] + v[j][1]) + (v[j][2] + v[j][3]); }
            mean = wsum(s) * (1.0f / DM); s2 = 0.f;
#pragma unroll
            for (int j = 0; j < 8; ++j) { v[j] = v[j] - mean; s2 += (v[j][0] * v[j][0] + v[j][1] * v[j][1]) + (v[j][2] * v[j][2] + v[j][3] * v[j][3]); }
            rstd = 1.0f / sqrtf(wsum(s2) * (1.0f / DM) + 1e-5f);
#pragma unroll
            for (int j = 0; j < 8; ++j) { const int d = 4 * (le + 64 * j);
                const f32x4 sh = *(const LAS f32x4*)(psh + d), sc1 = *(const LAS f32x4*)(psc + d);
                const f32x4 y = v[j] * rstd * sc1 + sh; v[j] = y; }
#if !defined(NAIVE_PEER)
            {
                float mx = 0.f;
#pragma unroll
                for (int j = 0; j < 8; ++j) mx = fmaxf(fmaxf(mx, fmaxf(fabsf(v[j][0]), fabsf(v[j][1]))), fmaxf(fabsf(v[j][2]), fabsf(v[j][3])));
                mx = wmax(mx);
                const float hs = mx > 0.f ? 127.0f / mx : 1.0f;
                if (lane == 0) SH[row] = mx > 0.f ? mx * (1.0f / 127.0f) : 1.0f;
#pragma unroll
                for (int j = 0; j < 8; ++j) { const int d = 4 * (le + 64 * j); const f32x4 y = v[j] * hs;
                    *(unsigned*)(H2S + (size_t)row * DM + d) = pack_i8x4(y[0], y[1], y[2], y[3]); }
            }
#endif
        }
        }
#undef P8_LOAD
    }
    GRID_BAR(8);

    for (int rep_ = 0; rep_ < (IN(9) ? 1 + ((REP_MASK >> 9) & 1) : 0); ++rep_) {
        PH_LOCALS;
        pg8::Gemm g{(const bf16_t*)H2S, (const bf16_t*)WPQ8, T, DM, DM / 2}; pg8::StaticOrder S; S.init(T, DM, G, bid);
        pg8::EpiPlainQ8 E{Qp, DM, SH, WS4}; pg8::gemm_phase(tid, lds, g, S, E);
    }
    GRID_BAR(9);


#if defined(NAIVE_TOPK)
    for (int rep_ = 0; rep_ < (IN(10) ? 1 + ((REP_MASK >> 10) & 1) : 0); ++rep_) {
        PH_LOCALS;
        LAS float* vs = (LAS float*)(lds + wave * 256);
        for (int it = gw; it < T * 8; it += NGW) {
            const int t = it >> 3, h = it & 7;
            float sA[2][2];
#pragma unroll
            for (int half = 0; half < 2; ++half) {
                const bf16_t* qp = Qp + (size_t)t * DM + h * 256 + half * 128;
                const float* kp = half ? AR.in[17] : AR.in[16];
                float s0 = 0.f, s1 = 0.f;
                for (int d = 0; d < 128; ++d) { const float qv = __uint_as_float((unsigned)qp[d] << 16); s0 += qv * kp[lane * 128 + d]; s1 += qv * kp[(lane + 64) * 128 + d]; }
                sA[half][0] = s0; sA[half][1] = s1;
            }
#pragma unroll
            for (int half = 0; half < 2; ++half) {
                float c0 = sA[half][0], c1 = sA[half][1];
                for (int r = 0; r < 16; ++r) {
                    float bv = fmaxf(c0, c1); int bi = (c0 >= c1) ? lane : lane + 64;
#pragma unroll
                    for (int o = 1; o < 64; o <<= 1) { const float ov = __shfl_xor(bv, o); const int oi = __shfl_xor(bi, o); if (ov > bv || (ov == bv && oi < bi)) { bv = ov; bi = oi; } }
                    if (lane == 0) { vs[half * 16 + r] = bv; ((LAS int*)vs)[32 + half * 16 + r] = bi; }
                    if (bi == lane) c0 = -INFINITY; if (bi == lane + 64) c1 = -INFINITY;
                }
            }
            asm volatile("s_waitcnt lgkmcnt(0)" ::: "memory");
            float cd[4];
#pragma unroll
            for (int m2 = 0; m2 < 4; ++m2) { const int c = lane + 64 * m2; cd[m2] = vs[c >> 4] + vs[16 + (c & 15)]; }
            float val[16]; int ci[16];
#pragma unroll
            for (int r = 0; r < 16; ++r) {
                float bv = cd[0]; int bi = lane;
#pragma unroll
                for (int m2 = 1; m2 < 4; ++m2) if (cd[m2] > bv) { bv = cd[m2]; bi = lane + 64 * m2; }
#pragma unroll
                for (int o = 1; o < 64; o <<= 1) { const float ov = __shfl_xor(bv, o); const int oi = __shfl_xor(bi, o); if (ov > bv || (ov == bv && oi < bi)) { bv = ov; bi = oi; } }
                val[r] = bv; ci[r] = bi;
#pragma unroll
                for (int m2 = 0; m2 < 4; ++m2) if (bi == lane + 64 * m2) cd[m2] = -INFINITY;
            }
            float se = 0.f, e[16];
#pragma unroll
            for (int r = 0; r < 16; ++r) { e[r] = __expf(val[r] - val[0]); se += e[r]; }
            if (lane < 16) {
                float ev = 0.f; int cc = 0;
#pragma unroll
                for (int r = 0; r < 16; ++r) if (lane == r) { ev = e[r]; cc = ci[r]; }
                const int i1 = ((LAS int*)vs)[32 + (cc >> 4)], i2 = ((LAS int*)vs)[48 + (cc & 15)];
                IDX[((size_t)t * 8 + h) * 16 + lane] = (unsigned short)(i1 * 128 + i2);
                Gt[((size_t)t * 8 + h) * 16 + lane] = ev / se;
            }
            asm volatile("s_waitcnt lgkmcnt(0)" ::: "memory");
        }
    }
#else
    for (int rep_ = 0; rep_ < (IN(10) ? 1 + ((REP_MASK >> 10) & 1) : 0); ++rep_) {
        PH_LOCALS;
        for (int i = tid; i < 2 * 128 * 16; i += NWAVES * 64) { const int t2 = i >> 11, rem = i & 2047, key = rem >> 4, ch = rem & 15;
            const bf16x8 v = *(const bf16x8*)((t2 ? K2b : K1b) + key * 128 + ch * 8);
            *(LAS bf16x8*)(lds + t2 * 32768 + KSWZ(key, ch * 16)) = v; }
        __syncthreads();
        const int r32 = lane & 31, hi = lane >> 5;
        LAS unsigned char* tb8 = lds + 65536 + wave * 2048 + lane * 32;
        for (int tg = bid; tg < T / 32; tg += G) {
            const int tok = tg * 32 + r32;
            int v12[2][16];
#pragma unroll
            for (int half = 0; half < 2; ++half) {
                const bf16_t* qp = Qp + (size_t)tok * DM + wave * 256 + half * 128 + hi * 8;
                bf16x8 qf[8];
#pragma unroll
                for (int d0 = 0; d0 < 8; ++d0) qf[d0] = *(const bf16x8*)(qp + d0 * 16);
                int best[16];
#pragma unroll
                for (int kb = 0; kb < 4; ++kb) {
                    f32x16 acc = f32x16{};
#pragma unroll
                    for (int d0 = 0; d0 < 8; ++d0) { const bf16x8 a = *(const LAS bf16x8*)(lds + half * 32768 + KSWZ(32 * kb + r32, (d0 * 16 + hi * 8) * 2));
                        acc = __builtin_amdgcn_mfma_f32_32x32x16_bf16(a, qf[d0], acc, 0, 0, 0); }
                    int cur[16];
#pragma unroll
                    for (int r = 0; r < 16; ++r) cur[r] = (pk::f2key(acc[r]) & ~127) | (32 * kb + (r & 3) + 8 * (r >> 2) + 4 * hi);
                    pk::sort16(cur);
                    if (kb == 0) {
#pragma unroll
                        for (int r = 0; r < 16; ++r) best[r] = cur[r];
                    } else pk::merge_top16(best, cur);
                }
                int oth[16], mine[16];
#pragma unroll
                for (int r = 0; r < 16; ++r) { auto sw = __builtin_amdgcn_permlane32_swap((unsigned)best[r], (unsigned)best[r], false, false); mine[r] = (int)sw[0]; oth[r] = (int)sw[1]; }
                pk::merge_top16(mine, oth);
#pragma unroll
                for (int r = 0; r < 16; ++r) v12[half][r] = mine[r];
            }
            {
                u32x4 w0, w1;
#pragma unroll
                for (int q = 0; q < 4; ++q) {
                    w0[q] = (unsigned)(v12[0][4 * q] & 127) | ((unsigned)(v12[0][4 * q + 1] & 127) << 8) | ((unsigned)(v12[0][4 * q + 2] & 127) << 16) | ((unsigned)(v12[0][4 * q + 3] & 127) << 24);
                    w1[q] = (unsigned)(v12[1][4 * q] & 127) | ((unsigned)(v12[1][4 * q + 1] & 127) << 8) | ((unsigned)(v12[1][4 * q + 2] & 127) << 16) | ((unsigned)(v12[1][4 * q + 3] & 127) << 24);
                }
                *(LAS u32x4*)(tb8) = w0; *(LAS u32x4*)(tb8 + 16) = w1;
            }
            float f1[16], f2[16];
#pragma unroll
            for (int r = 0; r < 16; ++r) { f1[r] = pk::key2f(v12[0][r]); f2[r] = pk::key2f(v12[1][r]); }
#define CAND(i, j) ((pk::f2key(f1[i] + f2[j]) & ~255) | ((i) * 16 + (j)))
            int M[16], Gb[16];
#pragma unroll
            for (int j = 0; j < 16; ++j) M[j] = CAND(0, j);
#pragma unroll
            for (int j = 0; j < 8; ++j) { Gb[j] = CAND(1, j); Gb[8 + j] = CAND(15 - j, 0); }
            pk::bmerge16(Gb); pk::merge_top16(M, Gb);
            Gb[0] = CAND(2, 0); Gb[1] = CAND(2, 1); Gb[2] = CAND(2, 2); Gb[3] = CAND(2, 3); Gb[4] = CAND(2, 4);
            Gb[5] = CAND(3, 0); Gb[6] = CAND(3, 1); Gb[7] = CAND(3, 2); Gb[8] = CAND(3, 3);
            Gb[9] = CAND(4, 0); Gb[10] = CAND(4, 1); Gb[11] = CAND(4, 2);
            Gb[12] = CAND(5, 0); Gb[13] = CAND(5, 1); Gb[14] = CAND(6, 0); Gb[15] = CAND(6, 1);
            pk::sort16(Gb); pk::merge_top16(M, Gb);
            Gb[0] = CAND(7, 0); Gb[1] = CAND(7, 1);
#pragma unroll
            for (int j = 2; j < 16; ++j) Gb[j] = (int)0x80000000;
            pk::merge_top16(M, Gb);
#undef CAND
            asm volatile("s_waitcnt lgkmcnt(0)" ::: "memory");
            float val[16], e[16]; float se = 0.f; unsigned short ex[16];
#pragma unroll
            for (int k = 0; k < 16; ++k) { val[k] = pk::key2f(M[k] & ~255); }
#pragma unroll
            for (int k = 0; k < 16; ++k) { e[k] = __expf(val[k] - val[0]); se += e[k];
                const int code = M[k] & 255; const unsigned i1 = *(const LAS unsigned char*)(tb8 + (code >> 4)), i2 = *(const LAS unsigned char*)(tb8 + 16 + (code & 15));
                ex[k] = (unsigned short)(i1 * 128 + i2); }
            const float inv = 1.0f / se;
#if defined(NAIVE_PEER)
            if (hi == 0) {
                u32x4 w0, w1;
#pragma unroll
                for (int q = 0; q < 4; ++q) { w0[q] = (unsigned)ex[2 * q] | ((unsigned)ex[2 * q + 1] << 16); w1[q] = (unsigned)ex[8 + 2 * q] | ((unsigned)ex[8 + 2 * q + 1] << 16); }
                u32x4* ip = (u32x4*)(IDX + ((size_t)tok * 8 + wave) * 16); ip[0] = w0; ip[1] = w1;
            } else {
                f32x4* gp = (f32x4*)(Gt + ((size_t)tok * 8 + wave) * 16);
#pragma unroll
                for (int q = 0; q < 4; ++q) gp[q] = (f32x4){e[4 * q] * inv, e[4 * q + 1] * inv, e[4 * q + 2] * inv, e[4 * q + 3] * inv};
            }
#else
            if (hi == 0) {
#pragma unroll
                for (int sl = 0; sl < 8; ++sl) *(unsigned*)(IDX2 + (size_t)tok * 128 + sl * 16 + wave * 2) = (unsigned)ex[sl] | ((unsigned)ex[sl + 8] << 16);
            } else {
#pragma unroll
                for (int sl = 0; sl < 8; ++sl) *(f32x2*)(Gt + (size_t)tok * 128 + sl * 16 + wave * 2) = (f32x2){e[sl] * inv, e[sl + 8] * inv};
            }
#endif
            asm volatile("s_waitcnt lgkmcnt(0)" ::: "memory");
        }
    }
#endif
    GRID_BAR(10);

#if defined(NAIVE_PEER)
    for (int rep_ = 0; rep_ < (IN(11) ? 1 + ((REP_MASK >> 11) & 1) : 0); ++rep_) {
        PH_LOCALS;
        const float* lg = AR.in[20]; const float* lb = AR.in[21];
        for (int t = gw; t < T; t += NGW) {
            const int b = t >> 11;
            u32x4 hv[4];
#pragma unroll
            for (int c = 0; c < 4; ++c) hv[c] = *(const u32x4*)(H2 + (size_t)t * DM + c * 512 + lane * 8);
            const unsigned idx2 = ((const unsigned*)IDX)[(size_t)t * 64 + lane];
            const f32x2 g2 = ((const f32x2*)Gt)[(size_t)t * 64 + lane];
            float a0 = 0.f, a1 = 0.f;
            for (int k = 0; k < 128; k += 4) {
                u32x4 uv[4][4];
#pragma unroll
                for (int j = 0; j < 4; ++j) { const unsigned pr = (unsigned)__builtin_amdgcn_readlane((int)idx2, (k + j) >> 1); const unsigned e = ((k + j) & 1) ? (pr >> 16) : (pr & 0xffffu);
                    const bf16_t* up = UT + (size_t)e * 2048 + lane * 8;
#pragma unroll
                    for (int c = 0; c < 4; ++c) uv[j][c] = *(const u32x4*)(up + c * 512); }
#pragma unroll
                for (int j = 0; j < 4; ++j) { float d = 0.f;
#pragma unroll
                    for (int c = 0; c < 4; ++c)
#pragma unroll
                        for (int q = 0; q < 4; ++q) { const unsigned ua = uv[j][c][q], ha = hv[c][q]; d = dot2bf(ua, ha, d); }
                    d = wave_sum(d);
                    if (lane == ((k + j) >> 1)) { if ((k + j) & 1) a1 = d; else a0 = d; } }
            }
            const float w0 = gelu_erf(a0) * g2[0], w1 = gelu_erf(a1) * g2[1];
            float acc[32];
#pragma unroll
            for (int i = 0; i < 32; ++i) acc[i] = 0.f;
            for (int k = 0; k < 128; k += 4) {
                u32x4 vv[4][4]; float wk[4];
#pragma unroll
                for (int j = 0; j < 4; ++j) { const unsigned pr = (unsigned)__builtin_amdgcn_readlane((int)idx2, (k + j) >> 1); const unsigned e = ((k + j) & 1) ? (pr >> 16) : (pr & 0xffffu);
                    wk[j] = __int_as_float(__builtin_amdgcn_readlane(__float_as_int(((k + j) & 1) ? w1 : w0), (k + j) >> 1));
                    const bf16_t* vp = VT + (size_t)e * 2048 + lane * 8;
#pragma unroll
                    for (int c = 0; c < 4; ++c) vv[j][c] = *(const u32x4*)(vp + c * 512); }
#pragma unroll
                for (int j = 0; j < 4; ++j)
#pragma unroll
                    for (int c = 0; c < 4; ++c)
#pragma unroll
                        for (int q = 0; q < 4; ++q) { acc[c * 8 + 2 * q] += wk[j] * bf_lo(vv[j][c][q]); acc[c * 8 + 2 * q + 1] += wk[j] * bf_hi(vv[j][c][q]); }
            }
            const float* mb = mod + (size_t)b * 12288 + 10240;
            float s = 0.f;
#pragma unroll
            for (int c = 0; c < 4; ++c) { const int d = c * 512 + lane * 8;
                const f32x4 x0 = *(const f32x4*)(AR.out + (size_t)t * DM + d), x1 = *(const f32x4*)(AR.out + (size_t)t * DM + d + 4);
                const f32x4 m0 = *(const f32x4*)(mb + d), m1 = *(const f32x4*)(mb + d + 4);
#pragma unroll
                for (int q = 0; q < 4; ++q) { acc[c * 8 + q] = x0[q] * DN_ALPHA + m0[q] * acc[c * 8 + q] * DBG_FFN; acc[c * 8 + 4 + q] = x1[q] * DN_ALPHA + m1[q] * acc[c * 8 + 4 + q] * DBG_FFN; }
#pragma unroll
                for (int q = 0; q < 8; ++q) s += acc[c * 8 + q]; }
            const float mean = wave_sum(s) * (1.0f / DM); float s2 = 0.f;
#pragma unroll
            for (int i = 0; i < 32; ++i) { acc[i] -= mean; s2 += acc[i] * acc[i]; }
            const float rstd = 1.0f / sqrtf(wave_sum(s2) * (1.0f / DM) + 1e-5f);
#pragma unroll
            for (int c = 0; c < 4; ++c) { const int d = c * 512 + lane * 8;
                const f32x4 g0 = *(const f32x4*)(lg + d), g1 = *(const f32x4*)(lg + d + 4), b0 = *(const f32x4*)(lb + d), b1 = *(const f32x4*)(lb + d + 4);
                f32x4 o0, o1;
#pragma unroll
                for (int q = 0; q < 4; ++q) { o0[q] = acc[c * 8 + q] * rstd * g0[q] + b0[q]; o1[q] = acc[c * 8 + 4 + q] * rstd * g1[q] + b1[q]; }
                *(f32x4*)(AR.out + (size_t)t * DM + d) = o0; *(f32x4*)(AR.out + (size_t)t * DM + d + 4) = o1; }
        }
    }
#else
    for (int rep_ = 0; rep_ < (IN(11) ? 1 + ((REP_MASK >> 11) & 1) : 0); ++rep_) {
        PH_LOCALS;
        typedef int v4i32 __attribute__((ext_vector_type(4)));
        const int xs = bid & 7, rank = bid >> 3, nrank = G >> 3;
        const int tstep = nrank * NWAVES, t0 = rank * NWAVES + wave;
        const int ntok = rank < nrank ? (T - t0 + tstep - 1) / tstep : 0;
        const int slice = xs;
        const unsigned char* Us = U8 + (size_t)slice * (2u << 20);
        LAS unsigned char* ring = lds + wave * 17408;
        const int r8d = lane >> 3, dcd = lane & 7;
        const unsigned dsw = (unsigned)((dcd ^ r8d) << 4);
        const int im = lane & 15, g = lane >> 4;
        int ura[2][2];
#pragma unroll
        for (int hi = 0; hi < 2; ++hi)
#pragma unroll
            for (int sx = 0; sx < 2; ++sx) { const int rgm = 4 * hi + (im >> 2), c = 4 * sx + g;
                ura[hi][sx] = (int)(uintptr_t)ring + (im & 3) * 1088 + rgm * 128 + ((c ^ rgm) << 4); }
#define U_GLD4(dst, sb, vo, imm) asm volatile("global_load_dwordx4 %0, %1, %2 offset:" #imm : "=v"(dst) : "v"(vo), "s"(sb) : "memory")
#define U_MISC(IA, IB, H, tt) do { const unsigned char* si_ = (const unsigned char*)IDX2 + (size_t)(tt) * 256; const unsigned char* sh_ = (const unsigned char*)H2S + (size_t)(tt) * 2048 + slice * 256; \
            U_GLD4(IA, si_, voI, 0); U_GLD4(IB, si_, voI, 16); U_GLD4(H[0], sh_, voH, 0); U_GLD4(H[1], sh_, voH, 16); U_GLD4(H[2], sh_, voH, 128); U_GLD4(H[3], sh_, voH, 144); } while (0)
#define U_MOV8(D, o, S0, S1, WAITSTR) asm volatile(WAITSTR "\n\tv_mov_b32 %0, %8\n\tv_mov_b32 %1, %9\n\tv_mov_b32 %2, %10\n\tv_mov_b32 %3, %11\n\tv_mov_b32 %4, %12\n\tv_mov_b32 %5, %13\n\tv_mov_b32 %6, %14\n\tv_mov_b32 %7, %15" \
                : "=&v"(D[o]), "=&v"(D[o + 1]), "=&v"(D[o + 2]), "=&v"(D[o + 3]), "=&v"(D[o + 4]), "=&v"(D[o + 5]), "=&v"(D[o + 6]), "=&v"(D[o + 7]) \
                : "v"(S0.x), "v"(S0.y), "v"(S0.z), "v"(S0.w), "v"(S1.x), "v"(S1.y), "v"(S1.z), "v"(S1.w) : "memory")
#define U_ROT(DI, DH, IA, IB, H, WAITSTR) do { U_MOV8(DI, 0, IA, IB, WAITSTR); U_MOV8(DH, 0, H[0], H[1], "s_nop 0"); U_MOV8(DH, 8, H[2], H[3], "s_nop 0"); } while (0)
        const unsigned voI = (unsigned)(r8d * 32), voH = (unsigned)(g * 32);
#define U_DMAQ(IX, b) do { _Pragma("unroll") for (int pc_ = 0; pc_ < 4; ++pc_) { const int m_ = 4 * (b) + pc_; const unsigned w_ = IX[m_ >> 1]; \
            const unsigned e_ = (m_ & 1) ? (w_ >> 16) : (w_ & 0xffffu); \
            __builtin_amdgcn_global_load_lds((const unsigned*)(Us + (e_ * 128u + dsw)), (LAS unsigned*)(ring + (b) * 4352 + pc_ * 1088), 16, 0, 0); } } while (0)
#define U_RD(dst, addr, off) asm volatile("ds_read_b128 %0, %1 offset:%2" : "=&v"(dst) : "v"(addr), "i"(off) : "memory")
#define U_MM(ACC, R, HH, o) do { const v4i32 lo_ = {(int)(R.x & 0x0F0F0F0Fu), (int)(R.y & 0x0F0F0F0Fu), (int)(R.z & 0x0F0F0F0Fu), (int)(R.w & 0x0F0F0F0Fu)}; \
            const v4i32 hi_ = {(int)((R.x >> 4) & 0x0F0F0F0Fu), (int)((R.y >> 4) & 0x0F0F0F0Fu), (int)((R.z >> 4) & 0x0F0F0F0Fu), (int)((R.w >> 4) & 0x0F0F0F0Fu)}; \
            const v4i32 be_ = {(int)HH[o], (int)HH[o + 2], (int)HH[o + 4], (int)HH[o + 6]}, bo_ = {(int)HH[o + 1], (int)HH[o + 3], (int)HH[o + 5], (int)HH[o + 7]}; \
            ACC = __builtin_amdgcn_mfma_i32_16x16x64_i8(lo_, be_, ACC, 0, 0, 0); ACC = __builtin_amdgcn_mfma_i32_16x16x64_i8(hi_, bo_, ACC, 0, 0, 0); } while (0)
#define U_QUARTER(b, HH) do { u32x4 r00_, r01_, r10_, r11_; \
            U_RD(r00_, ura[0][0], (b) * 4352); U_RD(r01_, ura[0][1], (b) * 4352); U_RD(r10_, ura[1][0], (b) * 4352); U_RD(r11_, ura[1][1], (b) * 4352); \
            asm volatile("s_waitcnt lgkmcnt(0)" ::: "memory"); __builtin_amdgcn_sched_barrier(0); \
            U_MM(acc[b][0], r00_, HH, 0); U_MM(acc[b][0], r01_, HH, 8); U_MM(acc[b][1], r10_, HH, 0); U_MM(acc[b][1], r11_, HH, 8); } while (0)
        if (ntok > 0) {
            u32x4 mia, mib, pia, pib, mh[4], ph[4];
            unsigned ci[8], ch[16], ni[8], nh[16];
            const int tlast = t0 + (ntok - 1) * tstep;
            U_MISC(mia, mib, mh, t0);
            { const int t1 = ntok > 1 ? t0 + tstep : t0; U_MISC(pia, pib, ph, t1); }
            U_ROT(ci, ch, mia, mib, mh, "s_waitcnt vmcnt(0)");
            U_ROT(ni, nh, pia, pib, ph, "s_nop 0");
            __builtin_amdgcn_sched_barrier(0);
            U_DMAQ(ci, 0); U_DMAQ(ci, 1); U_DMAQ(ci, 2); U_DMAQ(ci, 3);
            __builtin_amdgcn_sched_barrier(0);
            for (int i = 0; i < ntok; ++i) {
                const int t = t0 + i * tstep; const bool more = i + 1 < ntok;
                { const int tm = min(t + 2 * tstep, tlast); U_MISC(mia, mib, mh, tm); }
                __builtin_amdgcn_sched_barrier(0);
                v4i32 acc[4][2], accS = {0, 0, 0, 0};
#pragma unroll
                for (int b_ = 0; b_ < 4; ++b_) { acc[b_][0] = (v4i32){0, 0, 0, 0}; acc[b_][1] = (v4i32){0, 0, 0, 0}; }
#define U_WAITQ() do { if (!more) { asm volatile("s_waitcnt vmcnt(0)" ::: "memory"); } else if (i == 0) { asm volatile("s_waitcnt vmcnt(18)" ::: "memory"); } \
                       else { asm volatile("s_waitcnt vmcnt(20)" ::: "memory"); } __builtin_amdgcn_sched_barrier(0); } while (0)
                U_WAITQ(); U_QUARTER(0, ch); __builtin_amdgcn_sched_barrier(0); if (more) U_DMAQ(ni, 0); __builtin_amdgcn_sched_barrier(0);
                U_WAITQ(); U_QUARTER(1, ch); __builtin_amdgcn_sched_barrier(0); if (more) U_DMAQ(ni, 1); __builtin_amdgcn_sched_barrier(0);
                U_WAITQ(); U_QUARTER(2, ch); __builtin_amdgcn_sched_barrier(0); if (more) U_DMAQ(ni, 2); __builtin_amdgcn_sched_barrier(0);
                U_WAITQ(); U_QUARTER(3, ch); __builtin_amdgcn_sched_barrier(0); if (more) U_DMAQ(ni, 3); __builtin_amdgcn_sched_barrier(0);
#undef U_WAITQ
                { const v4i32 ones_ = {0x01010101, 0x01010101, 0x01010101, 0x01010101};
#pragma unroll
                  for (int o_ = 0; o_ < 16; o_ += 4) { const v4i32 hb_ = {(int)ch[o_], (int)ch[o_ + 1], (int)ch[o_ + 2], (int)ch[o_ + 3]};
                      accS = __builtin_amdgcn_mfma_i32_16x16x64_i8(ones_, hb_, accS, 0, 0, 0); } }
                { const int hoff = -8 * accS[0]; const bool hsel = (lane & 1) != 0; unsigned pw[8];
#pragma unroll
                  for (int b_ = 0; b_ < 4; ++b_) {
                      const int v0 = (hsel ? acc[b_][1][0] : acc[b_][0][0]) + hoff, v1 = (hsel ? acc[b_][1][1] : acc[b_][0][1]) + hoff;
                      const int v2 = (hsel ? acc[b_][1][2] : acc[b_][0][2]) + hoff, v3 = (hsel ? acc[b_][1][3] : acc[b_][0][3]) + hoff;
                      pw[2 * b_] = cvtpk((float)v0, (float)v1); pw[2 * b_ + 1] = cvtpk((float)v2, (float)v3); }
                  if (im < 2) { u32x4* dst_ = (u32x4*)((unsigned*)PART + ((size_t)slice * T + t) * 64 + (4 * (lane & 1) + g) * 8);
                      dst_[0] = (u32x4){pw[0], pw[1], pw[2], pw[3]}; dst_[1] = (u32x4){pw[4], pw[5], pw[6], pw[7]}; } }
                __builtin_amdgcn_sched_barrier(0);
#pragma unroll
                for (int k_ = 0; k_ < 8; ++k_) ci[k_] = ni[k_];
#pragma unroll
                for (int k_ = 0; k_ < 16; ++k_) ch[k_] = nh[k_];
                if (more) U_ROT(ni, nh, mia, mib, mh, "s_waitcnt vmcnt(18)"); else U_ROT(ni, nh, mia, mib, mh, "s_waitcnt vmcnt(0)");
                __builtin_amdgcn_sched_barrier(0);
            }
            asm volatile("s_waitcnt vmcnt(0)" ::: "memory");
        }
#undef U_GLD4
#undef U_MISC
#undef U_MOV8
#undef U_ROT
#undef U_DMAQ
#undef U_RD
#undef U_MM
#undef U_QUARTER
    }
    GRID_BAR(11);

    for (int rep_ = 0; rep_ < (IN(12) ? 1 + ((REP_MASK >> 12) & 1) : 0); ++rep_) {
        PH_LOCALS;
        unsigned nidx, npv[8]; f32x2 ng; float nhs, nsu0, nsu1, nsv0, nsv1;
#define P12_LOAD(tt) do { nidx = ((const unsigned*)IDX2)[(size_t)(tt) * 64 + lane]; ng = ((const f32x2*)Gt)[(size_t)(tt) * 64 + lane]; nhs = SH[(tt)]; \
            _Pragma("unroll") for (int sl = 0; sl < 8; ++sl) npv[sl] = ((const unsigned*)PART)[((size_t)sl * T + (tt)) * 64 + lane]; } while (0)
#define P12_SCALES() do { const unsigned e0_ = nidx & 0xffffu, e1_ = nidx >> 16; nsu0 = SU[e0_]; nsu1 = SU[e1_]; nsv0 = SU[NE + e0_]; nsv1 = SU[NE + e1_]; } while (0)
        if (gw < T) { P12_LOAD(gw); P12_SCALES(); }
        for (int t = gw; t < T; t += NGW) {
            const f32x2 g2 = ng; const float hs = nhs, su0 = nsu0, su1 = nsu1, sv0 = nsv0, sv1 = nsv1;
            f32x2 a = {0.f, 0.f};
#pragma unroll
            for (int sl = 0; sl < 8; ++sl) { const unsigned pv = npv[sl]; a[0] += bf_lo(pv); a[1] += bf_hi(pv); }
            if (t + NGW < T) P12_LOAD(t + NGW);
            const float w0 = gelu_erf(a[0] * hs * su0) * g2[0] * sv0, w1 = gelu_erf(a[1] * hs * su1) * g2[1] * sv1;
            const float wm = wmax(fmaxf(fabsf(w0), fabsf(w1)));
            const float qs = wm > 0.f ? 127.0f / wm : 1.0f;
            const int q0 = (int)__builtin_rintf(w0 * qs), q1 = (int)__builtin_rintf(w1 * qs);
            { const float wsc_ = wm > 0.f ? wm * (1.0f / 127.0f) : 1.0f, qsum = wsum((float)(q0 + q1));
              if (lane == 0) *(f32x2*)(WSC + 2 * (size_t)t) = (f32x2){wsc_, -8.0f * wsc_ * qsum}; }
            { const int j0 = 2 * lane, j1 = j0 + 1;
              WTq[(size_t)t * 128 + (j0 & 15) * 8 + (j0 >> 4)] = (unsigned char)((unsigned)q0 & 255u);
              WTq[(size_t)t * 128 + (j1 & 15) * 8 + (j1 >> 4)] = (unsigned char)((unsigned)q1 & 255u); }
            if (t + NGW < T) P12_SCALES();
        }
#undef P12_LOAD
#undef P12_SCALES
    }
    GRID_BAR(12);

    for (int rep_ = 0; rep_ < (IN(13) ? 1 + ((REP_MASK >> 13) & 1) : 0); ++rep_) {
        PH_LOCALS;
        typedef int v4i32 __attribute__((ext_vector_type(4)));
        const int xs = bid & 7, rank = bid >> 3, nrank = G >> 3;
        const int tstep = nrank * NWAVES, t0 = rank * NWAVES + wave;
        const int ntok = rank < nrank ? (T - t0 + tstep - 1) / tstep : 0;
        LAS unsigned char* ring = lds + wave * 17408;
        const int r8d = lane >> 3, dcd = lane & 7;
        const unsigned dsw = (unsigned)((dcd ^ r8d) << 4);
        const int g = lane >> 4, q4 = (lane >> 2) & 3, p4 = lane & 3;
        int tra[2][4];
#pragma unroll
        for (int hh = 0; hh < 2; ++hh)
#pragma unroll
            for (int nb = 0; nb < 4; ++nb) { const int r8 = 4 * hh + q4, c = 2 * nb + (p4 >> 1);
                tra[hh][nb] = (int)(uintptr_t)ring + g * 1088 + r8 * 128 + ((c ^ r8) << 4) + (p4 & 1) * 8; }
#define V_GLD4(dst, sb, vo, imm) asm volatile("global_load_dwordx4 %0, %1, %2 offset:" #imm : "=v"(dst) : "v"(vo), "s"(sb) : "memory")
#define V_GLD2(dst, sb, vo, imm) asm volatile("global_load_dwordx2 %0, %1, %2 offset:" #imm : "=v"(dst) : "v"(vo), "s"(sb) : "memory")
#define V_GLD1(dst, sb, vo)      asm volatile("global_load_dword %0, %1, %2" : "=v"(dst) : "v"(vo), "s"(sb) : "memory")
#define V_MISC(IA, IB, W, SC, tt) do { const unsigned char* si_ = (const unsigned char*)IDX2 + (size_t)(tt) * 256; const unsigned char* sw_ = (const unsigned char*)WTq + (size_t)(tt) * 128; \
            const float* sc_ = WSC + 2 * (size_t)(tt); V_GLD4(IA, si_, voI, 0); V_GLD4(IB, si_, voI, 16); V_GLD2(W[0], sw_, voW, 0); V_GLD2(W[1], sw_, voW, 32); V_GLD2(W[2], sw_, voW, 64); V_GLD2(W[3], sw_, voW, 96); \
            V_GLD2(SC, sc_, voZ, 0); } while (0)
#define V_ROT(DI, DW, DSC, IA, IB, W, SC, WAITSTR) do { \
            asm volatile(WAITSTR "\n\tv_mov_b32 %0, %8\n\tv_mov_b32 %1, %9\n\tv_mov_b32 %2, %10\n\tv_mov_b32 %3, %11\n\tv_mov_b32 %4, %12\n\tv_mov_b32 %5, %13\n\tv_mov_b32 %6, %14\n\tv_mov_b32 %7, %15" \
                : "=&v"(DI[0]), "=&v"(DI[1]), "=&v"(DI[2]), "=&v"(DI[3]), "=&v"(DI[4]), "=&v"(DI[5]), "=&v"(DI[6]), "=&v"(DI[7]) \
                : "v"(IA.x), "v"(IA.y), "v"(IA.z), "v"(IA.w), "v"(IB.x), "v"(IB.y), "v"(IB.z), "v"(IB.w) : "memory"); \
            asm volatile("v_mov_b32 %0, %10\n\tv_mov_b32 %1, %11\n\tv_mov_b32 %2, %12\n\tv_mov_b32 %3, %13\n\tv_mov_b32 %4, %14\n\tv_mov_b32 %5, %15\n\tv_mov_b32 %6, %16\n\tv_mov_b32 %7, %17\n\tv_mov_b32 %8, %18\n\tv_mov_b32 %9, %19" \
                : "=&v"(DW[0]), "=&v"(DW[1]), "=&v"(DW[2]), "=&v"(DW[3]), "=&v"(DW[4]), "=&v"(DW[5]), "=&v"(DW[6]), "=&v"(DW[7]), "=&v"(DSC[0]), "=&v"(DSC[1]) \
                : "v"(W[0].x), "v"(W[0].y), "v"(W[1].x), "v"(W[1].y), "v"(W[2].x), "v"(W[2].y), "v"(W[3].x), "v"(W[3].y), "v"(SC.x), "v"(SC.y) : "memory"); } while (0)
        const unsigned voI = (unsigned)(r8d * 32), voW = (unsigned)(g * 8), voZ = 0u;
#define V_DMAQ(IX, b) do { _Pragma("unroll") for (int pc_ = 0; pc_ < 4; ++pc_) { const int m_ = 4 * (b) + pc_; const unsigned w_ = IX[m_ >> 1]; \
            const unsigned e_ = (m_ & 1) ? (w_ >> 16) : (w_ & 0xffffu); \
            __builtin_amdgcn_global_load_lds((const unsigned*)(Vs + (e_ * 128u + dsw)), (LAS unsigned*)(ring + (b) * 4352 + pc_ * 1088), 16, 0, 0); } } while (0)
#define V_TR(dst, addr, off) asm volatile("ds_read_b64_tr_b16 %0, %1 offset:%2" : "=&v"(dst) : "v"(addr), "i"(off) : "memory")
#define V_QUARTER(b, W) do { \
            const unsigned wlo_ = W[2 * (b)], whi_ = W[2 * (b) + 1]; \
            const v4i32 a_ = {(int)__builtin_amdgcn_perm(wlo_, wlo_, sel0), (int)__builtin_amdgcn_perm(wlo_, wlo_, sel1), (int)__builtin_amdgcn_perm(whi_, whi_, sel0), (int)__builtin_amdgcn_perm(whi_, whi_, sel1)}; \
            u32x2 x0_, x1_, x2_, x3_, y0_, y1_, y2_, y3_; \
            V_TR(x0_, tra[0][0], (b) * 4352); V_TR(y0_, tra[1][0], (b) * 4352); V_TR(x1_, tra[0][1], (b) * 4352); V_TR(y1_, tra[1][1], (b) * 4352); \
            V_TR(x2_, tra[0][2], (b) * 4352); V_TR(y2_, tra[1][2], (b) * 4352); V_TR(x3_, tra[0][3], (b) * 4352); V_TR(y3_, tra[1][3], (b) * 4352); \
            asm volatile("s_waitcnt lgkmcnt(0)" ::: "memory"); __builtin_amdgcn_sched_barrier(0); \
            V_MM(0, x0_, y0_); V_MM(1, x1_, y1_); V_MM(2, x2_, y2_); V_MM(3, x3_, y3_); } while (0)
#define V_MM(nb, X, Y) do { const v4i32 lo_ = {(int)(X.x & 0x0F0F0F0Fu), (int)(X.y & 0x0F0F0F0Fu), (int)(Y.x & 0x0F0F0F0Fu), (int)(Y.y & 0x0F0F0F0Fu)}; \
            const v4i32 hi_ = {(int)((X.x >> 4) & 0x0F0F0F0Fu), (int)((X.y >> 4) & 0x0F0F0F0Fu), (int)((Y.x >> 4) & 0x0F0F0F0Fu), (int)((Y.y >> 4) & 0x0F0F0F0Fu)}; \
            aL[nb] = __builtin_amdgcn_mfma_i32_16x16x64_i8(a_, lo_, aL[nb], 0, 0, 0); aH[nb] = __builtin_amdgcn_mfma_i32_16x16x64_i8(a_, hi_, aH[nb], 0, 0, 0); } while (0)
        const unsigned sel0 = (lane & 1) ? 0x010C000Cu : 0x0C010C00u, sel1 = (lane & 1) ? 0x030C020Cu : 0x0C030C02u;
        {
            const int slice = xs;
            const unsigned char* Vs = U8 + (32u << 20) + (size_t)slice * (2u << 20);
            if (ntok > 0) {
                u32x4 mia, mib, pia, pib; u32x2 mwq[4], pwq[4]; f32x2 mwsc, pwsc;
                unsigned ci[8], cw[8], ni[8], nw[8]; float wsc[2], nsc[2];
                const int tlast = t0 + (ntok - 1) * tstep;
                V_MISC(mia, mib, mwq, mwsc, t0);
                { const int t1 = ntok > 1 ? t0 + tstep : t0; V_MISC(pia, pib, pwq, pwsc, t1); }
                V_ROT(ci, cw, wsc, mia, mib, mwq, mwsc, "s_waitcnt vmcnt(0)");
                V_ROT(ni, nw, nsc, pia, pib, pwq, pwsc, "s_nop 0");
                __builtin_amdgcn_sched_barrier(0);
                V_DMAQ(ci, 0); V_DMAQ(ci, 1); V_DMAQ(ci, 2); V_DMAQ(ci, 3);
                __builtin_amdgcn_sched_barrier(0);
                for (int i = 0; i < ntok; ++i) {
                    const int t = t0 + i * tstep; const bool more = i + 1 < ntok;
                    { const int tm = min(t + 2 * tstep, tlast); V_MISC(mia, mib, mwq, mwsc, tm); }
                    __builtin_amdgcn_sched_barrier(0);
                    v4i32 aL[4], aH[4];
#pragma unroll
                    for (int nb = 0; nb < 4; ++nb) { aL[nb] = (v4i32){0, 0, 0, 0}; aH[nb] = (v4i32){0, 0, 0, 0}; }
#define V_WAITQ() do { if (!more) { asm volatile("s_waitcnt vmcnt(0)" ::: "memory"); } else if (i == 0) { asm volatile("s_waitcnt vmcnt(19)" ::: "memory"); } \
                       else { asm volatile("s_waitcnt vmcnt(20)" ::: "memory"); } __builtin_amdgcn_sched_barrier(0); } while (0)
                    V_WAITQ(); V_QUARTER(0, cw); __builtin_amdgcn_sched_barrier(0); if (more) V_DMAQ(ni, 0); __builtin_amdgcn_sched_barrier(0);
                    V_WAITQ(); V_QUARTER(1, cw); __builtin_amdgcn_sched_barrier(0); if (more) V_DMAQ(ni, 1); __builtin_amdgcn_sched_barrier(0);
                    V_WAITQ(); V_QUARTER(2, cw); __builtin_amdgcn_sched_barrier(0); if (more) V_DMAQ(ni, 2); __builtin_amdgcn_sched_barrier(0);
                    V_WAITQ(); V_QUARTER(3, cw); __builtin_amdgcn_sched_barrier(0); if (more) V_DMAQ(ni, 3); __builtin_amdgcn_sched_barrier(0);
#undef V_WAITQ
                    { const int nbs = lane >> 4;
#define V_SEL(A, r) (nbs == 0 ? A[0][r] : (nbs == 1 ? A[1][r] : (nbs == 2 ? A[2][r] : A[3][r])))
                      const float d0 = (float)V_SEL(aL, 0) * wsc[0] + wsc[1], d1 = (float)V_SEL(aH, 0) * wsc[0] + wsc[1];
                      const float d2 = (float)V_SEL(aL, 1) * wsc[0] + wsc[1], d3 = (float)V_SEL(aH, 1) * wsc[0] + wsc[1];
#undef V_SEL
                      *(u32x2*)(FFN + (size_t)t * DM + slice * 256 + 4 * lane) = (u32x2){cvtpk(d0, d1), cvtpk(d2, d3)}; }
                    __builtin_amdgcn_sched_barrier(0);
#pragma unroll
                    for (int k_ = 0; k_ < 8; ++k_) { ci[k_] = ni[k_]; cw[k_] = nw[k_]; }
                    wsc[0] = nsc[0]; wsc[1] = nsc[1];
                    if (more) V_ROT(ni, nw, nsc, mia, mib, mwq, mwsc, "s_waitcnt vmcnt(17)"); else V_ROT(ni, nw, nsc, mia, mib, mwq, mwsc, "s_waitcnt vmcnt(0)");
                    __builtin_amdgcn_sched_barrier(0);
                }
                asm volatile("s_waitcnt vmcnt(0)" ::: "memory");
            }
        }
#undef V_GLD4
#undef V_GLD2
#undef V_GLD1
#undef V_MISC
#undef V_ROT
#undef V_DMAQ
#undef V_TR
#undef V_QUARTER
#undef V_MM
    }
    GRID_BAR(13);

    for (int rep_ = 0; rep_ < (IN(14) ? 1 + ((REP_MASK >> 14) & 1) : 0); ++rep_) {
        PH_LOCALS;
        const int nb_ = G >> 4, b = bid / nb_, r0 = (bid % nb_) * NWAVES + wave, rstep = nb_ * NWAVES;
        LAS float* pg2 = (LAS float*)lds; LAS float* plg = pg2 + 2048; LAS float* plb = pg2 + 4096;
        __syncthreads();
        if (b < 16) { *(LAS f32x4*)(pg2 + 4 * tid) = *(const f32x4*)(mod + (size_t)b * 12288 + 10240 + 4 * tid);
            *(LAS f32x4*)(plg + 4 * tid) = *(const f32x4*)(AR.in[20] + 4 * tid); *(LAS f32x4*)(plb + 4 * tid) = *(const f32x4*)(AR.in[21] + 4 * tid); }
        __syncthreads();
        if (b < 16) {
        u32x4 nx[4]; u32x4 nf[4];
#define P14_LOAD(tt) do { _Pragma("unroll") for (int c = 0; c < 4; ++c) { const int d_ = c * 512 + lane * 8; nf[c] = *(const u32x4*)(FFN + (size_t)(tt) * DM + d_); \
            nx[c] = *(const u32x4*)(X1b + (size_t)(tt) * DM + d_); } } while (0)
        P14_LOAD(b * 2048 + r0);
        for (int r = r0; r < 2048; r += rstep) {
            const int t = b * 2048 + r;
            float acc[32]; float s = 0.f;
#pragma unroll
            for (int c = 0; c < 4; ++c) { const int d = c * 512 + lane * 8;
                const u32x4 fv = nf[c]; const u32x4 xv = nx[c]; const unsigned xa = xv.x, xb = xv.y, xc = xv.z, xd = xv.w;
                const f32x4 x0 = {bf_lo(xa), bf_hi(xa), bf_lo(xb), bf_hi(xb)}, x1 = {bf_lo(xc), bf_hi(xc), bf_lo(xd), bf_hi(xd)};
                const f32x4 m0 = *(const LAS f32x4*)(pg2 + d), m1 = *(const LAS f32x4*)(pg2 + d + 4);
                const unsigned f0 = fv.x, f1 = fv.y, f2 = fv.z, f3 = fv.w;
                acc[c * 8 + 0] = x0[0] * DN_ALPHA + m0[0] * bf_lo(f0); acc[c * 8 + 1] = x0[1] * DN_ALPHA + m0[1] * bf_hi(f0);
                acc[c * 8 + 2] = x0[2] * DN_ALPHA + m0[2] * bf_lo(f1); acc[c * 8 + 3] = x0[3] * DN_ALPHA + m0[3] * bf_hi(f1);
                acc[c * 8 + 4] = x1[0] * DN_ALPHA + m1[0] * bf_lo(f2); acc[c * 8 + 5] = x1[1] * DN_ALPHA + m1[1] * bf_hi(f2);
                acc[c * 8 + 6] = x1[2] * DN_ALPHA + m1[2] * bf_lo(f3); acc[c * 8 + 7] = x1[3] * DN_ALPHA + m1[3] * bf_hi(f3);
#pragma unroll
                for (int q = 0; q < 8; ++q) s += acc[c * 8 + q]; }
            if (r + rstep < 2048) P14_LOAD(t + rstep);
            const float mean = wsum(s) * (1.0f / DM); float s2 = 0.f;
#pragma unroll
            for (int i = 0; i < 32; ++i) { acc[i] -= mean; s2 += acc[i] * acc[i]; }
            const float rstd = 1.0f / sqrtf(wsum(s2) * (1.0f / DM) + 1e-5f);
#pragma unroll
            for (int c = 0; c < 4; ++c) { const int d = c * 512 + lane * 8;
                const f32x4 g0 = *(const LAS f32x4*)(plg + d), g1 = *(const LAS f32x4*)(plg + d + 4), b0 = *(const LAS f32x4*)(plb + d), b1 = *(const LAS f32x4*)(plb + d + 4);
                f32x4 o0, o1;
#pragma unroll
                for (int q = 0; q < 4; ++q) { o0[q] = acc[c * 8 + q] * rstd * g0[q] + b0[q]; o1[q] = acc[c * 8 + 4 + q] * rstd * g1[q] + b1[q]; }
                *(f32x4*)(AR.out + (size_t)t * DM + d) = o0; *(f32x4*)(AR.out + (size_t)t * DM + d + 4) = o1; }
        }
        }
    }
#endif
#undef IN
#undef GRID_BAR
}

extern "C" void kernel_launch(void* const* d_in, const int* in_sizes, int n_in, void* d_out, int out_size, void* d_ws, size_t ws_size, hipStream_t stream) {
    static int grid = 0;
    if (grid == 0) {
        if (n_in != 22 || out_size != T * DM || ws_size < WS_END) { fprintf(stderr, "kernel_launch: unexpected shapes (n_in %d out %d ws %zu)\n", n_in, out_size, ws_size); grid = -1; return; }
        int dev = 0, cus = 0, per_cu = 0;
        if (hipGetDevice(&dev) != hipSuccess || hipDeviceGetAttribute(&cus, hipDeviceAttributeMultiprocessorCount, dev) != hipSuccess) { grid = -1; return; }
        if (hipFuncSetAttribute((const void*)mega_fwd, hipFuncAttributeMaxDynamicSharedMemorySize, LDS_BYTES) != hipSuccess) { fprintf(stderr, "kernel_launch: hipFuncSetAttribute failed\n"); grid = -1; return; }
        if (hipOccupancyMaxActiveBlocksPerMultiprocessor(&per_cu, (const void*)mega_fwd, NWAVES * 64, LDS_BYTES) != hipSuccess || per_cu < 1) { fprintf(stderr, "kernel_launch: occupancy query says %d\n", per_cu); grid = -1; (void)hipGetLastError(); return; }
        grid = cus;
    }
    if (grid < 0) return;
    (void)hipMemsetAsync(d_ws, 0, 16384, stream);
    Args a{};
    for (int i = 0; i < 22; ++i) a.in[i] = (const float*)d_in[i];
    a.out = (float*)d_out; a.ws = (unsigned char*)d_ws;
#if MK_N_LAUNCHES == 1
    a.ph_lo = 0; a.ph_hi = N_PHASES;
    void* kargs[] = {&a};
    hipError_t e = hipLaunchCooperativeKernel((const void*)mega_fwd, dim3(grid), dim3(NWAVES * 64), kargs, LDS_BYTES, stream);
    if (e != hipSuccess) fprintf(stderr, "kernel_launch: cooperative launch failed: %s (grid %d)\n", hipGetErrorString(e), grid);
#else
    for (int p = 0; p < N_PHASES; ++p) {
        a.ph_lo = p; a.ph_hi = p + 1;
        hipLaunchKernelGGL(mega_fwd, dim3(grid), dim3(NWAVES * 64), LDS_BYTES, stream, a);
    }
    const hipError_t le = hipPeekAtLastError();
    if (le != hipSuccess) fprintf(stderr, "kernel_launch: launch failed: %s\n", hipGetErrorName(le));
#endif
}
```

```cpp
#include <hip/hip_runtime.h>
#include <hip/hip_cooperative_groups.h>
#include <cstdio>
#include <cstdint>
namespace cg = cooperative_groups;

#ifndef MK_N_LAUNCHES
#define MK_N_LAUNCHES 1
#ifndef REP_MASK
#define REP_MASK 0
#endif
#define DBG_MIX 1.0f
#define DBG_FFN 1.0f
#endif

#define LAS __attribute__((address_space(3)))
typedef unsigned short bf16_t;
typedef short bf16x8 __attribute__((ext_vector_type(8)));
typedef short s16x4 __attribute__((ext_vector_type(4)));
typedef float f32x2 __attribute__((ext_vector_type(2)));
typedef float f32x4 __attribute__((ext_vector_type(4)));
typedef float f32x16 __attribute__((ext_vector_type(16)));
typedef unsigned u32x2 __attribute__((ext_vector_type(2)));
typedef unsigned u32x4 __attribute__((ext_vector_type(4)));
typedef int i32x4 __attribute__((ext_vector_type(4)));
typedef __bf16 bf16x2_t __attribute__((ext_vector_type(2)));

constexpr int NB = 16, SEQ = 2048, DM = 2048, T = NB * SEQ;
constexpr int NPROJ = 4160, NPROJ_PAD = 4352;
constexpr float DN_ALPHA = 1.189207115002721f;
constexpr int NE = 16384;

constexpr size_t MiB = 1u << 20;
constexpr size_t WS_MOD = 1 * MiB;
constexpr size_t WS_ROPEA = 2 * MiB;
constexpr size_t WS_ROPEB = 2 * MiB + 256 * 1024;
constexpr size_t WS_CQS = 2 * MiB;
constexpr size_t WS_CMQ = 2 * MiB + 262144;
constexpr size_t WS_WSQ = 2 * MiB + 327680;
constexpr size_t WS_SSQ_Q = 3 * MiB;
constexpr size_t WS_SSQ_KV = 4 * MiB;
constexpr size_t WS_SSQ_O = 5 * MiB;
constexpr size_t WS_SM = 7 * MiB;
constexpr size_t WS_SL = 8 * MiB;
constexpr size_t WS_K1 = 9 * MiB;
constexpr size_t WS_K2 = 9 * MiB + 32768;
constexpr size_t WS_WIN = 10 * MiB;
constexpr size_t WS_WUQ = 27 * MiB;
constexpr size_t WS_WUKV = 29 * MiB;
constexpr size_t WS_WO = 31 * MiB;
constexpr size_t WS_WPQ = 39 * MiB;
constexpr size_t WS_UT = 64 * MiB;
constexpr size_t WS_VT = 128 * MiB;
constexpr size_t WS_A = 192 * MiB;
constexpr size_t WS_QA = 320 * MiB, WS_KA = 384 * MiB, WS_VA = 448 * MiB, WS_CQ = 512 * MiB, WS_CKV = 544 * MiB, WS_KR = 576 * MiB;
constexpr size_t WS_Y = 320 * MiB;
constexpr size_t WS_QN = 580 * MiB, WS_QR = 644 * MiB, WS_KN = 676 * MiB, WS_VB = 740 * MiB;
constexpr size_t WS_H2 = 580 * MiB;
constexpr size_t WS_O = 804 * MiB;
constexpr size_t WS_IDX = 932 * MiB;
constexpr size_t WS_G = 940 * MiB;
constexpr size_t WS_END = 972 * MiB;
constexpr size_t WS_SU = 9 * MiB + 65536;
constexpr size_t WS_SH = 9 * MiB + 196608;
constexpr size_t WS_CMAX = 9 * MiB + 327680;
constexpr size_t WS_WS1 = 9 * MiB + 491520;
constexpr size_t WS_HS1 = 9 * MiB + 524288;
constexpr size_t WS_CMAX2 = 9 * MiB + 655360;
constexpr size_t WS_WS4 = 9 * MiB + 720896;
constexpr size_t WS_OS = 9 * MiB + 786432;
constexpr size_t WS_CMAX3 = 9 * MiB + 917504;
constexpr size_t WS_WS3 = 9 * MiB + 983040;
constexpr size_t WS_U8 = 64 * MiB;
constexpr size_t WS_V8 = 96 * MiB;
constexpr size_t WS_PART = 320 * MiB;
constexpr size_t WS_H8 = 804 * MiB;
constexpr size_t WS_IDX2 = 932 * MiB;
constexpr size_t WS_WT = 956 * MiB;
constexpr size_t WS_H2S = 128 * MiB;
constexpr size_t WS_X1 = 804 * MiB;
constexpr size_t WS_FFN = 192 * MiB;

constexpr int NWAVES = 8;
constexpr int LDS_BYTES = 155648;

__device__ __forceinline__ int opaque(int v) { asm volatile("" : "+v"(v)); return v; }
__device__ __forceinline__ unsigned cvtpk(float lo, float hi) { f32x2 v = {lo, hi}; bf16x2_t b = __builtin_convertvector(v, bf16x2_t); return __builtin_bit_cast(unsigned, b); }
__device__ __forceinline__ float dot2bf(unsigned a, unsigned b, float c) { return __builtin_amdgcn_fdot2_f32_bf16(__builtin_bit_cast(bf16x2_t, a), __builtin_bit_cast(bf16x2_t, b), c, false); }
__device__ __forceinline__ void fmac(float& d, float a, float b) { asm("v_fmac_f32_e32 %0, %1, %2" : "+v"(d) : "v"(a), "v"(b)); }
__device__ __forceinline__ float bf_lo(unsigned u) { return __uint_as_float(u << 16); }
__device__ __forceinline__ float bf_hi(unsigned u) { return __uint_as_float(u & 0xffff0000u); }
#define DPPF(v, ctrl) __builtin_bit_cast(float, __builtin_amdgcn_update_dpp(0, __builtin_bit_cast(int, (v)), (ctrl), 0xf, 0xf, false))
#define RLF(v, l) __builtin_bit_cast(float, __builtin_amdgcn_readlane(__builtin_bit_cast(int, (v)), (l)))
__device__ __forceinline__ float wsum(float v) {
    v += DPPF(v, 0xB1); v += DPPF(v, 0x4E); v += DPPF(v, 0x141); v += DPPF(v, 0x140);
    return (RLF(v, 0) + RLF(v, 16)) + (RLF(v, 32) + RLF(v, 48));
}
__device__ __forceinline__ float wmax(float v) {
    v = fmaxf(v, DPPF(v, 0xB1)); v = fmaxf(v, DPPF(v, 0x4E)); v = fmaxf(v, DPPF(v, 0x141)); v = fmaxf(v, DPPF(v, 0x140));
    return fmaxf(fmaxf(RLF(v, 0), RLF(v, 16)), fmaxf(RLF(v, 32), RLF(v, 48)));
}
__device__ __forceinline__ float wave_max(float v) {
#pragma unroll
    for (int o = 1; o < 64; o <<= 1) v = fmaxf(v, __shfl_xor(v, o));
    return v;
}
__device__ __forceinline__ unsigned pack_fp8x4(float a, float b, float c, float d) {
    int w = __builtin_amdgcn_cvt_pk_fp8_f32(a, b, 0, false); w = __builtin_amdgcn_cvt_pk_fp8_f32(c, d, w, true); return (unsigned)w;
}
__device__ __forceinline__ unsigned pack_i8x4(float a, float b, float c, float d) {
    const int ia = (int)__builtin_rintf(a), ib = (int)__builtin_rintf(b), ic = (int)__builtin_rintf(c), id = (int)__builtin_rintf(d);
    return ((unsigned)ia & 255u) | (((unsigned)ib & 255u) << 8) | (((unsigned)ic & 255u) << 16) | ((unsigned)id << 24);
}
__device__ __forceinline__ float wave_sum(float v) {
#pragma unroll
    for (int o = 1; o < 64; o <<= 1) v += __shfl_xor(v, o);
    return v;
}

namespace pg8 {
constexpr int BM = 256, BK = 64, HALF = 128, HTB = HALF * BK * 2, STAGE_BYTES = 8 * HTB, NXCD = 8, WGM = 8;
__host__ __device__ __forceinline__ int lds_byte(int r, int c) { const int st = (r >> 4) * 2 + (c >> 5), rr = r & 15, cc = c & 31, ob = rr * 64 + cc * 2; return st * 1024 + (ob ^ (((ob >> 9) & 1) << 5)); }
__host__ __device__ __forceinline__ void stage_rc(int b, int& R, int& C) { const int st = b / 1024, sb = b % 1024, swz = sb ^ (((sb >> 9) & 1) << 5); R = (st >> 1) * 16 + swz / 64; C = (st & 1) * 32 + (swz % 64) / 2; }
__host__ __device__ __forceinline__ int perm32(int rho) { const int n = rho >> 4, i = rho & 15; return 8 * (i >> 2) + 4 * n + (i & 3); }

struct Unit { int pm, pn; };
struct Gemm { const bf16_t* A; const bf16_t* Bt; int M, N, K; };

struct StaticOrder {
    int nM, nN, nwg, G, c;
    __host__ __device__ __forceinline__ void init(int M, int N, int G_, int c_) { nM = M / BM; nN = N / BM; nwg = nM * nN; G = G_; c = c_; }
    __host__ __device__ __forceinline__ bool next(int i, Unit& u) const {
        const long L = (long)i * G + c; if (L >= nwg) return false;
        int wgid = (int)L; { const int q = nwg / NXCD, r = nwg % NXCD, xcd = wgid % NXCD, off = wgid / NXCD; wgid = (xcd < r ? xcd * (q + 1) : r * (q + 1) + (xcd - r) * q) + off; }
        const int nig = WGM * nN, gid = wgid / nig, fm = gid * WGM, gsz = (nM - fm) < WGM ? (nM - fm) : WGM;
        u.pm = fm + ((wgid % nig) % gsz); u.pn = (wgid % nig) / gsz; return true;
    }
};

template <class Epi, class Sched>
__device__ __forceinline__ void gemm_phase(const int tid, LAS unsigned char* lds, const Gemm g, const Sched& S, const Epi& E) {
    const int wid = __builtin_amdgcn_readfirstlane(tid >> 6), lane = tid & 63, wr = wid >> 2, wc = wid & 3, fr = lane & 15, fq = lane >> 4;
    const int K = g.K, nt = K / BK;
    unsigned voffA[2], voffB[2];
#pragma unroll
    for (int i = 0; i < 2; ++i) { int R, C; stage_rc(tid * 16 + i * 8192, R, C); const int Rb = Epi::PERM ? ((R & ~31) + perm32(R & 31)) : R;
        voffA[i] = (unsigned)(R * K + C) * 2u; voffB[i] = (unsigned)(Rb * K + C) * 2u; }
    const size_t kstep = (size_t)(BK * 2);
    const size_t hstep = (size_t)HALF * K * 2;
    const size_t tstep = 2 * hstep;
    const unsigned ldsw = (unsigned)wid * 1024u;
    const int aoff = lds_byte(wr * 64 + fr, fq * 8), boff = lds_byte(wc * 32 + fr, fq * 8);
#define PG8_SA(b, h) (((b) * 2 + (h)) * HTB)
#define PG8_SB(b, h) ((4 + (b) * 2 + (h)) * HTB)
#define PG8_STAGE(bufoff, gbase, voff) do { _Pragma("unroll") for (int _i = 0; _i < 2; ++_i) \
        __builtin_amdgcn_global_load_lds((const unsigned*)((const char*)(gbase) + (voff)[_i]), (LAS unsigned*)(lds + (bufoff) + ldsw + _i * 8192), 16, 0, 0); } while (0)
#define PG8_LDA(dst, b, h) do { _Pragma("unroll") for (int m = 0; m < 4; ++m) _Pragma("unroll") for (int k = 0; k < 2; ++k) dst[m][k] = *(const LAS bf16x8*)(lds + PG8_SA(b, h) + aoff + m * 2048 + k * 1024); } while (0)
#define PG8_LDB(dst, b, h) do { _Pragma("unroll") for (int n = 0; n < 2; ++n) _Pragma("unroll") for (int k = 0; k < 2; ++k) dst[n][k] = *(const LAS bf16x8*)(lds + PG8_SB(b, h) + boff + n * 2048 + k * 1024); } while (0)
#define PG8_MMA(ai, bj, At, Bt) do { __builtin_amdgcn_s_setprio(1); _Pragma("unroll") for (int m = 0; m < 4; ++m) _Pragma("unroll") for (int n = 0; n < 2; ++n) _Pragma("unroll") for (int k = 0; k < 2; ++k) \
        { if constexpr (Epi::I8) acc[ai][bj][m][n] = __builtin_bit_cast(f32x4, __builtin_amdgcn_mfma_i32_16x16x64_i8(__builtin_bit_cast(i32x4, Bt[n][k]), __builtin_bit_cast(i32x4, At[m][k]), __builtin_bit_cast(i32x4, acc[ai][bj][m][n]), 0, 0, 0)); \
          else acc[ai][bj][m][n] = __builtin_amdgcn_mfma_f32_16x16x32_bf16(Bt[n][k], At[m][k], acc[ai][bj][m][n], 0, 0, 0); } __builtin_amdgcn_s_setprio(0); } while (0)
#define PG8_WAIT_V(n) asm volatile("s_waitcnt vmcnt(" #n ")" ::: "memory")
#define PG8_WAIT_L(n) asm volatile("s_waitcnt lgkmcnt(" #n ")" ::: "memory")
#define PG8_BAR __builtin_amdgcn_s_barrier()
#define PG8_SCHED __builtin_amdgcn_sched_barrier(0)
    Unit cur, nxt; int ui = 0;
    if (!S.next(0, cur)) return;
    f32x4 acc[2][2][4][2];
#pragma unroll
    for (int a = 0; a < 2; ++a)
#pragma unroll
        for (int b = 0; b < 2; ++b)
#pragma unroll
            for (int m = 0; m < 4; ++m)
#pragma unroll
                for (int n = 0; n < 2; ++n) acc[a][b][m][n] = (f32x4){0.f, 0.f, 0.f, 0.f};
    bf16x8 At[4][2], B0[2][2], B1[2][2];
    const char* cA = (const char*)g.A + (size_t)cur.pm * tstep; const char* cB = (const char*)g.Bt + (size_t)cur.pn * tstep;
    PG8_STAGE(PG8_SB(0, 0), cB, voffB); PG8_STAGE(PG8_SB(0, 1), cB + hstep, voffB); PG8_STAGE(PG8_SA(0, 0), cA, voffA); PG8_STAGE(PG8_SA(0, 1), cA + hstep, voffA);
    if (wr == 1) PG8_BAR;
    PG8_WAIT_V(2); PG8_BAR;
    PG8_STAGE(PG8_SB(1, 0), cB + kstep, voffB); PG8_STAGE(PG8_SA(1, 0), cA + kstep, voffA); PG8_STAGE(PG8_SB(1, 1), cB + hstep + kstep, voffB);
    PG8_WAIT_V(6); PG8_BAR;
    for (;;) {
        const bool has_next = S.next(ui + 1, nxt);
        const char* nA = has_next ? (const char*)g.A + (size_t)nxt.pm * tstep : cA; const char* nB = has_next ? (const char*)g.Bt + (size_t)nxt.pn * tstep : cB;
        for (int t = 0; t < nt; t += 2) {
            if constexpr (Epi::MID) { if (t == (nt >> 1)) E.mid(acc, cur, ui, tid); }
            const bool last = (t == nt - 2);
            const char* a1 = cA + (size_t)(t + 1) * kstep;
            const char* a2 = last ? nA : cA + (size_t)(t + 2) * kstep; const char* b2 = last ? nB : cB + (size_t)(t + 2) * kstep;
            const char* a3 = a2 + kstep; const char* b3 = b2 + kstep;
            PG8_LDB(B0, 0, 0); PG8_LDB(B1, 0, 1); PG8_SCHED; PG8_LDA(At, 0, 0); PG8_STAGE(PG8_SA(1, 1), a1 + hstep, voffA);
            PG8_WAIT_V(8); PG8_WAIT_L(0); PG8_BAR; PG8_MMA(0, 0, At, B0); PG8_MMA(0, 1, At, B1); PG8_BAR; PG8_SCHED;
            PG8_LDA(At, 0, 1); PG8_STAGE(PG8_SB(0, 0), b2, voffB); PG8_STAGE(PG8_SB(0, 1), b2 + hstep, voffB); PG8_STAGE(PG8_SA(0, 0), a2, voffA);
            PG8_WAIT_V(8); PG8_WAIT_L(0); PG8_BAR; PG8_MMA(1, 0, At, B0); PG8_MMA(1, 1, At, B1); PG8_BAR; PG8_SCHED;
            PG8_LDB(B0, 1, 0); PG8_LDB(B1, 1, 1); PG8_SCHED; PG8_LDA(At, 1, 0); PG8_STAGE(PG8_SA(0, 1), a2 + hstep, voffA);
            PG8_WAIT_V(8); PG8_WAIT_L(0); PG8_BAR; PG8_MMA(0, 0, At, B0); PG8_MMA(0, 1, At, B1); PG8_BAR; PG8_SCHED;
            PG8_LDA(At, 1, 1); PG8_STAGE(PG8_SB(1, 0), b3, voffB); PG8_STAGE(PG8_SB(1, 1), b3 + hstep, voffB); PG8_STAGE(PG8_SA(1, 0), a3, voffA);
            PG8_WAIT_V(8); PG8_WAIT_L(0); PG8_BAR; PG8_MMA(1, 0, At, B0); PG8_MMA(1, 1, At, B1); PG8_BAR; PG8_SCHED;
        }
        if (wr == 0) PG8_BAR;
        E(acc, cur, ui, tid);
        if (!has_next) break;
#pragma unroll
        for (int a = 0; a < 2; ++a)
#pragma unroll
            for (int b = 0; b < 2; ++b)
#pragma unroll
                for (int m = 0; m < 4; ++m)
#pragma unroll
                    for (int n = 0; n < 2; ++n) acc[a][b][m][n] = (f32x4){0.f, 0.f, 0.f, 0.f};
        cur = nxt; cA = nA; cB = nB; ++ui;
        if (wr == 1) PG8_BAR;
    }
    PG8_WAIT_V(0);
    PG8_BAR;
#undef PG8_SA
#undef PG8_SB
#undef PG8_STAGE
#undef PG8_LDA
#undef PG8_LDB
#undef PG8_MMA
#undef PG8_WAIT_V
#undef PG8_WAIT_L
#undef PG8_BAR
#undef PG8_SCHED
}

__device__ __forceinline__ void store8(bf16_t* p, f32x4 v0, f32x4 v1) {
    u32x4 w; w.x = cvtpk(v0[0], v0[1]); w.y = cvtpk(v0[2], v0[3]); w.z = cvtpk(v1[0], v1[1]); w.w = cvtpk(v1[2], v1[3]);
    *(u32x4*)p = w;
}


struct Rope4 { float f[4];
    __device__ __forceinline__ void init(int ibase, float kexp) {
#pragma unroll
        for (int j = 0; j < 4; ++j) f[j] = __builtin_amdgcn_exp2f(-(float)(ibase + j) * kexp) * 0.15915494309189535f; }
    __device__ __forceinline__ void sincos(int s, f32x4& cs, f32x4& sn) const {
#pragma unroll
        for (int j = 0; j < 4; ++j) { float rev = (float)s * f[j]; rev -= floorf(rev); sn[j] = __builtin_amdgcn_sinf(rev); cs[j] = __builtin_amdgcn_cosf(rev); } }
    __device__ __forceinline__ static void rot(f32x4& v0, f32x4& v1, const f32x4& cs, const f32x4& sn) {
        const f32x4 a = v0 * cs - v1 * sn, b = v1 * cs + v0 * sn; v0 = a; v1 = b; }
    __device__ __forceinline__ void apply(f32x4& v0, f32x4& v1, int s) const { f32x4 cs, sn; sincos(s, cs, sn); rot(v0, v1, cs, sn); }
};
constexpr float ROPE_KA = 18.931568569324174f / 16.0f, ROPE_KB = 18.931568569324174f / 32.0f;

struct EpiProj {
    static constexpr bool PERM = true, MID = false, I8 = true;
    bf16_t* QKV;
    bf16_t* CQKV;
    bf16_t* KR; float* ssq;
    const LAS float* tr; const LAS float* tc;
    unsigned char* C8; float* csc; LAS float* etab;
    static __device__ __forceinline__ f32x4 rescale_i(const f32x4 a, const float r) { const float a0 = a[0], a1 = a[1], a2 = a[2], a3 = a[3];
        return (f32x4){__int_as_float((int)__builtin_rintf((float)__float_as_int(a0) * r)), __int_as_float((int)__builtin_rintf((float)__float_as_int(a1) * r)),
                       __int_as_float((int)__builtin_rintf((float)__float_as_int(a2) * r)), __int_as_float((int)__builtin_rintf((float)__float_as_int(a3) * r))}; }
    static __device__ __forceinline__ f32x4 i2f4x(const f32x4 a, const int z) { const float a0 = a[0], a1 = a[1], a2 = a[2], a3 = a[3];
        return (f32x4){(float)(__float_as_int(a0) ^ z), (float)(__float_as_int(a1) ^ z), (float)(__float_as_int(a2) ^ z), (float)(__float_as_int(a3) ^ z)}; }
    static __device__ __forceinline__ f32x4 i2f4(const f32x4 a) { const float a0 = a[0], a1 = a[1], a2 = a[2], a3 = a[3];
        return (f32x4){(float)__float_as_int(a0), (float)__float_as_int(a1), (float)__float_as_int(a2), (float)__float_as_int(a3)}; }
    __device__ __forceinline__ void mid(f32x4 (&)[2][2][4][2], const Unit&, int, int) const {}
    __device__ __forceinline__ void operator()(const f32x4 (&acc_)[2][2][4][2], const Unit& u, int ui, int tid_) const {
        const int tid = opaque(tid_), lane = tid & 63, wid = __builtin_amdgcn_readfirstlane(tid >> 6), wr = wid >> 2, wc = wid & 3, fr = lane & 15, fq = lane >> 4;
        const int pn = u.pn, row0 = u.pm * BM + wr * 64 + fr;
        f32x4 cs[2][2]; float rs[2][4];
        { const LAS float* wp_ = tc + ui * 256 + wc * 32 + 8 * fq;
#pragma unroll
          for (int bj = 0; bj < 2; ++bj) { cs[bj][0] = *(const LAS f32x4*)(wp_ + bj * HALF); cs[bj][1] = *(const LAS f32x4*)(wp_ + bj * HALF + 4); }
#pragma unroll
          for (int ai = 0; ai < 2; ++ai)
#pragma unroll
              for (int m = 0; m < 4; ++m) rs[ai][m] = tr[ui * 256 + wr * 64 + fr + ai * HALF + m * 16]; }
#define ACCF(ai, bj, m, n) (i2f4(acc_[ai][bj][m][n]) * rs[ai][m] * cs[bj][n])
        if (pn < 12) {
            bf16_t* base = QKV + (size_t)(pn >> 2) * (32u << 20);
            const int colt = (pn & 3) * 256 + wc * 32 + 8 * fq;
            const bool rope = (pn < 8) && (wc == 0);
            Rope4 R; R.init(4 * fq, ROPE_KA);
#pragma unroll
            for (int ai = 0; ai < 2; ++ai)
#pragma unroll
                for (int m = 0; m < 4; ++m) {
                    const int row = row0 + ai * HALF + m * 16; const int s = row & (SEQ - 1);
                    f32x4 rcs = {1.f, 1.f, 1.f, 1.f}, rsn = {0.f, 0.f, 0.f, 0.f};
                    if (rope) R.sincos(s, rcs, rsn);
#pragma unroll
                    for (int bj = 0; bj < 2; ++bj) {
                        f32x4 v0 = ACCF(ai, bj, m, 0), v1 = ACCF(ai, bj, m, 1);
                        if (rope) Rope4::rot(v0, v1, rcs, rsn);
                        if (pn < 4) store8(base + (size_t)row * 1024 + colt + bj * HALF, v0, v1);
                        else { u32x2 w; w.x = pack_fp8x4(v0[0], v0[1], v0[2], v0[3]); w.y = pack_fp8x4(v1[0], v1[1], v1[2], v1[3]);
                            *(u32x2*)((unsigned char*)base + (size_t)row * 1024 + colt + bj * HALF) = w; }
                    }
                }
        } else if (pn < 16) {
            const int tsel = (pn >> 1) & 1, uh = pn & 1, rl0 = wr * 64 + fr;
            unsigned char* base8 = C8 + (size_t)tsel * (16u << 20); float* sq = ssq + (size_t)tsel * (256u << 10); float* cso = csc + (size_t)(tsel * 2 + uh) * T;
            const int colt = uh * 256 + wc * 32 + 8 * fq; const int slot = uh * 4 + wc;
#pragma unroll
            for (int ai = 0; ai < 2; ++ai)
#pragma unroll
                for (int m = 0; m < 4; ++m) {
                    const int row = row0 + ai * HALF + m * 16; float q = 0.f, mx = 0.f;
#pragma unroll
                    for (int bj = 0; bj < 2; ++bj) {
                        const f32x4 v0 = ACCF(ai, bj, m, 0), v1 = ACCF(ai, bj, m, 1);
                        q += (v0[0] * v0[0] + v0[1] * v0[1]) + (v0[2] * v0[2] + v0[3] * v0[3]) + (v1[0] * v1[0] + v1[1] * v1[1]) + (v1[2] * v1[2] + v1[3] * v1[3]);
                        mx = fmaxf(mx, fmaxf(fmaxf(fmaxf(fabsf(v0[0]), fabsf(v0[1])), fmaxf(fabsf(v0[2]), fabsf(v0[3]))), fmaxf(fmaxf(fabsf(v1[0]), fabsf(v1[1])), fmaxf(fabsf(v1[2]), fabsf(v1[3])))));
                    }
                    q += __shfl_xor(q, 16); q += __shfl_xor(q, 32); mx = fmaxf(mx, __shfl_xor(mx, 16)); mx = fmaxf(mx, __shfl_xor(mx, 32));
                    if (fq == 0) { sq[(size_t)slot * T + row] = q; etab[wc * 256 + rl0 + ai * HALF + m * 16] = mx; }
                }
            __syncthreads();
            int zo = 0; asm volatile("" : "+v"(zo));
#pragma unroll
            for (int ai = 0; ai < 2; ++ai)
#pragma unroll
                for (int m = 0; m < 4; ++m) {
                    const int row = row0 + ai * HALF + m * 16, rl = rl0 + ai * HALF + m * 16;
                    const float mx = fmaxf(fmaxf(etab[rl], etab[256 + rl]), fmaxf(etab[512 + rl], etab[768 + rl]));
                    const float qs = mx > 0.f ? 127.0f / mx : 1.0f;
                    if (wc == 0 && fq == 0) cso[row] = mx > 0.f ? mx * (1.0f / 127.0f) : 1.0f;
                    const float rq_ = rs[ai][m] * qs;
#pragma unroll
                    for (int bj = 0; bj < 2; ++bj) {
                        const f32x4 v0 = i2f4x(acc_[ai][bj][m][0], zo) * rq_ * cs[bj][0], v1 = i2f4x(acc_[ai][bj][m][1], zo) * rq_ * cs[bj][1];
                        u32x2 w; w.x = pack_i8x4(v0[0], v0[1], v0[2], v0[3]); w.y = pack_i8x4(v1[0], v1[1], v1[2], v1[3]);
                        *(u32x2*)(base8 + (size_t)row * 512 + colt + bj * HALF) = w;
                    }
                }
        } else {
            if (wc < 2) {
                Rope4 R; R.init(16 * wc + 4 * fq, ROPE_KB);
#pragma unroll
                for (int ai = 0; ai < 2; ++ai)
#pragma unroll
                    for (int m = 0; m < 4; ++m) {
                        const int row = row0 + ai * HALF + m * 16; const int s = row & (SEQ - 1);
                        f32x4 v0 = ACCF(ai, 0, m, 0), v1 = ACCF(ai, 0, m, 1);
                        R.apply(v0, v1, s);
                        store8(KR + (size_t)row * 64 + wc * 32 + 8 * fq, v0, v1);
                    }
            }
        }
    }
};
#undef ACCF

struct EpiKr {
    static constexpr bool PERM = true, MID = false, I8 = false;
    bf16_t* KR;
    __device__ __forceinline__ void mid(f32x4 (&)[2][2][4][2], const Unit&, int, int) const {}
    __device__ __forceinline__ void operator()(const f32x4 (&acc)[2][2][4][2], const Unit& u, int ui, int tid_) const {
        const int tid = opaque(tid_), lane = tid & 63, wid = __builtin_amdgcn_readfirstlane(tid >> 6), wr = wid >> 2, wc = wid & 3, fr = lane & 15, fq = lane >> 4;
        const int row0 = u.pm * BM + wr * 64 + fr;
        if (wc < 2) {
            Rope4 R; R.init(16 * wc + 4 * fq, ROPE_KB);
#pragma unroll
            for (int ai = 0; ai < 2; ++ai)
#pragma unroll
                for (int m = 0; m < 4; ++m) {
                    const int row = row0 + ai * HALF + m * 16; const int s = row & (SEQ - 1);
                    f32x4 v0 = acc[ai][0][m][0] * 1.0f, v1 = acc[ai][0][m][1] * 1.0f;
                    R.apply(v0, v1, s);
                    store8(KR + (size_t)row * 64 + wc * 32 + 8 * fq, v0, v1);
                }
        }
    }
};

struct EpiQ {
    static constexpr bool PERM = true, MID = true, I8 = true;
    bf16_t *Qn, *Qr; const LAS float* tab; const LAS float* tc;
    __device__ __forceinline__ void mid(f32x4 (&acc)[2][2][4][2], const Unit& u, int ui, int tid_) const {
        const int tid = opaque(tid_), lane = tid & 63, wid = __builtin_amdgcn_readfirstlane(tid >> 6), wr = wid >> 2, fr = lane & 15;
        const int rl0 = wr * 64 + fr;
#pragma unroll
        for (int ai = 0; ai < 2; ++ai)
#pragma unroll
            for (int m = 0; m < 4; ++m) { const float ratio = tab[(ui * 256 + rl0 + ai * HALF + m * 16) * 2 + 1];
#pragma unroll
                for (int bj = 0; bj < 2; ++bj) { acc[ai][bj][m][0] = EpiProj::rescale_i(acc[ai][bj][m][0], ratio); acc[ai][bj][m][1] = EpiProj::rescale_i(acc[ai][bj][m][1], ratio); } }
    }
    __device__ __forceinline__ void operator()(const f32x4 (&acc)[2][2][4][2], const Unit& u, int ui, int tid_) const {
        const int tid = opaque(tid_), lane = tid & 63, wid = __builtin_amdgcn_readfirstlane(tid >> 6), wr = wid >> 2, wc = wid & 3, fr = lane & 15, fq = lane >> 4;
        const int pn = u.pn, rl0 = wr * 64 + fr, row0 = u.pm * BM + rl0;
        Rope4 R; R.init(16 * (wc & 1) + 4 * fq, ROPE_KB);
        f32x4 cs[2][2];
#pragma unroll
        for (int bj = 0; bj < 2; ++bj) { const LAS float* wp_ = tc + ui * 256 + bj * HALF + wc * 32 + 8 * fq; cs[bj][0] = *(const LAS f32x4*)wp_; cs[bj][1] = *(const LAS f32x4*)(wp_ + 4); }
#pragma unroll
        for (int ai = 0; ai < 2; ++ai)
#pragma unroll
            for (int m = 0; m < 4; ++m) {
                const int row = row0 + ai * HALF + m * 16; const int s = row & (SEQ - 1);
                const float rs = tab[(ui * 256 + rl0 + ai * HALF + m * 16) * 2];
                if (pn < 4) {
#pragma unroll
                    for (int bj = 0; bj < 2; ++bj)
                        store8(Qn + (size_t)row * 1024 + pn * 256 + bj * HALF + wc * 32 + 8 * fq, EpiProj::i2f4(acc[ai][bj][m][0]) * rs * cs[bj][0], EpiProj::i2f4(acc[ai][bj][m][1]) * rs * cs[bj][1]);
                } else {
                    f32x4 rcs, rsn; R.sincos(s, rcs, rsn);
#pragma unroll
                    for (int bj = 0; bj < 2; ++bj) {
                        f32x4 v0 = EpiProj::i2f4(acc[ai][bj][m][0]) * rs * cs[bj][0], v1 = EpiProj::i2f4(acc[ai][bj][m][1]) * rs * cs[bj][1];
                        Rope4::rot(v0, v1, rcs, rsn);
                        store8(Qr + (size_t)row * 512 + (pn - 4) * 256 + bj * HALF + wc * 32 + 8 * fq, v0, v1);
                    }
                }
            }
    }
};

struct EpiKV {
    static constexpr bool PERM = true, MID = true, I8 = true;
    bf16_t *Kn, *Vb; const LAS float* tab; const LAS float* tc;
    __device__ __forceinline__ void mid(f32x4 (&acc)[2][2][4][2], const Unit& u, int ui, int tid_) const {
        const int tid = opaque(tid_), lane = tid & 63, wid = __builtin_amdgcn_readfirstlane(tid >> 6), wr = wid >> 2, fr = lane & 15;
        const int rl0 = wr * 64 + fr;
#pragma unroll
        for (int ai = 0; ai < 2; ++ai)
#pragma unroll
            for (int m = 0; m < 4; ++m) { const float ratio = tab[(ui * 256 + rl0 + ai * HALF + m * 16) * 2 + 1];
#pragma unroll
                for (int bj = 0; bj < 2; ++bj) { acc[ai][bj][m][0] = EpiProj::rescale_i(acc[ai][bj][m][0], ratio); acc[ai][bj][m][1] = EpiProj::rescale_i(acc[ai][bj][m][1], ratio); } }
    }
    __device__ __forceinline__ void operator()(const f32x4 (&acc)[2][2][4][2], const Unit& u, int ui, int tid_) const {
        const int tid = opaque(tid_), lane = tid & 63, wid = __builtin_amdgcn_readfirstlane(tid >> 6), wr = wid >> 2, wc = wid & 3, fr = lane & 15, fq = lane >> 4;
        const int pn = u.pn, rl0 = wr * 64 + fr, row0 = u.pm * BM + rl0;
        bf16_t* base = pn < 4 ? Kn : Vb;
        f32x4 cs[2][2];
#pragma unroll
        for (int bj = 0; bj < 2; ++bj) { const LAS float* wp_ = tc + ui * 256 + bj * HALF + wc * 32 + 8 * fq; cs[bj][0] = *(const LAS f32x4*)wp_; cs[bj][1] = *(const LAS f32x4*)(wp_ + 4); }
#pragma unroll
        for (int ai = 0; ai < 2; ++ai)
#pragma unroll
            for (int m = 0; m < 4; ++m) {
                const int row = row0 + ai * HALF + m * 16;
                const float rs = tab[(ui * 256 + rl0 + ai * HALF + m * 16) * 2];
#pragma unroll
                for (int bj = 0; bj < 2; ++bj)
                    store8(base + (size_t)row * 1024 + (pn & 3) * 256 + bj * HALF + wc * 32 + 8 * fq, EpiProj::i2f4(acc[ai][bj][m][0]) * rs * cs[bj][0], EpiProj::i2f4(acc[ai][bj][m][1]) * rs * cs[bj][1]);
            }
    }
};

struct EpiMix {
    static constexpr bool PERM = true, MID = true, I8 = false;
    bf16_t* MIX; const LAS float* tab;
    __device__ __forceinline__ void mid(f32x4 (&acc)[2][2][4][2], const Unit& u, int ui, int tid_) const {
        const int tid = opaque(tid_), lane = tid & 63, wid = __builtin_amdgcn_readfirstlane(tid >> 6), wr = wid >> 2, wc = wid & 3, fr = lane & 15, fq = lane >> 4;
        const int rl0 = wr * 64 + fr;
#pragma unroll
        for (int ai = 0; ai < 2; ++ai)
#pragma unroll
            for (int m = 0; m < 4; ++m) {
                const float ratio = tab[(ui * 256 + rl0 + ai * HALF + m * 16) * 2];
#pragma unroll
                for (int bj = 0; bj < 2; ++bj) { acc[ai][bj][m][0] *= ratio; acc[ai][bj][m][1] *= ratio; }
            }
    }
    __device__ __forceinline__ void operator()(const f32x4 (&acc)[2][2][4][2], const Unit& u, int ui, int tid_) const {
        const int tid = opaque(tid_), lane = tid & 63, wid = __builtin_amdgcn_readfirstlane(tid >> 6), wr = wid >> 2, wc = wid & 3, fr = lane & 15, fq = lane >> 4;
        const int rl0 = wr * 64 + fr, row0 = u.pm * BM + rl0;
#pragma unroll
        for (int ai = 0; ai < 2; ++ai)
#pragma unroll
            for (int m = 0; m < 4; ++m) {
                const int row = row0 + ai * HALF + m * 16;
                const float rb = tab[(ui * 256 + rl0 + ai * HALF + m * 16) * 2 + 1];
#pragma unroll
                for (int bj = 0; bj < 2; ++bj)
                    store8(MIX + (size_t)row * DM + u.pn * BM + bj * HALF + wc * 32 + 8 * fq, acc[ai][bj][m][0] * rb, acc[ai][bj][m][1] * rb);
            }
    }
};

struct EpiPlainQ8 {
    static constexpr bool PERM = true, MID = false, I8 = true;
    bf16_t* O; int ldc; const LAS float* tr; const LAS float* tc;
    __device__ __forceinline__ void mid(f32x4 (&)[2][2][4][2], const Unit&, int, int) const {}
    __device__ __forceinline__ void operator()(const f32x4 (&acc)[2][2][4][2], const Unit& u, int ui, int tid_) const {
        const int tid = opaque(tid_), lane = tid & 63, wid = __builtin_amdgcn_readfirstlane(tid >> 6), wr = wid >> 2, wc = wid & 3, fr = lane & 15, fq = lane >> 4;
        const int row0 = u.pm * BM + wr * 64 + fr, col0 = u.pn * BM + wc * 32 + 8 * fq;
        f32x4 cs[2][2];
#pragma unroll
        for (int bj = 0; bj < 2; ++bj) { const LAS float* wp_ = tc + ui * 256 + bj * HALF + wc * 32 + 8 * fq; cs[bj][0] = *(const LAS f32x4*)wp_; cs[bj][1] = *(const LAS f32x4*)(wp_ + 4); }
#pragma unroll
        for (int ai = 0; ai < 2; ++ai)
#pragma unroll
            for (int m = 0; m < 4; ++m) {
                const int row = row0 + ai * HALF + m * 16; const float rs = tr[ui * 256 + wr * 64 + fr + ai * HALF + m * 16];
#pragma unroll
                for (int bj = 0; bj < 2; ++bj)
                    store8(O + (size_t)row * ldc + col0 + bj * HALF, EpiProj::i2f4(acc[ai][bj][m][0]) * rs * cs[bj][0], EpiProj::i2f4(acc[ai][bj][m][1]) * rs * cs[bj][1]);
            }
    }
};

struct EpiPlain {
    static constexpr bool PERM = true, MID = false, I8 = false;
    bf16_t* O; int ldc;
    __device__ __forceinline__ void mid(f32x4 (&)[2][2][4][2], const Unit&, int, int) const {}
    __device__ __forceinline__ void operator()(const f32x4 (&acc)[2][2][4][2], const Unit& u, int ui, int tid_) const {
        const int tid = opaque(tid_), lane = tid & 63, wid = __builtin_amdgcn_readfirstlane(tid >> 6), wr = wid >> 2, wc = wid & 3, fr = lane & 15, fq = lane >> 4;
        const int row0 = u.pm * BM + wr * 64 + fr;
#pragma unroll
        for (int ai = 0; ai < 2; ++ai)
#pragma unroll
            for (int m = 0; m < 4; ++m) {
                const int row = row0 + ai * HALF + m * 16;
#pragma unroll
                for (int bj = 0; bj < 2; ++bj)
                    store8(O + (size_t)row * ldc + u.pn * BM + bj * HALF + wc * 32 + 8 * fq, acc[ai][bj][m][0], acc[ai][bj][m][1]);
            }
    }
};
}

namespace att {
#define KSWZ(row, colB) ((row) * 256 + ((colB) ^ (((row) & 7) << 4)))
#define SBAR() __builtin_amdgcn_sched_barrier(0)
__device__ __forceinline__ int crow(int r, int hi) { return (r & 3) + 8 * (r >> 2) + 4 * hi; }
constexpr int L_KN = 0, L_KR = 32768, L_V = 49152, L_WS = 81920, L_QR = 83968, L_END = 83968 + 32768;
__device__ __forceinline__ int v_st(int k, int c) { const int kk = (k & ~0xC) | ((k & 4) << 1) | ((k & 8) >> 1); return ((kk >> 3) * 4 + (c >> 5)) * 512 + ((kk & 7) * 32 + (c & 31)) * 2; }
__device__ __forceinline__ int v_rd_base(int lane) { return ((lane & 3) << 3) | (((lane >> 2) & 3) << 6) | (((lane >> 4) & 1) << 5) | (((lane >> 5) & 1) << 8); }
constexpr int v_rd_off(int d0, int ks, int half) { return d0 * 512 + ks * 4096 + half * 2048; }
template <int OFF> __device__ __forceinline__ s16x4 tr_read(int vb) {
    s16x4 r; asm volatile("ds_read_b64_tr_b16 %0, %1 offset:%2" : "=&v"(r) : "v"(vb), "i"(OFF) : "memory"); return r;
}
template <int D0> __device__ __forceinline__ void pv_one(f32x16& od, int vb, bf16x8 pa0, bf16x8 pa1, bf16x8 pa2, bf16x8 pa3) {
    const s16x4 l0 = tr_read<v_rd_off(D0, 0, 0)>(vb), h0 = tr_read<v_rd_off(D0, 0, 1)>(vb), l1 = tr_read<v_rd_off(D0, 1, 0)>(vb), h1 = tr_read<v_rd_off(D0, 1, 1)>(vb);
    const s16x4 l2 = tr_read<v_rd_off(D0, 2, 0)>(vb), h2 = tr_read<v_rd_off(D0, 2, 1)>(vb), l3 = tr_read<v_rd_off(D0, 3, 0)>(vb), h3 = tr_read<v_rd_off(D0, 3, 1)>(vb);
    asm volatile("s_waitcnt lgkmcnt(0)" ::: "memory"); SBAR();
#define PK(L, H) (bf16x8){L[0], L[1], L[2], L[3], H[0], H[1], H[2], H[3]}
    od = __builtin_amdgcn_mfma_f32_32x32x16_bf16(pa0, PK(l0, h0), od, 0, 0, 0);
    od = __builtin_amdgcn_mfma_f32_32x32x16_bf16(pa1, PK(l1, h1), od, 0, 0, 0);
    od = __builtin_amdgcn_mfma_f32_32x32x16_bf16(pa2, PK(l2, h2), od, 0, 0, 0);
    od = __builtin_amdgcn_mfma_f32_32x32x16_bf16(pa3, PK(l3, h3), od, 0, 0, 0);
#undef PK
}

struct UnitP { int b, h, dil, rho0, ngrp, qbase, kfirst, tpg, W, mode; };
struct Tens { const bf16_t *Qm, *Qr, *Km, *Kr, *Vm; bf16_t* So; float *Sm, *Sl; bf16_t* Oout; int ocol0; float* ssq; int ssq0; };

template <bool MLA>
__device__ __forceinline__ void attn_unit(const int tid_in, const UnitP P, LAS unsigned char* lds, const Tens& X) {
    const int tid = opaque(tid_in);
    constexpr float SCALE = MLA ? 0.07216878364870322f : 0.08838834764831845f;
    constexpr float C = SCALE * 1.4426950408889634f;
    constexpr float THRS = 8.f / SCALE;
    constexpr int NQ = 8;
    const int wid = __builtin_amdgcn_readfirstlane(tid >> 6), lane = tid & 63, r32 = lane & 31, hi = lane >> 5;
    const int g = (P.ngrp == 2) ? (wid >> 2) : 0, wq = (P.ngrp == 2) ? (wid & 3) : wid;
    const int qpos0 = P.qbase + 32 * wq, rho_w = P.rho0 + g;
    const long tb = (long)P.b * SEQ;
    const long qtok = tb + (long)(qpos0 + r32) * P.dil + rho_w;
    LAS float* wsf = (LAS float*)(lds + L_WS) + wid * 64;
    bf16x8 qr[NQ];
    { const bf16_t* qp = X.Qm + qtok * 1024 + P.h * 128 + hi * 8;
#pragma unroll
      for (int d0 = 0; d0 < 8; ++d0) qr[d0] = *(const bf16x8*)(qp + d0 * 16); }
    LAS unsigned char* qrp = lds + L_QR + wid * 4096 + lane * 16;
    if constexpr (MLA) { const bf16_t* qp = X.Qr + qtok * 512 + P.h * 64 + hi * 8;
#pragma unroll
      for (int d0 = 0; d0 < 4; ++d0) *(LAS bf16x8*)(qrp + d0 * 1024) = *(const bf16x8*)(qp + d0 * 16); }
    float m_reg = -1e30f, l_reg = 0.f; f32x16 o[4];
#pragma unroll
    for (int d = 0; d < 4; ++d) o[d] = f32x16{};
    LAS unsigned char* stg = lds + wid * 8704;
    if (P.mode & 1) {
        m_reg = X.Sm[qtok * 8 + P.h]; l_reg = X.Sl[qtok * 8 + P.h];
#pragma unroll 2
        for (int i = 0; i < 8; ++i) { const int le = opaque(lane), row = i * 4 + (le >> 4), ch = le & 15; const long tr = tb + (long)(qpos0 + row) * P.dil + rho_w;
            *(LAS u32x4*)(stg + row * 272 + ch * 16) = *(const u32x4*)(X.So + tr * 1024 + P.h * 128 + ch * 8); }
        asm volatile("s_waitcnt lgkmcnt(0)" ::: "memory");
#pragma unroll
        for (int r = 0; r < 16; ++r)
#pragma unroll
            for (int d = 0; d < 4; ++d) o[d][r] = __uint_as_float((unsigned)(*(const LAS unsigned short*)(stg + crow(r, hi) * 272 + (32 * d + r32) * 2)) << 16);
        asm volatile("s_waitcnt lgkmcnt(0)" ::: "memory");
        __syncthreads();
    }
    const int sr = tid >> 4, sc = (tid & 15) * 8;
    const int rr = tid >> 3, rc = tid & 7;
    const int NT = P.ngrp * P.tpg;
    const int vb0 = (int)(uintptr_t)(lds + L_V) + v_rd_base(lane);
    bf16x8 ks0, ks1, vs0, vs1, krs;
#define LOADT(jt) do { const int gj_ = (jt) / P.tpg; const int kp_ = P.kfirst + 64 * ((jt) - gj_ * P.tpg); const int rho_ = P.rho0 + gj_; \
        const long t0_ = tb + (long)(kp_ + sr) * P.dil + rho_, t1_ = tb + (long)(kp_ + 32 + sr) * P.dil + rho_; \
        ks0 = *(const bf16x8*)(X.Km + t0_ * 1024 + P.h * 128 + sc); ks1 = *(const bf16x8*)(X.Km + t1_ * 1024 + P.h * 128 + sc); \
        vs0 = *(const bf16x8*)(X.Vm + t0_ * 1024 + P.h * 128 + sc); vs1 = *(const bf16x8*)(X.Vm + t1_ * 1024 + P.h * 128 + sc); \
        if constexpr (MLA) { const long t2_ = tb + (long)(kp_ + rr) * P.dil + rho_; krs = *(const bf16x8*)(X.Kr + t2_ * 64 + rc * 8); } } while (0)
#define WRITET(buf) do { *(LAS bf16x8*)(lds + L_KN + (buf) * 16384 + KSWZ(sr, sc * 2)) = ks0; *(LAS bf16x8*)(lds + L_KN + (buf) * 16384 + KSWZ(32 + sr, sc * 2)) = ks1; \
        *(LAS bf16x8*)(lds + L_V + (buf) * 16384 + v_st(sr, sc)) = vs0; *(LAS bf16x8*)(lds + L_V + (buf) * 16384 + v_st(32 + sr, sc)) = vs1; \
        if constexpr (MLA) { *(LAS bf16x8*)(lds + L_KR + (buf) * 8192 + rr * 128 + ((rc ^ ((rr >> 1) & 7)) << 4)) = krs; } } while (0)
    LOADT(0);
    if (wid >= 4) __builtin_amdgcn_s_setprio(1);
    for (int jt = 0; jt < NT; ++jt) {
        const int buf = jt & 1;
        WRITET(buf);
        if (jt + 1 < NT) LOADT(jt + 1);
        __syncthreads();
        const int gj = jt / P.tpg, kpos0 = P.kfirst + 64 * (jt - gj * P.tpg);
        const bool active = (gj == g) && (kpos0 <= qpos0 + 31) && (kpos0 + 63 >= qpos0 - P.W);
        if (active) {
            f32x16 p0 = f32x16{}, p1 = f32x16{};
            { const LAS unsigned char* kb = lds + L_KN + buf * 16384;
#pragma unroll
              for (int d0 = 0; d0 < 8; ++d0) { const int cb = (d0 * 16 + hi * 8) * 2;
                const bf16x8 b0 = *(const LAS bf16x8*)(kb + KSWZ(r32, cb)), b1 = *(const LAS bf16x8*)(kb + KSWZ(32 + r32, cb));
                p0 = __builtin_amdgcn_mfma_f32_32x32x16_bf16(b0, qr[d0], p0, 0, 0, 0);
                p1 = __builtin_amdgcn_mfma_f32_32x32x16_bf16(b1, qr[d0], p1, 0, 0, 0); } }
            if constexpr (MLA) { const LAS unsigned char* kb = lds + L_KR + buf * 8192;
#pragma unroll
              for (int d0 = 0; d0 < 4; ++d0) { const int ch = 2 * d0 + hi; const int off = ((ch ^ ((r32 >> 1) & 7)) << 4);
                const bf16x8 b0 = *(const LAS bf16x8*)(kb + r32 * 128 + off), b1 = *(const LAS bf16x8*)(kb + (32 + r32) * 128 + off);
                const bf16x8 qf = *(const LAS bf16x8*)(qrp + d0 * 1024);
                p0 = __builtin_amdgcn_mfma_f32_32x32x16_bf16(b0, qf, p0, 0, 0, 0);
                p1 = __builtin_amdgcn_mfma_f32_32x32x16_bf16(b1, qf, p1, 0, 0, 0); } }
            const bool full = (kpos0 + 63 <= qpos0) && (kpos0 >= qpos0 + 31 - P.W);
            if (!full) { const int qp = qpos0 + r32;
#pragma unroll
                for (int r = 0; r < 16; ++r) { const int dq0 = qp - (kpos0 + crow(r, hi)), dq1 = dq0 - 32;
                    if (dq0 < 0 || dq0 > P.W) p0[r] = -INFINITY; if (dq1 < 0 || dq1 > P.W) p1[r] = -INFINITY; } }
            float pmax = p0[0];
#pragma unroll
            for (int r = 1; r < 16; ++r) pmax = fmaxf(pmax, p0[r]);
#pragma unroll
            for (int r = 0; r < 16; ++r) pmax = fmaxf(pmax, p1[r]);
            { auto sw = __builtin_amdgcn_permlane32_swap(__float_as_uint(pmax), __float_as_uint(pmax), false, false); pmax = fmaxf(__uint_as_float(sw[0]), __uint_as_float(sw[1])); }
            float mn, alpha;
            if (__builtin_expect(__all(pmax - m_reg <= THRS), 1)) { mn = m_reg; alpha = 1.f; }
            else { mn = fmaxf(m_reg, pmax); alpha = __builtin_amdgcn_exp2f((m_reg - mn) * C); m_reg = mn; }
            const float mnC = -mn * C;
#pragma unroll
            for (int r = 0; r < 16; ++r) { p0[r] = __builtin_amdgcn_exp2f(fmaf(p0[r], C, mnC)); p1[r] = __builtin_amdgcn_exp2f(fmaf(p1[r], C, mnC)); }
            if (__any(alpha < 1.f)) { if (hi == 0) wsf[r32] = alpha; asm volatile("s_waitcnt lgkmcnt(0)" ::: "memory");
#pragma unroll
                for (int r = 0; r < 16; ++r) { const float al = wsf[crow(r, hi)];
#pragma unroll
                    for (int d = 0; d < 4; ++d) o[d][r] *= al; }
                asm volatile("s_waitcnt lgkmcnt(0)" ::: "memory"); }
            float ps = 0.f;
#pragma unroll
            for (int r = 0; r < 16; ++r) ps += p0[r];
#pragma unroll
            for (int r = 0; r < 16; ++r) ps += p1[r];
            { auto sw = __builtin_amdgcn_permlane32_swap(__float_as_uint(ps), __float_as_uint(ps), false, false); ps = __uint_as_float(sw[0]) + __uint_as_float(sw[1]); }
            l_reg = l_reg * alpha + ps;
            bf16x8 pa0, pa1, pa2, pa3;
#define PK4(Pv, BASE, OUT) do { unsigned a0 = cvtpk(Pv[BASE + 0], Pv[BASE + 1]), a1 = cvtpk(Pv[BASE + 2], Pv[BASE + 3]);   \
    unsigned b0 = cvtpk(Pv[BASE + 4], Pv[BASE + 5]), b1 = cvtpk(Pv[BASE + 6], Pv[BASE + 7]);                              \
    auto r0 = __builtin_amdgcn_permlane32_swap(a0, b0, false, false); auto r1 = __builtin_amdgcn_permlane32_swap(a1, b1, false, false); \
    u32x4 w = {r0[0], r1[0], r0[1], r1[1]}; OUT = __builtin_bit_cast(bf16x8, w); } while (0)
            PK4(p0, 0, pa0); PK4(p0, 8, pa1); PK4(p1, 0, pa2); PK4(p1, 8, pa3);
#undef PK4
            SBAR();
            const int vb = vb0 + buf * 16384;
            pv_one<0>(o[0], vb, pa0, pa1, pa2, pa3); pv_one<1>(o[1], vb, pa0, pa1, pa2, pa3); pv_one<2>(o[2], vb, pa0, pa1, pa2, pa3); pv_one<3>(o[3], vb, pa0, pa1, pa2, pa3);
        }
    }
#undef LOADT
#undef WRITET
    __builtin_amdgcn_s_setprio(0);
    asm volatile("s_waitcnt lgkmcnt(0)" ::: "memory");
    __syncthreads();
    if (P.mode & 2) {
        if (hi == 0) wsf[32 + r32] = l_reg; asm volatile("s_waitcnt lgkmcnt(0)" ::: "memory");
#pragma unroll
        for (int r = 0; r < 16; ++r) { const int qrow = crow(r, hi); const float rl = 1.0f / wsf[32 + qrow];
            const long tr = tb + (long)(qpos0 + qrow) * P.dil + rho_w; float sq = 0.f;
#pragma unroll
            for (int d = 0; d < 4; ++d) { const float v = o[d][r] * rl; sq += v * v; *(LAS unsigned short*)(stg + qrow * 272 + (32 * d + r32) * 2) = (unsigned short)(cvtpk(v, v) & 0xffffu); }
            sq += __shfl_xor(sq, 1); sq += __shfl_xor(sq, 2); sq += __shfl_xor(sq, 4); sq += __shfl_xor(sq, 8); sq += __shfl_xor(sq, 16);
            if (r32 == 0) X.ssq[tr * 16 + X.ssq0 + P.h] = sq; }
        asm volatile("s_waitcnt lgkmcnt(0)" ::: "memory");
#pragma unroll 2
        for (int i = 0; i < 8; ++i) { const int le = opaque(lane), row = i * 4 + (le >> 4), ch = le & 15; const long tr = tb + (long)(qpos0 + row) * P.dil + rho_w;
            *(u32x4*)(X.Oout + tr * 2048 + X.ocol0 + P.h * 128 + ch * 8) = *(const LAS u32x4*)(stg + row * 272 + ch * 16); }
    } else {
        if (hi == 0) { X.Sm[qtok * 8 + P.h] = m_reg; X.Sl[qtok * 8 + P.h] = l_reg; }
#pragma unroll
        for (int r = 0; r < 16; ++r)
#pragma unroll
            for (int d = 0; d < 4; ++d) { const float v = o[d][r]; *(LAS unsigned short*)(stg + crow(r, hi) * 272 + (32 * d + r32) * 2) = (unsigned short)(cvtpk(v, v) & 0xffffu); }
        asm volatile("s_waitcnt lgkmcnt(0)" ::: "memory");
#pragma unroll 2
        for (int i = 0; i < 8; ++i) { const int le = opaque(lane), row = i * 4 + (le >> 4), ch = le & 15; const long tr = tb + (long)(qpos0 + row) * P.dil + rho_w;
            *(u32x4*)(X.So + tr * 1024 + P.h * 128 + ch * 8) = *(const LAS u32x4*)(stg + row * 272 + ch * 16); }
    }
    asm volatile("s_waitcnt lgkmcnt(0)" ::: "memory");
    __syncthreads();
}

struct WaveA { int b, h, dil, rho, qpos0, mode; };
__device__ __forceinline__ void attnA_wave(const int lane_in, const WaveA P, LAS unsigned char* wl  , LAS float* wsf, const Tens& X) {
    constexpr float SCALE = 0.08838834764831845f, C = SCALE * 1.4426950408889634f, THRS = 8.f / SCALE;
    const int lane = opaque(lane_in), r32 = lane & 31, hi = lane >> 5;
    const long tb = (long)P.b * SEQ;
    const long qtok = tb + (long)(P.qpos0 + r32) * P.dil + P.rho;
    LAS unsigned char* vbuf = wl; LAS unsigned char* stg = wl + 8192;
    bf16x8 qr[8];
    { const bf16_t* qp = X.Qm + qtok * 1024 + P.h * 128 + hi * 64;
#pragma unroll
      for (int d0 = 0; d0 < 8; ++d0) qr[d0] = *(const bf16x8*)(qp + d0 * 8); }
    float m_reg = -1e30f, l_reg = 0.f; f32x16 o[4];
#pragma unroll
    for (int d = 0; d < 4; ++d) o[d] = f32x16{};
    if (P.mode & 1) {
        m_reg = X.Sm[qtok * 8 + P.h]; l_reg = X.Sl[qtok * 8 + P.h];
#pragma unroll 2
        for (int i = 0; i < 8; ++i) { const int le = opaque(lane), row = i * 4 + (le >> 4), ch = le & 15; const long tr = tb + (long)(P.qpos0 + row) * P.dil + P.rho;
            *(LAS u32x4*)(stg + row * 272 + ch * 16) = *(const u32x4*)(X.So + tr * 1024 + P.h * 128 + ch * 8); }
        asm volatile("s_waitcnt lgkmcnt(0)" ::: "memory");
#pragma unroll
        for (int r = 0; r < 16; ++r)
#pragma unroll
            for (int d = 0; d < 4; ++d) o[d][r] = __uint_as_float((unsigned)(*(const LAS unsigned short*)(stg + crow(r, hi) * 272 + (32 * d + r32) * 2)) << 16);
    }
    const int kfirst = P.qpos0 >= 128 ? P.qpos0 - 128 : 0;
    const int vrow = lane >> 3, vcol = (lane & 7) * 16;
    const int vb = (int)(uintptr_t)vbuf + v_rd_base(lane);
    const unsigned char* K8 = (const unsigned char*)X.Km; const unsigned char* V8 = (const unsigned char*)X.Vm;
    u32x4 nk[4], nv[4];
#define A_LOAD(kc) do { const long tk_ = tb + (long)((kc) + r32) * P.dil + P.rho; const unsigned char* kp_ = K8 + tk_ * 1024 + P.h * 128 + hi * 64; \
        _Pragma("unroll") for (int j = 0; j < 4; ++j) nk[j] = *(const u32x4*)(kp_ + j * 16); \
        _Pragma("unroll") for (int i = 0; i < 4; ++i) { const long tv_ = tb + (long)((kc) + vrow + 8 * i) * P.dil + P.rho; nv[i] = *(const u32x4*)(V8 + tv_ * 1024 + P.h * 128 + vcol); } } while (0)
#define A_CVT8(lo, hi_) ({ const f32x2 a_ = __builtin_amdgcn_cvt_pk_f32_fp8((int)(lo), false), b_ = __builtin_amdgcn_cvt_pk_f32_fp8((int)(lo), true), \
        c_ = __builtin_amdgcn_cvt_pk_f32_fp8((int)(hi_), false), d_ = __builtin_amdgcn_cvt_pk_f32_fp8((int)(hi_), true); \
        u32x4 w_ = {cvtpk(a_[0], a_[1]), cvtpk(b_[0], b_[1]), cvtpk(c_[0], c_[1]), cvtpk(d_[0], d_[1])}; __builtin_bit_cast(bf16x8, w_); })
    A_LOAD(kfirst);
    for (int kc0 = kfirst; kc0 <= P.qpos0; kc0 += 32) {
        bf16x8 kf[8];
#pragma unroll
        for (int j = 0; j < 4; ++j) { const unsigned x0 = nk[j][0], x1 = nk[j][1], x2 = nk[j][2], x3 = nk[j][3]; kf[2 * j] = A_CVT8(x0, x1); kf[2 * j + 1] = A_CVT8(x2, x3); }
#pragma unroll
        for (int i = 0; i < 4; ++i) { const unsigned x0 = nv[i][0], x1 = nv[i][1], x2 = nv[i][2], x3 = nv[i][3];
            *(LAS bf16x8*)(vbuf + v_st(vrow + 8 * i, vcol)) = A_CVT8(x0, x1); *(LAS bf16x8*)(vbuf + v_st(vrow + 8 * i, vcol + 8)) = A_CVT8(x2, x3); }
        if (kc0 + 32 <= P.qpos0) A_LOAD(kc0 + 32);
        f32x16 p0 = f32x16{};
#pragma unroll
        for (int d0 = 0; d0 < 8; ++d0) p0 = __builtin_amdgcn_mfma_f32_32x32x16_bf16(kf[d0], qr[d0], p0, 0, 0, 0);
        const bool full = (kc0 + 31 <= P.qpos0) && (kc0 >= P.qpos0 + 31 - 128);
        if (!full) { const int qp = P.qpos0 + r32;
#pragma unroll
            for (int r = 0; r < 16; ++r) { const int dq = qp - (kc0 + crow(r, hi)); if (dq < 0 || dq > 128) p0[r] = -INFINITY; } }
        float pmax = p0[0];
#pragma unroll
        for (int r = 1; r < 16; ++r) pmax = fmaxf(pmax, p0[r]);
        { auto sw = __builtin_amdgcn_permlane32_swap(__float_as_uint(pmax), __float_as_uint(pmax), false, false); pmax = fmaxf(__uint_as_float(sw[0]), __uint_as_float(sw[1])); }
        float mn, alpha;
        if (__builtin_expect(__all(pmax - m_reg <= THRS), 1)) { mn = m_reg; alpha = 1.f; }
        else { mn = fmaxf(m_reg, pmax); alpha = __builtin_amdgcn_exp2f((m_reg - mn) * C); m_reg = mn; }
        const float mnC = -mn * C;
#pragma unroll
        for (int r = 0; r < 16; ++r) p0[r] = __builtin_amdgcn_exp2f(fmaf(p0[r], C, mnC));
        if (__any(alpha < 1.f)) { if (hi == 0) wsf[r32] = alpha; asm volatile("s_waitcnt lgkmcnt(0)" ::: "memory");
#pragma unroll
            for (int r = 0; r < 16; ++r) { const float al = wsf[crow(r, hi)];
#pragma unroll
                for (int d = 0; d < 4; ++d) o[d][r] *= al; }
            asm volatile("s_waitcnt lgkmcnt(0)" ::: "memory"); }
        float ps = 0.f;
#pragma unroll
        for (int r = 0; r < 16; ++r) ps += p0[r];
        { auto sw = __builtin_amdgcn_permlane32_swap(__float_as_uint(ps), __float_as_uint(ps), false, false); ps = __uint_as_float(sw[0]) + __uint_as_float(sw[1]); }
        l_reg = l_reg * alpha + ps;
        bf16x8 pa0, pa1;
#define PK4(Pv, BASE, OUT) do { unsigned a0 = cvtpk(Pv[BASE + 0], Pv[BASE + 1]), a1 = cvtpk(Pv[BASE + 2], Pv[BASE + 3]);   \
    unsigned b0 = cvtpk(Pv[BASE + 4], Pv[BASE + 5]), b1 = cvtpk(Pv[BASE + 6], Pv[BASE + 7]);                              \
    auto r0 = __builtin_amdgcn_permlane32_swap(a0, b0, false, false); auto r1 = __builtin_amdgcn_permlane32_swap(a1, b1, false, false); \
    u32x4 w = {r0[0], r1[0], r0[1], r1[1]}; OUT = __builtin_bit_cast(bf16x8, w); } while (0)
        PK4(p0, 0, pa0); PK4(p0, 8, pa1);
#undef PK4
        SBAR();
#define A_PV(D0) do { const s16x4 l0 = tr_read<v_rd_off(D0, 0, 0)>(vb), h0 = tr_read<v_rd_off(D0, 0, 1)>(vb), l1 = tr_read<v_rd_off(D0, 1, 0)>(vb), h1 = tr_read<v_rd_off(D0, 1, 1)>(vb); \
        asm volatile("s_waitcnt lgkmcnt(0)" ::: "memory"); SBAR(); \
        o[D0] = __builtin_amdgcn_mfma_f32_32x32x16_bf16(pa0, (bf16x8){l0[0], l0[1], l0[2], l0[3], h0[0], h0[1], h0[2], h0[3]}, o[D0], 0, 0, 0); \
        o[D0] = __builtin_amdgcn_mfma_f32_32x32x16_bf16(pa1, (bf16x8){l1[0], l1[1], l1[2], l1[3], h1[0], h1[1], h1[2], h1[3]}, o[D0], 0, 0, 0); } while (0)
        A_PV(0); A_PV(1); A_PV(2); A_PV(3);
#undef A_PV
        asm volatile("s_waitcnt lgkmcnt(0)" ::: "memory");
    }
#undef A_LOAD
#undef A_CVT8
    if (P.mode & 2) {
        if (hi == 0) wsf[32 + r32] = l_reg; asm volatile("s_waitcnt lgkmcnt(0)" ::: "memory");
#pragma unroll
        for (int r = 0; r < 16; ++r) { const int qrow = crow(r, hi); const float rl = 1.0f / wsf[32 + qrow];
            const long tr = tb + (long)(P.qpos0 + qrow) * P.dil + P.rho; float sq = 0.f;
#pragma unroll
            for (int d = 0; d < 4; ++d) { const float v = o[d][r] * rl; sq += v * v; *(LAS unsigned short*)(stg + qrow * 272 + (32 * d + r32) * 2) = (unsigned short)(cvtpk(v, v) & 0xffffu); }
            sq += __shfl_xor(sq, 1); sq += __shfl_xor(sq, 2); sq += __shfl_xor(sq, 4); sq += __shfl_xor(sq, 8); sq += __shfl_xor(sq, 16);
            if (r32 == 0) X.ssq[tr * 16 + X.ssq0 + P.h] = sq; }
        asm volatile("s_waitcnt lgkmcnt(0)" ::: "memory");
#pragma unroll 2
        for (int i = 0; i < 8; ++i) { const int le = opaque(lane), row = i * 4 + (le >> 4), ch = le & 15; const long tr = tb + (long)(P.qpos0 + row) * P.dil + P.rho;
            *(u32x4*)(X.Oout + tr * 2048 + X.ocol0 + P.h * 128 + ch * 8) = *(const LAS u32x4*)(stg + row * 272 + ch * 16); }
    } else {
        if (hi == 0) { X.Sm[qtok * 8 + P.h] = m_reg; X.Sl[qtok * 8 + P.h] = l_reg; }
#pragma unroll
        for (int r = 0; r < 16; ++r)
#pragma unroll
            for (int d = 0; d < 4; ++d) { const float v = o[d][r]; *(LAS unsigned short*)(stg + crow(r, hi) * 272 + (32 * d + r32) * 2) = (unsigned short)(cvtpk(v, v) & 0xffffu); }
        asm volatile("s_waitcnt lgkmcnt(0)" ::: "memory");
#pragma unroll 2
        for (int i = 0; i < 8; ++i) { const int le = opaque(lane), row = i * 4 + (le >> 4), ch = le & 15; const long tr = tb + (long)(P.qpos0 + row) * P.dil + P.rho;
            *(u32x4*)(X.So + tr * 1024 + P.h * 128 + ch * 8) = *(const LAS u32x4*)(stg + row * 272 + ch * 16); }
    }
    asm volatile("s_waitcnt lgkmcnt(0)" ::: "memory");
}
}

namespace pk {
__device__ __forceinline__ void ce(int& a, int& b) { const int hi = max(a, b), lo = min(a, b); a = hi; b = lo; }
__device__ __forceinline__ void sort16(int (&v)[16]) {
#pragma unroll
    for (int k = 2; k <= 16; k <<= 1)
#pragma unroll
        for (int j = k >> 1; j > 0; j >>= 1)
#pragma unroll
            for (int i = 0; i < 16; ++i) { const int l = i ^ j; if (l > i) { if ((i & k) == 0) ce(v[i], v[l]); else ce(v[l], v[i]); } }
}
__device__ __forceinline__ void bmerge16(int (&c)[16]) {
#pragma unroll
    for (int j = 8; j > 0; j >>= 1)
#pragma unroll
        for (int i = 0; i < 16; ++i) { const int l = i ^ j; if (l > i) ce(c[i], c[l]); }
}
__device__ __forceinline__ void merge_top16(int (&a)[16], const int (&b)[16]) {
#pragma unroll
    for (int i = 0; i < 16; ++i) a[i] = max(a[i], b[15 - i]);
    bmerge16(a);
}
__device__ __forceinline__ int f2key(float f) { const int b = __float_as_int(f); return b ^ ((b >> 31) & 0x7fffffff); }
__device__ __forceinline__ float key2f(int k) { return __int_as_float(k ^ ((k >> 31) & 0x7fffffff)); }
}

#define XB_TMO      128
#define XB_XCNT(j)  (256  + 64 * (j))
#define XB_XSUB(j)  (1280 + 64 * (j))
#define XB_XGEN(j)  (2304 + 64 * (j))
#define XB_TOP      3328
#define XB_TOPGEN   3392
#define XCD_BAR_WORDS 3456
#define XB_SPIN_CAP (1u << 22)
__device__ __forceinline__ unsigned xb_ld(unsigned* p)              { return __hip_atomic_load(p, __ATOMIC_RELAXED, __HIP_MEMORY_SCOPE_AGENT); }
__device__ __forceinline__ unsigned xb_add(unsigned* p, unsigned v) { return __hip_atomic_fetch_add(p, v, __ATOMIC_RELAXED, __HIP_MEMORY_SCOPE_AGENT); }
__device__ __forceinline__ unsigned xb_xcc_id() { return (unsigned)__builtin_amdgcn_s_getreg((3 << 11) | 20) & 0xFu; }
#define XB_SPIN(cond, bar) do { unsigned _sp = 0; while (cond) { __builtin_amdgcn_s_sleep(1); \
    if ((++_sp & 255u) == 0u) { if (xb_ld(&(bar)[XB_TMO])) break; if (_sp > XB_SPIN_CAP) { atomicAdd(&(bar)[XB_TMO], 1u); break; } } } } while (0)
struct XcdBarrier { unsigned* bar; unsigned x; volatile LAS unsigned* st; };
__device__ __forceinline__ XcdBarrier xcd_barrier_post(unsigned* bar, volatile LAS unsigned* st) {
    XcdBarrier b; b.bar = bar; b.x = xb_xcc_id(); b.st = st;
    if (threadIdx.x == 0) (void)xb_add(&bar[XB_XCNT(b.x)], 1u);
    return b;
}
__device__ __forceinline__ void xcd_barrier_complete(unsigned* bar, unsigned x, unsigned& nloc, unsigned& nx) {
    const unsigned G = gridDim.x * gridDim.y * gridDim.z;
    unsigned sum, cnt, mine, sp = 0u;
    for (;;) {
        sum = 0u; cnt = 0u; mine = 0u;
#pragma unroll
        for (unsigned j = 0; j < 16; ++j) { const unsigned c = xb_ld(&bar[XB_XCNT(j)]); sum += c; cnt += (c > 0u) ? 1u : 0u; mine = (j == x) ? c : mine; }
        if (sum == G) break;
        __builtin_amdgcn_s_sleep(1);
        if ((++sp & 255u) == 0u) { if (xb_ld(&bar[XB_TMO])) break; if (sp > XB_SPIN_CAP) { atomicAdd(&bar[XB_TMO], 1u); break; } }
    }
    nloc = mine > 0u ? mine : 1u; nx = cnt > 0u ? cnt : 1u;
}
__device__ __forceinline__ void xcd_barrier(const XcdBarrier& b) {
    asm volatile("s_waitcnt vmcnt(0)" ::: "memory");
    __syncthreads();
    if (threadIdx.x == 0) {
        unsigned* bar = b.bar;
        __builtin_amdgcn_s_waitcnt(0);
        unsigned nloc = b.st[0], nx = b.st[1];
        if (nloc == 0u) { xcd_barrier_complete(bar, b.x, nloc, nx); b.st[0] = nloc; b.st[1] = nx; }
        const unsigned old = xb_add(&bar[XB_XSUB(b.x)], 1u);
        const unsigned gen = old / nloc;
        if (old + 1u == (gen + 1u) * nloc) {
            __builtin_amdgcn_fence(__ATOMIC_RELEASE, "agent");
            asm volatile("s_waitcnt vmcnt(0)" ::: "memory");
            const unsigned og = xb_add(&bar[XB_TOP], 1u);
            const unsigned tg = og / nx;
            if (og + 1u == (tg + 1u) * nx) xb_add(&bar[XB_TOPGEN], 1u);
            else XB_SPIN(xb_ld(&bar[XB_TOPGEN]) == tg, bar);
            __builtin_amdgcn_fence(__ATOMIC_ACQUIRE, "agent");
            xb_add(&bar[XB_XGEN(b.x)], 1u);
            asm volatile("s_waitcnt vmcnt(0)" ::: "memory");
        } else {
            XB_SPIN(xb_ld(&bar[XB_XGEN(b.x)]) == gen, bar);
            __builtin_amdgcn_fence(__ATOMIC_ACQUIRE, "agent");
            asm volatile("s_waitcnt vmcnt(0)" ::: "memory");
        }
    }
    __syncthreads();
}

struct Args { const float* in[22]; float* out; unsigned char* ws; int ph_lo, ph_hi; };
#if defined(NAIVE_PEER)
constexpr int N_PHASES = 12;
#else
constexpr int N_PHASES = 15;
#endif

__device__ __forceinline__ float gelu_erf(float v) { return 0.5f * v * (1.0f + erff(v * 0.70710678118654752f)); }

template <class Map>
__device__ __forceinline__ void transpose_item(const float* W, int K, int N, bf16_t* WT, const float* rscale, LAS float* scr, int item, int lane, Map dst_row) {
    const int nblk = N / 32, kb = item / nblk, nb = item % nblk, k0 = 64 * kb, n0 = 32 * nb;
    float tv[32];
#pragma unroll
    for (int i = 0; i < 32; ++i) tv[i] = W[(size_t)(k0 + 2 * i + (lane >> 5)) * N + n0 + (lane & 31)];
    if (rscale) {
#pragma unroll
        for (int i = 0; i < 32; ++i) tv[i] *= rscale[k0 + 2 * i + (lane >> 5)];
    }
#pragma unroll
    for (int i = 0; i < 32; ++i) scr[(2 * i + (lane >> 5)) * 33 + (lane & 31)] = tv[i];
    asm volatile("s_waitcnt lgkmcnt(0)" ::: "memory");
    const int c = lane & 7;
#pragma unroll
    for (int j = 0; j < 4; ++j) { const int n = (lane >> 3) + 8 * j; const LAS float* s = scr + (8 * c) * 33 + n;
        u32x4 o; o.x = cvtpk(s[0 * 33], s[1 * 33]); o.y = cvtpk(s[2 * 33], s[3 * 33]); o.z = cvtpk(s[4 * 33], s[5 * 33]); o.w = cvtpk(s[6 * 33], s[7 * 33]);
        *(u32x4*)(WT + (size_t)dst_row(n0 + n) * K + k0 + 8 * c) = o; }
    asm volatile("s_waitcnt lgkmcnt(0)" ::: "memory");
}
template <class Map>
__device__ __forceinline__ void transpose_item_q8(const float* W, int K, int N, unsigned char* WT, const float* rscale, const float* cmax, int ncm, int cstride, float* wscale, LAS float* scr, int item, int lane, Map dst_row) {
    const int nblk = N / 32, kb = item / nblk, nb = item % nblk, k0 = 64 * kb, n0 = 32 * nb;
    float tv[32];
#pragma unroll
    for (int i = 0; i < 32; ++i) tv[i] = __builtin_nontemporal_load(W + (size_t)(k0 + 2 * i + (lane >> 5)) * N + n0 + (lane & 31));
    if (rscale) {
#pragma unroll
        for (int i = 0; i < 32; ++i) tv[i] *= rscale[k0 + 2 * i + (lane >> 5)];
    }
    float mx = 0.f;
#pragma unroll
    for (int c = 0; c < 8; ++c) if (c < ncm) mx = fmaxf(mx, cmax[c * cstride + n0 + (lane & 31)]);
    const float inv = mx > 0.f ? 127.0f / mx : 1.0f;
    if (kb == 0 && lane < 32) wscale[dst_row(n0 + lane)] = mx > 0.f ? mx * (1.0f / 127.0f) : 1.0f;
#pragma unroll
    for (int i = 0; i < 32; ++i) scr[(2 * i + (lane >> 5)) * 33 + (lane & 31)] = tv[i] * inv;
    asm volatile("s_waitcnt lgkmcnt(0)" ::: "memory");
    const int c = lane & 7;
#pragma unroll
    for (int j = 0; j < 4; ++j) { const int n = (lane >> 3) + 8 * j; const LAS float* s = scr + (8 * c) * 33 + n;
        u32x2 o; o.x = pack_i8x4(s[0 * 33], s[1 * 33], s[2 * 33], s[3 * 33]); o.y = pack_i8x4(s[4 * 33], s[5 * 33], s[6 * 33], s[7 * 33]);
        *(u32x2*)(WT + (size_t)dst_row(n0 + n) * K + k0 + 8 * c) = o; }
    asm volatile("s_waitcnt lgkmcnt(0)" ::: "memory");
}
struct MapIn { __device__ __forceinline__ int operator()(int o) const {
    if (o < 2048) { const int e = o & 127; if (e < 32) { const int i = e & 15, n = e >> 4; return (o & ~127) + 8 * (i >> 2) + 4 * n + (i & 3); } return o; }
    if (o < 4096) return o;
    const int e = o - 4096, n = e >> 5, i = e & 31; return 4096 + 32 * (i >> 4) + 8 * ((i >> 2) & 3) + 4 * n + (i & 3); } };
struct MapUq { __device__ __forceinline__ int operator()(int o) const {
    const int hd = o / 192, e = o - hd * 192; if (e < 128) return hd * 128 + e;
    const int r = e - 128, n = r >> 5, i = r & 31; return 1024 + hd * 64 + 32 * (i >> 4) + 8 * ((i >> 2) & 3) + 4 * n + (i & 3); } };
struct MapOff { int off; __device__ __forceinline__ int operator()(int o) const { return o + off; } };

#define WS_PTRS \
    const float* x = AR.in[0]; \
    float* mod = (float*)(ws + WS_MOD); \
    float* ropeA = (float*)(ws + WS_ROPEA); float* ropeB = (float*)(ws + WS_ROPEB); \
    bf16_t* Win_t = (bf16_t*)(ws + WS_WIN); bf16_t* Wuq_t = (bf16_t*)(ws + WS_WUQ); bf16_t* Wukv_t = (bf16_t*)(ws + WS_WUKV); \
    bf16_t* Wo_t = (bf16_t*)(ws + WS_WO); bf16_t* Wpq_t = (bf16_t*)(ws + WS_WPQ); \
    bf16_t* UT = (bf16_t*)(ws + WS_UT); bf16_t* VT = (bf16_t*)(ws + WS_VT); \
    unsigned char* HI8 = ws + WS_A; unsigned char* WT8 = ws + WS_WIN; unsigned char* WPQ8 = ws + WS_WPQ; unsigned char* WUQ8 = ws + WS_WUQ; unsigned char* WUKV8 = ws + WS_WUKV; unsigned char* CQ8 = ws + WS_CQ; unsigned char* CKV8 = ws + WS_CQ + 16 * MiB; float* CSC = (float*)(ws + WS_CKV);       float* CMQ = (float*)(ws + WS_CMQ); float* CMKV = CMQ + 4096; float* WSQ = (float*)(ws + WS_WSQ); float* WSKV = WSQ + 2048; unsigned char* WO8 = ws + WS_WO; unsigned char* O8 = ws + WS_A; float* OS = (float*)(ws + WS_OS); float* CMAX3 = (float*)(ws + WS_CMAX3); float* WS3 = (float*)(ws + WS_WS3); float* CMAX2 = (float*)(ws + WS_CMAX2); float* WS4 = (float*)(ws + WS_WS4); float* CMAX = (float*)(ws + WS_CMAX); float* WS1 = (float*)(ws + WS_WS1); float* HS1 = (float*)(ws + WS_HS1); \
    bf16_t* Hb = (bf16_t*)(ws + WS_A); bf16_t* So = (bf16_t*)(ws + WS_A); bf16_t* Qp = (bf16_t*)(ws + WS_A); \
    bf16_t* QA = (bf16_t*)(ws + WS_QA); bf16_t* KA = (bf16_t*)(ws + WS_KA); bf16_t* VA = (bf16_t*)(ws + WS_VA); \
    bf16_t* CQ = (bf16_t*)(ws + WS_CQ); bf16_t* CKV = (bf16_t*)(ws + WS_CKV); bf16_t* KR = (bf16_t*)(ws + WS_KR); \
    float* Y = (float*)(ws + WS_Y); bf16_t* MIXb = (bf16_t*)(ws + WS_Y); \
    bf16_t* Qn = (bf16_t*)(ws + WS_QN); bf16_t* Qr = (bf16_t*)(ws + WS_QR); bf16_t* Kn = (bf16_t*)(ws + WS_KN); bf16_t* Vb = (bf16_t*)(ws + WS_VB); \
    bf16_t* H2 = (bf16_t*)(ws + WS_H2); bf16_t* Ob = (bf16_t*)(ws + WS_O); \
    float* ssq_q = (float*)(ws + WS_SSQ_Q); float* ssq_kv = (float*)(ws + WS_SSQ_KV); float* ssq_o = (float*)(ws + WS_SSQ_O); \
    float* Sm = (float*)(ws + WS_SM); float* Sl = (float*)(ws + WS_SL); \
    bf16_t* K1b = (bf16_t*)(ws + WS_K1); bf16_t* K2b = (bf16_t*)(ws + WS_K2); \
    unsigned short* IDX = (unsigned short*)(ws + WS_IDX); float* Gt = (float*)(ws + WS_G); \
    float* SU = (float*)(ws + WS_SU); float* SH = (float*)(ws + WS_SH); \
    unsigned char* U8 = ws + WS_U8; unsigned char* H8 = ws + WS_H8; \
    float* PART = (float*)(ws + WS_PART); unsigned short* IDX2 = (unsigned short*)(ws + WS_IDX2); unsigned char* WTq = ws + WS_WT; float* WSC = (float*)(ws + WS_WT + 8 * MiB); \
    bf16_t* FFN = (bf16_t*)(ws + WS_FFN); bf16_t* X1b = (bf16_t*)(ws + WS_X1); unsigned char* H2S = ws + WS_H2S;

__global__ void __launch_bounds__(NWAVES * 64, 2) mega_fwd(Args args) {
    extern __shared__ __attribute__((aligned(16))) unsigned char lds_raw[];
    LAS unsigned char* lds = (LAS unsigned char*)lds_raw;
    const int G = gridDim.x, bid = blockIdx.x, NGW = G * NWAVES;
    const int wave0 = __builtin_amdgcn_readfirstlane((int)threadIdx.x >> 6);
#define PH_LOCALS const int lane = opaque((int)__builtin_amdgcn_mbcnt_hi(~0u, __builtin_amdgcn_mbcnt_lo(~0u, 0u))), wave = wave0, tid = wave * 64 + lane, gw = bid * NWAVES + wave; (void)gw; \
    const __attribute__((address_space(4))) Args* arp_ = (const __attribute__((address_space(4))) Args*)__builtin_amdgcn_kernarg_segment_ptr(); asm volatile("" : "+s"(arp_)); const __attribute__((address_space(4))) Args& AR = *arp_; unsigned char* ws = AR.ws; WS_PTRS
    unsigned char* ws0 = args.ws;
    const int lo = args.ph_lo, hi_ph = args.ph_hi;
    if (threadIdx.x < 4) ((LAS unsigned*)(lds + LDS_BYTES - 16))[threadIdx.x] = 0u;
    __syncthreads();
    XcdBarrier xbar = xcd_barrier_post((unsigned*)ws0, (volatile LAS unsigned*)(lds + LDS_BYTES - 16));
#ifdef ONLY_PH
#define IN(k) ((k) == ONLY_PH && lo <= (k) && (k) < hi_ph)
#else
#define IN(k) (lo <= (k) && (k) < hi_ph)
#endif
#if MK_N_LAUNCHES == 1
#define GRID_BAR(k) do { if (IN(k) && IN((k) + 1)) { if ((k) == 0) cg::this_grid().sync(); else xcd_barrier(xbar); } } while (0)
#else
#define GRID_BAR(k) do { } while (0)
#endif
    constexpr int TB_SPLIT = 6656;
#define TB_LOAD(BUF, rr) do { const float* src_ = (((rr) >> 14) ? AR.in[19] : AR.in[18]) + (size_t)((rr) & (NE - 1)) * 2048; \
                    _Pragma("unroll") for (int c = 0; c < 4; ++c) { const f32x4* p_ = (const f32x4*)(src_ + c * 512 + lane * 8); BUF[2 * c] = __builtin_nontemporal_load(p_); BUF[2 * c + 1] = __builtin_nontemporal_load(p_ + 1); } } while (0)
#define TB_STEP(BUF, RR, NW, REND) do { const int r = (RR); \
                    const int tbl = r >> 14, e = r & (NE - 1); \
                    f32x4 v[8]; float mx = 0.f, sq = 0.f; \
_Pragma("unroll") \
                    for (int i = 0; i < 8; ++i) { v[i] = BUF[i]; mx = fmaxf(fmaxf(mx, fmaxf(fabsf(v[i][0]), fabsf(v[i][1]))), fmaxf(fabsf(v[i][2]), fabsf(v[i][3]))); \
                        sq += (v[i][0] * v[i][0] + v[i][1] * v[i][1]) + (v[i][2] * v[i][2] + v[i][3] * v[i][3]); } \
                    if (r + 2 * (NW) < (REND)) TB_LOAD(BUF, r + 2 * (NW)); \
                    mx = wmax(mx); \
                    if (tbl == 0) { \
                          \
                          \
                        const float rms = sqrtf(wsum(sq) * (1.0f / 2048.0f)); \
                        const float step = rms > 0.f ? fmaxf(0.335f * rms, mx * (1.0f / 64.0f)) : 1.0f; \
                        const float inv = 1.0f / step; \
                        if (lane == 0) SU[e] = step; \
                        unsigned char* dst = U8 + (size_t)e * 128 + (lane & 31) * 4; \
_Pragma("unroll") \
                        for (int c = 0; c < 4; ++c) { unsigned w = 0u; \
_Pragma("unroll") \
                            for (int i = 0; i < 4; ++i) { const float a = v[2 * c][i] * inv, b = v[2 * c + 1][i] * inv; \
                                const int qa = (int)__builtin_rintf(fminf(fmaxf(a, -7.f), 7.f)) + 8, qb = (int)__builtin_rintf(fminf(fmaxf(b, -7.f), 7.f)) + 8; \
                                w |= ((unsigned)qa | ((unsigned)qb << 4)) << (8 * i); } \
                            __builtin_nontemporal_store(w, (unsigned*)(dst + (size_t)(c * 2 + (lane >> 5)) * (2u << 20))); } \
                    } else { \
                          \
                        const float rms = sqrtf(wsum(sq) * (1.0f / 2048.0f)); \
                        const float step = rms > 0.f ? fmaxf(0.335f * rms, mx * (1.0f / 64.0f)) : 1.0f; \
                        const float inv = 1.0f / step; \
                        if (lane == 0) SU[NE + e] = step; \
                        unsigned char* dst = U8 + (size_t)(32u << 20) + (size_t)e * 128 + (lane & 31) * 4; \
_Pragma("unroll") \
                        for (int c = 0; c < 4; ++c) { unsigned w = 0u; \
_Pragma("unroll") \
                            for (int i = 0; i < 4; ++i) { const float a = (i < 2 ? v[2 * c][2 * i] : v[2 * c + 1][2 * i - 4]) * inv, b = (i < 2 ? v[2 * c][2 * i + 1] : v[2 * c + 1][2 * i - 3]) * inv; \
                                const int qa = (int)__builtin_rintf(fminf(fmaxf(a, -7.f), 7.f)) + 8, qb = (int)__builtin_rintf(fminf(fmaxf(b, -7.f), 7.f)) + 8; \
                                w |= ((unsigned)qa | ((unsigned)qb << 4)) << (8 * i); } \
                            __builtin_nontemporal_store(w, (unsigned*)(dst + (size_t)(c * 2 + (lane >> 5)) * (2u << 20))); } \
                    } \
    } while (0)
#define TABLE_CONVERT(W0, NW, RBEG, REND) do { \
            f32x4 nva[8], nvb[8]; const int r0_ = (RBEG) + (W0); \
            if (r0_ < (REND)) TB_LOAD(nva, r0_); \
            if (r0_ + (NW) < (REND)) TB_LOAD(nvb, r0_ + (NW)); \
            for (int rr_ = r0_; rr_ < (REND); rr_ += 2 * (NW)) { \
                TB_STEP(nva, rr_, NW, REND); \
                if (rr_ + (NW) < (REND)) TB_STEP(nvb, rr_ + (NW), NW, REND); \
            } \
    } while (0)
    for (int rep_ = 0; rep_ < (IN(0) ? 1 + ((REP_MASK >> 0) & 1) : 0); ++rep_) {
        PH_LOCALS;
        for (int cb = bid; cb < 192; cb += G) {
            LAS float* cact = (LAS float*)lds;
            const float* cin = AR.in[1];
#pragma unroll 8
            for (int i = tid; i < 16 * 2048 / 4; i += NWAVES * 64) { f32x4 v = ((const f32x4*)cin)[i];
#pragma unroll
                for (int q = 0; q < 4; ++q) v[q] = v[q] / (1.0f + __expf(-v[q]));
                ((LAS f32x4*)cact)[i] = v; }
            __syncthreads();
            const int col = cb * 64 + lane;
            float acc[16];
#pragma unroll
            for (int b = 0; b < 16; ++b) acc[b] = 0.f;
            const float* wp = AR.in[2] + (size_t)(wave * 256) * 12288 + col;
            for (int k0 = 0; k0 < 256; k0 += 16) {
                float w[16];
#pragma unroll
                for (int i = 0; i < 16; ++i) w[i] = __builtin_nontemporal_load(wp + (size_t)(k0 + i) * 12288);
#pragma unroll
                for (int b = 0; b < 16; ++b) {
#pragma unroll
                    for (int i4 = 0; i4 < 4; ++i4) { const f32x4 cv = *(const LAS f32x4*)(cact + b * 2048 + wave * 256 + k0 + 4 * i4);
                        acc[b] += cv[0] * w[4 * i4] + cv[1] * w[4 * i4 + 1] + cv[2] * w[4 * i4 + 2] + cv[3] * w[4 * i4 + 3]; }
                }
            }
            __syncthreads();
            LAS float* red = (LAS float*)lds;
#pragma unroll
            for (int b = 0; b < 16; ++b) red[(wave * 16 + b) * 64 + lane] = acc[b];
            __syncthreads();
            for (int o = tid; o < 1024; o += NWAVES * 64) { const int b = o >> 6, cl = o & 63; float s = 0.f;
#pragma unroll
                for (int w = 0; w < 8; ++w) s += red[(w * 16 + b) * 64 + cl];
                mod[(size_t)b * 12288 + cb * 64 + cl] = s + AR.in[3][cb * 64 + cl]; }
            __syncthreads();
        }
#if defined(NAIVE_PEER)
        for (int r = gw; r < 2 * NE; r += NGW) {
            const float* src = (r < NE ? AR.in[18] : AR.in[19]) + (size_t)(r & (NE - 1)) * 2048;
            bf16_t* dst = (r < NE ? UT : VT) + (size_t)(r & (NE - 1)) * 2048;
            f32x4 v[8];
#pragma unroll
            for (int c = 0; c < 4; ++c) { const f32x4* p = (const f32x4*)(src + c * 512 + lane * 8); v[2 * c] = p[0]; v[2 * c + 1] = p[1]; }
#pragma unroll
            for (int c = 0; c < 4; ++c) pg8::store8(dst + c * 512 + lane * 8, v[2 * c], v[2 * c + 1]);
        }
#else
        if (G == 256) { constexpr int TB_MID = TB_SPLIT + 17280;
            if (bid < 192) TABLE_CONVERT(gw, 192 * NWAVES, TB_SPLIT, TB_MID); else TABLE_CONVERT((bid - 192) * NWAVES + wave, 64 * NWAVES, TB_MID, 2 * NE); }
        else TABLE_CONVERT(gw, NGW, TB_SPLIT, 2 * NE);
#endif
        {
            LAS float* scr = (LAS float*)(lds + wave * 16384);
            constexpr int I_IN = 8 * 65, I_UQ = 2 * 24, I_UK = 2 * 16, I_UV = 2 * 16, I_O = 8 * 32, I_PQ = 8 * 32;
            constexpr int NITEMS = I_IN + I_UQ + I_UK + I_UV + I_O + I_PQ;
            for (int it = gw; it < NITEMS; it += NGW) {
                int r = it;
                if (r < I_IN) {
                    const int kc = r / 65, nb = r % 65; const float* wp = AR.in[4] + (size_t)(kc * 256) * NPROJ + nb * 64 + lane; float mx = 0.f;
#pragma unroll 1
                    for (int k0 = 0; k0 < 256; k0 += 32) { float w[32];
#pragma unroll
                        for (int i = 0; i < 32; ++i) w[i] = wp[(size_t)(k0 + i) * NPROJ];
#pragma unroll
                        for (int i = 0; i < 32; ++i) mx = fmaxf(mx, fabsf(w[i])); }
                    CMAX[kc * NPROJ_PAD + nb * 64 + lane] = mx; continue; } r -= I_IN;
                if (r < I_UQ + I_UK + I_UV) {
                    const int t3 = r < I_UQ ? 0 : (r < I_UQ + I_UK ? 1 : 2), rr = r - (t3 == 0 ? 0 : (t3 == 1 ? I_UQ : I_UQ + I_UK));
                    const int N3 = t3 == 0 ? 1536 : 1024, nb3 = N3 / 64, kc = rr / nb3, nb = rr % nb3;
                    const float* wp = (t3 == 0 ? AR.in[7] : (t3 == 1 ? AR.in[8] : AR.in[9])) + (size_t)(kc * 256) * N3 + nb * 64 + lane;
                    const float* gp = (t3 == 0 ? AR.in[5] : AR.in[6]) + kc * 256; float mx = 0.f;
#pragma unroll 1
                    for (int k0 = 0; k0 < 256; k0 += 32) { float w[32];
#pragma unroll
                        for (int i = 0; i < 32; ++i) w[i] = wp[(size_t)(k0 + i) * N3];
#pragma unroll
                        for (int i = 0; i < 32; ++i) mx = fmaxf(mx, fabsf(w[i] * gp[k0 + i])); }
                    (t3 == 0 ? CMQ + kc * 1536 : CMKV + kc * 2048 + (t3 == 2 ? 1024 : 0))[nb * 64 + lane] = mx; continue; } r -= I_UQ + I_UK + I_UV;
                if (r < I_O) {
                    const int kc = r >> 5, nb = r & 31; const float* wp = AR.in[12] + (size_t)(kc * 256) * 2048 + nb * 64 + lane;
                    const float* gp = (kc < 4 ? AR.in[10] : AR.in[11] - 1024) + kc * 256; float mx = 0.f;
#pragma unroll 1
                    for (int k0 = 0; k0 < 256; k0 += 32) { float w[32];
#pragma unroll
                        for (int i = 0; i < 32; ++i) w[i] = wp[(size_t)(k0 + i) * 2048];
#pragma unroll
                        for (int i = 0; i < 32; ++i) mx = fmaxf(mx, fabsf(w[i] * gp[k0 + i])); }
                    CMAX3[kc * 2048 + nb * 64 + lane] = mx; continue; } r -= I_O;
                {
                    const int kc = r >> 5, nb = r & 31; const float* wp = AR.in[15] + (size_t)(kc * 256) * 2048 + nb * 64 + lane; float mx = 0.f;
#pragma unroll 1
                    for (int k0 = 0; k0 < 256; k0 += 32) { float w[32];
#pragma unroll
                        for (int i = 0; i < 32; ++i) w[i] = wp[(size_t)(k0 + i) * 2048];
#pragma unroll
                        for (int i = 0; i < 32; ++i) mx = fmaxf(mx, fabsf(w[i])); }
                    CMAX2[kc * 2048 + nb * 64 + lane] = mx; }
            }
            for (size_t i = (size_t)gw * 64 + lane; i < (size_t)(NPROJ_PAD - NPROJ) * 2048 / 16; i += (size_t)NGW * 64)
                *(u32x4*)(WT8 + (size_t)NPROJ * 2048 + i * 16) = (u32x4){0u, 0u, 0u, 0u};
            if (gw == 0) for (int i = lane; i < NPROJ_PAD - NPROJ; i += 64) WS1[NPROJ + i] = 1.0f;
        }
        for (int i = gw * 64 + lane; i < 2 * 16384; i += NGW * 64) {
            const float v = (i < 16384 ? AR.in[16] : AR.in[17])[i & 16383];
            (i < 16384 ? K1b : K2b)[i & 16383] = (bf16_t)(cvtpk(v, v) & 0xffffu);
        }
    }
    GRID_BAR(0);

    for (int rep_ = 0; rep_ < (IN(1) ? 1 + ((REP_MASK >> 1) & 1) : 0); ++rep_) {
        PH_LOCALS;
        const int nb_ = G >> 4, b = bid / nb_, r0 = (bid % nb_) * NWAVES + wave, rstep = nb_ * NWAVES;
        LAS float* psh = (LAS float*)lds; LAS float* psc = psh + 2048;
        __syncthreads();
        if (b < 16) { const float* mb = mod + (size_t)b * 12288;
            *(LAS f32x4*)(psh + 4 * tid) = *(const f32x4*)(mb + 4 * tid); *(LAS f32x4*)(psc + 4 * tid) = *(const f32x4*)(mb + 2048 + 4 * tid) + 1.0f; }
        __syncthreads();
#pragma unroll 1
        for (int pass_ = 0; pass_ < 2; ++pass_) {
        const bool dot_ = (pass_ == 0) != ((wave & 1) != 0);
        if (dot_) { LAS float* scr = (LAS float*)(lds + 16384 + wave * 8704);
          for (int it = gw; it < 32 * 130; it += NGW) transpose_item_q8(AR.in[4], 2048, NPROJ, WT8, (const float*)nullptr, CMAX, 8, NPROJ_PAD, WS1, scr, it, lane, MapIn{});
          for (int it = gw; it < 32 * 64; it += NGW) transpose_item_q8(AR.in[15], 2048, 2048, WPQ8, (const float*)nullptr, CMAX2, 8, 2048, WS4, scr, it, lane, MapOff{0});
          for (int it = gw; it < 32 * 64; it += NGW) { const int kb = it / 64; transpose_item_q8(AR.in[12], 2048, 2048, WO8, kb < 16 ? AR.in[10] : AR.in[11] - 1024, CMAX3, 8, 2048, WS3, scr, it, lane, MapOff{0}); }
          for (int it = gw; it < 8 * 48; it += NGW) transpose_item_q8(AR.in[7], 512, 1536, WUQ8, AR.in[5], CMQ, 2, 1536, WSQ, scr, it, lane, MapUq{});
          for (int it = gw; it < 8 * 32; it += NGW) transpose_item_q8(AR.in[8], 512, 1024, WUKV8, AR.in[6], CMKV, 2, 2048, WSKV, scr, it, lane, MapOff{0});
          for (int it = gw; it < 8 * 32; it += NGW) transpose_item_q8(AR.in[9], 512, 1024, WUKV8, AR.in[6], CMKV + 1024, 2, 2048, WSKV, scr, it, lane, MapOff{1024}); }
        else if (b < 16) {
            f32x4 nv[8];
            { const f32x4* xr = (const f32x4*)(x + ((size_t)b * 2048 + r0) * DM) + lane;
#pragma unroll
              for (int j = 0; j < 8; ++j) nv[j] = __builtin_nontemporal_load(xr + 64 * j); }
            for (int r = r0; r < 2048; r += rstep) {
                const int row = b * 2048 + r;
                f32x4 v[8]; float s = 0.f;
#pragma unroll
                for (int j = 0; j < 8; ++j) { v[j] = nv[j]; s += (v[j][0] + v[j][1]) + (v[j][2] + v[j][3]); }
                if (r + rstep < 2048) { const f32x4* xr = (const f32x4*)(x + (size_t)(row + rstep) * DM) + lane;
#pragma unroll
                    for (int j = 0; j < 8; ++j) nv[j] = __builtin_nontemporal_load(xr + 64 * j); }
                const float mean = wsum(s) * (1.0f / DM); float s2 = 0.f;
#pragma unroll
                for (int j = 0; j < 8; ++j) { v[j] = v[j] - mean; s2 += (v[j][0] * v[j][0] + v[j][1] * v[j][1]) + (v[j][2] * v[j][2] + v[j][3] * v[j][3]); }
                const float rstd = 1.0f / sqrtf(wsum(s2) * (1.0f / DM) + 1e-5f);
                float mx = 0.f;
#pragma unroll
                for (int j = 0; j < 8; ++j) { const int d = 4 * (lane + 64 * j);
                    const f32x4 sh = *(const LAS f32x4*)(psh + d), sc1 = *(const LAS f32x4*)(psc + d);
                    v[j] = v[j] * rstd * sc1 + sh; mx = fmaxf(fmaxf(mx, fmaxf(fabsf(v[j][0]), fabsf(v[j][1]))), fmaxf(fabsf(v[j][2]), fabsf(v[j][3]))); }
                mx = wmax(mx);
                const float qs = mx > 0.f ? 127.0f / mx : 1.0f;
                if (lane == 0) HS1[row] = mx > 0.f ? mx * (1.0f / 127.0f) : 1.0f;
#pragma unroll
                for (int j = 0; j < 8; ++j) { const int d = 4 * (lane + 64 * j); const f32x4 y = v[j] * qs;
                    *(unsigned*)(HI8 + (size_t)row * DM + d) = pack_i8x4(y[0], y[1], y[2], y[3]); }
            }
        }
        }
    }
    GRID_BAR(1);

    for (int rep_ = 0; rep_ < (IN(2) ? 1 + ((REP_MASK >> 2) & 1) : 0); ++rep_) {
        PH_LOCALS;
        pg8::Gemm g{(const bf16_t*)HI8, (const bf16_t*)WT8, T, NPROJ_PAD, DM / 2}; pg8::StaticOrder S; S.init(T, NPROJ_PAD, G, bid);
        LAS float* tabR = (LAS float*)(lds + pg8::STAGE_BYTES); LAS float* tabC = tabR + 9 * 256; LAS float* etab = tabC + 9 * 256;
        if (tid < 256) {
#pragma unroll
            for (int i = 0; i < 9; ++i) { pg8::Unit u; if (S.next(i, u)) { tabR[i * 256 + tid] = HS1[u.pm * 256 + tid]; tabC[i * 256 + tid] = WS1[u.pn * 256 + tid]; } } }
        __syncthreads();
        pg8::EpiProj E{QA, CQ, KR, ssq_q, tabR, tabC, CQ8, CSC, etab};
        pg8::gemm_phase(tid, lds, g, S, E);
#if !defined(NAIVE_PEER)
        {
            const int nun_ = (T / 256) * (NPROJ_PAD / 256), rem_ = nun_ % G;
            const int tw0_ = ((rem_ ? bid - rem_ : bid) * NWAVES + wave), tnw_ = (rem_ ? G - rem_ : G) * NWAVES;
            if (tw0_ >= 0) {
                TABLE_CONVERT(tw0_, tnw_, 0, TB_SPLIT);
            }
        }
#endif
    }
    GRID_BAR(2);

    for (int rep_ = 0; rep_ < (IN(3) ? 1 + ((REP_MASK >> 3) & 1) : 0); ++rep_) {
        PH_LOCALS;
        LAS float* tab = (LAS float*)(lds + pg8::STAGE_BYTES); LAS float* tabC = tab + 4 * 256 * 2;
        { pg8::Gemm g{(const bf16_t*)CQ8, (const bf16_t*)WUQ8, T, 1536, 256}; pg8::StaticOrder S; S.init(T, 1536, G, bid);
          if (tid < 256) {
              float qv[4][8], s1[4], s2[4]; bool ok[4];
#pragma unroll
              for (int i = 0; i < 4; ++i) { pg8::Unit u; ok[i] = S.next(i, u); const int row = (ok[i] ? u.pm : 0) * 256 + tid; s1[i] = CSC[row]; s2[i] = CSC[T + row];
#pragma unroll
                  for (int sl = 0; sl < 8; ++sl) qv[i][sl] = ssq_q[(size_t)sl * T + row]; }
#pragma unroll
              for (int i = 0; i < 4; ++i) if (ok[i]) { float q = 0.f;
#pragma unroll
                  for (int sl = 0; sl < 8; ++sl) q += qv[i][sl];
                  tab[(i * 256 + tid) * 2] = s2[i] / sqrtf(q * (1.0f / 512.0f) + 1e-6f); tab[(i * 256 + tid) * 2 + 1] = fminf(s1[i] / s2[i], 512.0f); }
#pragma unroll
              for (int i = 0; i < 4; ++i) { pg8::Unit u; if (S.next(i, u)) tabC[i * 256 + tid] = WSQ[u.pn * 256 + tid]; } }
          __syncthreads();
          pg8::EpiQ E{Qn, Qr, tab, tabC}; pg8::gemm_phase(tid, lds, g, S, E); }
        __syncthreads();
        { pg8::Gemm g{(const bf16_t*)CKV8, (const bf16_t*)WUKV8, T, 2048, 256}; pg8::StaticOrder S; S.init(T, 2048, G, bid);
          if (tid < 256) {
              float qv[4][8], s1[4], s2[4]; bool ok[4];
#pragma unroll
              for (int i = 0; i < 4; ++i) { pg8::Unit u; ok[i] = S.next(i, u); const int row = (ok[i] ? u.pm : 0) * 256 + tid; s1[i] = CSC[2 * T + row]; s2[i] = CSC[3 * T + row];
#pragma unroll
                  for (int sl = 0; sl < 8; ++sl) qv[i][sl] = ssq_kv[(size_t)sl * T + row]; }
#pragma unroll
              for (int i = 0; i < 4; ++i) if (ok[i]) { float q = 0.f;
#pragma unroll
                  for (int sl = 0; sl < 8; ++sl) q += qv[i][sl];
                  tab[(i * 256 + tid) * 2] = s2[i] / sqrtf(q * (1.0f / 512.0f) + 1e-6f); tab[(i * 256 + tid) * 2 + 1] = fminf(s1[i] / s2[i], 512.0f); }
#pragma unroll
              for (int i = 0; i < 4; ++i) { pg8::Unit u; if (S.next(i, u)) tabC[i * 256 + tid] = WSKV[u.pn * 256 + tid]; } }
          __syncthreads();
          pg8::EpiKV E{Kn, Vb, tab, tabC}; pg8::gemm_phase(tid, lds, g, S, E); }
    }
    GRID_BAR(3);


#if defined(NAIVE_ATTN)
    for (int rep_ = 0; rep_ < (IN(4) ? 1 + ((REP_MASK >> 4) & 1) : 0); ++rep_) {
        PH_LOCALS;
        for (int it = gw; it < T * 8; it += NGW) {
            const int t = it >> 3, h = it & 7, b = t >> 11, s = t & 2047;
            {
                const unsigned qv = *(const unsigned*)(QA + (size_t)t * 1024 + h * 128 + 2 * lane);
                const float q0 = bf_lo(qv), q1 = bf_hi(qv);
                float m = -1e30f, l = 0.f, a0 = 0.f, a1 = 0.f;
                for (int br = 0; br < 3; ++br) { const int dil = br == 0 ? 1 : (br == 1 ? 4 : 16);
                    for (int j = 0; j <= 128; ++j) { const int sk = s - j * dil; if (sk < 0) break;
                        const size_t tk = (size_t)b * SEQ + sk;
                        const unsigned kv = *(const unsigned*)(KA + tk * 1024 + h * 128 + 2 * lane);
                        const unsigned vv = *(const unsigned*)(VA + tk * 1024 + h * 128 + 2 * lane);
                        const float sc = wave_sum(q0 * bf_lo(kv) + q1 * bf_hi(kv)) * 0.08838834764831845f;
                        const float mn = fmaxf(m, sc), corr = __expf(m - mn), pp = __expf(sc - mn);
                        l = l * corr + pp; a0 = a0 * corr + pp * bf_lo(vv); a1 = a1 * corr + pp * bf_hi(vv); m = mn; } }
                const float r0 = a0 / l, r1 = a1 / l;
                *(unsigned*)(Ob + (size_t)t * 2048 + h * 128 + 2 * lane) = cvtpk(r0, r1);
                const float sq = wave_sum(r0 * r0 + r1 * r1);
                if (lane == 0) ssq_o[(size_t)t * 16 + h] = sq;
            }
            {
                const unsigned qv = *(const unsigned*)(Qn + (size_t)t * 1024 + h * 128 + 2 * lane);
                const float q0 = bf_lo(qv), q1 = bf_hi(qv);
                const unsigned short qrv = Qr[(size_t)t * 512 + h * 64 + lane]; const float qr0 = __uint_as_float((unsigned)qrv << 16);
                float m = -1e30f, l = 0.f, a0 = 0.f, a1 = 0.f;
                for (int sk = 0; sk <= s; ++sk) { const size_t tk = (size_t)b * SEQ + sk;
                    const unsigned kv = *(const unsigned*)(Kn + tk * 1024 + h * 128 + 2 * lane);
                    const unsigned vv = *(const unsigned*)(Vb + tk * 1024 + h * 128 + 2 * lane);
                    const float krv = __uint_as_float((unsigned)KR[tk * 64 + lane] << 16);
                    const float sc = wave_sum(q0 * bf_lo(kv) + q1 * bf_hi(kv) + qr0 * krv) * 0.07216878364870322f;
                    const float mn = fmaxf(m, sc), corr = __expf(m - mn), pp = __expf(sc - mn);
                    l = l * corr + pp; a0 = a0 * corr + pp * bf_lo(vv); a1 = a1 * corr + pp * bf_hi(vv); m = mn; }
                const float r0 = a0 / l, r1 = a1 / l;
                *(unsigned*)(Ob + (size_t)t * 2048 + 1024 + h * 128 + 2 * lane) = cvtpk(r0, r1);
                const float sq = wave_sum(r0 * r0 + r1 * r1);
                if (lane == 0) ssq_o[(size_t)t * 16 + 8 + h] = sq;
            }
        }
    }
#else
    for (int rep_ = 0; rep_ < (IN(4) ? 1 + ((REP_MASK >> 4) & 1) : 0); ++rep_) {
        PH_LOCALS;
        att::Tens XA{QA, nullptr, KA, nullptr, VA, So, Sm, Sl, Ob, 0, ssq_o, 0};
        {
            LAS unsigned char* wl = lds + wave * 17408; LAS float* wsf = (LAS float*)(lds + 8 * 17408) + wave * 64;
            for (int repa = 0; repa < 1 + ((REP_MASK >> 16) & 1); ++repa)
            for (int u = bid; u < 512; u += G) {
                const int J = (u >> 3) & 3, bh = (u & 7) + 8 * (u >> 5), b = bh >> 3, h = bh & 7;
#pragma unroll 1
                for (int br = 0; br < 3; ++br) {
#pragma unroll 1
                    for (int k = 0; k < 2; ++k) { const int wu = wave + 8 * k;
                        att::WaveA P;
                        P.b = b; P.h = h; P.mode = br == 0 ? 0 : (br == 1 ? 1 : 3);
                        if (br == 0) { P.dil = 1; P.rho = 0; P.qpos0 = 512 * J + 32 * wu; }
                        else if (br == 1) { P.dil = 4; P.rho = wu >> 2; P.qpos0 = 128 * J + 32 * (wu & 3); }
                        else { P.dil = 16; P.rho = wu; P.qpos0 = 32 * J; }
                        att::attnA_wave(lane, P, wl, wsf, XA); }
                    asm volatile("s_waitcnt vmcnt(0)" ::: "memory");
                    __syncthreads();
                }
            }
            __syncthreads();
        }
        att::Tens XB{Qn, Qr, Kn, KR, Vb, nullptr, nullptr, nullptr, Ob, 1024, ssq_o, 8};
        for (int repb = 0; repb < 1 + ((REP_MASK >> 17) & 1); ++repb)
        for (int i = 0; i < 4 * ((1024 + 4 * G - 1) / (4 * G)); ++i) {
            const int v = bid + (i >> 2) * G; if (v >= 256) break;
            const int bh = (v & 7) + 8 * (v >> 4), s = (v >> 3) & 1, ii = i & 3;
            const int qt = ii == 0 ? 2 * s : (ii == 1 ? 2 * s + 1 : (ii == 2 ? 7 - 2 * s : 6 - 2 * s));
            att::UnitP P{bh >> 3, bh & 7, 1, 0, 1, 256 * qt, 0, 4 * (qt + 1), 1 << 28, 2};
            att::attn_unit<true>(tid, P, lds, XB);
        }
    }
    GRID_BAR(4);


#endif

    for (int rep_ = 0; rep_ < (IN(6) ? 1 + ((REP_MASK >> 6) & 1) : 0); ++rep_) {
        PH_LOCALS;
        u32x4 no[4]; f32x4 nq[4];
#define P6_LOAD(rr) do { _Pragma("unroll") for (int c = 0; c < 4; ++c) { no[c] = __builtin_nontemporal_load((const u32x4*)(Ob + (size_t)(rr) * DM + c * 512 + lane * 8)); nq[c] = *(const f32x4*)(ssq_o + (size_t)(rr) * 16 + 4 * c); } } while (0)
        P6_LOAD(gw);
        for (int row = gw; row < T; row += NGW) {
            const float sa = ((nq[0][0] + nq[0][1]) + (nq[0][2] + nq[0][3])) + ((nq[1][0] + nq[1][1]) + (nq[1][2] + nq[1][3]));
            const float sb = ((nq[2][0] + nq[2][1]) + (nq[2][2] + nq[2][3])) + ((nq[3][0] + nq[3][1]) + (nq[3][2] + nq[3][3]));
            const float ra = 1.0f / sqrtf(sa * (1.0f / 1024.0f) + 1e-6f), rb = 1.0f / sqrtf(sb * (1.0f / 1024.0f) + 1e-6f);
            float f[32]; float mx = 0.f;
#pragma unroll
            for (int c = 0; c < 4; ++c) { const u32x4 o4 = no[c]; const unsigned w0 = o4.x, w1 = o4.y, w2 = o4.z, w3 = o4.w; const float r_ = c < 2 ? ra : rb;
                f[8 * c + 0] = bf_lo(w0) * r_; f[8 * c + 1] = bf_hi(w0) * r_; f[8 * c + 2] = bf_lo(w1) * r_; f[8 * c + 3] = bf_hi(w1) * r_;
                f[8 * c + 4] = bf_lo(w2) * r_; f[8 * c + 5] = bf_hi(w2) * r_; f[8 * c + 6] = bf_lo(w3) * r_; f[8 * c + 7] = bf_hi(w3) * r_; }
            if (row + NGW < T) P6_LOAD(row + NGW);
#pragma unroll
            for (int i = 0; i < 32; ++i) mx = fmaxf(mx, fabsf(f[i]));
            mx = wmax(mx);
            const float qs = mx > 0.f ? 127.0f / mx : 1.0f;
            if (lane == 0) OS[row] = mx > 0.f ? mx * (1.0f / 127.0f) : 1.0f;
#pragma unroll
            for (int c = 0; c < 4; ++c) { u32x2 w; w.x = pack_i8x4(f[8 * c] * qs, f[8 * c + 1] * qs, f[8 * c + 2] * qs, f[8 * c + 3] * qs); w.y = pack_i8x4(f[8 * c + 4] * qs, f[8 * c + 5] * qs, f[8 * c + 6] * qs, f[8 * c + 7] * qs);
                *(u32x2*)(O8 + (size_t)row * DM + c * 512 + lane * 8) = w; }
        }
#undef P6_LOAD
    }
    GRID_BAR(6);

    for (int rep_ = 0; rep_ < (IN(7) ? 1 + ((REP_MASK >> 7) & 1) : 0); ++rep_) {
        PH_LOCALS;
        pg8::Gemm g{(const bf16_t*)O8, (const bf16_t*)WO8, T, DM, DM / 2}; pg8::StaticOrder S; S.init(T, DM, G, bid);
        LAS float* tabR = (LAS float*)(lds + pg8::STAGE_BYTES); LAS float* tabC = tabR + 4 * 256;
        if (tid < 256) {
#pragma unroll
            for (int i = 0; i < 4; ++i) { pg8::Unit u; if (S.next(i, u)) { tabR[i * 256 + tid] = OS[u.pm * 256 + tid]; tabC[i * 256 + tid] = WS3[u.pn * 256 + tid]; } } }
        __syncthreads();
        pg8::EpiPlainQ8 E{MIXb, DM, tabR, tabC}; pg8::gemm_phase(tid, lds, g, S, E);
    }
    GRID_BAR(7);

    for (int rep_ = 0; rep_ < (IN(8) ? 1 + ((REP_MASK >> 8) & 1) : 0); ++rep_) {
        PH_LOCALS;
        const int nb_ = G >> 4, b = bid / nb_, r0 = (bid % nb_) * NWAVES + wave, rstep = nb_ * NWAVES;
        LAS float* pg1 = (LAS float*)lds; LAS float* psh = pg1 + 2048; LAS float* psc = pg1 + 4096; LAS float* plg = pg1 + 6144; LAS float* plb = pg1 + 8192;
        __syncthreads();
        if (b < 16) { const float* mb = mod + (size_t)b * 12288;
            *(LAS f32x4*)(pg1 + 4 * tid) = *(const f32x4*)(mb + 4096 + 4 * tid) * DBG_MIX; *(LAS f32x4*)(psh + 4 * tid) = *(const f32x4*)(mb + 6144 + 4 * tid);
            *(LAS f32x4*)(psc + 4 * tid) = *(const f32x4*)(mb + 8192 + 4 * tid) + 1.0f;
            *(LAS f32x4*)(plg + 4 * tid) = *(const f32x4*)(AR.in[13] + 4 * tid); *(LAS f32x4*)(plb + 4 * tid) = *(const f32x4*)(AR.in[14] + 4 * tid); }
        __syncthreads();
        if (b < 16) {
        f32x4 nx[8]; u32x2 nm[8];
#define P8_LOAD(rr) do { const f32x4* xr_ = (const f32x4*)(x + (size_t)(rr) * DM) + lane; const u32x2* mr_ = (const u32x2*)(MIXb + (size_t)(rr) * DM) + lane; \
            _Pragma("unroll") for (int j = 0; j < 8; ++j) { nx[j] = __builtin_nontemporal_load(xr_ + 64 * j); nm[j] = __builtin_nontemporal_load(mr_ + 64 * j); } } while (0)
        P8_LOAD(b * 2048 + r0);
        for (int r = r0; r < 2048; r += rstep) {
            const int row = b * 2048 + r, le = opaque(lane);
            f32x4 v[8]; float s = 0.f;
#pragma unroll
            for (int j = 0; j < 8; ++j) { const f32x4 xv = nx[j], gv = *(const LAS f32x4*)(pg1 + 4 * (le + 64 * j)); const unsigned m0 = nm[j].x, m1 = nm[j].y;
                v[j][0] = xv[0] * DN_ALPHA + gv[0] * bf_lo(m0); v[j][1] = xv[1] * DN_ALPHA + gv[1] * bf_hi(m0);
                v[j][2] = xv[2] * DN_ALPHA + gv[2] * bf_lo(m1); v[j][3] = xv[3] * DN_ALPHA + gv[3] * bf_hi(m1);
                s += (v[j][0] + v[j][1]) + (v[j][2] + v[j][3]); }
            if (r + rstep < 2048) P8_LOAD(row + rstep);
            float mean = wsum(s) * (1.0f / DM); float s2 = 0.f;
#pragma unroll
            for (int j = 0; j < 8; ++j) { v[j] = v[j] - mean; s2 += (v[j][0] * v[j][0] + v[j][1] * v[j][1]) + (v[j][2] * v[j][2] + v[j][3] * v[j][3]); }
            float rstd = 1.0f / sqrtf(wsum(s2) * (1.0f / DM) + 1e-5f);
            s = 0.f;
#pragma unroll
            for (int j = 0; j < 8; ++j) { const int d = 4 * (le + 64 * j);
                v[j] = v[j] * rstd * *(const LAS f32x4*)(plg + d) + *(const LAS f32x4*)(plb + d);
#if defined(NAIVE_PEER)
                *(f32x4*)(AR.out + (size_t)row * DM + d) = v[j];
#else
                { u32x2 w1; w1.x = cvtpk(v[j][0], v[j][1]); w1.y = cvtpk(v[j][2], v[j][3]); __builtin_nontemporal_store(w1, (u32x2*)(X1b + (size_t)row * DM + d)); }
#endif
                s += (v[j][0] + v[j][1]) + (v[j][2] + v[j][3]); }
            mean = wsum(s) * (1.0f / DM); s2 = 0.f;
#pragma unroll
            for (int j = 0; j < 8; ++j) { v[j] = v[j] - mean; s2 += (v[j][0] * v[j][0] + v[j][1] * v[j][1]) + (v[j][2] * v[j][2] + v[j][3] * v[j][3]); }
            rstd = 1.0f / sqrtf(wsum(s2) * (1.0f / DM) + 1e-5f);
#pragma unroll
            for (int j = 0; j < 8; ++j) { const int d = 4 * (le + 64 * j);
                const f32x4 sh = *(const LAS f32x4*)(psh + d), sc1 = *(const LAS f32x4*)(psc + d);
                const f32x4 y = v[j] * rstd * sc1 + sh; v[j] = y; }
#if !defined(NAIVE_PEER)
            {
                float mx = 0.f;
#pragma unroll
                for (int j = 0; j < 8; ++j) mx = fmaxf(fmaxf(mx, fmaxf(fabsf(v[j][0]), fabsf(v[j][1]))), fmaxf(fabsf(v[j][2]), fabsf(v[j][3])));
                mx = wmax(mx);
                const float hs = mx > 0.f ? 127.0f / mx : 1.0f;
                if (lane == 0) SH[row] = mx > 0.f ? mx * (1.0f / 127.0f) : 1.0f;
#pragma unroll
                for (int j = 0; j < 8; ++j) { const int d = 4 * (le + 64 * j); const f32x4 y = v[j] * hs;
                    *(unsigned*)(H2S + (size_t)row * DM + d) = pack_i8x4(y[0], y[1], y[2], y[3]); }
            }
#endif
        }
        }
#undef P8_LOAD
    }
    GRID_BAR(8);

    for (int rep_ = 0; rep_ < (IN(9) ? 1 + ((REP_MASK >> 9) & 1) : 0); ++rep_) {
        PH_LOCALS;
        pg8::Gemm g{(const bf16_t*)H2S, (const bf16_t*)WPQ8, T, DM, DM / 2}; pg8::StaticOrder S; S.init(T, DM, G, bid);
        LAS float* tabR = (LAS float*)(lds + pg8::STAGE_BYTES); LAS float* tabC = tabR + 4 * 256;
        if (tid < 256) {
#pragma unroll
            for (int i = 0; i < 4; ++i) { pg8::Unit u; if (S.next(i, u)) { tabR[i * 256 + tid] = SH[u.pm * 256 + tid]; tabC[i * 256 + tid] = WS4[u.pn * 256 + tid]; } } }
        __syncthreads();
        pg8::EpiPlainQ8 E{Qp, DM, tabR, tabC}; pg8::gemm_phase(tid, lds, g, S, E);
    }
    GRID_BAR(9);


#if defined(NAIVE_TOPK)
    for (int rep_ = 0; rep_ < (IN(10) ? 1 + ((REP_MASK >> 10) & 1) : 0); ++rep_) {
        PH_LOCALS;
        LAS float* vs = (LAS float*)(lds + wave * 256);
        for (int it = gw; it < T * 8; it += NGW) {
            const int t = it >> 3, h = it & 7;
            float sA[2][2];
#pragma unroll
            for (int half = 0; half < 2; ++half) {
                const bf16_t* qp = Qp + (size_t)t * DM + h * 256 + half * 128;
                const float* kp = half ? AR.in[17] : AR.in[16];
                float s0 = 0.f, s1 = 0.f;
                for (int d = 0; d < 128; ++d) { const float qv = __uint_as_float((unsigned)qp[d] << 16); s0 += qv * kp[lane * 128 + d]; s1 += qv * kp[(lane + 64) * 128 + d]; }
                sA[half][0] = s0; sA[half][1] = s1;
            }
#pragma unroll
            for (int half = 0; half < 2; ++half) {
                float c0 = sA[half][0], c1 = sA[half][1];
                for (int r = 0; r < 16; ++r) {
                    float bv = fmaxf(c0, c1); int bi = (c0 >= c1) ? lane : lane + 64;
#pragma unroll
                    for (int o = 1; o < 64; o <<= 1) { const float ov = __shfl_xor(bv, o); const int oi = __shfl_xor(bi, o); if (ov > bv || (ov == bv && oi < bi)) { bv = ov; bi = oi; } }
                    if (lane == 0) { vs[half * 16 + r] = bv; ((LAS int*)vs)[32 + half * 16 + r] = bi; }
                    if (bi == lane) c0 = -INFINITY; if (bi == lane + 64) c1 = -INFINITY;
                }
            }
            asm volatile("s_waitcnt lgkmcnt(0)" ::: "memory");
            float cd[4];
#pragma unroll
            for (int m2 = 0; m2 < 4; ++m2) { const int c = lane + 64 * m2; cd[m2] = vs[c >> 4] + vs[16 + (c & 15)]; }
            float val[16]; int ci[16];
#pragma unroll
            for (int r = 0; r < 16; ++r) {
                float bv = cd[0]; int bi = lane;
#pragma unroll
                for (int m2 = 1; m2 < 4; ++m2) if (cd[m2] > bv) { bv = cd[m2]; bi = lane + 64 * m2; }
#pragma unroll
                for (int o = 1; o < 64; o <<= 1) { const float ov = __shfl_xor(bv, o); const int oi = __shfl_xor(bi, o); if (ov > bv || (ov == bv && oi < bi)) { bv = ov; bi = oi; } }
                val[r] = bv; ci[r] = bi;
#pragma unroll
                for (int m2 = 0; m2 < 4; ++m2) if (bi == lane + 64 * m2) cd[m2] = -INFINITY;
            }
            float se = 0.f, e[16];
#pragma unroll
            for (int r = 0; r < 16; ++r) { e[r] = __expf(val[r] - val[0]); se += e[r]; }
            if (lane < 16) {
                float ev = 0.f; int cc = 0;
#pragma unroll
                for (int r = 0; r < 16; ++r) if (lane == r) { ev = e[r]; cc = ci[r]; }
                const int i1 = ((LAS int*)vs)[32 + (cc >> 4)], i2 = ((LAS int*)vs)[48 + (cc & 15)];
                IDX[((size_t)t * 8 + h) * 16 + lane] = (unsigned short)(i1 * 128 + i2);
                Gt[((size_t)t * 8 + h) * 16 + lane] = ev / se;
            }
            asm volatile("s_waitcnt lgkmcnt(0)" ::: "memory");
        }
    }
#else
    for (int rep_ = 0; rep_ < (IN(10) ? 1 + ((REP_MASK >> 10) & 1) : 0); ++rep_) {
        PH_LOCALS;
        for (int i = tid; i < 2 * 128 * 16; i += NWAVES * 64) { const int t2 = i >> 11, rem = i & 2047, key = rem >> 4, ch = rem & 15;
            const bf16x8 v = *(const bf16x8*)((t2 ? K2b : K1b) + key * 128 + ch * 8);
            *(LAS bf16x8*)(lds + t2 * 32768 + KSWZ(key, ch * 16)) = v; }
        __syncthreads();
        const int r32 = lane & 31, hi = lane >> 5;
        LAS unsigned char* tb8 = lds + 65536 + wave * 2048 + lane * 32;
        bf16x8 qfa[8], qfb[8];
#define P10_LOADQ(BUF, tgi, half_) do { const bf16_t* qp_ = Qp + (size_t)((tgi) * 32 + r32) * DM + wave * 256 + (half_) * 128 + hi * 8; \
            _Pragma("unroll") for (int d0 = 0; d0 < 8; ++d0) BUF[d0] = __builtin_nontemporal_load((const bf16x8*)(qp_ + d0 * 16)); } while (0)
        if (bid < T / 32) P10_LOADQ(qfa, bid, 0);
        for (int tg = bid; tg < T / 32; tg += G) {
            const int tok = tg * 32 + r32;
            int v12[2][16];
#pragma unroll
            for (int half = 0; half < 2; ++half) {
                bf16x8 qf[8];
#pragma unroll
                for (int d0 = 0; d0 < 8; ++d0) qf[d0] = half == 0 ? qfa[d0] : qfb[d0];
                if (half == 0) P10_LOADQ(qfb, tg, 1); else if (tg + G < T / 32) P10_LOADQ(qfa, tg + G, 0);
                int best[16];
#pragma unroll
                for (int kb = 0; kb < 4; ++kb) {
                    f32x16 acc = f32x16{};
#pragma unroll
                    for (int d0 = 0; d0 < 8; ++d0) { const bf16x8 a = *(const LAS bf16x8*)(lds + half * 32768 + KSWZ(32 * kb + r32, (d0 * 16 + hi * 8) * 2));
                        acc = __builtin_amdgcn_mfma_f32_32x32x16_bf16(a, qf[d0], acc, 0, 0, 0); }
                    int cur[16];
#pragma unroll
                    for (int r = 0; r < 16; ++r) cur[r] = (pk::f2key(acc[r]) & ~127) | (32 * kb + (r & 3) + 8 * (r >> 2) + 4 * hi);
                    pk::sort16(cur);
                    if (kb == 0) {
#pragma unroll
                        for (int r = 0; r < 16; ++r) best[r] = cur[r];
                    } else pk::merge_top16(best, cur);
                }
                int oth[16], mine[16];
#pragma unroll
                for (int r = 0; r < 16; ++r) { auto sw = __builtin_amdgcn_permlane32_swap((unsigned)best[r], (unsigned)best[r], false, false); mine[r] = (int)sw[0]; oth[r] = (int)sw[1]; }
                pk::merge_top16(mine, oth);
#pragma unroll
                for (int r = 0; r < 16; ++r) v12[half][r] = mine[r];
            }
            {
                u32x4 w0, w1;
#pragma unroll
                for (int q = 0; q < 4; ++q) {
                    w0[q] = (unsigned)(v12[0][4 * q] & 127) | ((unsigned)(v12[0][4 * q + 1] & 127) << 8) | ((unsigned)(v12[0][4 * q + 2] & 127) << 16) | ((unsigned)(v12[0][4 * q + 3] & 127) << 24);
                    w1[q] = (unsigned)(v12[1][4 * q] & 127) | ((unsigned)(v12[1][4 * q + 1] & 127) << 8) | ((unsigned)(v12[1][4 * q + 2] & 127) << 16) | ((unsigned)(v12[1][4 * q + 3] & 127) << 24);
                }
                *(LAS u32x4*)(tb8) = w0; *(LAS u32x4*)(tb8 + 16) = w1;
            }
            float f1[16], f2[16];
#pragma unroll
            for (int r = 0; r < 16; ++r) { f1[r] = pk::key2f(v12[0][r]); f2[r] = pk::key2f(v12[1][r]); }
#define CAND(i, j) ((pk::f2key(f1[i] + f2[j]) & ~255) | ((i) * 16 + (j)))
            int M[16], Gb[16];
#pragma unroll
            for (int j = 0; j < 16; ++j) M[j] = CAND(0, j);
#pragma unroll
            for (int j = 0; j < 8; ++j) { Gb[j] = CAND(1, j); Gb[8 + j] = CAND(15 - j, 0); }
            pk::bmerge16(Gb); pk::merge_top16(M, Gb);
            Gb[0] = CAND(2, 0); Gb[1] = CAND(2, 1); Gb[2] = CAND(2, 2); Gb[3] = CAND(2, 3); Gb[4] = CAND(2, 4);
            Gb[5] = CAND(3, 0); Gb[6] = CAND(3, 1); Gb[7] = CAND(3, 2); Gb[8] = CAND(3, 3);
            Gb[9] = CAND(4, 0); Gb[10] = CAND(4, 1); Gb[11] = CAND(4, 2);
            Gb[12] = CAND(5, 0); Gb[13] = CAND(5, 1); Gb[14] = CAND(6, 0); Gb[15] = CAND(6, 1);
            pk::sort16(Gb); pk::merge_top16(M, Gb);
            Gb[0] = CAND(7, 0); Gb[1] = CAND(7, 1);
#pragma unroll
            for (int j = 2; j < 16; ++j) Gb[j] = (int)0x80000000;
            pk::merge_top16(M, Gb);
#undef CAND
            asm volatile("s_waitcnt lgkmcnt(0)" ::: "memory");
            float val[16], e[16]; float se = 0.f; unsigned short ex[16];
#pragma unroll
            for (int k = 0; k < 16; ++k) { val[k] = pk::key2f(M[k] & ~255); }
#pragma unroll
            for (int k = 0; k < 16; ++k) { e[k] = __expf(val[k] - val[0]); se += e[k];
                const int code = M[k] & 255; const unsigned i1 = *(const LAS unsigned char*)(tb8 + (code >> 4)), i2 = *(const LAS unsigned char*)(tb8 + 16 + (code & 15));
                ex[k] = (unsigned short)(i1 * 128 + i2); }
            const float inv = 1.0f / se;
#if defined(NAIVE_PEER)
            if (hi == 0) {
                u32x4 w0, w1;
#pragma unroll
                for (int q = 0; q < 4; ++q) { w0[q] = (unsigned)ex[2 * q] | ((unsigned)ex[2 * q + 1] << 16); w1[q] = (unsigned)ex[8 + 2 * q] | ((unsigned)ex[8 + 2 * q + 1] << 16); }
                u32x4* ip = (u32x4*)(IDX + ((size_t)tok * 8 + wave) * 16); ip[0] = w0; ip[1] = w1;
            } else {
                f32x4* gp = (f32x4*)(Gt + ((size_t)tok * 8 + wave) * 16);
#pragma unroll
                for (int q = 0; q < 4; ++q) gp[q] = (f32x4){e[4 * q] * inv, e[4 * q + 1] * inv, e[4 * q + 2] * inv, e[4 * q + 3] * inv};
            }
#else
            if (hi == 0) {
#pragma unroll
                for (int sl = 0; sl < 8; ++sl) *(unsigned*)(IDX2 + (size_t)tok * 128 + sl * 16 + wave * 2) = (unsigned)ex[sl] | ((unsigned)ex[sl + 8] << 16);
            } else {
#pragma unroll
                for (int sl = 0; sl < 8; ++sl) *(f32x2*)(Gt + (size_t)tok * 128 + sl * 16 + wave * 2) = (f32x2){e[sl] * inv, e[sl + 8] * inv};
            }
#endif
            asm volatile("s_waitcnt lgkmcnt(0)" ::: "memory");
        }
    }
#endif
    GRID_BAR(10);

#if defined(NAIVE_PEER)
    for (int rep_ = 0; rep_ < (IN(11) ? 1 + ((REP_MASK >> 11) & 1) : 0); ++rep_) {
        PH_LOCALS;
        const float* lg = AR.in[20]; const float* lb = AR.in[21];
        for (int t = gw; t < T; t += NGW) {
            const int b = t >> 11;
            u32x4 hv[4];
#pragma unroll
            for (int c = 0; c < 4; ++c) hv[c] = *(const u32x4*)(H2 + (size_t)t * DM + c * 512 + lane * 8);
            const unsigned idx2 = ((const unsigned*)IDX)[(size_t)t * 64 + lane];
            const f32x2 g2 = ((const f32x2*)Gt)[(size_t)t * 64 + lane];
            float a0 = 0.f, a1 = 0.f;
            for (int k = 0; k < 128; k += 4) {
                u32x4 uv[4][4];
#pragma unroll
                for (int j = 0; j < 4; ++j) { const unsigned pr = (unsigned)__builtin_amdgcn_readlane((int)idx2, (k + j) >> 1); const unsigned e = ((k + j) & 1) ? (pr >> 16) : (pr & 0xffffu);
                    const bf16_t* up = UT + (size_t)e * 2048 + lane * 8;
#pragma unroll
                    for (int c = 0; c < 4; ++c) uv[j][c] = *(const u32x4*)(up + c * 512); }
#pragma unroll
                for (int j = 0; j < 4; ++j) { float d = 0.f;
#pragma unroll
                    for (int c = 0; c < 4; ++c)
#pragma unroll
                        for (int q = 0; q < 4; ++q) { const unsigned ua = uv[j][c][q], ha = hv[c][q]; d = dot2bf(ua, ha, d); }
                    d = wave_sum(d);
                    if (lane == ((k + j) >> 1)) { if ((k + j) & 1) a1 = d; else a0 = d; } }
            }
            const float w0 = gelu_erf(a0) * g2[0], w1 = gelu_erf(a1) * g2[1];
            float acc[32];
#pragma unroll
            for (int i = 0; i < 32; ++i) acc[i] = 0.f;
            for (int k = 0; k < 128; k += 4) {
                u32x4 vv[4][4]; float wk[4];
#pragma unroll
                for (int j = 0; j < 4; ++j) { const unsigned pr = (unsigned)__builtin_amdgcn_readlane((int)idx2, (k + j) >> 1); const unsigned e = ((k + j) & 1) ? (pr >> 16) : (pr & 0xffffu);
                    wk[j] = __int_as_float(__builtin_amdgcn_readlane(__float_as_int(((k + j) & 1) ? w1 : w0), (k + j) >> 1));
                    const bf16_t* vp = VT + (size_t)e * 2048 + lane * 8;
#pragma unroll
                    for (int c = 0; c < 4; ++c) vv[j][c] = *(const u32x4*)(vp + c * 512); }
#pragma unroll
                for (int j = 0; j < 4; ++j)
#pragma unroll
                    for (int c = 0; c < 4; ++c)
#pragma unroll
                        for (int q = 0; q < 4; ++q) { acc[c * 8 + 2 * q] += wk[j] * bf_lo(vv[j][c][q]); acc[c * 8 + 2 * q + 1] += wk[j] * bf_hi(vv[j][c][q]); }
            }
            const float* mb = mod + (size_t)b * 12288 + 10240;
            float s = 0.f;
#pragma unroll
            for (int c = 0; c < 4; ++c) { const int d = c * 512 + lane * 8;
                const f32x4 x0 = *(const f32x4*)(AR.out + (size_t)t * DM + d), x1 = *(const f32x4*)(AR.out + (size_t)t * DM + d + 4);
                const f32x4 m0 = *(const f32x4*)(mb + d), m1 = *(const f32x4*)(mb + d + 4);
#pragma unroll
                for (int q = 0; q < 4; ++q) { acc[c * 8 + q] = x0[q] * DN_ALPHA + m0[q] * acc[c * 8 + q] * DBG_FFN; acc[c * 8 + 4 + q] = x1[q] * DN_ALPHA + m1[q] * acc[c * 8 + 4 + q] * DBG_FFN; }
#pragma unroll
                for (int q = 0; q < 8; ++q) s += acc[c * 8 + q]; }
            const float mean = wave_sum(s) * (1.0f / DM); float s2 = 0.f;
#pragma unroll
            for (int i = 0; i < 32; ++i) { acc[i] -= mean; s2 += acc[i] * acc[i]; }
            const float rstd = 1.0f / sqrtf(wave_sum(s2) * (1.0f / DM) + 1e-5f);
#pragma unroll
            for (int c = 0; c < 4; ++c) { const int d = c * 512 + lane * 8;
                const f32x4 g0 = *(const f32x4*)(lg + d), g1 = *(const f32x4*)(lg + d + 4), b0 = *(const f32x4*)(lb + d), b1 = *(const f32x4*)(lb + d + 4);
                f32x4 o0, o1;
#pragma unroll
                for (int q = 0; q < 4; ++q) { o0[q] = acc[c * 8 + q] * rstd * g0[q] + b0[q]; o1[q] = acc[c * 8 + 4 + q] * rstd * g1[q] + b1[q]; }
                *(f32x4*)(AR.out + (size_t)t * DM + d) = o0; *(f32x4*)(AR.out + (size_t)t * DM + d + 4) = o1; }
        }
    }
#else
    for (int rep_ = 0; rep_ < (IN(11) ? 1 + ((REP_MASK >> 11) & 1) : 0); ++rep_) {
        PH_LOCALS;
        typedef int v4i32 __attribute__((ext_vector_type(4)));
        const int xs = bid & 7, rank = bid >> 3, nrank = G >> 3;
        const int tstep = nrank * NWAVES, t0 = rank * NWAVES + wave;
        const int ntok = rank < nrank ? (T - t0 + tstep - 1) / tstep : 0;
        const int slice = xs;
        const unsigned char* Us = U8 + (size_t)slice * (2u << 20);
        LAS unsigned char* ring = lds + wave * 17408;
        const int r8d = lane >> 3, dcd = lane & 7;
        const unsigned dsw = (unsigned)((dcd ^ r8d) << 4);
        const int im = lane & 15, g = lane >> 4;
        int ura[2][2];
#pragma unroll
        for (int hi = 0; hi < 2; ++hi)
#pragma unroll
            for (int sx = 0; sx < 2; ++sx) { const int rgm = 4 * hi + (im >> 2), c = 4 * sx + g;
                ura[hi][sx] = (int)(uintptr_t)ring + (im & 3) * 1088 + rgm * 128 + ((c ^ rgm) << 4); }
#define U_GLD4(dst, sb, vo, imm) asm volatile("global_load_dwordx4 %0, %1, %2 offset:" #imm : "=v"(dst) : "v"(vo), "s"(sb) : "memory")
#define U_MISC(IA, IB, H, tt) do { const unsigned char* si_ = (const unsigned char*)IDX2 + (size_t)(tt) * 256; const unsigned char* sh_ = (const unsigned char*)H2S + (size_t)(tt) * 2048 + slice * 256; \
            U_GLD4(IA, si_, voI, 0); U_GLD4(IB, si_, voI, 16); U_GLD4(H[0], sh_, voH, 0); U_GLD4(H[1], sh_, voH, 16); U_GLD4(H[2], sh_, voH, 128); U_GLD4(H[3], sh_, voH, 144); } while (0)
#define U_MOV8(D, o, S0, S1, WAITSTR) asm volatile(WAITSTR "\n\tv_mov_b32 %0, %8\n\tv_mov_b32 %1, %9\n\tv_mov_b32 %2, %10\n\tv_mov_b32 %3, %11\n\tv_mov_b32 %4, %12\n\tv_mov_b32 %5, %13\n\tv_mov_b32 %6, %14\n\tv_mov_b32 %7, %15" \
                : "=&v"(D[o]), "=&v"(D[o + 1]), "=&v"(D[o + 2]), "=&v"(D[o + 3]), "=&v"(D[o + 4]), "=&v"(D[o + 5]), "=&v"(D[o + 6]), "=&v"(D[o + 7]) \
                : "v"(S0.x), "v"(S0.y), "v"(S0.z), "v"(S0.w), "v"(S1.x), "v"(S1.y), "v"(S1.z), "v"(S1.w) : "memory")
#define U_ROT(DI, DH, IA, IB, H, WAITSTR) do { U_MOV8(DI, 0, IA, IB, WAITSTR); U_MOV8(DH, 0, H[0], H[1], "s_nop 0"); U_MOV8(DH, 8, H[2], H[3], "s_nop 0"); } while (0)
        const unsigned voI = (unsigned)(r8d * 32), voH = (unsigned)(g * 32);
#define U_DMAQ(IX, b) do { _Pragma("unroll") for (int pc_ = 0; pc_ < 4; ++pc_) { const int m_ = 4 * (b) + pc_; const unsigned w_ = IX[m_ >> 1]; \
            const unsigned e_ = (m_ & 1) ? (w_ >> 16) : (w_ & 0xffffu); \
            __builtin_amdgcn_global_load_lds((const unsigned*)(Us + (e_ * 128u + dsw)), (LAS unsigned*)(ring + (b) * 4352 + pc_ * 1088), 16, 0, 0); } } while (0)
#define U_RD(dst, addr, off) asm volatile("ds_read_b128 %0, %1 offset:%2" : "=&v"(dst) : "v"(addr), "i"(off) : "memory")
#define U_MM(ACC, R, HH, o) do { const v4i32 lo_ = {(int)(R.x & 0x0F0F0F0Fu), (int)(R.y & 0x0F0F0F0Fu), (int)(R.z & 0x0F0F0F0Fu), (int)(R.w & 0x0F0F0F0Fu)}; \
            const v4i32 hi_ = {(int)((R.x >> 4) & 0x0F0F0F0Fu), (int)((R.y >> 4) & 0x0F0F0F0Fu), (int)((R.z >> 4) & 0x0F0F0F0Fu), (int)((R.w >> 4) & 0x0F0F0F0Fu)}; \
            const v4i32 be_ = {(int)HH[o], (int)HH[o + 2], (int)HH[o + 4], (int)HH[o + 6]}, bo_ = {(int)HH[o + 1], (int)HH[o + 3], (int)HH[o + 5], (int)HH[o + 7]}; \
            ACC = __builtin_amdgcn_mfma_i32_16x16x64_i8(lo_, be_, ACC, 0, 0, 0); ACC = __builtin_amdgcn_mfma_i32_16x16x64_i8(hi_, bo_, ACC, 0, 0, 0); } while (0)
#define U_QUARTER(b, HH) do { u32x4 r00_, r01_, r10_, r11_; \
            U_RD(r00_, ura[0][0], (b) * 4352); U_RD(r01_, ura[0][1], (b) * 4352); U_RD(r10_, ura[1][0], (b) * 4352); U_RD(r11_, ura[1][1], (b) * 4352); \
            asm volatile("s_waitcnt lgkmcnt(0)" ::: "memory"); __builtin_amdgcn_sched_barrier(0); \
            U_MM(acc[b][0], r00_, HH, 0); U_MM(acc[b][0], r01_, HH, 8); U_MM(acc[b][1], r10_, HH, 0); U_MM(acc[b][1], r11_, HH, 8); } while (0)
        if (ntok > 0) {
            u32x4 mia, mib, pia, pib, mh[4], ph[4];
            unsigned ci[8], ch[16], ni[8], nh[16];
            const int tlast = t0 + (ntok - 1) * tstep;
            U_MISC(mia, mib, mh, t0);
            { const int t1 = ntok > 1 ? t0 + tstep : t0; U_MISC(pia, pib, ph, t1); }
            U_ROT(ci, ch, mia, mib, mh, "s_waitcnt vmcnt(0)");
            U_ROT(ni, nh, pia, pib, ph, "s_nop 0");
            __builtin_amdgcn_sched_barrier(0);
            U_DMAQ(ci, 0); U_DMAQ(ci, 1); U_DMAQ(ci, 2); U_DMAQ(ci, 3);
            __builtin_amdgcn_sched_barrier(0);
            for (int i = 0; i < ntok; ++i) {
                const int t = t0 + i * tstep; const bool more = i + 1 < ntok;
                { const int tm = min(t + 2 * tstep, tlast); U_MISC(mia, mib, mh, tm); }
                __builtin_amdgcn_sched_barrier(0);
                v4i32 acc[4][2], accS = {0, 0, 0, 0};
#pragma unroll
                for (int b_ = 0; b_ < 4; ++b_) { acc[b_][0] = (v4i32){0, 0, 0, 0}; acc[b_][1] = (v4i32){0, 0, 0, 0}; }
#define U_WAITQ() do { if (!more) { asm volatile("s_waitcnt vmcnt(0)" ::: "memory"); } else if (i == 0) { asm volatile("s_waitcnt vmcnt(18)" ::: "memory"); } \
                       else { asm volatile("s_waitcnt vmcnt(20)" ::: "memory"); } __builtin_amdgcn_sched_barrier(0); } while (0)
                U_WAITQ(); U_QUARTER(0, ch); __builtin_amdgcn_sched_barrier(0); if (more) U_DMAQ(ni, 0); __builtin_amdgcn_sched_barrier(0);
                U_WAITQ(); U_QUARTER(1, ch); __builtin_amdgcn_sched_barrier(0); if (more) U_DMAQ(ni, 1); __builtin_amdgcn_sched_barrier(0);
                U_WAITQ(); U_QUARTER(2, ch); __builtin_amdgcn_sched_barrier(0); if (more) U_DMAQ(ni, 2); __builtin_amdgcn_sched_barrier(0);
                U_WAITQ(); U_QUARTER(3, ch); __builtin_amdgcn_sched_barrier(0); if (more) U_DMAQ(ni, 3); __builtin_amdgcn_sched_barrier(0);
#undef U_WAITQ
                { const v4i32 ones_ = {0x01010101, 0x01010101, 0x01010101, 0x01010101};
#pragma unroll
                  for (int o_ = 0; o_ < 16; o_ += 4) { const v4i32 hb_ = {(int)ch[o_], (int)ch[o_ + 1], (int)ch[o_ + 2], (int)ch[o_ + 3]};
                      accS = __builtin_amdgcn_mfma_i32_16x16x64_i8(ones_, hb_, accS, 0, 0, 0); } }
                { const int hoff = -8 * accS[0]; const bool hsel = (lane & 1) != 0; unsigned pw[8];
#pragma unroll
                  for (int b_ = 0; b_ < 4; ++b_) {
                      const int v0 = (hsel ? acc[b_][1][0] : acc[b_][0][0]) + hoff, v1 = (hsel ? acc[b_][1][1] : acc[b_][0][1]) + hoff;
                      const int v2 = (hsel ? acc[b_][1][2] : acc[b_][0][2]) + hoff, v3 = (hsel ? acc[b_][1][3] : acc[b_][0][3]) + hoff;
                      pw[2 * b_] = cvtpk((float)v0, (float)v1); pw[2 * b_ + 1] = cvtpk((float)v2, (float)v3); }
                  if (im < 2) { u32x4* dst_ = (u32x4*)((unsigned*)PART + ((size_t)slice * T + t) * 64 + (4 * (lane & 1) + g) * 8);
                      dst_[0] = (u32x4){pw[0], pw[1], pw[2], pw[3]}; dst_[1] = (u32x4){pw[4], pw[5], pw[6], pw[7]}; } }
                __builtin_amdgcn_sched_barrier(0);
#pragma unroll
                for (int k_ = 0; k_ < 8; ++k_) ci[k_] = ni[k_];
#pragma unroll
                for (int k_ = 0; k_ < 16; ++k_) ch[k_] = nh[k_];
                if (more) U_ROT(ni, nh, mia, mib, mh, "s_waitcnt vmcnt(18)"); else U_ROT(ni, nh, mia, mib, mh, "s_waitcnt vmcnt(0)");
                __builtin_amdgcn_sched_barrier(0);
            }
            asm volatile("s_waitcnt vmcnt(0)" ::: "memory");
        }
#undef U_GLD4
#undef U_MISC
#undef U_MOV8
#undef U_ROT
#undef U_DMAQ
#undef U_RD
#undef U_MM
#undef U_QUARTER
    }
    GRID_BAR(11);

    for (int rep_ = 0; rep_ < (IN(12) ? 1 + ((REP_MASK >> 12) & 1) : 0); ++rep_) {
        PH_LOCALS;
        unsigned nidx, npv[8]; f32x2 ng; float nhs, nsu0, nsu1, nsv0, nsv1;
#define P12_LOAD(tt) do { nidx = ((const unsigned*)IDX2)[(size_t)(tt) * 64 + lane]; ng = ((const f32x2*)Gt)[(size_t)(tt) * 64 + lane]; nhs = SH[(tt)]; \
            _Pragma("unroll") for (int sl = 0; sl < 8; ++sl) npv[sl] = __builtin_nontemporal_load((const unsigned*)PART + ((size_t)sl * T + (tt)) * 64 + lane); } while (0)
#define P12_SCALES() do { const unsigned e0_ = nidx & 0xffffu, e1_ = nidx >> 16; nsu0 = SU[e0_]; nsu1 = SU[e1_]; nsv0 = SU[NE + e0_]; nsv1 = SU[NE + e1_]; } while (0)
        if (gw < T) { P12_LOAD(gw); P12_SCALES(); }
        for (int t = gw; t < T; t += NGW) {
            const f32x2 g2 = ng; const float hs = nhs, su0 = nsu0, su1 = nsu1, sv0 = nsv0, sv1 = nsv1;
            f32x2 a = {0.f, 0.f};
#pragma unroll
            for (int sl = 0; sl < 8; ++sl) { const unsigned pv = npv[sl]; a[0] += bf_lo(pv); a[1] += bf_hi(pv); }
            if (t + NGW < T) P12_LOAD(t + NGW);
            const float w0 = gelu_erf(a[0] * hs * su0) * g2[0] * sv0, w1 = gelu_erf(a[1] * hs * su1) * g2[1] * sv1;
            const float wm = wmax(fmaxf(fabsf(w0), fabsf(w1)));
            const float qs = wm > 0.f ? 127.0f / wm : 1.0f;
            const int q0 = (int)__builtin_rintf(w0 * qs), q1 = (int)__builtin_rintf(w1 * qs);
            { const float wsc_ = wm > 0.f ? wm * (1.0f / 127.0f) : 1.0f, qsum = wsum((float)(q0 + q1));
              if (lane == 0) *(f32x2*)(WSC + 2 * (size_t)t) = (f32x2){wsc_, -8.0f * wsc_ * qsum}; }
            { const int j0 = 2 * lane, j1 = j0 + 1;
              WTq[(size_t)t * 128 + (j0 & 15) * 8 + (j0 >> 4)] = (unsigned char)((unsigned)q0 & 255u);
              WTq[(size_t)t * 128 + (j1 & 15) * 8 + (j1 >> 4)] = (unsigned char)((unsigned)q1 & 255u); }
            if (t + NGW < T) P12_SCALES();
        }
#undef P12_LOAD
#undef P12_SCALES
    }
    GRID_BAR(12);

    for (int rep_ = 0; rep_ < (IN(13) ? 1 + ((REP_MASK >> 13) & 1) : 0); ++rep_) {
        PH_LOCALS;
        typedef int v4i32 __attribute__((ext_vector_type(4)));
        const int xs = bid & 7, rank = bid >> 3, nrank = G >> 3;
        const int tstep = nrank * NWAVES, t0 = rank * NWAVES + wave;
        const int ntok = rank < nrank ? (T - t0 + tstep - 1) / tstep : 0;
        LAS unsigned char* ring = lds + wave * 17408;
        const int r8d = lane >> 3, dcd = lane & 7;
        const unsigned dsw = (unsigned)((dcd ^ r8d) << 4);
        const int g = lane >> 4, q4 = (lane >> 2) & 3, p4 = lane & 3;
        int tra[2][4];
#pragma unroll
        for (int hh = 0; hh < 2; ++hh)
#pragma unroll
            for (int nb = 0; nb < 4; ++nb) { const int r8 = 4 * hh + q4, c = 2 * nb + (p4 >> 1);
                tra[hh][nb] = (int)(uintptr_t)ring + g * 1088 + r8 * 128 + ((c ^ r8) << 4) + (p4 & 1) * 8; }
#define V_GLD4(dst, sb, vo, imm) asm volatile("global_load_dwordx4 %0, %1, %2 offset:" #imm : "=v"(dst) : "v"(vo), "s"(sb) : "memory")
#define V_GLD2(dst, sb, vo, imm) asm volatile("global_load_dwordx2 %0, %1, %2 offset:" #imm : "=v"(dst) : "v"(vo), "s"(sb) : "memory")
#define V_GLD1(dst, sb, vo)      asm volatile("global_load_dword %0, %1, %2" : "=v"(dst) : "v"(vo), "s"(sb) : "memory")
#define V_MISC(IA, IB, W, SC, tt) do { const unsigned char* si_ = (const unsigned char*)IDX2 + (size_t)(tt) * 256; const unsigned char* sw_ = (const unsigned char*)WTq + (size_t)(tt) * 128; \
            const float* sc_ = WSC + 2 * (size_t)(tt); V_GLD4(IA, si_, voI, 0); V_GLD4(IB, si_, voI, 16); V_GLD2(W[0], sw_, voW, 0); V_GLD2(W[1], sw_, voW, 32); V_GLD2(W[2], sw_, voW, 64); V_GLD2(W[3], sw_, voW, 96); \
            V_GLD2(SC, sc_, voZ, 0); } while (0)
#define V_ROT(DI, DW, DSC, IA, IB, W, SC, WAITSTR) do { \
            asm volatile(WAITSTR "\n\tv_mov_b32 %0, %8\n\tv_mov_b32 %1, %9\n\tv_mov_b32 %2, %10\n\tv_mov_b32 %3, %11\n\tv_mov_b32 %4, %12\n\tv_mov_b32 %5, %13\n\tv_mov_b32 %6, %14\n\tv_mov_b32 %7, %15" \
                : "=&v"(DI[0]), "=&v"(DI[1]), "=&v"(DI[2]), "=&v"(DI[3]), "=&v"(DI[4]), "=&v"(DI[5]), "=&v"(DI[6]), "=&v"(DI[7]) \
                : "v"(IA.x), "v"(IA.y), "v"(IA.z), "v"(IA.w), "v"(IB.x), "v"(IB.y), "v"(IB.z), "v"(IB.w) : "memory"); \
            asm volatile("v_mov_b32 %0, %10\n\tv_mov_b32 %1, %11\n\tv_mov_b32 %2, %12\n\tv_mov_b32 %3, %13\n\tv_mov_b32 %4, %14\n\tv_mov_b32 %5, %15\n\tv_mov_b32 %6, %16\n\tv_mov_b32 %7, %17\n\tv_mov_b32 %8, %18\n\tv_mov_b32 %9, %19" \
                : "=&v"(DW[0]), "=&v"(DW[1]), "=&v"(DW[2]), "=&v"(DW[3]), "=&v"(DW[4]), "=&v"(DW[5]), "=&v"(DW[6]), "=&v"(DW[7]), "=&v"(DSC[0]), "=&v"(DSC[1]) \
                : "v"(W[0].x), "v"(W[0].y), "v"(W[1].x), "v"(W[1].y), "v"(W[2].x), "v"(W[2].y), "v"(W[3].x), "v"(W[3].y), "v"(SC.x), "v"(SC.y) : "memory"); } while (0)
        const unsigned voI = (unsigned)(r8d * 32), voW = (unsigned)(g * 8), voZ = 0u;
#define V_DMAQ(IX, b) do { _Pragma("unroll") for (int pc_ = 0; pc_ < 4; ++pc_) { const int m_ = 4 * (b) + pc_; const unsigned w_ = IX[m_ >> 1]; \
            const unsigned e_ = (m_ & 1) ? (w_ >> 16) : (w_ & 0xffffu); \
            __builtin_amdgcn_global_load_lds((const unsigned*)(Vs + (e_ * 128u + dsw)), (LAS unsigned*)(ring + (b) * 4352 + pc_ * 1088), 16, 0, 0); } } while (0)
#define V_TR(dst, addr, off) asm volatile("ds_read_b64_tr_b16 %0, %1 offset:%2" : "=&v"(dst) : "v"(addr), "i"(off) : "memory")
#define V_QUARTER(b, W) do { \
            const unsigned wlo_ = W[2 * (b)], whi_ = W[2 * (b) + 1]; \
            const v4i32 a_ = {(int)__builtin_amdgcn_perm(wlo_, wlo_, sel0), (int)__builtin_amdgcn_perm(wlo_, wlo_, sel1), (int)__builtin_amdgcn_perm(whi_, whi_, sel0), (int)__builtin_amdgcn_perm(whi_, whi_, sel1)}; \
            u32x2 x0_, x1_, x2_, x3_, y0_, y1_, y2_, y3_; \
            V_TR(x0_, tra[0][0], (b) * 4352); V_TR(y0_, tra[1][0], (b) * 4352); V_TR(x1_, tra[0][1], (b) * 4352); V_TR(y1_, tra[1][1], (b) * 4352); \
            V_TR(x2_, tra[0][2], (b) * 4352); V_TR(y2_, tra[1][2], (b) * 4352); V_TR(x3_, tra[0][3], (b) * 4352); V_TR(y3_, tra[1][3], (b) * 4352); \
            asm volatile("s_waitcnt lgkmcnt(0)" ::: "memory"); __builtin_amdgcn_sched_barrier(0); \
            V_MM(0, x0_, y0_); V_MM(1, x1_, y1_); V_MM(2, x2_, y2_); V_MM(3, x3_, y3_); } while (0)
#define V_MM(nb, X, Y) do { const v4i32 lo_ = {(int)(X.x & 0x0F0F0F0Fu), (int)(X.y & 0x0F0F0F0Fu), (int)(Y.x & 0x0F0F0F0Fu), (int)(Y.y & 0x0F0F0F0Fu)}; \
            const v4i32 hi_ = {(int)((X.x >> 4) & 0x0F0F0F0Fu), (int)((X.y >> 4) & 0x0F0F0F0Fu), (int)((Y.x >> 4) & 0x0F0F0F0Fu), (int)((Y.y >> 4) & 0x0F0F0F0Fu)}; \
            aL[nb] = __builtin_amdgcn_mfma_i32_16x16x64_i8(a_, lo_, aL[nb], 0, 0, 0); aH[nb] = __builtin_amdgcn_mfma_i32_16x16x64_i8(a_, hi_, aH[nb], 0, 0, 0); } while (0)
        const unsigned sel0 = (lane & 1) ? 0x010C000Cu : 0x0C010C00u, sel1 = (lane & 1) ? 0x030C020Cu : 0x0C030C02u;
        {
            const int slice = xs;
            const unsigned char* Vs = U8 + (32u << 20) + (size_t)slice * (2u << 20);
            if (ntok > 0) {
                u32x4 mia, mib, pia, pib; u32x2 mwq[4], pwq[4]; f32x2 mwsc, pwsc;
                unsigned ci[8], cw[8], ni[8], nw[8]; float wsc[2], nsc[2];
                const int tlast = t0 + (ntok - 1) * tstep;
                V_MISC(mia, mib, mwq, mwsc, t0);
                { const int t1 = ntok > 1 ? t0 + tstep : t0; V_MISC(pia, pib, pwq, pwsc, t1); }
                V_ROT(ci, cw, wsc, mia, mib, mwq, mwsc, "s_waitcnt vmcnt(0)");
                V_ROT(ni, nw, nsc, pia, pib, pwq, pwsc, "s_nop 0");
                __builtin_amdgcn_sched_barrier(0);
                V_DMAQ(ci, 0); V_DMAQ(ci, 1); V_DMAQ(ci, 2); V_DMAQ(ci, 3);
                __builtin_amdgcn_sched_barrier(0);
                for (int i = 0; i < ntok; ++i) {
                    const int t = t0 + i * tstep; const bool more = i + 1 < ntok;
                    { const int tm = min(t + 2 * tstep, tlast); V_MISC(mia, mib, mwq, mwsc, tm); }
                    __builtin_amdgcn_sched_barrier(0);
                    v4i32 aL[4], aH[4];
#pragma unroll
                    for (int nb = 0; nb < 4; ++nb) { aL[nb] = (v4i32){0, 0, 0, 0}; aH[nb] = (v4i32){0, 0, 0, 0}; }
#define V_WAITQ() do { if (!more) { asm volatile("s_waitcnt vmcnt(0)" ::: "memory"); } else if (i == 0) { asm volatile("s_waitcnt vmcnt(19)" ::: "memory"); } \
                       else { asm volatile("s_waitcnt vmcnt(20)" ::: "memory"); } __builtin_amdgcn_sched_barrier(0); } while (0)
                    V_WAITQ(); V_QUARTER(0, cw); __builtin_amdgcn_sched_barrier(0); if (more) V_DMAQ(ni, 0); __builtin_amdgcn_sched_barrier(0);
                    V_WAITQ(); V_QUARTER(1, cw); __builtin_amdgcn_sched_barrier(0); if (more) V_DMAQ(ni, 1); __builtin_amdgcn_sched_barrier(0);
                    V_WAITQ(); V_QUARTER(2, cw); __builtin_amdgcn_sched_barrier(0); if (more) V_DMAQ(ni, 2); __builtin_amdgcn_sched_barrier(0);
                    V_WAITQ(); V_QUARTER(3, cw); __builtin_amdgcn_sched_barrier(0); if (more) V_DMAQ(ni, 3); __builtin_amdgcn_sched_barrier(0);
#undef V_WAITQ
                    { const int nbs = lane >> 4;
#define V_SEL(A, r) (nbs == 0 ? A[0][r] : (nbs == 1 ? A[1][r] : (nbs == 2 ? A[2][r] : A[3][r])))
                      const float d0 = (float)V_SEL(aL, 0) * wsc[0] + wsc[1], d1 = (float)V_SEL(aH, 0) * wsc[0] + wsc[1];
                      const float d2 = (float)V_SEL(aL, 1) * wsc[0] + wsc[1], d3 = (float)V_SEL(aH, 1) * wsc[0] + wsc[1];
#undef V_SEL
                      *(u32x2*)(FFN + (size_t)t * DM + slice * 256 + 4 * lane) = (u32x2){cvtpk(d0, d1), cvtpk(d2, d3)}; }
                    __builtin_amdgcn_sched_barrier(0);
#pragma unroll
                    for (int k_ = 0; k_ < 8; ++k_) { ci[k_] = ni[k_]; cw[k_] = nw[k_]; }
                    wsc[0] = nsc[0]; wsc[1] = nsc[1];
                    if (more) V_ROT(ni, nw, nsc, mia, mib, mwq, mwsc, "s_waitcnt vmcnt(17)"); else V_ROT(ni, nw, nsc, mia, mib, mwq, mwsc, "s_waitcnt vmcnt(0)");
                    __builtin_amdgcn_sched_barrier(0);
                }
                asm volatile("s_waitcnt vmcnt(0)" ::: "memory");
            }
        }
#undef V_GLD4
#undef V_GLD2
#undef V_GLD1
#undef V_MISC
#undef V_ROT
#undef V_DMAQ
#undef V_TR
#undef V_QUARTER
#undef V_MM
    }
    GRID_BAR(13);

    for (int rep_ = 0; rep_ < (IN(14) ? 1 + ((REP_MASK >> 14) & 1) : 0); ++rep_) {
        PH_LOCALS;
        const int nb_ = G >> 4, b = bid / nb_, r0 = (bid % nb_) * NWAVES + wave, rstep = nb_ * NWAVES;
        LAS float* pg2 = (LAS float*)lds; LAS float* plg = pg2 + 2048; LAS float* plb = pg2 + 4096;
        __syncthreads();
        if (b < 16) { *(LAS f32x4*)(pg2 + 4 * tid) = *(const f32x4*)(mod + (size_t)b * 12288 + 10240 + 4 * tid);
            *(LAS f32x4*)(plg + 4 * tid) = *(const f32x4*)(AR.in[20] + 4 * tid); *(LAS f32x4*)(plb + 4 * tid) = *(const f32x4*)(AR.in[21] + 4 * tid); }
        __syncthreads();
        if (b < 16) {
        u32x4 nx[4]; u32x4 nf[4];
#define P14_LOAD(tt) do { _Pragma("unroll") for (int c = 0; c < 4; ++c) { const int d_ = c * 512 + lane * 8; nf[c] = __builtin_nontemporal_load((const u32x4*)(FFN + (size_t)(tt) * DM + d_)); \
            nx[c] = __builtin_nontemporal_load((const u32x4*)(X1b + (size_t)(tt) * DM + d_)); } } while (0)
        P14_LOAD(b * 2048 + r0);
        for (int r = r0; r < 2048; r += rstep) {
            const int t = b * 2048 + r;
            float acc[32]; float s = 0.f;
#pragma unroll
            for (int c = 0; c < 4; ++c) { const int d = c * 512 + lane * 8;
                const u32x4 fv = nf[c]; const u32x4 xv = nx[c]; const unsigned xa = xv.x, xb = xv.y, xc = xv.z, xd = xv.w;
                const f32x4 x0 = {bf_lo(xa), bf_hi(xa), bf_lo(xb), bf_hi(xb)}, x1 = {bf_lo(xc), bf_hi(xc), bf_lo(xd), bf_hi(xd)};
                const f32x4 m0 = *(const LAS f32x4*)(pg2 + d), m1 = *(const LAS f32x4*)(pg2 + d + 4);
                const unsigned f0 = fv.x, f1 = fv.y, f2 = fv.z, f3 = fv.w;
                acc[c * 8 + 0] = x0[0] * DN_ALPHA + m0[0] * bf_lo(f0); acc[c * 8 + 1] = x0[1] * DN_ALPHA + m0[1] * bf_hi(f0);
                acc[c * 8 + 2] = x0[2] * DN_ALPHA + m0[2] * bf_lo(f1); acc[c * 8 + 3] = x0[3] * DN_ALPHA + m0[3] * bf_hi(f1);
                acc[c * 8 + 4] = x1[0] * DN_ALPHA + m1[0] * bf_lo(f2); acc[c * 8 + 5] = x1[1] * DN_ALPHA + m1[1] * bf_hi(f2);
                acc[c * 8 + 6] = x1[2] * DN_ALPHA + m1[2] * bf_lo(f3); acc[c * 8 + 7] = x1[3] * DN_ALPHA + m1[3] * bf_hi(f3);
#pragma unroll
                for (int q = 0; q < 8; ++q) s += acc[c * 8 + q]; }
            if (r + rstep < 2048) P14_LOAD(t + rstep);
            const float mean = wsum(s) * (1.0f / DM); float s2 = 0.f;
#pragma unroll
            for (int i = 0; i < 32; ++i) { acc[i] -= mean; s2 += acc[i] * acc[i]; }
            const float rstd = 1.0f / sqrtf(wsum(s2) * (1.0f / DM) + 1e-5f);
#pragma unroll
            for (int c = 0; c < 4; ++c) { const int d = c * 512 + lane * 8;
                const f32x4 g0 = *(const LAS f32x4*)(plg + d), g1 = *(const LAS f32x4*)(plg + d + 4), b0 = *(const LAS f32x4*)(plb + d), b1 = *(const LAS f32x4*)(plb + d + 4);
                f32x4 o0, o1;
#pragma unroll
                for (int q = 0; q < 4; ++q) { o0[q] = acc[c * 8 + q] * rstd * g0[q] + b0[q]; o1[q] = acc[c * 8 + 4 + q] * rstd * g1[q] + b1[q]; }
                __builtin_nontemporal_store(o0, (f32x4*)(AR.out + (size_t)t * DM + d)); __builtin_nontemporal_store(o1, (f32x4*)(AR.out + (size_t)t * DM + d + 4)); }
        }
        }
    }
#endif
#undef IN
#undef GRID_BAR
}

extern "C" void kernel_launch(void* const* d_in, const int* in_sizes, int n_in, void* d_out, int out_size, void* d_ws, size_t ws_size, hipStream_t stream) {
    static int grid = 0;
    if (grid == 0) {
        if (n_in != 22 || out_size != T * DM || ws_size < WS_END) { fprintf(stderr, "kernel_launch: unexpected shapes (n_in %d out %d ws %zu)\n", n_in, out_size, ws_size); grid = -1; return; }
        int dev = 0, cus = 0, per_cu = 0;
        if (hipGetDevice(&dev) != hipSuccess || hipDeviceGetAttribute(&cus, hipDeviceAttributeMultiprocessorCount, dev) != hipSuccess) { grid = -1; return; }
        if (hipFuncSetAttribute((const void*)mega_fwd, hipFuncAttributeMaxDynamicSharedMemorySize, LDS_BYTES) != hipSuccess) { fprintf(stderr, "kernel_launch: hipFuncSetAttribute failed\n"); grid = -1; return; }
        if (hipOccupancyMaxActiveBlocksPerMultiprocessor(&per_cu, (const void*)mega_fwd, NWAVES * 64, LDS_BYTES) != hipSuccess || per_cu < 1) { fprintf(stderr, "kernel_launch: occupancy query says %d\n", per_cu); grid = -1; (void)hipGetLastError(); return; }
        grid = cus;
    }
    if (grid < 0) return;
    (void)hipMemsetAsync(d_ws, 0, 16384, stream);
    Args a{};
    for (int i = 0; i < 22; ++i) a.in[i] = (const float*)d_in[i];
    a.out = (float*)d_out; a.ws = (unsigned char*)d_ws;
#if MK_N_LAUNCHES == 1
    a.ph_lo = 0; a.ph_hi = N_PHASES;
    void* kargs[] = {&a};
    hipError_t e = hipLaunchCooperativeKernel((const void*)mega_fwd, dim3(grid), dim3(NWAVES * 64), kargs, LDS_BYTES, stream);
    if (e != hipSuccess) fprintf(stderr, "kernel_launch: cooperative launch failed: %s (grid %d)\n", hipGetErrorString(e), grid);
#else
    for (int p = 0; p < N_PHASES; ++p) {
        a.ph_lo = p; a.ph_hi = p + 1;
        hipLaunchKernelGGL(mega_fwd, dim3(grid), dim3(NWAVES * 64), LDS_BYTES, stream, a);
    }
    const hipError_t le = hipPeekAtLastError();
    if (le != hipSuccess) fprintf(stderr, "kernel_launch: launch failed: %s\n", hipGetErrorName(le));
#endif
}
```
